# Optimizing an MI355X kernel written in HIP

```python
import jax, jax.numpy as jnp
from jax import lax
import numpy as np

D_MODEL = 2048
BATCH = 1
SEQ = 8192
DEPTH = 2

PLE_DIM = 256
N_MIXERS = 2
RET_HEADS = 8
RET_QK_DIM = D_MODEL // RET_HEADS
RET_V_DIM = 2 * D_MODEL // RET_HEADS
RET_PROJ = 2 * RET_HEADS * RET_QK_DIM + 2 * RET_HEADS * RET_V_DIM
RET_CHUNK = 128
ROPE_BASE = 10000.0
POOL_WIDTH = 2 * D_MODEL
POOL_WINDOWS = (2, 4, 8, 16)
POOL_GROUPS = len(POOL_WINDOWS)
POOL_GROUP_DIM = POOL_WIDTH // POOL_GROUPS
N_RET_LAYERS = (DEPTH + 1) // 2
N_POOL_LAYERS = DEPTH // 2
NORM_EPS = 1e-6
GN_EPS = 1e-5

kernel_name = "retnet_pool_interleaved_hybrid"


def rms_norm(x, gain):
    x32 = x.astype(jnp.float32)
    y = x32 * lax.rsqrt(jnp.mean(x32 * x32, axis=-1, keepdims=True) + NORM_EPS)
    return (y * gain.astype(jnp.float32)).astype(x.dtype)


def rotate_pairs(x, cos, sin):
    xr = x.reshape(x.shape[:-1] + (x.shape[-1] // 2, 2))
    x0, x1 = xr[..., 0], xr[..., 1]
    out = jnp.stack([x0 * cos - x1 * sin, x1 * cos + x0 * sin], axis=-1)
    return out.reshape(x.shape)


def retention_branch(xn, w_in, w_out):
    b, s, _ = xn.shape
    h, dk, dv, c = RET_HEADS, RET_QK_DIM, RET_V_DIM, RET_CHUNK
    n = s // c
    f32 = jnp.float32
    q, k, v, g = jnp.split(xn @ w_in, [h * dk, 2 * h * dk, 2 * h * dk + h * dv], axis=-1)
    q = q.reshape(b, s, h, dk).astype(f32)
    k = k.reshape(b, s, h, dk).astype(f32)
    v = v.reshape(b, s, h, dv).astype(f32)
    pos = jnp.arange(s, dtype=f32)
    freq = ROPE_BASE ** (-jnp.linspace(0.0, 1.0, dk // 2, dtype=f32))
    ang = pos[:, None] * freq[None, :]
    cos = jnp.cos(ang)[None, :, None, :]
    sin = jnp.sin(ang)[None, :, None, :]
    q = rotate_pairs(q, cos, sin)
    k = rotate_pairs(k, cos, sin) * (dk ** -0.5)
    log_gamma = jnp.log1p(-(2.0 ** (-5.0 - jnp.arange(h, dtype=f32))))
    idx = jnp.arange(c, dtype=f32)
    diff = idx[:, None] - idx[None, :]
    inner_decay = jnp.where(diff[None] >= 0,
                            jnp.exp(jnp.maximum(diff, 0.0)[None] * log_gamma[:, None, None]),
                            0.0)
    q_decay = jnp.exp((idx + 1.0)[:, None] * log_gamma[None, :])
    k_decay = jnp.exp((c - 1.0 - idx)[:, None] * log_gamma[None, :])
    chunk_decay = jnp.exp(c * log_gamma)
    qc = q.reshape(b, n, c, h, dk)
    kc = k.reshape(b, n, c, h, dk)
    vc = v.reshape(b, n, c, h, dv)
    scores = jnp.einsum('bnihd,bnjhd->bnhij', qc, kc) * inner_decay
    y_inner = jnp.einsum('bnhij,bnjhv->bnihv', scores, vc)

    def step(state, inp):
        q_n, k_n, v_n = inp
        y = jnp.einsum('bihd,bhdv->bihv', q_n, state) * q_decay[None, :, :, None]
        state = state * chunk_decay[None, :, None, None] + jnp.einsum(
            'bjhd,bjhv->bhdv', k_n * k_decay[None, :, :, None], v_n)
        return state, y

    state0 = jnp.zeros((b, h, dk, dv), f32)
    _, y_cross = lax.scan(step, state0, (jnp.moveaxis(qc, 1, 0), jnp.moveaxis(kc, 1, 0),
                                         jnp.moveaxis(vc, 1, 0)))
    y = (y_inner + jnp.moveaxis(y_cross, 0, 1)).reshape(b, s, h, dv)
    mu = jnp.mean(y, axis=-1, keepdims=True)
    var = jnp.mean(jnp.square(y - mu), axis=-1, keepdims=True)
    y = ((y - mu) * lax.rsqrt(var + GN_EPS)).reshape(b, s, h * dv).astype(xn.dtype)
    return (jax.nn.silu(g) * y) @ w_out


def pool_branch(xn, w_in, w_group, scale, w_out):
    b, s, _ = xn.shape
    u, g = jnp.split(xn @ w_in, 2, axis=-1)
    u32 = u.astype(jnp.float32)
    csum = jnp.cumsum(u32, axis=1)
    t = jnp.arange(s)
    outs = []
    for gi, w in enumerate(POOL_WINDOWS):
        lo, hi = gi * POOL_GROUP_DIM, (gi + 1) * POOL_GROUP_DIM
        c_g = csum[..., lo:hi]
        c_lag = jnp.pad(c_g, ((0, 0), (w, 0), (0, 0)))[:, :s]
        cnt = jnp.minimum(t + 1, w).astype(jnp.float32)[None, :, None]
        outs.append((c_g - c_lag) / cnt - u32[..., lo:hi])
    d = jnp.stack(outs, axis=2).astype(xn.dtype)
    mixed = jnp.einsum('bsgc,gce->bsge', d, w_group).reshape(b, s, POOL_WIDTH) * scale
    return (mixed * jax.nn.silu(g)) @ w_out


def setup_inputs(seed: int = 0) -> dict:
    key = jax.random.key(seed)
    ks = jax.random.split(key, 16)
    nrm = jax.random.normal
    f32 = jnp.float32
    x = nrm(ks[0], (BATCH, SEQ, D_MODEL), f32)
    p = nrm(ks[1], (DEPTH, BATCH, SEQ, PLE_DIM), f32)
    ret_norm = 1.0 + 0.02 * nrm(ks[2], (N_RET_LAYERS, D_MODEL), f32)
    ret_w_in = nrm(ks[3], (N_RET_LAYERS, D_MODEL, RET_PROJ), f32) * D_MODEL ** -0.5
    ret_w_out = nrm(ks[4], (N_RET_LAYERS, RET_HEADS * RET_V_DIM, D_MODEL), f32) * (RET_HEADS * RET_V_DIM) ** -0.5
    pool_norm = 1.0 + 0.02 * nrm(ks[5], (N_POOL_LAYERS, D_MODEL), f32)
    pool_w_in = nrm(ks[6], (N_POOL_LAYERS, D_MODEL, 2 * POOL_WIDTH), f32) * D_MODEL ** -0.5
    pool_w_group = nrm(ks[7], (N_POOL_LAYERS, POOL_GROUPS, POOL_GROUP_DIM, POOL_GROUP_DIM), f32) * POOL_GROUP_DIM ** -0.5
    pool_scale = 1.0 + 0.1 * nrm(ks[8], (N_POOL_LAYERS, POOL_WIDTH), f32)
    pool_w_out = nrm(ks[9], (N_POOL_LAYERS, POOL_WIDTH, D_MODEL), f32) * POOL_WIDTH ** -0.5
    ple_norm = 1.0 + 0.02 * nrm(ks[10], (DEPTH, D_MODEL), f32)
    ple_w_gate = nrm(ks[11], (DEPTH, D_MODEL, D_MODEL), f32) * D_MODEL ** -0.5
    ple_w_proj = nrm(ks[12], (DEPTH, PLE_DIM, D_MODEL), f32) * PLE_DIM ** -0.5
    final_norm = 1.0 + 0.02 * nrm(ks[13], (D_MODEL,), f32)
    return {"x": x, "p": p, "ret_norm": ret_norm, "ret_w_in": ret_w_in, "ret_w_out": ret_w_out,
            "pool_norm": pool_norm, "pool_w_in": pool_w_in, "pool_w_group": pool_w_group,
            "pool_scale": pool_scale, "pool_w_out": pool_w_out, "ple_norm": ple_norm,
            "ple_w_gate": ple_w_gate, "ple_w_proj": ple_w_proj, "final_norm": final_norm}


def reference(x, p, ret_norm, ret_w_in, ret_w_out, pool_norm, pool_w_in, pool_w_group,
              pool_scale, pool_w_out, ple_norm, ple_w_gate, ple_w_proj, final_norm):
    h = x
    for i in range(DEPTH):
        j = i // N_MIXERS
        if i % N_MIXERS == 0:
            h = h + retention_branch(rms_norm(h, ret_norm[j]), ret_w_in[j], ret_w_out[j])
        else:
            h = h + pool_branch(rms_norm(h, pool_norm[j]), pool_w_in[j], pool_w_group[j],
                                pool_scale[j], pool_w_out[j])
        gate = jax.nn.sigmoid(rms_norm(h, ple_norm[i]) @ ple_w_gate[i])
        h = h + gate * (p[i] @ ple_w_proj[i])
    return rms_norm(h, final_norm)
```

```cpp
#include <hip/hip_runtime.h>
#include <cstdio>
#include <cstdint>
#include <cmath>

#ifndef MK_N_LAUNCHES
#define MK_N_LAUNCHES 1
#define CV_BIG 1
#endif

#define LAS __attribute__((address_space(3)))
#define GAS __attribute__((address_space(1)))
typedef unsigned short bf16_t;
typedef short bf16x8 __attribute__((ext_vector_type(8)));
typedef short s16x4 __attribute__((ext_vector_type(4)));
typedef float f32x4 __attribute__((ext_vector_type(4)));
typedef float f32x2 __attribute__((ext_vector_type(2)));
typedef unsigned u32x4 __attribute__((ext_vector_type(4)));
typedef unsigned u32x2 __attribute__((ext_vector_type(2)));

constexpr int SEQ = 8192, DM = 2048, RPROJ = 12288, NH = 8, DKH = 256, DVH = 512, PW = 4096, PLE = 256;
constexpr float NORM_EPS = 1e-6f, GN_EPS = 1e-5f;

constexpr size_t MiB = 1u << 20;
constexpr size_t WS_CTL = 0, CTL_ZERO_BYTES = 128 * 1024;
constexpr size_t WS_RP = 1 * MiB;
constexpr size_t WS_ROPE = 5 * MiB;
constexpr size_t WS_PBF = 13 * MiB;
constexpr size_t WS_WT_RO = 21 * MiB;
constexpr size_t WS_WT_G0 = 37 * MiB;
constexpr size_t WS_WT_P0 = 45 * MiB;
constexpr size_t WS_WT_RI = 46 * MiB;
constexpr size_t WS_XN0 = 94 * MiB;
constexpr size_t WS_QD = 126 * MiB, WS_KD = 158 * MiB, WS_V = 190 * MiB, WS_SG = 254 * MiB;
constexpr size_t WS_Z = WS_SG;
constexpr size_t WS_ST = 318 * MiB;
constexpr size_t WS_WU = 46 * MiB;
constexpr size_t WS_WT_PI = 62 * MiB;
constexpr size_t WS_WT_GR = 94 * MiB, WS_WT_PO = 102 * MiB, WS_WT_G1 = 118 * MiB, WS_WT_P1 = 382 * MiB;
constexpr size_t WS_H1 = 126 * MiB, WS_A1 = 190 * MiB, WS_PE0 = 222 * MiB;
constexpr size_t WS_H2 = 254 * MiB, WS_A2 = 318 * MiB;
constexpr size_t WS_U = 126 * MiB, WS_SG1 = 190 * MiB, WS_ZZ = 254 * MiB;
constexpr size_t WS_H3 = 126 * MiB, WS_A3 = 190 * MiB, WS_PE1 = 222 * MiB;
constexpr size_t WS_END = 383 * MiB;

constexpr int RING_BYTES = 131072;
constexpr int LDS_BYTES = 155648;
constexpr int MISC_OFF = LDS_BYTES - 256;

#define LDS_WAIT() asm volatile("s_waitcnt lgkmcnt(0)" ::: "memory")
#define VM_WAIT() asm volatile("s_waitcnt vmcnt(0)" ::: "memory")

__device__ __forceinline__ unsigned cvt_pk_bf16(float lo, float hi) { unsigned r; asm volatile("v_cvt_pk_bf16_f32 %0, %1, %2" : "=v"(r) : "v"(lo), "v"(hi)); return r; }
__device__ __forceinline__ float bf_lo(unsigned w) { return __uint_as_float(w << 16); }
__device__ __forceinline__ float bf_hi(unsigned w) { return __uint_as_float(w & 0xffff0000u); }
__device__ __forceinline__ float fsigmoid(float x) { return __builtin_amdgcn_rcpf(1.0f + __builtin_amdgcn_exp2f(-1.44269504089f * x)); }
__device__ __forceinline__ float fsilu(float x) { return x * fsigmoid(x); }
__device__ __forceinline__ int lane_id() { int l; asm volatile("v_mbcnt_lo_u32_b32 %0, -1, 0\n\tv_mbcnt_hi_u32_b32 %0, -1, %0" : "=v"(l)); return l; }
__device__ __forceinline__ float wave_sum(float v) {
#pragma unroll
    for (int o = 1; o < 64; o <<= 1) v += __shfl_xor(v, o);
    return v;
}

namespace pg8 {
constexpr int BM = 256, BK = 64, HALF = 128, HTB = HALF * BK * 2, STAGE_BYTES = 8 * HTB, NXCD = 8, WGM = 8;
__host__ __device__ __forceinline__ int lds_byte(int r, int c) { const int st = (r >> 4) * 2 + (c >> 5), rr = r & 15, cc = c & 31, ob = rr * 64 + cc * 2; return st * 1024 + (ob ^ (((ob >> 9) & 1) << 5)); }
__host__ __device__ __forceinline__ void stage_rc(int b, int& R, int& C) { const int st = b / 1024, sb = b % 1024, swz = sb ^ (((sb >> 9) & 1) << 5); R = (st >> 1) * 16 + swz / 64; C = (st & 1) * 32 + (swz % 64) / 2; }
__host__ __device__ __forceinline__ int perm32(int rho) { const int n = rho >> 4, i = rho & 15; return 8 * (i >> 2) + 4 * n + (i & 3); }

struct Unit { int pm, pn, slot; };
struct Gemm { const bf16_t* A; const bf16_t* Bt; int M, N, K, lda, ldb; };

struct StaticOrder {
    int nM, nN, nwg, G, c;
    __host__ __device__ void init(int M, int N, int G_, int c_) { nM = M / BM; nN = N / BM; nwg = nM * nN; G = G_; c = c_; }
    __host__ __device__ bool next(int i, Unit& u) const {
        const long L = (long)i * G + c; if (L >= nwg) return false;
        int wgid = (int)L; { const int q = nwg / NXCD, r = nwg % NXCD, xcd = wgid % NXCD, off = wgid / NXCD; wgid = (xcd < r ? xcd * (q + 1) : r * (q + 1) + (xcd - r) * q) + off; }
        const int nig = WGM * nN, gid = wgid / nig, fm = gid * WGM, gsz = (nM - fm) < WGM ? (nM - fm) : WGM;
        u.pm = fm + ((wgid % nig) % gsz); u.pn = (wgid % nig) / gsz; u.slot = i; return true;
    }
    __device__ __forceinline__ size_t a_off(const Unit&) const { return 0; }
    __device__ __forceinline__ size_t b_off(const Unit&) const { return 0; }
};
struct UpperHalfOrder : StaticOrder {
    __host__ __device__ bool next(int i, Unit& u) const { const int hw = G >> 1, per = nwg / hw; if (c < hw || i >= per) return false; const int L = (c - hw) * per + i; u.pm = L / nN; u.pn = L - u.pm * nN; u.slot = i; return true; }
};
struct CombOrder : StaticOrder {
    __device__ __forceinline__ size_t b_off(const Unit& u) const { return (size_t)(u.pm >> 2) * 2048; }
};

template <class Epi, class Sched, int EPI_REPS = 1>
__device__ __forceinline__ void gemm_phase(LAS unsigned char* lds, const Gemm g, const Sched& S, const Epi& E, const int wid) {
    int lane_ = lane_id(); asm volatile("" : "+v"(lane_));
    const int lane = lane_, tid = wid * 64 + lane, wr = wid >> 2, wc = wid & 3, fr = lane & 15, fq = lane >> 4;
    const int K = g.K, nt = K / BK;
    unsigned voffA[2], voffB[2];
#pragma unroll
    for (int i = 0; i < 2; ++i) { int R, C; stage_rc(tid * 16 + i * 8192, R, C); const int Rb = (R & ~31) + perm32(R & 31);
        voffA[i] = (unsigned)(R * g.lda + C) * 2u; voffB[i] = (unsigned)(Rb * g.ldb + C) * 2u; }
    const size_t kstep = (size_t)(BK * 2);
    const size_t hstepA = (size_t)HALF * g.lda * 2, hstepB = (size_t)HALF * g.ldb * 2;
    const size_t tstepA = 2 * hstepA, tstepB = 2 * hstepB;
    const unsigned ldsw = (unsigned)wid * 1024u;
    const int aoff = lds_byte(wr * 64 + fr, fq * 8), boff = lds_byte(wc * 32 + fr, fq * 8);
#define PG8_SA(b, h) (((b) * 2 + (h)) * HTB)
#define PG8_SB(b, h) ((4 + (b) * 2 + (h)) * HTB)
#define PG8_STAGE(bufoff, gbase, voff) do { _Pragma("unroll") for (int _i = 0; _i < 2; ++_i) \
        __builtin_amdgcn_global_load_lds((const unsigned*)((const char*)(gbase) + (voff)[_i]), (LAS unsigned*)(lds + (bufoff) + ldsw + _i * 8192), 16, 0, 0); } while (0)
#define PG8_LDA(dst, b, h) do { _Pragma("unroll") for (int m = 0; m < 4; ++m) _Pragma("unroll") for (int k = 0; k < 2; ++k) dst[m][k] = *(const LAS bf16x8*)(lds + PG8_SA(b, h) + aoff + m * 2048 + k * 1024); } while (0)
#define PG8_LDB(dst, b, h) do { _Pragma("unroll") for (int n = 0; n < 2; ++n) _Pragma("unroll") for (int k = 0; k < 2; ++k) dst[n][k] = *(const LAS bf16x8*)(lds + PG8_SB(b, h) + boff + n * 2048 + k * 1024); } while (0)
#define PG8_MMA(ai, bj, At, Bt) do { __builtin_amdgcn_s_setprio(1); _Pragma("unroll") for (int m = 0; m < 4; ++m) _Pragma("unroll") for (int n = 0; n < 2; ++n) _Pragma("unroll") for (int k = 0; k < 2; ++k) \
        acc[ai][bj][m][n] = __builtin_amdgcn_mfma_f32_16x16x32_bf16(Bt[n][k], At[m][k], acc[ai][bj][m][n], 0, 0, 0); __builtin_amdgcn_s_setprio(0); } while (0)
#define PG8_WAIT_V(n) asm volatile("s_waitcnt vmcnt(" #n ")" ::: "memory")
#define PG8_WAIT_L(n) asm volatile("s_waitcnt lgkmcnt(" #n ")" ::: "memory")
#define PG8_BAR __builtin_amdgcn_s_barrier()
#define PG8_SCHED __builtin_amdgcn_sched_barrier(0)
    Unit cur, nxt; int ui = 0;
    if (!S.next(0, cur)) return;
    f32x4 acc[2][2][4][2];
#pragma unroll
    for (int a = 0; a < 2; ++a)
#pragma unroll
        for (int b = 0; b < 2; ++b)
#pragma unroll
            for (int m = 0; m < 4; ++m)
#pragma unroll
                for (int n = 0; n < 2; ++n) acc[a][b][m][n] = (f32x4){0.f, 0.f, 0.f, 0.f};
    bf16x8 At[4][2], B0[2][2], B1[2][2];
    const char* cA = (const char*)g.A + (size_t)cur.pm * tstepA + S.a_off(cur); const char* cB = (const char*)g.Bt + (size_t)cur.pn * tstepB + S.b_off(cur);
    PG8_STAGE(PG8_SB(0, 0), cB, voffB); PG8_STAGE(PG8_SB(0, 1), cB + hstepB, voffB); PG8_STAGE(PG8_SA(0, 0), cA, voffA); PG8_STAGE(PG8_SA(0, 1), cA + hstepA, voffA);
    if (wr == 1) PG8_BAR;
    PG8_WAIT_V(2); PG8_BAR;
    PG8_STAGE(PG8_SB(1, 0), cB + kstep, voffB); PG8_STAGE(PG8_SA(1, 0), cA + kstep, voffA); PG8_STAGE(PG8_SB(1, 1), cB + hstepB + kstep, voffB);
    PG8_WAIT_V(6); PG8_BAR;
    for (;;) {
        const bool has_next = S.next(ui + 1, nxt);
        const char* nA = has_next ? (const char*)g.A + (size_t)nxt.pm * tstepA + S.a_off(nxt) : cA; const char* nB = has_next ? (const char*)g.Bt + (size_t)nxt.pn * tstepB + S.b_off(nxt) : cB;
        for (int t = 0; t < nt; t += 2) {
            const bool last = (t == nt - 2);
            const char* a1 = cA + (size_t)(t + 1) * kstep;
            const char* a2 = last ? nA : cA + (size_t)(t + 2) * kstep; const char* b2 = last ? nB : cB + (size_t)(t + 2) * kstep;
            const char* a3 = a2 + kstep; const char* b3 = b2 + kstep;
            PG8_LDB(B0, 0, 0); PG8_LDB(B1, 0, 1); PG8_SCHED; PG8_LDA(At, 0, 0); PG8_STAGE(PG8_SA(1, 1), a1 + hstepA, voffA);
            PG8_WAIT_V(8); PG8_WAIT_L(0); PG8_BAR; PG8_MMA(0, 0, At, B0); PG8_MMA(0, 1, At, B1); PG8_BAR; PG8_SCHED;
            PG8_LDA(At, 0, 1); PG8_STAGE(PG8_SB(0, 0), b2, voffB); PG8_STAGE(PG8_SB(0, 1), b2 + hstepB, voffB); PG8_STAGE(PG8_SA(0, 0), a2, voffA);
            PG8_WAIT_V(8); PG8_WAIT_L(0); PG8_BAR; PG8_MMA(1, 0, At, B0); PG8_MMA(1, 1, At, B1); PG8_BAR; PG8_SCHED;
            PG8_LDB(B0, 1, 0); PG8_LDB(B1, 1, 1); PG8_SCHED; PG8_LDA(At, 1, 0); PG8_STAGE(PG8_SA(0, 1), a2 + hstepA, voffA);
            PG8_WAIT_V(8); PG8_WAIT_L(0); PG8_BAR; PG8_MMA(0, 0, At, B0); PG8_MMA(0, 1, At, B1); PG8_BAR; PG8_SCHED;
            PG8_LDA(At, 1, 1); PG8_STAGE(PG8_SB(1, 0), b3, voffB); PG8_STAGE(PG8_SB(1, 1), b3 + hstepB, voffB); PG8_STAGE(PG8_SA(1, 0), a3, voffA);
            PG8_WAIT_V(8); PG8_WAIT_L(0); PG8_BAR; PG8_MMA(1, 0, At, B0); PG8_MMA(1, 1, At, B1); PG8_BAR; PG8_SCHED;
        }
        if (wr == 0) PG8_BAR;
        for (int er_ = 0; er_ < EPI_REPS; ++er_) { int fr2 = fr, fq2 = fq; asm volatile("" : "+v"(fr2), "+v"(fq2)); E(acc, cur, wr, wc, fr2, fq2); }
        if (!has_next) break;
#pragma unroll
        for (int a = 0; a < 2; ++a)
#pragma unroll
            for (int b = 0; b < 2; ++b)
#pragma unroll
                for (int m = 0; m < 4; ++m)
#pragma unroll
                    for (int n = 0; n < 2; ++n) acc[a][b][m][n] = (f32x4){0.f, 0.f, 0.f, 0.f};
        cur = nxt; cA = nA; cB = nB; ++ui;
        if (wr == 1) PG8_BAR;
    }
    PG8_WAIT_V(0);
    PG8_BAR;
#undef PG8_SA
#undef PG8_SB
#undef PG8_STAGE
#undef PG8_LDA
#undef PG8_LDB
#undef PG8_MMA
#undef PG8_WAIT_V
#undef PG8_WAIT_L
#undef PG8_BAR
#undef PG8_SCHED
}
}
using pg8::Unit;

#define EPI_ARGS f32x4 (&acc)[2][2][4][2], const Unit& u, int wr, int wc, int fr, int fq
__device__ __forceinline__ u32x4 pack8(const f32x4 a, const f32x4 b) { u32x4 w; w.x = cvt_pk_bf16(a[0], a[1]); w.y = cvt_pk_bf16(a[2], a[3]); w.z = cvt_pk_bf16(b[0], b[1]); w.w = cvt_pk_bf16(b[2], b[3]); return w; }
__device__ __forceinline__ void unpack8(const u32x4 w, f32x4& a, f32x4& b) { a = (f32x4){bf_lo(w.x), bf_hi(w.x), bf_lo(w.y), bf_hi(w.y)}; b = (f32x4){bf_lo(w.z), bf_hi(w.z), bf_lo(w.w), bf_hi(w.w)}; }
__device__ __forceinline__ float row_rstd(const float* rp, int row) {
    const f32x4* q = (const f32x4*)(rp + (size_t)row * 32); f32x4 s = q[0];
#pragma unroll
    for (int i = 1; i < 8; ++i) s += q[i];
    return __builtin_amdgcn_rsqf(((s[0] + s[1]) + (s[2] + s[3])) * (1.0f / DM) + NORM_EPS);
}
constexpr int RSTD_OFF = RING_BYTES;
template <class Sched> __device__ __forceinline__ void rstd_table(LAS unsigned char* lds, const float* rp, const Sched& S, int tid) {
    LAS float* tab = (LAS float*)(lds + RSTD_OFF); Unit u;
    for (int i = 0; i < 8 && S.next(i, u); ++i) if (tid < 256) tab[i * 256 + tid] = row_rstd(rp, u.pm * 256 + tid);
    __syncthreads();
}
__device__ __forceinline__ float rstd_lds(const LAS unsigned char* lds, int slot, int r) { return ((const LAS float*)(lds + RSTD_OFF))[slot * 256 + r]; }

struct EpiRet1 {
    bf16_t *qd, *kd, *v, *sg; const float* rope; const float* l2g;
    __device__ __forceinline__ void operator()(EPI_ARGS) const {
        const int pn = u.pn, row0 = u.pm * 256 + wr * 64 + fr, c0 = wc * 32 + 8 * fq;
        if (pn < 16) {
            const int head = pn & 7; const bool isk = pn >= 8;
            bf16_t* out = (isk ? kd : qd) + head * 256; const float lg = l2g[head];
#pragma unroll
            for (int ai = 0; ai < 2; ++ai)
#pragma unroll
                for (int m = 0; m < 4; ++m) { const int row = row0 + ai * 128 + m * 16, r = row & 255;
                    const float dec = isk ? __builtin_amdgcn_exp2f(lg * (float)(255 - r)) * 0.0625f : __builtin_amdgcn_exp2f(lg * (float)(r - 255));
#pragma unroll
                    for (int bj = 0; bj < 2; ++bj) { const int c = c0 + bj * 128;
                        const f32x4* rp = (const f32x4*)(rope + ((size_t)row * 128 + (c >> 1)) * 2); const f32x4 t0 = rp[0], t1 = rp[1];
                        const f32x4 x = acc[ai][bj][m][0], y = acc[ai][bj][m][1]; f32x4 o0, o1;
                        o0[0] = (x[0] * t0[0] - x[1] * t0[1]) * dec; o0[1] = (x[1] * t0[0] + x[0] * t0[1]) * dec;
                        o0[2] = (x[2] * t0[2] - x[3] * t0[3]) * dec; o0[3] = (x[3] * t0[2] + x[2] * t0[3]) * dec;
                        o1[0] = (y[0] * t1[0] - y[1] * t1[1]) * dec; o1[1] = (y[1] * t1[0] + y[0] * t1[1]) * dec;
                        o1[2] = (y[2] * t1[2] - y[3] * t1[3]) * dec; o1[3] = (y[3] * t1[2] + y[2] * t1[3]) * dec;
                        *(u32x4*)(out + (size_t)row * DM + c) = pack8(o0, o1); } }
        } else if (pn < 32) {
            bf16_t* out = v + (pn - 16) * 256 + c0;
#pragma unroll
            for (int ai = 0; ai < 2; ++ai)
#pragma unroll
                for (int m = 0; m < 4; ++m) { const int row = row0 + ai * 128 + m * 16;
#pragma unroll
                    for (int bj = 0; bj < 2; ++bj) *(u32x4*)(out + (size_t)row * PW + bj * 128) = pack8(acc[ai][bj][m][0], acc[ai][bj][m][1]); }
        } else {
            bf16_t* out = sg + (pn - 32) * 256 + c0;
#pragma unroll
            for (int ai = 0; ai < 2; ++ai)
#pragma unroll
                for (int m = 0; m < 4; ++m) { const int row = row0 + ai * 128 + m * 16;
#pragma unroll
                    for (int bj = 0; bj < 2; ++bj) { f32x4 a = acc[ai][bj][m][0], b = acc[ai][bj][m][1];
#pragma unroll
                        for (int e = 0; e < 4; ++e) { a[e] = fsilu(a[e]); b[e] = fsilu(b[e]); }
                        *(u32x4*)(out + (size_t)row * PW + bj * 128) = pack8(a, b); } }
        }
    }
};
struct EpiPlain {
    bf16_t* O; int ldc;
    __device__ __forceinline__ void operator()(EPI_ARGS) const {
        bf16_t* out = O + (size_t)(u.pm * 256 + wr * 64 + fr) * ldc + u.pn * 256 + wc * 32 + 8 * fq;
#pragma unroll
        for (int ai = 0; ai < 2; ++ai)
#pragma unroll
            for (int m = 0; m < 4; ++m)
#pragma unroll
                for (int bj = 0; bj < 2; ++bj) *(u32x4*)(out + (size_t)(ai * 128 + m * 16) * ldc + bj * 128) = pack8(acc[ai][bj][m][0], acc[ai][bj][m][1]);
    }
};
template <bool RESF> struct EpiRes {
    const float* resf; const bf16_t* resb; bf16_t* aout; float* rpo;
    __device__ __forceinline__ void operator()(EPI_ARGS) const {
        const int row0 = u.pm * 256 + wr * 64 + fr, col0 = u.pn * 256 + wc * 32 + 8 * fq;
#pragma unroll
        for (int ai = 0; ai < 2; ++ai) {
            f32x4 rv[4][2][2];
#pragma unroll
            for (int m = 0; m < 4; ++m)
#pragma unroll
                for (int bj = 0; bj < 2; ++bj) { const size_t o = (size_t)(row0 + ai * 128 + m * 16) * DM + col0 + bj * 128;
                    if (RESF) { rv[m][bj][0] = __builtin_nontemporal_load((const f32x4*)(resf + o)); rv[m][bj][1] = __builtin_nontemporal_load((const f32x4*)(resf + o + 4)); }
                    else unpack8(*(const u32x4*)(resb + o), rv[m][bj][0], rv[m][bj][1]); }
#pragma unroll
            for (int m = 0; m < 4; ++m) { const int row = row0 + ai * 128 + m * 16; const size_t off = (size_t)row * DM + col0; float ss = 0.f;
#pragma unroll
                for (int bj = 0; bj < 2; ++bj) { const size_t o = off + bj * 128;
                    const f32x4 h0 = rv[m][bj][0] + acc[ai][bj][m][0], h1 = rv[m][bj][1] + acc[ai][bj][m][1];
                    ss += (h0[0] * h0[0] + h0[1] * h0[1]) + (h0[2] * h0[2] + h0[3] * h0[3]) + (h1[0] * h1[0] + h1[1] * h1[1]) + (h1[2] * h1[2] + h1[3] * h1[3]);
                    *(u32x4*)(aout + o) = pack8(h0, h1); }
                ss += __shfl_xor(ss, 16); ss += __shfl_xor(ss, 32);
                if (fq == 0) rpo[(size_t)row * 32 + u.pn * 4 + wc] = ss; }
            asm volatile("" ::: "memory"); }
    }
};
struct EpiPle {
    const bf16_t* hin; const bf16_t* pe; const LAS unsigned char* lds; bf16_t* aout; float* rpo;
    __device__ __forceinline__ void operator()(EPI_ARGS) const {
        const int row0 = u.pm * 256 + wr * 64 + fr, col0 = u.pn * 256 + wc * 32 + 8 * fq;
#pragma unroll
        for (int ai = 0; ai < 2; ++ai) {
            u32x4 hv[4][2], pv[4][2];
#pragma unroll
            for (int m = 0; m < 4; ++m)
#pragma unroll
                for (int bj = 0; bj < 2; ++bj) { const size_t o = (size_t)(row0 + ai * 128 + m * 16) * DM + col0 + bj * 128; hv[m][bj] = *(const u32x4*)(hin + o); pv[m][bj] = *(const u32x4*)(pe + o); }
#pragma unroll
            for (int m = 0; m < 4; ++m) { const int row = row0 + ai * 128 + m * 16; const size_t off = (size_t)row * DM + col0; float ss = 0.f;
                const float rstd = rstd_lds(lds, u.slot, row & 255);
#pragma unroll
                for (int bj = 0; bj < 2; ++bj) { const size_t o = off + bj * 128;
                    f32x4 h0, h1, p0, p1; unpack8(hv[m][bj], h0, h1); unpack8(pv[m][bj], p0, p1);
                    const f32x4 a0 = acc[ai][bj][m][0], a1 = acc[ai][bj][m][1];
#pragma unroll
                    for (int e = 0; e < 4; ++e) { h0[e] += fsigmoid(a0[e] * rstd) * p0[e]; h1[e] += fsigmoid(a1[e] * rstd) * p1[e]; }
                    ss += (h0[0] * h0[0] + h0[1] * h0[1]) + (h0[2] * h0[2] + h0[3] * h0[3]) + (h1[0] * h1[0] + h1[1] * h1[1]) + (h1[2] * h1[2] + h1[3] * h1[3]);
                    *(u32x4*)(aout + o) = pack8(h0, h1); }
                ss += __shfl_xor(ss, 16); ss += __shfl_xor(ss, 32);
                if (fq == 0) rpo[(size_t)row * 32 + u.pn * 4 + wc] = ss; }
            asm volatile("" ::: "memory"); }
    }
};
constexpr int FN_P_OFF = RING_BYTES + 8192, FN_S_OFF = FN_P_OFF + 4096;
constexpr int CW_FN_CNT = 16384, CW_FN_X = 32768;
struct EpiPleFinal {
    const bf16_t* hin; const bf16_t* pe; LAS unsigned char* lds; float* out; const float* gain; unsigned* ctl;
    __device__ __forceinline__ void operator()(EPI_ARGS) const {
        const int row0 = u.pm * 256 + wr * 64 + fr, col0 = u.pn * 256 + wc * 32 + 8 * fq;
        const int wid = wr * 4 + wc, tid = wid * 64 + fq * 16 + fr;
        LAS float* P = (LAS float*)(lds + FN_P_OFF); LAS float* S = (LAS float*)(lds + FN_S_OFF);
#pragma unroll
        for (int ai = 0; ai < 2; ++ai)
#pragma unroll
            for (int mp = 0; mp < 2; ++mp) {
                u32x4 hv[2][2], pv[2][2];
#pragma unroll
                for (int mm = 0; mm < 2; ++mm)
#pragma unroll
                    for (int bj = 0; bj < 2; ++bj) { const size_t o = (size_t)(row0 + ai * 128 + (2 * mp + mm) * 16) * DM + col0 + bj * 128;
                        hv[mm][bj] = *(const u32x4*)(hin + o); pv[mm][bj] = *(const u32x4*)(pe + o); }
#pragma unroll
                for (int mm = 0; mm < 2; ++mm) { const int m = 2 * mp + mm, row = row0 + ai * 128 + m * 16; float ss = 0.f;
                    const float rstd = rstd_lds(lds, u.slot, row & 255);
#pragma unroll
                    for (int bj = 0; bj < 2; ++bj) {
                        f32x4 h0, h1, p0, p1; unpack8(hv[mm][bj], h0, h1); unpack8(pv[mm][bj], p0, p1);
                        const f32x4 a0 = acc[ai][bj][m][0], a1 = acc[ai][bj][m][1];
#pragma unroll
                        for (int e = 0; e < 4; ++e) { h0[e] += fsigmoid(a0[e] * rstd) * p0[e]; h1[e] += fsigmoid(a1[e] * rstd) * p1[e]; }
                        acc[ai][bj][m][0] = h0; acc[ai][bj][m][1] = h1;
                        ss += (h0[0] * h0[0] + h0[1] * h0[1]) + (h0[2] * h0[2] + h0[3] * h0[3]) + (h1[0] * h1[0] + h1[1] * h1[1]) + (h1[2] * h1[2] + h1[3] * h1[3]); }
                    ss += __shfl_xor(ss, 16); ss += __shfl_xor(ss, 32);
                    if (fq == 0) P[(row & 255) * 4 + wc] = ss; }
                asm volatile("" ::: "memory"); }
        asm volatile("s_waitcnt lgkmcnt(0)" ::: "memory"); __builtin_amdgcn_s_barrier(); asm volatile("" ::: "memory");
        float* X = (float*)(ctl + CW_FN_X); unsigned* cnt = ctl + CW_FN_CNT + 64 * u.pm;
        if (tid < 256) { const float t = (P[tid * 4 + 0] + P[tid * 4 + 1]) + (P[tid * 4 + 2] + P[tid * 4 + 3]);
            __hip_atomic_store(X + ((size_t)(u.pm * 256 + tid) * 8 + u.pn), t, __ATOMIC_RELAXED, __HIP_MEMORY_SCOPE_AGENT);
            asm volatile("s_waitcnt vmcnt(0)" ::: "memory");
            if ((tid & 63) == 0) __hip_atomic_fetch_add(cnt, 1u, __ATOMIC_RELAXED, __HIP_MEMORY_SCOPE_AGENT); }
        if (wid == 0) {
            unsigned spins = 0;
            while ((unsigned)__builtin_amdgcn_readfirstlane(__hip_atomic_load(cnt, __ATOMIC_RELAXED, __HIP_MEMORY_SCOPE_AGENT)) < 32u) { __builtin_amdgcn_s_sleep(2); if (++spins > (1u << 22)) break; }
            __builtin_amdgcn_fence(__ATOMIC_ACQUIRE, "agent");
            asm volatile("s_waitcnt vmcnt(0)" ::: "memory"); }
        asm volatile("s_waitcnt vmcnt(0) lgkmcnt(0)" ::: "memory"); __builtin_amdgcn_s_barrier(); asm volatile("" ::: "memory");
        if (tid < 256) { const float* xs = X + (size_t)(u.pm * 256 + tid) * 8; float s = 0.f;
#pragma unroll
            for (int t = 0; t < 8; ++t) s += __hip_atomic_load(xs + t, __ATOMIC_RELAXED, __HIP_MEMORY_SCOPE_AGENT);
            S[tid] = __builtin_amdgcn_rsqf(s * (1.0f / DM) + NORM_EPS); }
        asm volatile("s_waitcnt lgkmcnt(0)" ::: "memory"); __builtin_amdgcn_s_barrier(); asm volatile("" ::: "memory");
        f32x4 gv[2][2];
#pragma unroll
        for (int bj = 0; bj < 2; ++bj) { gv[bj][0] = *(const f32x4*)(gain + col0 + bj * 128); gv[bj][1] = *(const f32x4*)(gain + col0 + bj * 128 + 4); }
#pragma unroll
        for (int ai = 0; ai < 2; ++ai)
#pragma unroll
            for (int m = 0; m < 4; ++m) { const int row = row0 + ai * 128 + m * 16; const float rs = S[row & 255]; const size_t off = (size_t)row * DM + col0;
#pragma unroll
                for (int bj = 0; bj < 2; ++bj) { *(f32x4*)(out + off + bj * 128) = acc[ai][bj][m][0] * rs * gv[bj][0]; *(f32x4*)(out + off + bj * 128 + 4) = acc[ai][bj][m][1] * rs * gv[bj][1]; } }
    }
};
struct EpiPoolIn {
    const LAS unsigned char* lds; bf16_t* uo; bf16_t* sgo;
    __device__ __forceinline__ void operator()(EPI_ARGS) const {
        const int row0 = u.pm * 256 + wr * 64 + fr; const bool isg = u.pn >= 16;
        bf16_t* out = (isg ? sgo : uo) + (u.pn & 15) * 256 + wc * 32 + 8 * fq;
#pragma unroll
        for (int ai = 0; ai < 2; ++ai)
#pragma unroll
            for (int m = 0; m < 4; ++m) { const int row = row0 + ai * 128 + m * 16; const float rstd = rstd_lds(lds, u.slot, row & 255);
#pragma unroll
                for (int bj = 0; bj < 2; ++bj) { f32x4 a = acc[ai][bj][m][0] * rstd, b = acc[ai][bj][m][1] * rstd;
                    if (isg) {
#pragma unroll
                        for (int e = 0; e < 4; ++e) { a[e] = fsilu(a[e]); b[e] = fsilu(b[e]); } }
                    *(u32x4*)(out + (size_t)row * PW + bj * 128) = pack8(a, b); } }
    }
};
struct EpiComb {
    bf16_t* O; int ldc; const float* scale;
    __device__ __forceinline__ void operator()(EPI_ARGS) const {
        const int row0 = u.pm * 256 + wr * 64 + fr;
        bf16_t* out = O + (size_t)row0 * ldc + u.pn * 256 + wc * 32 + 8 * fq;
#pragma unroll
        for (int ai = 0; ai < 2; ++ai)
#pragma unroll
            for (int m = 0; m < 4; ++m) { const float sc = scale[row0 + ai * 128 + m * 16];
#pragma unroll
                for (int bj = 0; bj < 2; ++bj) *(u32x4*)(out + (size_t)(ai * 128 + m * 16) * ldc + bj * 128) = pack8(acc[ai][bj][m][0] * sc, acc[ai][bj][m][1] * sc); }
    }
};

typedef GAS unsigned gu32;
#define RLX_AGENT __ATOMIC_RELAXED, __HIP_MEMORY_SCOPE_AGENT
#define XB_TMO      128
#define XB_XCNT(j)  (256  + 64 * (j))
#define XB_XSUB(j)  (1280 + 64 * (j))
#define XB_XGEN(j)  (2304 + 64 * (j))
#define XB_TOP      3328
#define XB_TOPGEN   3392
#define XCD_BAR_WORDS 3456
#define XB_SPIN_CAP (1u << 20)
__device__ __forceinline__ unsigned xb_ld(unsigned* p)              { return __hip_atomic_load(p, __ATOMIC_RELAXED, __HIP_MEMORY_SCOPE_AGENT); }
__device__ __forceinline__ unsigned xb_add(unsigned* p, unsigned v) { return __hip_atomic_fetch_add(p, v, __ATOMIC_RELAXED, __HIP_MEMORY_SCOPE_AGENT); }
__device__ __forceinline__ unsigned xb_xcc_id() { return (unsigned)__builtin_amdgcn_s_getreg((3 << 11) | 20) & 0xFu; }
#define XB_SPIN(cond, bar) do { unsigned _sp = 0; while (cond) { __builtin_amdgcn_s_sleep(1); \
    if ((++_sp & 255u) == 0u) { if (xb_ld(&(bar)[XB_TMO])) break; if (_sp > XB_SPIN_CAP) { atomicAdd(&(bar)[XB_TMO], 1u); break; } } } } while (0)
struct XcdBarrier { unsigned* bar; unsigned x; volatile LAS unsigned* st; };
__device__ __forceinline__ XcdBarrier xcd_barrier_post(unsigned* bar, volatile LAS unsigned* st, const int wave) {
    XcdBarrier b; b.bar = bar; b.x = xb_xcc_id(); b.st = st;
    if (wave == 0 && lane_id() == 0) (void)xb_add(&bar[XB_XCNT(b.x)], 1u);
    return b;
}
__device__ __forceinline__ void xcd_barrier_complete(unsigned* bar, unsigned x, unsigned& nloc, unsigned& nx) {
    const unsigned G = gridDim.x * gridDim.y * gridDim.z;
    unsigned sum, cnt, mine, sp = 0u;
    for (;;) {
        sum = 0u; cnt = 0u; mine = 0u;
#pragma unroll
        for (unsigned j = 0; j < 16; ++j) { const unsigned c = xb_ld(&bar[XB_XCNT(j)]); sum += c; cnt += (c > 0u) ? 1u : 0u; mine = (j == x) ? c : mine; }
        if (sum == G) break;
        __builtin_amdgcn_s_sleep(1);
        if ((++sp & 255u) == 0u) { if (xb_ld(&bar[XB_TMO])) break; if (sp > XB_SPIN_CAP) { atomicAdd(&bar[XB_TMO], 1u); break; } }
    }
    nloc = mine > 0u ? mine : 1u; nx = cnt > 0u ? cnt : 1u;
}
__device__ __forceinline__ void xcd_barrier(const XcdBarrier& b, const int wave) {
    asm volatile("s_waitcnt vmcnt(0)" ::: "memory");
    __syncthreads();
    if (wave == 0 && lane_id() == 0) {
        unsigned* bar = b.bar;
        __builtin_amdgcn_s_waitcnt(0);
        unsigned nloc = b.st[0], nx = b.st[1];
        if (nloc == 0u) { xcd_barrier_complete(bar, b.x, nloc, nx); b.st[0] = nloc; b.st[1] = nx; }
        const unsigned old = xb_add(&bar[XB_XSUB(b.x)], 1u);
        const unsigned gen = old / nloc;
        if (old + 1u == (gen + 1u) * nloc) {
            __builtin_amdgcn_fence(__ATOMIC_RELEASE, "agent");
            asm volatile("s_waitcnt vmcnt(0)" ::: "memory");
            const unsigned og = xb_add(&bar[XB_TOP], 1u);
            const unsigned tg = og / nx;
            if (og + 1u == (tg + 1u) * nx) xb_add(&bar[XB_TOPGEN], 1u);
            else XB_SPIN(xb_ld(&bar[XB_TOPGEN]) == tg, bar);
            __builtin_amdgcn_fence(__ATOMIC_ACQUIRE, "agent");
            xb_add(&bar[XB_XGEN(b.x)], 1u);
            asm volatile("s_waitcnt vmcnt(0)" ::: "memory");
        } else {
            XB_SPIN(xb_ld(&bar[XB_XGEN(b.x)]) == gen, bar);
            __builtin_amdgcn_fence(__ATOMIC_ACQUIRE, "agent");
            asm volatile("s_waitcnt vmcnt(0)" ::: "memory");
        }
    }
    __syncthreads();
}

__device__ __forceinline__ void tr_item(const float* W, int N, bf16_t* WT, int Kt, LAS float* scr, int item, int lane) {
    const int nblk = N >> 6, kb = item / nblk, nb = item - kb * nblk, k0 = kb << 6, n0 = nb << 6;
    const int c = lane & 15, rr = lane >> 4;
    f32x4 v[16];
#pragma unroll
    for (int i = 0; i < 16; ++i) v[i] = __builtin_nontemporal_load((const f32x4*)(W + (size_t)(k0 + 4 * i + rr) * N + n0 + 4 * c));
#pragma unroll
    for (int i = 0; i < 16; ++i) { LAS float* s = scr + (4 * i + rr) * 65 + 4 * c; s[0] = v[i][0]; s[1] = v[i][1]; s[2] = v[i][2]; s[3] = v[i][3]; }
    LDS_WAIT();
    const int kc = lane & 7;
#pragma unroll
    for (int jj = 0; jj < 8; ++jj) { const int n = (lane >> 3) + 8 * jj; const LAS float* s = scr + (8 * kc) * 65 + n;
        u32x4 o; o.x = cvt_pk_bf16(s[0], s[65]); o.y = cvt_pk_bf16(s[130], s[195]); o.z = cvt_pk_bf16(s[260], s[325]); o.w = cvt_pk_bf16(s[390], s[455]);
        *(u32x4*)(WT + (size_t)(n0 + n) * Kt + k0 + 8 * kc) = o; }
    LDS_WAIT();
}
__device__ __forceinline__ double sin2pi(double r) {
    r -= rint(r);
    if (r > 0.25) r = 0.5 - r; else if (r < -0.25) r = -0.5 - r;
    const double x = r * 6.283185307179586476925, x2 = x * x;
    double p = -1.0 / 1307674368000.0;
    p = p * x2 + 1.0 / 6227020800.0; p = p * x2 - 1.0 / 39916800.0; p = p * x2 + 1.0 / 362880.0; p = p * x2 - 1.0 / 5040.0;
    p = p * x2 + 1.0 / 120.0; p = p * x2 - 1.0 / 6.0; p = p * x2 + 1.0;
    return x * p;
}

struct Args { const float* in[14]; float* out; unsigned char* ws; float freq[128]; float l2g[8]; float g256[8]; int ph_lo, ph_hi; };

__device__ __forceinline__ void p_prologue(const Args& a, LAS unsigned char* lds, const int wave) {
    const int lane = lane_id(), tid = wave * 64 + lane;
    unsigned char* ws = a.ws;
    LAS float* scr = (LAS float*)(lds + wave * 16640);
    const int gw = blockIdx.x * 8 + wave, NGW = gridDim.x * 8;
    constexpr int I_RI = (DM / 64) * (RPROJ / 64);
    for (int it = gw; it < I_RI; it += NGW) tr_item(a.in[3], RPROJ, (bf16_t*)(ws + WS_WT_RI), DM, scr, it, lane);
    const float* x = a.in[0]; const float* gain = a.in[2]; bf16_t* xn = (bf16_t*)(ws + WS_XN0);
    for (int m = gw; m < SEQ; m += NGW) {
        const f32x4* xr = (const f32x4*)(x + (size_t)m * DM) + lane; f32x4 v[8]; float s = 0.f;
#pragma unroll
        for (int j = 0; j < 8; ++j) { v[j] = __builtin_nontemporal_load(xr + 64 * j); s += (v[j][0] * v[j][0] + v[j][1] * v[j][1]) + (v[j][2] * v[j][2] + v[j][3] * v[j][3]); }
        const float rstd = __builtin_amdgcn_rsqf(wave_sum(s) * (1.0f / DM) + NORM_EPS);
        u32x2* o = (u32x2*)(xn + (size_t)m * DM) + lane;
#pragma unroll
        for (int j = 0; j < 8; ++j) { const f32x4 g = *((const f32x4*)gain + lane + 64 * j); const f32x4 y = v[j] * rstd * g; u32x2 w; w.x = cvt_pk_bf16(y[0], y[1]); w.y = cvt_pk_bf16(y[2], y[3]); o[64 * j] = w; }
    }
    const int gt = blockIdx.x * 512 + tid, NGT = gridDim.x * 512;
    { const float* p = a.in[1]; bf16_t* pb = (bf16_t*)(ws + WS_PBF);
      for (int i = gt; i < 2 * SEQ * PLE / 8; i += NGT) { const f32x4 a0 = __builtin_nontemporal_load((const f32x4*)(p + (size_t)i * 8)), a1 = __builtin_nontemporal_load((const f32x4*)(p + (size_t)i * 8 + 4)); *(u32x4*)(pb + (size_t)i * 8) = pack8(a0, a1); } }
    { f32x2* rope = (f32x2*)(ws + WS_ROPE);
      for (int i = gt; i < SEQ * 128; i += NGT) { const int pos = i >> 7, fi = i & 127; const float ang = (float)pos * a.freq[fi];
          const double rev = (double)ang * 0.15915494309189533577; f32x2 cs; cs.x = (float)sin2pi(rev + 0.25); cs.y = (float)sin2pi(rev); rope[i] = cs; } }
}
struct CvDesc { const float* src; bf16_t* dst; const float* kg; int N, Kt, plain; };
constexpr int CV_RO = (PW / 64) * (DM / 32), CV_G = (DM / 64) * (DM / 32), CV_P = (PLE / 64) * (DM / 32), CV_PIG = (DM / 64) * (PW / 32), CV_GR = (1024 / 64) * (1024 / 32), CV_WU = DM * PW / 2048;
constexpr int CV_ITEMS = CV_RO + 2 * CV_G + 2 * CV_P + CV_PIG + 4 * CV_GR + CV_RO + CV_WU;
__device__ __forceinline__ CvDesc cv_tr(const float* W, int N, int ncols, bf16_t* WT, int Kt, int r, const float* kg = nullptr) {
    const int nblk = ncols >> 5, kb = r / nblk, nb = r - kb * nblk; CvDesc d; d.src = W + (size_t)(kb * 64) * N + nb * 32; d.dst = WT + (size_t)(nb * 32) * Kt + kb * 64; d.kg = kg ? kg + kb * 64 : nullptr; d.N = N; d.Kt = Kt; d.plain = 0; return d; }
__device__ __forceinline__ CvDesc cv_decode(const Args& a, int r) {
    unsigned char* ws = a.ws;
    if (r < CV_RO) return cv_tr(a.in[4], DM, DM, (bf16_t*)(ws + WS_WT_RO), PW, r); r -= CV_RO;
    if (r < CV_G) return cv_tr(a.in[11], DM, DM, (bf16_t*)(ws + WS_WT_G0), DM, r, a.in[10]); r -= CV_G;
    if (r < CV_G) return cv_tr(a.in[11] + (size_t)DM * DM, DM, DM, (bf16_t*)(ws + WS_WT_G1), DM, r, a.in[10] + DM); r -= CV_G;
    if (r < CV_P) return cv_tr(a.in[12], DM, DM, (bf16_t*)(ws + WS_WT_P0), PLE, r); r -= CV_P;
    if (r < CV_P) return cv_tr(a.in[12] + (size_t)PLE * DM, DM, DM, (bf16_t*)(ws + WS_WT_P1), PLE, r); r -= CV_P;
    if (r < CV_PIG) return cv_tr(a.in[6] + PW, 2 * PW, PW, (bf16_t*)(ws + WS_WT_PI) + (size_t)PW * DM, DM, r, a.in[5]); r -= CV_PIG;
    if (r < 4 * CV_GR) { const int g = r / CV_GR; return cv_tr(a.in[7] + (size_t)g * 1024 * 1024, 1024, 1024, (bf16_t*)(ws + WS_WT_GR) + (size_t)g * 1024 * 1024, 1024, r - g * CV_GR); } r -= 4 * CV_GR;
    if (r < CV_RO) return cv_tr(a.in[9], DM, DM, (bf16_t*)(ws + WS_WT_PO), PW, r); r -= CV_RO;
    CvDesc d; const int row = r >> 1, c0 = (r & 1) * 2048; d.src = a.in[6] + (size_t)row * (2 * PW) + c0; d.dst = (bf16_t*)(ws + WS_WU) + (size_t)row * PW + c0; d.kg = a.in[5] + row; d.N = 0; d.Kt = 0; d.plain = 1; return d;
}
__device__ __forceinline__ void cv_load(const CvDesc& d, f32x4 (&cv)[8], int lane) {
    if (d.plain) {
#pragma unroll
        for (int j = 0; j < 4; ++j) { cv[2 * j] = __builtin_nontemporal_load((const f32x4*)(d.src + lane * 8 + 512 * j)); cv[2 * j + 1] = __builtin_nontemporal_load((const f32x4*)(d.src + lane * 8 + 512 * j + 4)); }
    } else {
#pragma unroll
        for (int i = 0; i < 8; ++i) cv[i] = __builtin_nontemporal_load((const f32x4*)(d.src + (size_t)(8 * i + (lane >> 3)) * d.N + 4 * (lane & 7)));
    }
}
__device__ __forceinline__ void cv_store(const CvDesc& d, const f32x4 (&cv)[8], LAS float* scr, int lane) {
    if (d.plain) {
        const float kgv = d.kg[0];
#pragma unroll
        for (int j = 0; j < 4; ++j) *(u32x4*)(d.dst + lane * 8 + 512 * j) = pack8(cv[2 * j] * kgv, cv[2 * j + 1] * kgv);
    } else {
#pragma unroll
        for (int i = 0; i < 8; ++i) { const float kgv = d.kg ? d.kg[8 * i + (lane >> 3)] : 1.0f; LAS float* s = scr + (8 * i + (lane >> 3)) * 33 + 4 * (lane & 7); s[0] = cv[i][0] * kgv; s[1] = cv[i][1] * kgv; s[2] = cv[i][2] * kgv; s[3] = cv[i][3] * kgv; }
        LDS_WAIT();
        const int kc = lane & 7;
#pragma unroll
        for (int j = 0; j < 4; ++j) { const int n = (lane >> 3) + 8 * j; const LAS float* s = scr + (8 * kc) * 33 + n;
            u32x4 o; o.x = cvt_pk_bf16(s[0], s[33]); o.y = cvt_pk_bf16(s[66], s[99]); o.z = cvt_pk_bf16(s[132], s[165]); o.w = cvt_pk_bf16(s[198], s[231]);
            *(u32x4*)(d.dst + (size_t)n * d.Kt + 8 * kc) = o; }
        LDS_WAIT();
    }
}

__device__ __forceinline__ void tr_item_g(const float* W, int N, int ncols, bf16_t* WT, int Kt, LAS float* scr, int item, int lane, const float* kg) {
    const int nblk = ncols >> 6, kb = item / nblk, nb = item - kb * nblk, k0 = kb << 6, n0 = nb << 6;
    const int c = lane & 15, rr = lane >> 4;
    f32x4 v[16];
#pragma unroll
    for (int i = 0; i < 16; ++i) v[i] = __builtin_nontemporal_load((const f32x4*)(W + (size_t)(k0 + 4 * i + rr) * N + n0 + 4 * c));
#pragma unroll
    for (int i = 0; i < 16; ++i) { const float g = kg ? kg[k0 + 4 * i + rr] : 1.0f; LAS float* s = scr + (4 * i + rr) * 65 + 4 * c; s[0] = v[i][0] * g; s[1] = v[i][1] * g; s[2] = v[i][2] * g; s[3] = v[i][3] * g; }
    LDS_WAIT();
    const int kc = lane & 7;
#pragma unroll
    for (int jj = 0; jj < 8; ++jj) { const int n = (lane >> 3) + 8 * jj; const LAS float* s = scr + (8 * kc) * 65 + n;
        u32x4 o; o.x = cvt_pk_bf16(s[0], s[65]); o.y = cvt_pk_bf16(s[130], s[195]); o.z = cvt_pk_bf16(s[260], s[325]); o.w = cvt_pk_bf16(s[390], s[455]);
        *(u32x4*)(WT + (size_t)(n0 + n) * Kt + k0 + 8 * kc) = o; }
    LDS_WAIT();
}
__device__ __forceinline__ void p_weights_big(const Args& a, LAS unsigned char* lds, const int wave) {
    const int lane = lane_id();
    unsigned char* ws = a.ws;
    LAS float* scr = (LAS float*)(lds + wave * 16640);
    const int gw = (blockIdx.x - 128) * 8 + wave, NGW = (gridDim.x - 128) * 8;
    constexpr int I_RO = (PW / 64) * (DM / 64), I_G = (DM / 64) * (DM / 64), I_P = (PLE / 64) * (DM / 64), I_PIG = (DM / 64) * (PW / 64), I_GR = (1024 / 64) * (1024 / 64), I_WU = DM * PW / 2048;
    for (int it = gw; it < I_RO + 2 * I_G + 2 * I_P + I_PIG + 4 * I_GR + I_RO + I_WU; it += NGW) {
        int r = it;
        if (r < I_RO) { tr_item_g(a.in[4], DM, DM, (bf16_t*)(ws + WS_WT_RO), PW, scr, r, lane, nullptr); continue; } r -= I_RO;
        if (r < I_G) { tr_item_g(a.in[11], DM, DM, (bf16_t*)(ws + WS_WT_G0), DM, scr, r, lane, a.in[10]); continue; } r -= I_G;
        if (r < I_G) { tr_item_g(a.in[11] + (size_t)DM * DM, DM, DM, (bf16_t*)(ws + WS_WT_G1), DM, scr, r, lane, a.in[10] + DM); continue; } r -= I_G;
        if (r < I_P) { tr_item_g(a.in[12], DM, DM, (bf16_t*)(ws + WS_WT_P0), PLE, scr, r, lane, nullptr); continue; } r -= I_P;
        if (r < I_P) { tr_item_g(a.in[12] + (size_t)PLE * DM, DM, DM, (bf16_t*)(ws + WS_WT_P1), PLE, scr, r, lane, nullptr); continue; } r -= I_P;
        if (r < I_PIG) { tr_item_g(a.in[6] + PW, 2 * PW, PW, (bf16_t*)(ws + WS_WT_PI) + (size_t)PW * DM, DM, scr, r, lane, a.in[5]); continue; } r -= I_PIG;
        if (r < 4 * I_GR) { const int g = r / I_GR; tr_item_g(a.in[7] + (size_t)g * 1024 * 1024, 1024, 1024, (bf16_t*)(ws + WS_WT_GR) + (size_t)g * 1024 * 1024, 1024, scr, r - g * I_GR, lane, nullptr); continue; } r -= 4 * I_GR;
        if (r < I_RO) { tr_item_g(a.in[9], DM, DM, (bf16_t*)(ws + WS_WT_PO), PW, scr, r, lane, nullptr); continue; } r -= I_RO;
        { const int row = r >> 1, c0 = (r & 1) * 2048 + lane * 8; const float* srcp = a.in[6] + (size_t)row * (2 * PW) + c0; bf16_t* dstp = (bf16_t*)(ws + WS_WU) + (size_t)row * PW + c0; const float g = a.in[5][row];
#pragma unroll
            for (int j = 0; j < 4; ++j) { const f32x4 x0 = __builtin_nontemporal_load((const f32x4*)(srcp + 512 * j)), x1 = __builtin_nontemporal_load((const f32x4*)(srcp + 512 * j + 4)); *(u32x4*)(dstp + 512 * j) = pack8(x0 * g, x1 * g); } }
    }
}

__device__ __forceinline__ bf16x8 tr_frag(const LAS unsigned char* p, int pitch16) {
    const s16x4 lo = __builtin_amdgcn_ds_read_tr16_b64_v4i16((LAS s16x4*)p), hi = __builtin_amdgcn_ds_read_tr16_b64_v4i16((LAS s16x4*)(p + pitch16));
    return (bf16x8){lo[0], lo[1], lo[2], lo[3], hi[0], hi[1], hi[2], hi[3]};
}

__device__ __forceinline__ void p_scan(const Args& a, LAS unsigned char* lds, const int w) {
    const int lane = lane_id();
    const int tid = w * 64 + lane, b = blockIdx.x, h = b & 7, tt = b >> 3, dt = tt >> 2, vt = tt & 3;
    const int db = w >> 1, vbp = w & 1, g = lane >> 4, i16 = lane & 15, q4 = i16 >> 2, p4 = i16 & 3;
    const float g256 = a.g256[h];
    constexpr int PK = 160, PV = 288, TK = 128 * PK, TV = 128 * PV, BUF = TK + TV;
    const bf16_t* kbase = (const bf16_t*)(a.ws + WS_KD) + h * 256 + dt * 64;
    const bf16_t* vbase = (const bf16_t*)(a.ws + WS_V) + h * 512 + vt * 128;
    bf16_t* st = (bf16_t*)(a.ws + WS_ST);
    u32x4 rk0[2], rv0[4], rk1[2], rv1[4], rk2[2], rv2[4], rk3[2], rv3[4];
#define P2_LOAD(RK, RV, hs) do { const int _hs = (hs) < 62 ? (hs) : 61; \
        _Pragma("unroll") for (int _i = 0; _i < 2; ++_i) { const int _p = tid + 512 * _i; RK[_i] = *(const u32x4*)(kbase + (size_t)(_hs * 128 + (_p >> 3)) * DM + (_p & 7) * 8); } \
        _Pragma("unroll") for (int _i = 0; _i < 4; ++_i) { const int _p = tid + 512 * _i; RV[_i] = *(const u32x4*)(vbase + (size_t)(_hs * 128 + (_p >> 4)) * PW + (_p & 15) * 8); } } while (0)
#define P2_STORE(RK, RV, s) do { \
        _Pragma("unroll") for (int _i = 0; _i < 2; ++_i) { const int _p = tid + 512 * _i; *(LAS u32x4*)(lds + (s) * BUF + (_p >> 3) * PK + (_p & 7) * 16) = RK[_i]; } \
        _Pragma("unroll") for (int _i = 0; _i < 4; ++_i) { const int _p = tid + 512 * _i; *(LAS u32x4*)(lds + (s) * BUF + TK + (_p >> 4) * PV + (_p & 15) * 16) = RV[_i]; } } while (0)
    f32x4 acc[4];
#pragma unroll
    for (int j = 0; j < 4; ++j) acc[j] = (f32x4){0.f, 0.f, 0.f, 0.f};
    const int lk = (4 * g + q4) * PK + 8 * p4 + db * 32, lv = (4 * g + q4) * PV + 8 * p4 + vbp * 128;
#define P2_STEP(hs, RKN, RVN) do { const int _h = (hs); if (_h < 62) { \
        const LAS unsigned char* kt = lds + (_h & 1) * BUF + lk; const LAS unsigned char* vtp = lds + (_h & 1) * BUF + TK + lv; \
        _Pragma("unroll") for (int ks = 0; ks < 4; ++ks) { \
            const bf16x8 kf = tr_frag(kt + ks * 32 * PK, 16 * PK); \
            _Pragma("unroll") for (int j = 0; j < 4; ++j) { const bf16x8 vf = tr_frag(vtp + ks * 32 * PV + 32 * j, 16 * PV); acc[j] = __builtin_amdgcn_mfma_f32_16x16x32_bf16(vf, kf, acc[j], 0, 0, 0); } } \
        if (_h & 1) { const int n = _h >> 1; \
            bf16_t* o = st + ((size_t)(n * 8 + h) * 256 + dt * 64 + db * 16 + i16) * 512 + vt * 128 + vbp * 64 + 4 * g; \
            _Pragma("unroll") for (int j = 0; j < 4; ++j) { acc[j] *= g256; u32x2 w0; w0.x = cvt_pk_bf16(acc[j][0], acc[j][1]); w0.y = cvt_pk_bf16(acc[j][2], acc[j][3]); *(u32x2*)(o + 16 * j) = w0; } } \
        if (_h + 1 < 62) { P2_STORE(RKN, RVN, (_h + 1) & 1); P2_LOAD(RKN, RVN, _h + 5); } \
        __syncthreads(); } } while (0)
    P2_LOAD(rk0, rv0, 0); P2_LOAD(rk1, rv1, 1); P2_LOAD(rk2, rv2, 2); P2_LOAD(rk3, rv3, 3);
    P2_STORE(rk0, rv0, 0); P2_LOAD(rk0, rv0, 4); __syncthreads();
    for (int hs = 0; hs < 62; hs += 4) {
        P2_STEP(hs, rk1, rv1); P2_STEP(hs + 1, rk2, rv2); P2_STEP(hs + 2, rk3, rv3); P2_STEP(hs + 3, rk0, rv0);
    }
#undef P2_STEP
#undef P2_LOAD
#undef P2_STORE
}

__device__ __forceinline__ void p_retention(const Args& a, LAS unsigned char* lds, const int w) {
    const int lane = lane_id();
    const int tid = w * 64 + lane, b = blockIdx.x;
    const int g = lane >> 4, i16 = lane & 15, q4 = i16 >> 2, p4 = i16 & 3;
    constexpr int PP = 528, RINGO = 128 * PP, RB = 33792, ST1 = RINGO + 2 * RB, ST2 = ST1 + 8192;
    const bf16_t* qd = (const bf16_t*)(a.ws + WS_QD); const bf16_t* kd = (const bf16_t*)(a.ws + WS_KD); const bf16_t* v = (const bf16_t*)(a.ws + WS_V);
    const bf16_t* sg = (const bf16_t*)(a.ws + WS_SG); const bf16_t* st = (const bf16_t*)(a.ws + WS_ST); bf16_t* z = (bf16_t*)(a.ws + WS_Z);
    const unsigned offk = (unsigned)(((tid >> 5) * DM + (tid & 31) * 8) * 2), offv = (unsigned)(((tid >> 6) * PW + (tid & 63) * 8) * 2), offt = (unsigned)(((tid >> 6) * 512 + (tid & 63) * 8) * 2);
    const int xs = b & 7, kq = b >> 3, pair = kq >> 1, member = kq & 1;
    for (int rnd = 0; rnd < 2; ++rnd) {
        const int nh = (pair * 2 + rnd) * 8 + xs, n = nh >> 3, h = nh & 7, hf = member ^ rnd;
        const int nsb = 2 * (hf + 1), nvb = 4 * (hf + 1), ntb = n > 0 ? 8 : 0, nblk = nsb + nvb + ntb;
        const int rowbase = 256 * n + 128 * hf;
        u32x4 ra[4], rb[4];
#define P3_LOAD(R, it) do { const int _it = (it) < nblk ? (it) : nblk - 1; \
        if (_it < ntb) { const char* _b = (const char*)(st + ((size_t)((n - 1) * 8 + h) * 256 + 32 * _it) * 512); unsigned _o = offt; asm volatile("" : "+v"(_o)); \
            _Pragma("unroll") for (int _i = 0; _i < 4; ++_i) R[_i] = *(const u32x4*)(_b + (size_t)_i * (8 * 512 * 2) + _o); } \
        else if (_it < ntb + nsb) { const char* _b = (const char*)(kd + (size_t)(256 * n + 64 * (_it - ntb)) * DM + h * 256); unsigned _o = offk; asm volatile("" : "+v"(_o)); \
            _Pragma("unroll") for (int _i = 0; _i < 4; ++_i) R[_i] = *(const u32x4*)(_b + (size_t)_i * (16 * DM * 2) + _o); } \
        else { const char* _b = (const char*)(v + (size_t)(256 * n + 32 * (_it - ntb - nsb)) * PW + h * 512); unsigned _o = offv; asm volatile("" : "+v"(_o)); \
            _Pragma("unroll") for (int _i = 0; _i < 4; ++_i) R[_i] = *(const u32x4*)(_b + (size_t)_i * (8 * PW * 2) + _o); } } while (0)
#define P3_STORE(R, it) do { const int _it = (it); if (_it < nblk) { LAS unsigned char* _d = lds + RINGO + (_it & 1) * RB; \
        if (_it >= ntb && _it < ntb + nsb) { _Pragma("unroll") for (int _i = 0; _i < 4; ++_i) { const int _p = tid + 512 * _i; *(LAS u32x4*)(_d + (_p >> 5) * 528 + (_p & 31) * 16) = R[_i]; } } \
        else { _Pragma("unroll") for (int _i = 0; _i < 4; ++_i) { const int _p = tid + 512 * _i; *(LAS u32x4*)(_d + (_p >> 6) * 1056 + (_p & 63) * 16) = R[_i]; } } } } while (0)
        P3_LOAD(ra, 0); P3_LOAD(rb, 1);
        if (ntb) {
#pragma unroll 2
            for (int i = 0; i < 8; ++i) { const int p = tid + 512 * i, row = p >> 5, c = p & 31, G = c >> 2, cc = c & 3;
                const u32x4 x = *(const u32x4*)(qd + (size_t)(rowbase + row) * DM + h * 256 + c * 8);
                const int s = cc >> 1, glo = (2 * cc) & 3, ghi = (2 * cc + 1) & 3;
                LAS unsigned char* d = lds + row * PP + 64 * G;
                *(LAS u32x2*)(d + 8 * (2 * glo + s)) = (u32x2){x.x, x.y}; *(LAS u32x2*)(d + 8 * (2 * ghi + s)) = (u32x2){x.z, x.w}; }
        }
        P3_STORE(ra, 0); P3_LOAD(ra, 2); __syncthreads();
        f32x4 acc[8][4];
#pragma unroll
        for (int rbk = 0; rbk < 8; ++rbk)
#pragma unroll
            for (int cb = 0; cb < 4; ++cb) acc[rbk][cb] = (f32x4){0.f, 0.f, 0.f, 0.f};
#define P3_YSTEP(it_, RN, ISV) do { const int it = (it_); \
            const LAS unsigned char* ring = lds + RINGO + (it & 1) * RB; \
            { const int kk = (ISV) ? it - ntb - nsb : it; \
                bf16x8 vf[4]; \
                _Pragma("unroll") for (int cb = 0; cb < 4; ++cb) vf[cb] = tr_frag(ring + (4 * g + q4) * 1056 + (64 * w + 16 * cb + 4 * p4) * 2, 16 * 1056); \
                _Pragma("unroll") for (int rbk = 0; rbk < 8; ++rbk) { \
                    if ((ISV) && 32 * kk > 128 * hf + 16 * rbk + 15) continue; \
                    const bf16x8 pf = *(const LAS bf16x8*)(lds + (16 * rbk + i16) * PP + (32 * kk + 8 * g) * 2); \
                    _Pragma("unroll") for (int cb = 0; cb < 4; ++cb) acc[rbk][cb] = __builtin_amdgcn_mfma_f32_16x16x32_bf16(vf[cb], pf, acc[rbk][cb], 0, 0, 0); \
                } } \
            P3_STORE(RN, it + 1); P3_LOAD(RN, it + 3); \
            __syncthreads(); } while (0)
        for (int it2 = 0; it2 < ntb; it2 += 2) { P3_YSTEP(it2, rb, false); P3_YSTEP(it2 + 1, ra, false); }
        {
            bf16x8 qf[8];
#pragma unroll
            for (int ds = 0; ds < 8; ++ds) qf[ds] = *(const bf16x8*)(qd + (size_t)(rowbase + 16 * w + i16) * DM + h * 256 + 32 * ds + 8 * g);
#define P3_SSTEP(it_, RN) do { const int it = (it_), sbk = it - ntb; \
                const LAS unsigned char* ring = lds + RINGO + (it & 1) * RB; \
                _Pragma("unroll") for (int sb = 0; sb < 4; ++sb) { \
                    const int j0 = 64 * sbk + 16 * sb, i0 = 128 * hf + 16 * w; \
                    LAS unsigned char* dst = lds + (16 * w + i16) * PP + (32 * (2 * sbk + (sb >> 1)) + 8 * g + 4 * (sb & 1)) * 2; \
                    if (j0 > i0) { *(LAS u32x2*)dst = (u32x2){0u, 0u}; } \
                    else { \
                        f32x4 s4 = {0.f, 0.f, 0.f, 0.f}; \
                        _Pragma("unroll") for (int ds = 0; ds < 8; ++ds) { const bf16x8 kf = *(const LAS bf16x8*)(ring + (16 * sb + i16) * 528 + (32 * ds + 8 * g) * 2); \
                            s4 = __builtin_amdgcn_mfma_f32_16x16x32_bf16(kf, qf[ds], s4, 0, 0, 0); } \
                        if (j0 == i0) { _Pragma("unroll") for (int r = 0; r < 4; ++r) if (4 * g + r > i16) s4[r] = 0.f; } \
                        u32x2 wv; wv.x = cvt_pk_bf16(s4[0], s4[1]); wv.y = cvt_pk_bf16(s4[2], s4[3]); *(LAS u32x2*)dst = wv; \
                    } \
                } \
                P3_STORE(RN, it + 1); P3_LOAD(RN, it + 3); \
                __syncthreads(); } while (0)
            for (int it2 = ntb; it2 < ntb + nsb; it2 += 2) { P3_SSTEP(it2, rb); P3_SSTEP(it2 + 1, ra); }
#undef P3_SSTEP
        }
        for (int it2 = ntb + nsb; it2 < nblk; it2 += 2) { P3_YSTEP(it2, rb, true); P3_YSTEP(it2 + 1, ra, true); }
#undef P3_YSTEP
#undef P3_LOAD
#undef P3_STORE
        LAS f32x2* S1 = (LAS f32x2*)(lds + ST1); LAS f32x2* S2 = (LAS f32x2*)(lds + ST2);
#pragma unroll
        for (int rbk = 0; rbk < 8; ++rbk) { float s1 = 0.f, s2 = 0.f;
#pragma unroll
            for (int cb = 0; cb < 4; ++cb) { const f32x4 y = acc[rbk][cb]; s1 += (y[0] + y[1]) + (y[2] + y[3]); s2 += (y[0] * y[0] + y[1] * y[1]) + (y[2] * y[2] + y[3] * y[3]); }
            s1 += __shfl_xor(s1, 16); s1 += __shfl_xor(s1, 32); s2 += __shfl_xor(s2, 16); s2 += __shfl_xor(s2, 32);
            if (g == 0) S1[(16 * rbk + i16) * 8 + w] = (f32x2){s1, s2}; }
        __syncthreads();
        if (tid < 128) { float s1 = 0.f, s2 = 0.f;
#pragma unroll
            for (int k = 0; k < 8; ++k) { const f32x2 t = S1[tid * 8 + k]; s1 += t.x; s2 += t.y; }
            const float mean = s1 * (1.0f / 512.0f), var = s2 * (1.0f / 512.0f) - mean * mean;
            S2[tid] = (f32x2){mean, __builtin_amdgcn_rsqf(fmaxf(var, 0.f) + GN_EPS)}; }
        __syncthreads();
#pragma unroll
        for (int rbk = 0; rbk < 8; ++rbk) { const f32x2 ms = S2[16 * rbk + i16];
            const size_t off = (size_t)(rowbase + 16 * rbk + i16) * PW + h * 512 + 64 * w + 4 * g;
#pragma unroll
            for (int cb = 0; cb < 4; ++cb) { const u32x2 gw = __builtin_nontemporal_load((const u32x2*)(sg + off + 16 * cb)); const f32x4 y = acc[rbk][cb];
                u32x2 o; o.x = cvt_pk_bf16((y[0] - ms.x) * ms.y * bf_lo(gw.x), (y[1] - ms.x) * ms.y * bf_hi(gw.x)); o.y = cvt_pk_bf16((y[2] - ms.x) * ms.y * bf_lo(gw.y), (y[3] - ms.x) * ms.y * bf_hi(gw.y));
                *(u32x2*)(z + off + 16 * cb) = o; } }
        __syncthreads();
    }
}

__device__ __forceinline__ void p_pool(const Args& a, const int wave) {
    const int tid = wave * 64 + lane_id();
    const bf16_t* u = (const bf16_t*)(a.ws + WS_U); const bf16_t* sg = (const bf16_t*)(a.ws + WS_SG1); bf16_t* d = (bf16_t*)(a.ws + WS_ZZ);
    for (int task = blockIdx.x * 512 + tid; task < 512 * 256; task += gridDim.x * 512) {
        const int chunk = task & 511, run = task >> 9, w = 2 << (chunk >> 7), t0 = run * 32;
        const bf16_t* uc = u + chunk * 8; const bf16_t* gc = sg + chunk * 8; bf16_t* dc = d + chunk * 8;
        f32x4 s0 = {0.f, 0.f, 0.f, 0.f}, s1 = {0.f, 0.f, 0.f, 0.f};
        for (int t = (t0 - w > 0 ? t0 - w : 0); t < t0; ++t) { f32x4 x0, x1; unpack8(*(const u32x4*)(uc + (size_t)t * PW), x0, x1); s0 += x0; s1 += x1; }
        for (int t = t0; t < t0 + 32; ++t) {
            f32x4 x0, x1, g0, g1; unpack8(*(const u32x4*)(uc + (size_t)t * PW), x0, x1); unpack8(*(const u32x4*)(gc + (size_t)t * PW), g0, g1); s0 += x0; s1 += x1;
            if (t - w >= 0) { f32x4 y0, y1; unpack8(*(const u32x4*)(uc + (size_t)(t - w) * PW), y0, y1); s0 -= y0; s1 -= y1; }
            const float inv = 1.0f / (float)(t + 1 < w ? t + 1 : w);
            *(u32x4*)(dc + (size_t)t * PW) = pack8((s0 * inv - x0) * g0, (s1 * inv - x1) * g1);
        }
    }
}
__device__ __forceinline__ void p_final(const Args& a, const int wave) {
    const int lane = lane_id();
    const float* rp = (const float*)(a.ws + WS_RP + 3 * MiB); const float* gain = a.in[13]; float* out = a.out;
    for (int m = blockIdx.x * 8 + wave; m < SEQ; m += gridDim.x * 8) {
        const float part = lane < 32 ? rp[(size_t)m * 32 + lane] : 0.f;
        const float rstd = __builtin_amdgcn_rsqf(wave_sum(part) * (1.0f / DM) + NORM_EPS);
        f32x4* o = (f32x4*)(out + (size_t)m * DM) + lane;
#pragma unroll
        for (int j = 0; j < 8; ++j) { const f32x4 g = *((const f32x4*)gain + lane + 64 * j); o[64 * j] = o[64 * j] * rstd * g; }
    }
}

__global__ void __launch_bounds__(512, 2) trunk_fwd(Args args) {
    extern __shared__ __attribute__((aligned(16))) unsigned char lds_raw[];
    LAS unsigned char* lds = (LAS unsigned char*)lds_raw;
    const int wave = __builtin_amdgcn_readfirstlane(threadIdx.x >> 6);
    unsigned char* ws = args.ws;
    volatile LAS unsigned* MISC = (volatile LAS unsigned*)(lds + MISC_OFF);
    if (threadIdx.x < 64) MISC[threadIdx.x] = 0u;
    __syncthreads();
    XcdBarrier bar; bar.bar = (unsigned*)(ws + WS_CTL) + 4096; bar.x = 0; bar.st = nullptr;
    const int lo = args.ph_lo, hi = args.ph_hi;
    if (hi - lo > 1) bar = xcd_barrier_post((unsigned*)(ws + WS_CTL) + 4096, MISC + 8, wave);
#ifndef PH_MASK
#define PH_MASK 0x3FF
#endif
#define IN(k) (((PH_MASK >> (k)) & 1) && lo <= (k) && (k) < hi)
#define SEAM(k) do { if (IN(k) && IN((k) + 1)) xcd_barrier(bar, wave); } while (0)
#ifndef DUP_MASK
#define DUP_MASK 0
#endif
#define NDUP(k) (((DUP_MASK >> (k)) & 1) ? 2 : 1)
    const int G = gridDim.x, c = blockIdx.x;
    float* rp0 = (float*)(ws + WS_RP); float* rp1 = rp0 + SEQ * 32; float* rp2 = rp1 + SEQ * 32; float* rp3 = rp2 + SEQ * 32;

    if (IN(0)) for (int rep_ = 0; rep_ < NDUP(0); ++rep_) { if (rep_) xcd_barrier(bar, wave); p_prologue(args, lds, wave); VM_WAIT(); __syncthreads(); }
    SEAM(0);
    if (IN(1)) for (int rep_ = 0; rep_ < NDUP(1); ++rep_) { if (rep_) xcd_barrier(bar, wave);
        pg8::Gemm g{(const bf16_t*)(ws + WS_XN0), (const bf16_t*)(ws + WS_WT_RI), SEQ, RPROJ, DM, DM, DM}; pg8::StaticOrder S; S.init(SEQ, RPROJ, G, c);
        EpiRet1 E{(bf16_t*)(ws + WS_QD), (bf16_t*)(ws + WS_KD), (bf16_t*)(ws + WS_V), (bf16_t*)(ws + WS_SG), (const float*)(ws + WS_ROPE), args.l2g};
        pg8::gemm_phase(lds, g, S, E, wave);
    }
    SEAM(1);
    if (IN(2)) for (int rep_ = 0; rep_ < NDUP(2); ++rep_) { if (rep_) xcd_barrier(bar, wave); if (c < 128) p_scan(args, lds, wave); else p_weights_big(args, lds, wave);
        VM_WAIT(); __syncthreads(); }
    SEAM(2);
    if (IN(3)) for (int rep_ = 0; rep_ < NDUP(3); ++rep_) { if (rep_) xcd_barrier(bar, wave); p_retention(args, lds, wave); }
    SEAM(3);
    if (IN(4)) for (int rep_ = 0; rep_ < NDUP(4); ++rep_) { if (rep_) xcd_barrier(bar, wave);
        { pg8::Gemm g{(const bf16_t*)(ws + WS_Z), (const bf16_t*)(ws + WS_WT_RO), SEQ, DM, PW, PW, PW}; pg8::StaticOrder S; S.init(SEQ, DM, G, c);
          EpiRes<true> E{args.in[0], nullptr, (bf16_t*)(ws + WS_A1), rp0};
          pg8::gemm_phase(lds, g, S, E, wave); }
        { pg8::Gemm g{(const bf16_t*)(ws + WS_PBF), (const bf16_t*)(ws + WS_WT_P0), SEQ, DM, PLE, PLE, PLE}; pg8::UpperHalfOrder S; S.init(SEQ, DM, G, c);
          EpiPlain E{(bf16_t*)(ws + WS_PE0), DM};
          pg8::gemm_phase(lds, g, S, E, wave); }
        { pg8::Gemm g{(const bf16_t*)(ws + WS_WT_GR), (const bf16_t*)(ws + WS_WU), PW, DM, 1024, 1024, PW}; pg8::CombOrder S; S.init(PW, DM, G, c);
          EpiComb E{(bf16_t*)(ws + WS_WT_PI), DM, args.in[8]};
          pg8::gemm_phase(lds, g, S, E, wave); }
    }
    SEAM(4);
    if (IN(5)) for (int rep_ = 0; rep_ < NDUP(5); ++rep_) { if (rep_) xcd_barrier(bar, wave);
        pg8::Gemm g{(const bf16_t*)(ws + WS_A1), (const bf16_t*)(ws + WS_WT_G0), SEQ, DM, DM, DM, DM}; pg8::StaticOrder S; S.init(SEQ, DM, G, c);
        rstd_table(lds, rp0, S, wave * 64 + lane_id());
        EpiPle E{(const bf16_t*)(ws + WS_A1), (const bf16_t*)(ws + WS_PE0), lds, (bf16_t*)(ws + WS_A2), rp1};
        pg8::gemm_phase(lds, g, S, E, wave);
    }
    SEAM(5);
    if (IN(6)) for (int rep_ = 0; rep_ < NDUP(6); ++rep_) { if (rep_) xcd_barrier(bar, wave);
        pg8::Gemm g{(const bf16_t*)(ws + WS_A2), (const bf16_t*)(ws + WS_WT_PI), SEQ, 2 * PW, DM, DM, DM}; pg8::StaticOrder S; S.init(SEQ, 2 * PW, G, c);
        rstd_table(lds, rp1, S, wave * 64 + lane_id());
        EpiPoolIn E{lds, (bf16_t*)(ws + WS_U), (bf16_t*)(ws + WS_SG1)};
        pg8::gemm_phase(lds, g, S, E, wave);
    }
    SEAM(6);
    if (IN(7)) for (int rep_ = 0; rep_ < NDUP(7); ++rep_) { if (rep_) xcd_barrier(bar, wave); p_pool(args, wave); }
    SEAM(7);
    if (IN(8)) for (int rep_ = 0; rep_ < NDUP(8); ++rep_) { if (rep_) xcd_barrier(bar, wave);
        { pg8::Gemm g{(const bf16_t*)(ws + WS_ZZ), (const bf16_t*)(ws + WS_WT_PO), SEQ, DM, PW, PW, PW}; pg8::StaticOrder S; S.init(SEQ, DM, G, c);
          EpiRes<false> E{nullptr, (const bf16_t*)(ws + WS_A2), (bf16_t*)(ws + WS_A3), rp2};
          pg8::gemm_phase(lds, g, S, E, wave); }
        { pg8::Gemm g{(const bf16_t*)(ws + WS_PBF) + (size_t)SEQ * PLE, (const bf16_t*)(ws + WS_WT_P1), SEQ, DM, PLE, PLE, PLE}; pg8::StaticOrder S; S.init(SEQ, DM, G, c);
          EpiPlain E{(bf16_t*)(ws + WS_PE1), DM};
          pg8::gemm_phase(lds, g, S, E, wave); }
    }
    SEAM(8);
    if (IN(9)) for (int rep_ = 0; rep_ < NDUP(9); ++rep_) { if (rep_) xcd_barrier(bar, wave);
        pg8::Gemm g{(const bf16_t*)(ws + WS_A3), (const bf16_t*)(ws + WS_WT_G1), SEQ, DM, DM, DM, DM}; pg8::StaticOrder S; S.init(SEQ, DM, G, c);
        rstd_table(lds, rp2, S, wave * 64 + lane_id());
        EpiPleFinal E{(const bf16_t*)(ws + WS_A3), (const bf16_t*)(ws + WS_PE1), lds, args.out, args.in[13], (unsigned*)(ws + WS_CTL)};
        pg8::gemm_phase(lds, g, S, E, wave);
    }
#undef IN
#undef SEAM
}

extern "C" void kernel_launch(void* const* d_in, const int* in_sizes, int n_in, void* d_out, int out_size, void* d_ws, size_t ws_size, hipStream_t stream) {
    static int grid = 0;
    if (grid == 0) {
        if (n_in != 14 || out_size != SEQ * DM || ws_size < WS_END) { fprintf(stderr, "kernel_launch: unexpected problem: n_in %d out %d ws %zu (need %zu)\n", n_in, out_size, ws_size, (size_t)WS_END); grid = -1; return; }
        int dev = 0, cus = 0, per_cu = 0;
        if (hipGetDevice(&dev) != hipSuccess || hipDeviceGetAttribute(&cus, hipDeviceAttributeMultiprocessorCount, dev) != hipSuccess) { grid = -1; return; }
        if (hipFuncSetAttribute((const void*)trunk_fwd, hipFuncAttributeMaxDynamicSharedMemorySize, LDS_BYTES) != hipSuccess) { fprintf(stderr, "kernel_launch: hipFuncSetAttribute failed\n"); grid = -1; return; }
        if (hipOccupancyMaxActiveBlocksPerMultiprocessor(&per_cu, (const void*)trunk_fwd, 512, LDS_BYTES) != hipSuccess || per_cu < 1) { fprintf(stderr, "kernel_launch: occupancy query says %d\n", per_cu); (void)hipGetLastError(); }
        grid = cus;
        if (grid != 256) fprintf(stderr, "kernel_launch: %d CUs (built for 256)\n", grid);
    }
    if (grid < 0) return;
    (void)hipMemsetAsync((char*)d_ws + WS_CTL, 0, CTL_ZERO_BYTES, stream);
    Args a{};
    for (int i = 0; i < 14; ++i) a.in[i] = (const float*)d_in[i];
    a.out = (float*)d_out; a.ws = (unsigned char*)d_ws;
    for (int i = 0; i < 128; ++i) { const float lin = (float)i * (1.0f / 127.0f); a.freq[i] = (float)pow(10000.0, -(double)lin); }
    for (int h = 0; h < 8; ++h) { const double lg = log2(1.0 - pow(2.0, -5.0 - (double)h)); a.l2g[h] = (float)lg; a.g256[h] = (float)exp2(256.0 * lg); }
    constexpr int NPH = 10;
    if (MK_N_LAUNCHES == 1) {
        a.ph_lo = 0; a.ph_hi = NPH;
        hipLaunchKernelGGL(trunk_fwd, dim3(grid), dim3(512), LDS_BYTES, stream, a);
    } else {
        for (int ph = 0; ph < NPH; ++ph) { a.ph_lo = ph; a.ph_hi = ph + 1; hipLaunchKernelGGL(trunk_fwd, dim3(grid), dim3(512), LDS_BYTES, stream, a); }
    }
}
```

```cpp
#include <hip/hip_runtime.h>
#include <cstdio>
#include <cstdint>
#include <cmath>

#ifndef MK_N_LAUNCHES
#define MK_N_LAUNCHES 1
#define CV_BIG 1
#endif

#define LAS __attribute__((address_space(3)))
#define GAS __attribute__((address_space(1)))
typedef unsigned short bf16_t;
typedef short bf16x8 __attribute__((ext_vector_type(8)));
typedef short s16x4 __attribute__((ext_vector_type(4)));
typedef float f32x4 __attribute__((ext_vector_type(4)));
typedef float f32x2 __attribute__((ext_vector_type(2)));
typedef unsigned u32x4 __attribute__((ext_vector_type(4)));
typedef unsigned u32x2 __attribute__((ext_vector_type(2)));

constexpr int SEQ = 8192, DM = 2048, RPROJ = 12288, NH = 8, DKH = 256, DVH = 512, PW = 4096, PLE = 256;
constexpr float NORM_EPS = 1e-6f, GN_EPS = 1e-5f;

constexpr size_t MiB = 1u << 20;
constexpr size_t WS_CTL = 0, CTL_ZERO_BYTES = 128 * 1024;
constexpr size_t WS_RP = 1 * MiB;
constexpr size_t WS_ROPE = 5 * MiB;
constexpr size_t WS_PBF = 13 * MiB;
constexpr size_t WS_WT_RO = 21 * MiB;
constexpr size_t WS_WT_G0 = 37 * MiB;
constexpr size_t WS_WT_P0 = 45 * MiB;
constexpr size_t WS_WT_RI = 46 * MiB;
constexpr size_t WS_XN0 = 94 * MiB;
constexpr size_t WS_QD = 126 * MiB, WS_KD = 158 * MiB, WS_V = 190 * MiB, WS_SG = 254 * MiB;
constexpr size_t WS_Z = WS_SG;
constexpr size_t WS_ST = 318 * MiB;
constexpr size_t WS_WU = 46 * MiB;
constexpr size_t WS_WT_PI = 62 * MiB;
constexpr size_t WS_WT_GR = 94 * MiB, WS_WT_PO = 102 * MiB, WS_WT_G1 = 118 * MiB, WS_WT_P1 = 382 * MiB;
constexpr size_t WS_H1 = 126 * MiB, WS_A1 = 190 * MiB, WS_PE0 = 222 * MiB;
constexpr size_t WS_H2 = 254 * MiB, WS_A2 = 318 * MiB;
constexpr size_t WS_U = 126 * MiB, WS_SG1 = 190 * MiB, WS_ZZ = 254 * MiB;
constexpr size_t WS_H3 = 126 * MiB, WS_A3 = 190 * MiB, WS_PE1 = 222 * MiB;
constexpr size_t WS_END = 383 * MiB;

constexpr int RING_BYTES = 131072;
constexpr int LDS_BYTES = 155648;
constexpr int MISC_OFF = LDS_BYTES - 256;

#define LDS_WAIT() asm volatile("s_waitcnt lgkmcnt(0)" ::: "memory")
#define VM_WAIT() asm volatile("s_waitcnt vmcnt(0)" ::: "memory")

__device__ __forceinline__ unsigned cvt_pk_bf16(float lo, float hi) { unsigned r; asm volatile("v_cvt_pk_bf16_f32 %0, %1, %2" : "=v"(r) : "v"(lo), "v"(hi)); return r; }
__device__ __forceinline__ float bf_lo(unsigned w) { return __uint_as_float(w << 16); }
__device__ __forceinline__ float bf_hi(unsigned w) { return __uint_as_float(w & 0xffff0000u); }
__device__ __forceinline__ float fsigmoid(float x) { return __builtin_amdgcn_rcpf(1.0f + __builtin_amdgcn_exp2f(-1.44269504089f * x)); }
__device__ __forceinline__ float fsilu(float x) { return x * fsigmoid(x); }
__device__ __forceinline__ int lane_id() { int l; asm volatile("v_mbcnt_lo_u32_b32 %0, -1, 0\n\tv_mbcnt_hi_u32_b32 %0, -1, %0" : "=v"(l)); return l; }
__device__ __forceinline__ float wave_sum(float v) {
#pragma unroll
    for (int o = 1; o < 64; o <<= 1) v += __shfl_xor(v, o);
    return v;
}

namespace pg8 {
constexpr int BM = 256, BK = 64, HALF = 128, HTB = HALF * BK * 2, STAGE_BYTES = 8 * HTB, NXCD = 8, WGM = 8;
__host__ __device__ __forceinline__ int lds_byte(int r, int c) { const int st = (r >> 4) * 2 + (c >> 5), rr = r & 15, cc = c & 31, ob = rr * 64 + cc * 2; return st * 1024 + (ob ^ (((ob >> 9) & 1) << 5)); }
__host__ __device__ __forceinline__ void stage_rc(int b, int& R, int& C) { const int st = b / 1024, sb = b % 1024, swz = sb ^ (((sb >> 9) & 1) << 5); R = (st >> 1) * 16 + swz / 64; C = (st & 1) * 32 + (swz % 64) / 2; }
__host__ __device__ __forceinline__ int perm32(int rho) { const int n = rho >> 4, i = rho & 15; return 8 * (i >> 2) + 4 * n + (i & 3); }

struct Unit { int pm, pn, slot; };
struct Gemm { const bf16_t* A; const bf16_t* Bt; int M, N, K, lda, ldb; };

struct StaticOrder {
    int nM, nN, nwg, G, c;
    __host__ __device__ void init(int M, int N, int G_, int c_) { nM = M / BM; nN = N / BM; nwg = nM * nN; G = G_; c = c_; }
    __host__ __device__ bool next(int i, Unit& u) const {
        const long L = (long)i * G + c; if (L >= nwg) return false;
        int wgid = (int)L; { const int q = nwg / NXCD, r = nwg % NXCD, xcd = wgid % NXCD, off = wgid / NXCD; wgid = (xcd < r ? xcd * (q + 1) : r * (q + 1) + (xcd - r) * q) + off; }
        const int nig = WGM * nN, gid = wgid / nig, fm = gid * WGM, gsz = (nM - fm) < WGM ? (nM - fm) : WGM;
        u.pm = fm + ((wgid % nig) % gsz); u.pn = (wgid % nig) / gsz; u.slot = i; return true;
    }
    __device__ __forceinline__ size_t a_off(const Unit&) const { return 0; }
    __device__ __forceinline__ size_t b_off(const Unit&) const { return 0; }
};
struct UpperHalfOrder : StaticOrder {
    __host__ __device__ bool next(int i, Unit& u) const { const int hw = G >> 1, per = nwg / hw; if (c < hw || i >= per) return false; const int L = (c - hw) * per + i; u.pm = L / nN; u.pn = L - u.pm * nN; u.slot = i; return true; }
};
struct CombOrder : StaticOrder {
    __device__ __forceinline__ size_t b_off(const Unit& u) const { return (size_t)(u.pm >> 2) * 2048; }
};

template <class Epi, class Sched, int EPI_REPS = 1>
__device__ __forceinline__ void gemm_phase(LAS unsigned char* lds, const Gemm g, const Sched& S, const Epi& E, const int wid) {
    int lane_ = lane_id(); asm volatile("" : "+v"(lane_));
    const int lane = lane_, tid = wid * 64 + lane, wr = wid >> 2, wc = wid & 3, fr = lane & 15, fq = lane >> 4;
    const int K = g.K, nt = K / BK;
    unsigned voffA[2], voffB[2];
#pragma unroll
    for (int i = 0; i < 2; ++i) { int R, C; stage_rc(tid * 16 + i * 8192, R, C); const int Rb = (R & ~31) + perm32(R & 31);
        voffA[i] = (unsigned)(R * g.lda + C) * 2u; voffB[i] = (unsigned)(Rb * g.ldb + C) * 2u; }
    const size_t kstep = (size_t)(BK * 2);
    const size_t hstepA = (size_t)HALF * g.lda * 2, hstepB = (size_t)HALF * g.ldb * 2;
    const size_t tstepA = 2 * hstepA, tstepB = 2 * hstepB;
    const unsigned ldsw = (unsigned)wid * 1024u;
    const int aoff = lds_byte(wr * 64 + fr, fq * 8), boff = lds_byte(wc * 32 + fr, fq * 8);
#define PG8_SA(b, h) (((b) * 2 + (h)) * HTB)
#define PG8_SB(b, h) ((4 + (b) * 2 + (h)) * HTB)
#define PG8_STAGE(bufoff, gbase, voff) do { _Pragma("unroll") for (int _i = 0; _i < 2; ++_i) \
        __builtin_amdgcn_global_load_lds((const unsigned*)((const char*)(gbase) + (voff)[_i]), (LAS unsigned*)(lds + (bufoff) + ldsw + _i * 8192), 16, 0, 0); } while (0)
#define PG8_LDA(dst, b, h) do { _Pragma("unroll") for (int m = 0; m < 4; ++m) _Pragma("unroll") for (int k = 0; k < 2; ++k) dst[m][k] = *(const LAS bf16x8*)(lds + PG8_SA(b, h) + aoff + m * 2048 + k * 1024); } while (0)
#define PG8_LDB(dst, b, h) do { _Pragma("unroll") for (int n = 0; n < 2; ++n) _Pragma("unroll") for (int k = 0; k < 2; ++k) dst[n][k] = *(const LAS bf16x8*)(lds + PG8_SB(b, h) + boff + n * 2048 + k * 1024); } while (0)
#define PG8_MMA(ai, bj, At, Bt) do { __builtin_amdgcn_s_setprio(1); _Pragma("unroll") for (int m = 0; m < 4; ++m) _Pragma("unroll") for (int n = 0; n < 2; ++n) _Pragma("unroll") for (int k = 0; k < 2; ++k) \
        acc[ai][bj][m][n] = __builtin_amdgcn_mfma_f32_16x16x32_bf16(Bt[n][k], At[m][k], acc[ai][bj][m][n], 0, 0, 0); __builtin_amdgcn_s_setprio(0); } while (0)
#define PG8_WAIT_V(n) asm volatile("s_waitcnt vmcnt(" #n ")" ::: "memory")
#define PG8_WAIT_L(n) asm volatile("s_waitcnt lgkmcnt(" #n ")" ::: "memory")
#define PG8_BAR __builtin_amdgcn_s_barrier()
#define PG8_SCHED __builtin_amdgcn_sched_barrier(0)
    Unit cur, nxt; int ui = 0;
    if (!S.next(0, cur)) return;
    f32x4 acc[2][2][4][2];
#pragma unroll
    for (int a = 0; a < 2; ++a)
#pragma unroll
        for (int b = 0; b < 2; ++b)
#pragma unroll
            for (int m = 0; m < 4; ++m)
#pragma unroll
                for (int n = 0; n < 2; ++n) acc[a][b][m][n] = (f32x4){0.f, 0.f, 0.f, 0.f};
    bf16x8 At[4][2], B0[2][2], B1[2][2];
    const char* cA = (const char*)g.A + (size_t)cur.pm * tstepA + S.a_off(cur); const char* cB = (const char*)g.Bt + (size_t)cur.pn * tstepB + S.b_off(cur);
    PG8_STAGE(PG8_SB(0, 0), cB, voffB); PG8_STAGE(PG8_SB(0, 1), cB + hstepB, voffB); PG8_STAGE(PG8_SA(0, 0), cA, voffA); PG8_STAGE(PG8_SA(0, 1), cA + hstepA, voffA);
    if (wr == 1) PG8_BAR;
    PG8_WAIT_V(2); PG8_BAR;
    PG8_STAGE(PG8_SB(1, 0), cB + kstep, voffB); PG8_STAGE(PG8_SA(1, 0), cA + kstep, voffA); PG8_STAGE(PG8_SB(1, 1), cB + hstepB + kstep, voffB);
    PG8_WAIT_V(6); PG8_BAR;
    for (;;) {
        const bool has_next = S.next(ui + 1, nxt);
        const char* nA = has_next ? (const char*)g.A + (size_t)nxt.pm * tstepA + S.a_off(nxt) : cA; const char* nB = has_next ? (const char*)g.Bt + (size_t)nxt.pn * tstepB + S.b_off(nxt) : cB;
        for (int t = 0; t < nt; t += 2) {
            const bool last = (t == nt - 2);
            const char* a1 = cA + (size_t)(t + 1) * kstep;
            const char* a2 = last ? nA : cA + (size_t)(t + 2) * kstep; const char* b2 = last ? nB : cB + (size_t)(t + 2) * kstep;
            const char* a3 = a2 + kstep; const char* b3 = b2 + kstep;
            PG8_LDB(B0, 0, 0); PG8_LDB(B1, 0, 1); PG8_SCHED; PG8_LDA(At, 0, 0); PG8_STAGE(PG8_SA(1, 1), a1 + hstepA, voffA);
            PG8_WAIT_V(8); PG8_WAIT_L(0); PG8_BAR; PG8_MMA(0, 0, At, B0); PG8_MMA(0, 1, At, B1); PG8_BAR; PG8_SCHED;
            PG8_LDA(At, 0, 1); PG8_STAGE(PG8_SB(0, 0), b2, voffB); PG8_STAGE(PG8_SB(0, 1), b2 + hstepB, voffB); PG8_STAGE(PG8_SA(0, 0), a2, voffA);
            PG8_WAIT_V(8); PG8_WAIT_L(0); PG8_BAR; PG8_MMA(1, 0, At, B0); PG8_MMA(1, 1, At, B1); PG8_BAR; PG8_SCHED;
            PG8_LDB(B0, 1, 0); PG8_LDB(B1, 1, 1); PG8_SCHED; PG8_LDA(At, 1, 0); PG8_STAGE(PG8_SA(0, 1), a2 + hstepA, voffA);
            PG8_WAIT_V(8); PG8_WAIT_L(0); PG8_BAR; PG8_MMA(0, 0, At, B0); PG8_MMA(0, 1, At, B1); PG8_BAR; PG8_SCHED;
            PG8_LDA(At, 1, 1); PG8_STAGE(PG8_SB(1, 0), b3, voffB); PG8_STAGE(PG8_SB(1, 1), b3 + hstepB, voffB); PG8_STAGE(PG8_SA(1, 0), a3, voffA);
            PG8_WAIT_V(8); PG8_WAIT_L(0); PG8_BAR; PG8_MMA(1, 0, At, B0); PG8_MMA(1, 1, At, B1); PG8_BAR; PG8_SCHED;
        }
        if (wr == 0) PG8_BAR;
        for (int er_ = 0; er_ < EPI_REPS; ++er_) { int fr2 = fr, fq2 = fq; asm volatile("" : "+v"(fr2), "+v"(fq2)); E(acc, cur, wr, wc, fr2, fq2); }
        if (!has_next) break;
#pragma unroll
        for (int a = 0; a < 2; ++a)
#pragma unroll
            for (int b = 0; b < 2; ++b)
#pragma unroll
                for (int m = 0; m < 4; ++m)
#pragma unroll
                    for (int n = 0; n < 2; ++n) acc[a][b][m][n] = (f32x4){0.f, 0.f, 0.f, 0.f};
        cur = nxt; cA = nA; cB = nB; ++ui;
        if (wr == 1) PG8_BAR;
    }
    PG8_WAIT_V(0);
    PG8_BAR;
#undef PG8_SA
#undef PG8_SB
#undef PG8_STAGE
#undef PG8_LDA
#undef PG8_LDB
#undef PG8_MMA
#undef PG8_WAIT_V
#undef PG8_WAIT_L
#undef PG8_BAR
#undef PG8_SCHED
}
}
using pg8::Unit;

#define EPI_ARGS f32x4 (&acc)[2][2][4][2], const Unit& u, int wr, int wc, int fr, int fq
__device__ __forceinline__ u32x4 pack8(const f32x4 a, const f32x4 b) { u32x4 w; w.x = cvt_pk_bf16(a[0], a[1]); w.y = cvt_pk_bf16(a[2], a[3]); w.z = cvt_pk_bf16(b[0], b[1]); w.w = cvt_pk_bf16(b[2], b[3]); return w; }
__device__ __forceinline__ void unpack8(const u32x4 w, f32x4& a, f32x4& b) { a = (f32x4){bf_lo(w.x), bf_hi(w.x), bf_lo(w.y), bf_hi(w.y)}; b = (f32x4){bf_lo(w.z), bf_hi(w.z), bf_lo(w.w), bf_hi(w.w)}; }
__device__ __forceinline__ float row_rstd(const float* rp, int row) {
    const f32x4* q = (const f32x4*)(rp + (size_t)row * 32); f32x4 s = q[0];
#pragma unroll
    for (int i = 1; i < 8; ++i) s += q[i];
    return __builtin_amdgcn_rsqf(((s[0] + s[1]) + (s[2] + s[3])) * (1.0f / DM) + NORM_EPS);
}
constexpr int RSTD_OFF = RING_BYTES;
template <class Sched> __device__ __forceinline__ void rstd_table(LAS unsigned char* lds, const float* rp, const Sched& S, int tid) {
    LAS float* tab = (LAS float*)(lds + RSTD_OFF); Unit u;
    for (int i = 0; i < 8 && S.next(i, u); ++i) if (tid < 256) tab[i * 256 + tid] = row_rstd(rp, u.pm * 256 + tid);
    __syncthreads();
}
__device__ __forceinline__ float rstd_lds(const LAS unsigned char* lds, int slot, int r) { return ((const LAS float*)(lds + RSTD_OFF))[slot * 256 + r]; }

struct EpiRet1 {
    bf16_t *qd, *kd, *v, *sg; const float* rope; const float* l2g;
    __device__ __forceinline__ void operator()(EPI_ARGS) const {
        const int pn = u.pn, row0 = u.pm * 256 + wr * 64 + fr, c0 = wc * 32 + 8 * fq;
        if (pn < 16) {
            const int head = pn & 7; const bool isk = pn >= 8;
            bf16_t* out = (isk ? kd : qd) + head * 256; const float lg = l2g[head];
#pragma unroll
            for (int ai = 0; ai < 2; ++ai)
#pragma unroll
                for (int m = 0; m < 4; ++m) { const int row = row0 + ai * 128 + m * 16, r = row & 255;
                    const float dec = isk ? __builtin_amdgcn_exp2f(lg * (float)(255 - r)) * 0.0625f : __builtin_amdgcn_exp2f(lg * (float)(r - 255));
#pragma unroll
                    for (int bj = 0; bj < 2; ++bj) { const int c = c0 + bj * 128;
                        const f32x4* rp = (const f32x4*)(rope + ((size_t)row * 128 + (c >> 1)) * 2); const f32x4 t0 = rp[0], t1 = rp[1];
                        const f32x4 x = acc[ai][bj][m][0], y = acc[ai][bj][m][1]; f32x4 o0, o1;
                        o0[0] = (x[0] * t0[0] - x[1] * t0[1]) * dec; o0[1] = (x[1] * t0[0] + x[0] * t0[1]) * dec;
                        o0[2] = (x[2] * t0[2] - x[3] * t0[3]) * dec; o0[3] = (x[3] * t0[2] + x[2] * t0[3]) * dec;
                        o1[0] = (y[0] * t1[0] - y[1] * t1[1]) * dec; o1[1] = (y[1] * t1[0] + y[0] * t1[1]) * dec;
                        o1[2] = (y[2] * t1[2] - y[3] * t1[3]) * dec; o1[3] = (y[3] * t1[2] + y[2] * t1[3]) * dec;
                        *(u32x4*)(out + (size_t)row * DM + c) = pack8(o0, o1); } }
        } else if (pn < 32) {
            bf16_t* out = v + (pn - 16) * 256 + c0;
#pragma unroll
            for (int ai = 0; ai < 2; ++ai)
#pragma unroll
                for (int m = 0; m < 4; ++m) { const int row = row0 + ai * 128 + m * 16;
#pragma unroll
                    for (int bj = 0; bj < 2; ++bj) *(u32x4*)(out + (size_t)row * PW + bj * 128) = pack8(acc[ai][bj][m][0], acc[ai][bj][m][1]); }
        } else {
            bf16_t* out = sg + (pn - 32) * 256 + c0;
#pragma unroll
            for (int ai = 0; ai < 2; ++ai)
#pragma unroll
                for (int m = 0; m < 4; ++m) { const int row = row0 + ai * 128 + m * 16;
#pragma unroll
                    for (int bj = 0; bj < 2; ++bj) { f32x4 a = acc[ai][bj][m][0], b = acc[ai][bj][m][1];
#pragma unroll
                        for (int e = 0; e < 4; ++e) { a[e] = fsilu(a[e]); b[e] = fsilu(b[e]); }
                        *(u32x4*)(out + (size_t)row * PW + bj * 128) = pack8(a, b); } }
        }
    }
};
struct EpiPlain {
    bf16_t* O; int ldc;
    __device__ __forceinline__ void operator()(EPI_ARGS) const {
        bf16_t* out = O + (size_t)(u.pm * 256 + wr * 64 + fr) * ldc + u.pn * 256 + wc * 32 + 8 * fq;
#pragma unroll
        for (int ai = 0; ai < 2; ++ai)
#pragma unroll
            for (int m = 0; m < 4; ++m)
#pragma unroll
                for (int bj = 0; bj < 2; ++bj) *(u32x4*)(out + (size_t)(ai * 128 + m * 16) * ldc + bj * 128) = pack8(acc[ai][bj][m][0], acc[ai][bj][m][1]);
    }
};
template <bool RESF> struct EpiRes {
    const float* resf; const bf16_t* resb; bf16_t* aout; float* rpo;
    __device__ __forceinline__ void operator()(EPI_ARGS) const {
        const int row0 = u.pm * 256 + wr * 64 + fr, col0 = u.pn * 256 + wc * 32 + 8 * fq;
#pragma unroll
        for (int ai = 0; ai < 2; ++ai) {
            f32x4 rv[4][2][2];
#pragma unroll
            for (int m = 0; m < 4; ++m)
#pragma unroll
                for (int bj = 0; bj < 2; ++bj) { const size_t o = (size_t)(row0 + ai * 128 + m * 16) * DM + col0 + bj * 128;
                    if (RESF) { rv[m][bj][0] = __builtin_nontemporal_load((const f32x4*)(resf + o)); rv[m][bj][1] = __builtin_nontemporal_load((const f32x4*)(resf + o + 4)); }
                    else unpack8(*(const u32x4*)(resb + o), rv[m][bj][0], rv[m][bj][1]); }
#pragma unroll
            for (int m = 0; m < 4; ++m) { const int row = row0 + ai * 128 + m * 16; const size_t off = (size_t)row * DM + col0; float ss = 0.f;
#pragma unroll
                for (int bj = 0; bj < 2; ++bj) { const size_t o = off + bj * 128;
                    const f32x4 h0 = rv[m][bj][0] + acc[ai][bj][m][0], h1 = rv[m][bj][1] + acc[ai][bj][m][1];
                    ss += (h0[0] * h0[0] + h0[1] * h0[1]) + (h0[2] * h0[2] + h0[3] * h0[3]) + (h1[0] * h1[0] + h1[1] * h1[1]) + (h1[2] * h1[2] + h1[3] * h1[3]);
                    *(u32x4*)(aout + o) = pack8(h0, h1); }
                ss += __shfl_xor(ss, 16); ss += __shfl_xor(ss, 32);
                if (fq == 0) rpo[(size_t)row * 32 + u.pn * 4 + wc] = ss; }
            asm volatile("" ::: "memory"); }
    }
};
struct EpiPle {
    const bf16_t* hin; const bf16_t* pe; const LAS unsigned char* lds; bf16_t* aout; float* rpo;
    __device__ __forceinline__ void operator()(EPI_ARGS) const {
        const int row0 = u.pm * 256 + wr * 64 + fr, col0 = u.pn * 256 + wc * 32 + 8 * fq;
#pragma unroll
        for (int ai = 0; ai < 2; ++ai) {
            u32x4 hv[4][2], pv[4][2];
#pragma unroll
            for (int m = 0; m < 4; ++m)
#pragma unroll
                for (int bj = 0; bj < 2; ++bj) { const size_t o = (size_t)(row0 + ai * 128 + m * 16) * DM + col0 + bj * 128; hv[m][bj] = *(const u32x4*)(hin + o); pv[m][bj] = *(const u32x4*)(pe + o); }
#pragma unroll
            for (int m = 0; m < 4; ++m) { const int row = row0 + ai * 128 + m * 16; const size_t off = (size_t)row * DM + col0; float ss = 0.f;
                const float rstd = rstd_lds(lds, u.slot, row & 255);
#pragma unroll
                for (int bj = 0; bj < 2; ++bj) { const size_t o = off + bj * 128;
                    f32x4 h0, h1, p0, p1; unpack8(hv[m][bj], h0, h1); unpack8(pv[m][bj], p0, p1);
                    const f32x4 a0 = acc[ai][bj][m][0], a1 = acc[ai][bj][m][1];
#pragma unroll
                    for (int e = 0; e < 4; ++e) { h0[e] += fsigmoid(a0[e] * rstd) * p0[e]; h1[e] += fsigmoid(a1[e] * rstd) * p1[e]; }
                    ss += (h0[0] * h0[0] + h0[1] * h0[1]) + (h0[2] * h0[2] + h0[3] * h0[3]) + (h1[0] * h1[0] + h1[1] * h1[1]) + (h1[2] * h1[2] + h1[3] * h1[3]);
                    *(u32x4*)(aout + o) = pack8(h0, h1); }
                ss += __shfl_xor(ss, 16); ss += __shfl_xor(ss, 32);
                if (fq == 0) rpo[(size_t)row * 32 + u.pn * 4 + wc] = ss; }
            asm volatile("" ::: "memory"); }
    }
};
constexpr int FN_P_OFF = RING_BYTES + 8192, FN_S_OFF = FN_P_OFF + 4096;
constexpr int CW_FN_CNT = 16384, CW_FN_X = 32768;
struct EpiPleFinal {
    const bf16_t* hin; const bf16_t* pe; LAS unsigned char* lds; float* out; const float* gain; unsigned* ctl;
    __device__ __forceinline__ void operator()(EPI_ARGS) const {
        const int row0 = u.pm * 256 + wr * 64 + fr, col0 = u.pn * 256 + wc * 32 + 8 * fq;
        const int wid = wr * 4 + wc, tid = wid * 64 + fq * 16 + fr;
        LAS float* P = (LAS float*)(lds + FN_P_OFF); LAS float* S = (LAS float*)(lds + FN_S_OFF);
#pragma unroll
        for (int ai = 0; ai < 2; ++ai)
#pragma unroll
            for (int mp = 0; mp < 2; ++mp) {
                u32x4 hv[2][2], pv[2][2];
#pragma unroll
                for (int mm = 0; mm < 2; ++mm)
#pragma unroll
                    for (int bj = 0; bj < 2; ++bj) { const size_t o = (size_t)(row0 + ai * 128 + (2 * mp + mm) * 16) * DM + col0 + bj * 128;
                        hv[mm][bj] = *(const u32x4*)(hin + o); pv[mm][bj] = *(const u32x4*)(pe + o); }
#pragma unroll
                for (int mm = 0; mm < 2; ++mm) { const int m = 2 * mp + mm, row = row0 + ai * 128 + m * 16; float ss = 0.f;
                    const float rstd = rstd_lds(lds, u.slot, row & 255);
#pragma unroll
                    for (int bj = 0; bj < 2; ++bj) {
                        f32x4 h0, h1, p0, p1; unpack8(hv[mm][bj], h0, h1); unpack8(pv[mm][bj], p0, p1);
                        const f32x4 a0 = acc[ai][bj][m][0], a1 = acc[ai][bj][m][1];
#pragma unroll
                        for (int e = 0; e < 4; ++e) { h0[e] += fsigmoid(a0[e] * rstd) * p0[e]; h1[e] += fsigmoid(a1[e] * rstd) * p1[e]; }
                        acc[ai][bj][m][0] = h0; acc[ai][bj][m][1] = h1;
                        ss += (h0[0] * h0[0] + h0[1] * h0[1]) + (h0[2] * h0[2] + h0[3] * h0[3]) + (h1[0] * h1[0] + h1[1] * h1[1]) + (h1[2] * h1[2] + h1[3] * h1[3]); }
                    ss += __shfl_xor(ss, 16); ss += __shfl_xor(ss, 32);
                    if (fq == 0) P[(row & 255) * 4 + wc] = ss; }
                asm volatile("" ::: "memory"); }
        asm volatile("s_waitcnt lgkmcnt(0)" ::: "memory"); __builtin_amdgcn_s_barrier(); asm volatile("" ::: "memory");
        float* X = (float*)(ctl + CW_FN_X); unsigned* cnt = ctl + CW_FN_CNT + 64 * u.pm;
        if (tid < 256) { const float t = (P[tid * 4 + 0] + P[tid * 4 + 1]) + (P[tid * 4 + 2] + P[tid * 4 + 3]);
            __hip_atomic_store(X + ((size_t)(u.pm * 256 + tid) * 8 + u.pn), t, __ATOMIC_RELAXED, __HIP_MEMORY_SCOPE_AGENT);
            asm volatile("s_waitcnt vmcnt(0)" ::: "memory");
            if ((tid & 63) == 0) __hip_atomic_fetch_add(cnt, 1u, __ATOMIC_RELAXED, __HIP_MEMORY_SCOPE_AGENT); }
        if (wid == 0) {
            unsigned spins = 0;
            while ((unsigned)__builtin_amdgcn_readfirstlane(__hip_atomic_load(cnt, __ATOMIC_RELAXED, __HIP_MEMORY_SCOPE_AGENT)) < 32u) { __builtin_amdgcn_s_sleep(2); if (++spins > (1u << 22)) break; }
            __builtin_amdgcn_fence(__ATOMIC_ACQUIRE, "agent");
            asm volatile("s_waitcnt vmcnt(0)" ::: "memory"); }
        asm volatile("s_waitcnt vmcnt(0) lgkmcnt(0)" ::: "memory"); __builtin_amdgcn_s_barrier(); asm volatile("" ::: "memory");
        if (tid < 256) { const float* xs = X + (size_t)(u.pm * 256 + tid) * 8; float s = 0.f;
#pragma unroll
            for (int t = 0; t < 8; ++t) s += __hip_atomic_load(xs + t, __ATOMIC_RELAXED, __HIP_MEMORY_SCOPE_AGENT);
            S[tid] = __builtin_amdgcn_rsqf(s * (1.0f / DM) + NORM_EPS); }
        asm volatile("s_waitcnt lgkmcnt(0)" ::: "memory"); __builtin_amdgcn_s_barrier(); asm volatile("" ::: "memory");
        f32x4 gv[2][2];
#pragma unroll
        for (int bj = 0; bj < 2; ++bj) { gv[bj][0] = *(const f32x4*)(gain + col0 + bj * 128); gv[bj][1] = *(const f32x4*)(gain + col0 + bj * 128 + 4); }
#pragma unroll
        for (int ai = 0; ai < 2; ++ai)
#pragma unroll
            for (int m = 0; m < 4; ++m) { const int row = row0 + ai * 128 + m * 16; const float rs = S[row & 255]; const size_t off = (size_t)row * DM + col0;
#pragma unroll
                for (int bj = 0; bj < 2; ++bj) { *(f32x4*)(out + off + bj * 128) = acc[ai][bj][m][0] * rs * gv[bj][0]; *(f32x4*)(out + off + bj * 128 + 4) = acc[ai][bj][m][1] * rs * gv[bj][1]; } }
    }
};
struct EpiPoolIn {
    const LAS unsigned char* lds; bf16_t* uo; bf16_t* sgo;
    __device__ __forceinline__ void operator()(EPI_ARGS) const {
        const int row0 = u.pm * 256 + wr * 64 + fr; const bool isg = u.pn >= 16;
        bf16_t* out = (isg ? sgo : uo) + (u.pn & 15) * 256 + wc * 32 + 8 * fq;
#pragma unroll
        for (int ai = 0; ai < 2; ++ai)
#pragma unroll
            for (int m = 0; m < 4; ++m) { const int row = row0 + ai * 128 + m * 16; const float rstd = rstd_lds(lds, u.slot, row & 255);
#pragma unroll
                for (int bj = 0; bj < 2; ++bj) { f32x4 a = acc[ai][bj][m][0] * rstd, b = acc[ai][bj][m][1] * rstd;
                    if (isg) {
#pragma unroll
                        for (int e = 0; e < 4; ++e) { a[e] = fsilu(a[e]); b[e] = fsilu(b[e]); } }
                    *(u32x4*)(out + (size_t)row * PW + bj * 128) = pack8(a, b); } }
    }
};
struct EpiComb {
    bf16_t* O; int ldc; const float* scale;
    __device__ __forceinline__ void operator()(EPI_ARGS) const {
        const int row0 = u.pm * 256 + wr * 64 + fr;
        bf16_t* out = O + (size_t)row0 * ldc + u.pn * 256 + wc * 32 + 8 * fq;
#pragma unroll
        for (int ai = 0; ai < 2; ++ai)
#pragma unroll
            for (int m = 0; m < 4; ++m) { const float sc = scale[row0 + ai * 128 + m * 16];
#pragma unroll
                for (int bj = 0; bj < 2; ++bj) *(u32x4*)(out + (size_t)(ai * 128 + m * 16) * ldc + bj * 128) = pack8(acc[ai][bj][m][0] * sc, acc[ai][bj][m][1] * sc); }
    }
};

typedef GAS unsigned gu32;
#define RLX_AGENT __ATOMIC_RELAXED, __HIP_MEMORY_SCOPE_AGENT
#define XB_TMO      128
#define XB_XCNT(j)  (256  + 64 * (j))
#define XB_XSUB(j)  (1280 + 64 * (j))
#define XB_XGEN(j)  (2304 + 64 * (j))
#define XB_TOP      3328
#define XB_TOPGEN   3392
#define XCD_BAR_WORDS 3456
#define XB_SPIN_CAP (1u << 20)
__device__ __forceinline__ unsigned xb_ld(unsigned* p)              { return __hip_atomic_load(p, __ATOMIC_RELAXED, __HIP_MEMORY_SCOPE_AGENT); }
__device__ __forceinline__ unsigned xb_add(unsigned* p, unsigned v) { return __hip_atomic_fetch_add(p, v, __ATOMIC_RELAXED, __HIP_MEMORY_SCOPE_AGENT); }
__device__ __forceinline__ unsigned xb_xcc_id() { return (unsigned)__builtin_amdgcn_s_getreg((3 << 11) | 20) & 0xFu; }
#define XB_SPIN(cond, bar) do { unsigned _sp = 0; while (cond) { __builtin_amdgcn_s_sleep(1); \
    if ((++_sp & 255u) == 0u) { if (xb_ld(&(bar)[XB_TMO])) break; if (_sp > XB_SPIN_CAP) { atomicAdd(&(bar)[XB_TMO], 1u); break; } } } } while (0)
struct XcdBarrier { unsigned* bar; unsigned x; volatile LAS unsigned* st; };
__device__ __forceinline__ XcdBarrier xcd_barrier_post(unsigned* bar, volatile LAS unsigned* st, const int wave) {
    XcdBarrier b; b.bar = bar; b.x = xb_xcc_id(); b.st = st;
    if (wave == 0 && lane_id() == 0) (void)xb_add(&bar[XB_XCNT(b.x)], 1u);
    return b;
}
__device__ __forceinline__ void xcd_barrier_complete(unsigned* bar, unsigned x, unsigned& nloc, unsigned& nx) {
    const unsigned G = gridDim.x * gridDim.y * gridDim.z;
    unsigned sum, cnt, mine, sp = 0u;
    for (;;) {
        sum = 0u; cnt = 0u; mine = 0u;
#pragma unroll
        for (unsigned j = 0; j < 16; ++j) { const unsigned c = xb_ld(&bar[XB_XCNT(j)]); sum += c; cnt += (c > 0u) ? 1u : 0u; mine = (j == x) ? c : mine; }
        if (sum == G) break;
        __builtin_amdgcn_s_sleep(1);
        if ((++sp & 255u) == 0u) { if (xb_ld(&bar[XB_TMO])) break; if (sp > XB_SPIN_CAP) { atomicAdd(&bar[XB_TMO], 1u); break; } }
    }
    nloc = mine > 0u ? mine : 1u; nx = cnt > 0u ? cnt : 1u;
}
__device__ __forceinline__ void xcd_barrier(const XcdBarrier& b, const int wave) {
    asm volatile("s_waitcnt vmcnt(0)" ::: "memory");
    __syncthreads();
    if (wave == 0 && lane_id() == 0) {
        unsigned* bar = b.bar;
        __builtin_amdgcn_s_waitcnt(0);
        unsigned nloc = b.st[0], nx = b.st[1];
        if (nloc == 0u) { xcd_barrier_complete(bar, b.x, nloc, nx); b.st[0] = nloc; b.st[1] = nx; }
        const unsigned old = xb_add(&bar[XB_XSUB(b.x)], 1u);
        const unsigned gen = old / nloc;
        if (old + 1u == (gen + 1u) * nloc) {
            __builtin_amdgcn_fence(__ATOMIC_RELEASE, "agent");
            asm volatile("s_waitcnt vmcnt(0)" ::: "memory");
            const unsigned og = xb_add(&bar[XB_TOP], 1u);
            const unsigned tg = og / nx;
            if (og + 1u == (tg + 1u) * nx) xb_add(&bar[XB_TOPGEN], 1u);
            else XB_SPIN(xb_ld(&bar[XB_TOPGEN]) == tg, bar);
            __builtin_amdgcn_fence(__ATOMIC_ACQUIRE, "agent");
            xb_add(&bar[XB_XGEN(b.x)], 1u);
            asm volatile("s_waitcnt vmcnt(0)" ::: "memory");
        } else {
            XB_SPIN(xb_ld(&bar[XB_XGEN(b.x)]) == gen, bar);
            __builtin_amdgcn_fence(__ATOMIC_ACQUIRE, "agent");
            asm volatile("s_waitcnt vmcnt(0)" ::: "memory");
        }
    }
    __syncthreads();
}

__device__ __forceinline__ void tr_item(const float* W, int N, bf16_t* WT, int Kt, LAS float* scr, int item, int lane) {
    const int nblk = N >> 6, kb = item / nblk, nb = item - kb * nblk, k0 = kb << 6, n0 = nb << 6;
    const int c = lane & 15, rr = lane >> 4;
    f32x4 v[16];
#pragma unroll
    for (int i = 0; i < 16; ++i) v[i] = __builtin_nontemporal_load((const f32x4*)(W + (size_t)(k0 + 4 * i + rr) * N + n0 + 4 * c));
#pragma unroll
    for (int i = 0; i < 16; ++i) { LAS float* s = scr + (4 * i + rr) * 65 + 4 * c; s[0] = v[i][0]; s[1] = v[i][1]; s[2] = v[i][2]; s[3] = v[i][3]; }
    LDS_WAIT();
    const int kc = lane & 7;
#pragma unroll
    for (int jj = 0; jj < 8; ++jj) { const int n = (lane >> 3) + 8 * jj; const LAS float* s = scr + (8 * kc) * 65 + n;
        u32x4 o; o.x = cvt_pk_bf16(s[0], s[65]); o.y = cvt_pk_bf16(s[130], s[195]); o.z = cvt_pk_bf16(s[260], s[325]); o.w = cvt_pk_bf16(s[390], s[455]);
        *(u32x4*)(WT + (size_t)(n0 + n) * Kt + k0 + 8 * kc) = o; }
    LDS_WAIT();
}
__device__ __forceinline__ double sin2pi(double r) {
    r -= rint(r);
    if (r > 0.25) r = 0.5 - r; else if (r < -0.25) r = -0.5 - r;
    const double x = r * 6.283185307179586476925, x2 = x * x;
    double p = -1.0 / 1307674368000.0;
    p = p * x2 + 1.0 / 6227020800.0; p = p * x2 - 1.0 / 39916800.0; p = p * x2 + 1.0 / 362880.0; p = p * x2 - 1.0 / 5040.0;
    p = p * x2 + 1.0 / 120.0; p = p * x2 - 1.0 / 6.0; p = p * x2 + 1.0;
    return x * p;
}

struct Args { const float* in[14]; float* out; unsigned char* ws; float freq[128]; float l2g[8]; float g256[8]; int ph_lo, ph_hi; };

__device__ __forceinline__ void p_prologue(const Args& a, LAS unsigned char* lds, const int wave) {
    const int lane = lane_id(), tid = wave * 64 + lane;
    unsigned char* ws = a.ws;
    LAS float* scr = (LAS float*)(lds + wave * 16640);
    const int gw = blockIdx.x * 8 + wave, NGW = gridDim.x * 8;
    constexpr int I_RI = (DM / 64) * (RPROJ / 64);
    for (int it = gw; it < I_RI; it += NGW) tr_item(a.in[3], RPROJ, (bf16_t*)(ws + WS_WT_RI), DM, scr, it, lane);
    const float* x = a.in[0]; const float* gain = a.in[2]; bf16_t* xn = (bf16_t*)(ws + WS_XN0);
    for (int m = gw; m < SEQ; m += NGW) {
        const f32x4* xr = (const f32x4*)(x + (size_t)m * DM) + lane; f32x4 v[8]; float s = 0.f;
#pragma unroll
        for (int j = 0; j < 8; ++j) { v[j] = __builtin_nontemporal_load(xr + 64 * j); s += (v[j][0] * v[j][0] + v[j][1] * v[j][1]) + (v[j][2] * v[j][2] + v[j][3] * v[j][3]); }
        const float rstd = __builtin_amdgcn_rsqf(wave_sum(s) * (1.0f / DM) + NORM_EPS);
        u32x2* o = (u32x2*)(xn + (size_t)m * DM) + lane;
#pragma unroll
        for (int j = 0; j < 8; ++j) { const f32x4 g = *((const f32x4*)gain + lane + 64 * j); const f32x4 y = v[j] * rstd * g; u32x2 w; w.x = cvt_pk_bf16(y[0], y[1]); w.y = cvt_pk_bf16(y[2], y[3]); o[64 * j] = w; }
    }
    const int gt = blockIdx.x * 512 + tid, NGT = gridDim.x * 512;
    { const float* p = a.in[1]; bf16_t* pb = (bf16_t*)(ws + WS_PBF);
      for (int i = gt; i < 2 * SEQ * PLE / 8; i += NGT) { const f32x4 a0 = __builtin_nontemporal_load((const f32x4*)(p + (size_t)i * 8)), a1 = __builtin_nontemporal_load((const f32x4*)(p + (size_t)i * 8 + 4)); *(u32x4*)(pb + (size_t)i * 8) = pack8(a0, a1); } }
    { f32x2* rope = (f32x2*)(ws + WS_ROPE);
      for (int i = gt; i < SEQ * 128; i += NGT) { const int pos = i >> 7, fi = i & 127; const float ang = (float)pos * a.freq[fi];
          const double rev = (double)ang * 0.15915494309189533577; f32x2 cs; cs.x = (float)sin2pi(rev + 0.25); cs.y = (float)sin2pi(rev); rope[i] = cs; } }
}
struct CvDesc { const float* src; bf16_t* dst; const float* kg; int N, Kt, plain; };
constexpr int CV_RO = (PW / 64) * (DM / 32), CV_G = (DM / 64) * (DM / 32), CV_P = (PLE / 64) * (DM / 32), CV_PIG = (DM / 64) * (PW / 32), CV_GR = (1024 / 64) * (1024 / 32), CV_WU = DM * PW / 2048;
constexpr int CV_ITEMS = CV_RO + 2 * CV_G + 2 * CV_P + CV_PIG + 4 * CV_GR + CV_RO + CV_WU;
__device__ __forceinline__ CvDesc cv_tr(const float* W, int N, int ncols, bf16_t* WT, int Kt, int r, const float* kg = nullptr) {
    const int nblk = ncols >> 5, kb = r / nblk, nb = r - kb * nblk; CvDesc d; d.src = W + (size_t)(kb * 64) * N + nb * 32; d.dst = WT + (size_t)(nb * 32) * Kt + kb * 64; d.kg = kg ? kg + kb * 64 : nullptr; d.N = N; d.Kt = Kt; d.plain = 0; return d; }
__device__ __forceinline__ CvDesc cv_decode(const Args& a, int r) {
    unsigned char* ws = a.ws;
    if (r < CV_RO) return cv_tr(a.in[4], DM, DM, (bf16_t*)(ws + WS_WT_RO), PW, r); r -= CV_RO;
    if (r < CV_G) return cv_tr(a.in[11], DM, DM, (bf16_t*)(ws + WS_WT_G0), DM, r, a.in[10]); r -= CV_G;
    if (r < CV_G) return cv_tr(a.in[11] + (size_t)DM * DM, DM, DM, (bf16_t*)(ws + WS_WT_G1), DM, r, a.in[10] + DM); r -= CV_G;
    if (r < CV_P) return cv_tr(a.in[12], DM, DM, (bf16_t*)(ws + WS_WT_P0), PLE, r); r -= CV_P;
    if (r < CV_P) return cv_tr(a.in[12] + (size_t)PLE * DM, DM, DM, (bf16_t*)(ws + WS_WT_P1), PLE, r); r -= CV_P;
    if (r < CV_PIG) return cv_tr(a.in[6] + PW, 2 * PW, PW, (bf16_t*)(ws + WS_WT_PI) + (size_t)PW * DM, DM, r, a.in[5]); r -= CV_PIG;
    if (r < 4 * CV_GR) { const int g = r / CV_GR; return cv_tr(a.in[7] + (size_t)g * 1024 * 1024, 1024, 1024, (bf16_t*)(ws + WS_WT_GR) + (size_t)g * 1024 * 1024, 1024, r - g * CV_GR); } r -= 4 * CV_GR;
    if (r < CV_RO) return cv_tr(a.in[9], DM, DM, (bf16_t*)(ws + WS_WT_PO), PW, r); r -= CV_RO;
    CvDesc d; const int row = r >> 1, c0 = (r & 1) * 2048; d.src = a.in[6] + (size_t)row * (2 * PW) + c0; d.dst = (bf16_t*)(ws + WS_WU) + (size_t)row * PW + c0; d.kg = a.in[5] + row; d.N = 0; d.Kt = 0; d.plain = 1; return d;
}
__device__ __forceinline__ void cv_load(const CvDesc& d, f32x4 (&cv)[8], int lane) {
    if (d.plain) {
#pragma unroll
        for (int j = 0; j < 4; ++j) { cv[2 * j] = __builtin_nontemporal_load((const f32x4*)(d.src + lane * 8 + 512 * j)); cv[2 * j + 1] = __builtin_nontemporal_load((const f32x4*)(d.src + lane * 8 + 512 * j + 4)); }
    } else {
#pragma unroll
        for (int i = 0; i < 8; ++i) cv[i] = __builtin_nontemporal_load((const f32x4*)(d.src + (size_t)(8 * i + (lane >> 3)) * d.N + 4 * (lane & 7)));
    }
}
__device__ __forceinline__ void cv_store(const CvDesc& d, const f32x4 (&cv)[8], LAS float* scr, int lane) {
    if (d.plain) {
        const float kgv = d.kg[0];
#pragma unroll
        for (int j = 0; j < 4; ++j) *(u32x4*)(d.dst + lane * 8 + 512 * j) = pack8(cv[2 * j] * kgv, cv[2 * j + 1] * kgv);
    } else {
#pragma unroll
        for (int i = 0; i < 8; ++i) { const float kgv = d.kg ? d.kg[8 * i + (lane >> 3)] : 1.0f; LAS float* s = scr + (8 * i + (lane >> 3)) * 33 + 4 * (lane & 7); s[0] = cv[i][0] * kgv; s[1] = cv[i][1] * kgv; s[2] = cv[i][2] * kgv; s[3] = cv[i][3] * kgv; }
        LDS_WAIT();
        const int kc = lane & 7;
#pragma unroll
        for (int j = 0; j < 4; ++j) { const int n = (lane >> 3) + 8 * j; const LAS float* s = scr + (8 * kc) * 33 + n;
            u32x4 o; o.x = cvt_pk_bf16(s[0], s[33]); o.y = cvt_pk_bf16(s[66], s[99]); o.z = cvt_pk_bf16(s[132], s[165]); o.w = cvt_pk_bf16(s[198], s[231]);
            *(u32x4*)(d.dst + (size_t)n * d.Kt + 8 * kc) = o; }
        LDS_WAIT();
    }
}

__device__ __forceinline__ void tr_item_g(const float* W, int N, int ncols, bf16_t* WT, int Kt, LAS float* scr, int item, int lane, const float* kg) {
    const int nblk = ncols >> 6, kb = item / nblk, nb = item - kb * nblk, k0 = kb << 6, n0 = nb << 6;
    const int c = lane & 15, rr = lane >> 4;
    f32x4 v[16];
#pragma unroll
    for (int i = 0; i < 16; ++i) v[i] = __builtin_nontemporal_load((const f32x4*)(W + (size_t)(k0 + 4 * i + rr) * N + n0 + 4 * c));
#pragma unroll
    for (int i = 0; i < 16; ++i) { const float g = kg ? kg[k0 + 4 * i + rr] : 1.0f; LAS float* s = scr + (4 * i + rr) * 65 + 4 * c; s[0] = v[i][0] * g; s[1] = v[i][1] * g; s[2] = v[i][2] * g; s[3] = v[i][3] * g; }
    LDS_WAIT();
    const int kc = lane & 7;
#pragma unroll
    for (int jj = 0; jj < 8; ++jj) { const int n = (lane >> 3) + 8 * jj; const LAS float* s = scr + (8 * kc) * 65 + n;
        u32x4 o; o.x = cvt_pk_bf16(s[0], s[65]); o.y = cvt_pk_bf16(s[130], s[195]); o.z = cvt_pk_bf16(s[260], s[325]); o.w = cvt_pk_bf16(s[390], s[455]);
        *(u32x4*)(WT + (size_t)(n0 + n) * Kt + k0 + 8 * kc) = o; }
    LDS_WAIT();
}
__device__ __forceinline__ void p_weights_big(const Args& a, LAS unsigned char* lds, const int wave) {
    const int lane = lane_id();
    unsigned char* ws = a.ws;
    LAS float* scr = (LAS float*)(lds + wave * 16640);
    const int gw = (blockIdx.x - 128) * 8 + wave, NGW = (gridDim.x - 128) * 8;
    constexpr int I_RO = (PW / 64) * (DM / 64), I_G = (DM / 64) * (DM / 64), I_P = (PLE / 64) * (DM / 64), I_PIG = (DM / 64) * (PW / 64), I_GR = (1024 / 64) * (1024 / 64), I_WU = DM * PW / 2048;
    for (int it = gw; it < I_RO + 2 * I_G + 2 * I_P + I_PIG + 4 * I_GR + I_RO + I_WU; it += NGW) {
        int r = it;
        if (r < I_RO) { tr_item_g(a.in[4], DM, DM, (bf16_t*)(ws + WS_WT_RO), PW, scr, r, lane, nullptr); continue; } r -= I_RO;
        if (r < I_G) { tr_item_g(a.in[11], DM, DM, (bf16_t*)(ws + WS_WT_G0), DM, scr, r, lane, a.in[10]); continue; } r -= I_G;
        if (r < I_G) { tr_item_g(a.in[11] + (size_t)DM * DM, DM, DM, (bf16_t*)(ws + WS_WT_G1), DM, scr, r, lane, a.in[10] + DM); continue; } r -= I_G;
        if (r < I_P) { tr_item_g(a.in[12], DM, DM, (bf16_t*)(ws + WS_WT_P0), PLE, scr, r, lane, nullptr); continue; } r -= I_P;
        if (r < I_P) { tr_item_g(a.in[12] + (size_t)PLE * DM, DM, DM, (bf16_t*)(ws + WS_WT_P1), PLE, scr, r, lane, nullptr); continue; } r -= I_P;
        if (r < I_PIG) { tr_item_g(a.in[6] + PW, 2 * PW, PW, (bf16_t*)(ws + WS_WT_PI) + (size_t)PW * DM, DM, scr, r, lane, a.in[5]); continue; } r -= I_PIG;
        if (r < 4 * I_GR) { const int g = r / I_GR; tr_item_g(a.in[7] + (size_t)g * 1024 * 1024, 1024, 1024, (bf16_t*)(ws + WS_WT_GR) + (size_t)g * 1024 * 1024, 1024, scr, r - g * I_GR, lane, nullptr); continue; } r -= 4 * I_GR;
        if (r < I_RO) { tr_item_g(a.in[9], DM, DM, (bf16_t*)(ws + WS_WT_PO), PW, scr, r, lane, nullptr); continue; } r -= I_RO;
        { const int row = r >> 1, c0 = (r & 1) * 2048 + lane * 8; const float* srcp = a.in[6] + (size_t)row * (2 * PW) + c0; bf16_t* dstp = (bf16_t*)(ws + WS_WU) + (size_t)row * PW + c0; const float g = a.in[5][row];
#pragma unroll
            for (int j = 0; j < 4; ++j) { const f32x4 x0 = __builtin_nontemporal_load((const f32x4*)(srcp + 512 * j)), x1 = __builtin_nontemporal_load((const f32x4*)(srcp + 512 * j + 4)); *(u32x4*)(dstp + 512 * j) = pack8(x0 * g, x1 * g); } }
    }
}

__device__ __forceinline__ bf16x8 tr_frag(const LAS unsigned char* p, int pitch16) {
    const s16x4 lo = __builtin_amdgcn_ds_read_tr16_b64_v4i16((LAS s16x4*)p), hi = __builtin_amdgcn_ds_read_tr16_b64_v4i16((LAS s16x4*)(p + pitch16));
    return (bf16x8){lo[0], lo[1], lo[2], lo[3], hi[0], hi[1], hi[2], hi[3]};
}

__device__ __forceinline__ void p_scan(const Args& a, LAS unsigned char* lds, const int w) {
    const int lane = lane_id();
    const int tid = w * 64 + lane, b = blockIdx.x, h = b & 7, tt = b >> 3, dt = tt >> 2, vt = tt & 3;
    const int db = w >> 1, vbp = w & 1, g = lane >> 4, i16 = lane & 15, q4 = i16 >> 2, p4 = i16 & 3;
    const float g256 = a.g256[h];
    constexpr int PK = 160, PV = 288, TK = 128 * PK, TV = 128 * PV, BUF = TK + TV;
    const bf16_t* kbase = (const bf16_t*)(a.ws + WS_KD) + h * 256 + dt * 64;
    const bf16_t* vbase = (const bf16_t*)(a.ws + WS_V) + h * 512 + vt * 128;
    bf16_t* st = (bf16_t*)(a.ws + WS_ST);
    u32x4 rk0[2], rv0[4], rk1[2], rv1[4], rk2[2], rv2[4], rk3[2], rv3[4];
#define P2_LOAD(RK, RV, hs) do { const int _hs = (hs) < 62 ? (hs) : 61; \
        _Pragma("unroll") for (int _i = 0; _i < 2; ++_i) { const int _p = tid + 512 * _i; RK[_i] = *(const u32x4*)(kbase + (size_t)(_hs * 128 + (_p >> 3)) * DM + (_p & 7) * 8); } \
        _Pragma("unroll") for (int _i = 0; _i < 4; ++_i) { const int _p = tid + 512 * _i; RV[_i] = *(const u32x4*)(vbase + (size_t)(_hs * 128 + (_p >> 4)) * PW + (_p & 15) * 8); } } while (0)
#define P2_STORE(RK, RV, s) do { \
        _Pragma("unroll") for (int _i = 0; _i < 2; ++_i) { const int _p = tid + 512 * _i; *(LAS u32x4*)(lds + (s) * BUF + (_p >> 3) * PK + (_p & 7) * 16) = RK[_i]; } \
        _Pragma("unroll") for (int _i = 0; _i < 4; ++_i) { const int _p = tid + 512 * _i; *(LAS u32x4*)(lds + (s) * BUF + TK + (_p >> 4) * PV + (_p & 15) * 16) = RV[_i]; } } while (0)
    f32x4 acc[4];
#pragma unroll
    for (int j = 0; j < 4; ++j) acc[j] = (f32x4){0.f, 0.f, 0.f, 0.f};
    const int lk = (4 * g + q4) * PK + 8 * p4 + db * 32, lv = (4 * g + q4) * PV + 8 * p4 + vbp * 128;
#define P2_STEP(hs, RKN, RVN) do { const int _h = (hs); if (_h < 62) { \
        const LAS unsigned char* kt = lds + (_h & 1) * BUF + lk; const LAS unsigned char* vtp = lds + (_h & 1) * BUF + TK + lv; \
        _Pragma("unroll") for (int ks = 0; ks < 4; ++ks) { \
            const bf16x8 kf = tr_frag(kt + ks * 32 * PK, 16 * PK); \
            _Pragma("unroll") for (int j = 0; j < 4; ++j) { const bf16x8 vf = tr_frag(vtp + ks * 32 * PV + 32 * j, 16 * PV); acc[j] = __builtin_amdgcn_mfma_f32_16x16x32_bf16(vf, kf, acc[j], 0, 0, 0); } } \
        if (_h & 1) { const int n = _h >> 1; \
            bf16_t* o = st + ((size_t)(n * 8 + h) * 256 + dt * 64 + db * 16 + i16) * 512 + vt * 128 + vbp * 64 + 4 * g; \
            _Pragma("unroll") for (int j = 0; j < 4; ++j) { acc[j] *= g256; u32x2 w0; w0.x = cvt_pk_bf16(acc[j][0], acc[j][1]); w0.y = cvt_pk_bf16(acc[j][2], acc[j][3]); *(u32x2*)(o + 16 * j) = w0; } } \
        if (_h + 1 < 62) { P2_STORE(RKN, RVN, (_h + 1) & 1); P2_LOAD(RKN, RVN, _h + 5); } \
        __syncthreads(); } } while (0)
    P2_LOAD(rk0, rv0, 0); P2_LOAD(rk1, rv1, 1); P2_LOAD(rk2, rv2, 2); P2_LOAD(rk3, rv3, 3);
    P2_STORE(rk0, rv0, 0); P2_LOAD(rk0, rv0, 4); __syncthreads();
    for (int hs = 0; hs < 62; hs += 4) {
        P2_STEP(hs, rk1, rv1); P2_STEP(hs + 1, rk2, rv2); P2_STEP(hs + 2, rk3, rv3); P2_STEP(hs + 3, rk0, rv0);
    }
#undef P2_STEP
#undef P2_LOAD
#undef P2_STORE
}

__device__ __forceinline__ void p_retention(const Args& a, LAS unsigned char* lds, const int w) {
    const int lane = lane_id();
    const int tid = w * 64 + lane, b = blockIdx.x;
    const int g = lane >> 4, i16 = lane & 15, q4 = i16 >> 2, p4 = i16 & 3;
    constexpr int PP = 528, RINGO = 128 * PP, RB = 33792, ST1 = RINGO + 2 * RB, ST2 = ST1 + 8192;
    const bf16_t* qd = (const bf16_t*)(a.ws + WS_QD); const bf16_t* kd = (const bf16_t*)(a.ws + WS_KD); const bf16_t* v = (const bf16_t*)(a.ws + WS_V);
    const bf16_t* sg = (const bf16_t*)(a.ws + WS_SG); const bf16_t* st = (const bf16_t*)(a.ws + WS_ST); bf16_t* z = (bf16_t*)(a.ws + WS_Z);
    const unsigned offk = (unsigned)(((tid >> 5) * DM + (tid & 31) * 8) * 2), offv = (unsigned)(((tid >> 6) * PW + (tid & 63) * 8) * 2), offt = (unsigned)(((tid >> 6) * 512 + (tid & 63) * 8) * 2);
    const int xs = b & 7, kq = b >> 3, pair = kq >> 1, member = kq & 1;
    for (int rnd = 0; rnd < 2; ++rnd) {
        const int nh = (pair * 2 + rnd) * 8 + xs, n = nh >> 3, h = nh & 7, hf = member ^ rnd;
        const int nsb = 2 * (hf + 1), nvb = 4 * (hf + 1), ntb = n > 0 ? 8 : 0, nblk = nsb + nvb + ntb;
        const int rowbase = 256 * n + 128 * hf;
        u32x4 ra[4], rb[4];
#define P3_LOAD(R, it) do { const int _it = (it) < nblk ? (it) : nblk - 1; \
        if (_it < ntb) { const char* _b = (const char*)(st + ((size_t)((n - 1) * 8 + h) * 256 + 32 * _it) * 512); unsigned _o = offt; asm volatile("" : "+v"(_o)); \
            _Pragma("unroll") for (int _i = 0; _i < 4; ++_i) R[_i] = *(const u32x4*)(_b + (size_t)_i * (8 * 512 * 2) + _o); } \
        else if (_it < ntb + nsb) { const char* _b = (const char*)(kd + (size_t)(256 * n + 64 * (_it - ntb)) * DM + h * 256); unsigned _o = offk; asm volatile("" : "+v"(_o)); \
            _Pragma("unroll") for (int _i = 0; _i < 4; ++_i) R[_i] = *(const u32x4*)(_b + (size_t)_i * (16 * DM * 2) + _o); } \
        else { const char* _b = (const char*)(v + (size_t)(256 * n + 32 * (_it - ntb - nsb)) * PW + h * 512); unsigned _o = offv; asm volatile("" : "+v"(_o)); \
            _Pragma("unroll") for (int _i = 0; _i < 4; ++_i) R[_i] = *(const u32x4*)(_b + (size_t)_i * (8 * PW * 2) + _o); } } while (0)
#define P3_STORE(R, it) do { const int _it = (it); if (_it < nblk) { LAS unsigned char* _d = lds + RINGO + (_it & 1) * RB; \
        if (_it >= ntb && _it < ntb + nsb) { _Pragma("unroll") for (int _i = 0; _i < 4; ++_i) { const int _p = tid + 512 * _i; *(LAS u32x4*)(_d + (_p >> 5) * 528 + (_p & 31) * 16) = R[_i]; } } \
        else { _Pragma("unroll") for (int _i = 0; _i < 4; ++_i) { const int _p = tid + 512 * _i; *(LAS u32x4*)(_d + (_p >> 6) * 1056 + (_p & 63) * 16) = R[_i]; } } } } while (0)
        P3_LOAD(ra, 0); P3_LOAD(rb, 1);
        if (ntb) {
#pragma unroll 2
            for (int i = 0; i < 8; ++i) { const int p = tid + 512 * i, row = p >> 5, c = p & 31, G = c >> 2, cc = c & 3;
                const u32x4 x = *(const u32x4*)(qd + (size_t)(rowbase + row) * DM + h * 256 + c * 8);
                const int s = cc >> 1, glo = (2 * cc) & 3, ghi = (2 * cc + 1) & 3;
                LAS unsigned char* d = lds + row * PP + 64 * G;
                *(LAS u32x2*)(d + 8 * (2 * glo + s)) = (u32x2){x.x, x.y}; *(LAS u32x2*)(d + 8 * (2 * ghi + s)) = (u32x2){x.z, x.w}; }
        }
        P3_STORE(ra, 0); P3_LOAD(ra, 2); __syncthreads();
        f32x4 acc[8][4];
#pragma unroll
        for (int rbk = 0; rbk < 8; ++rbk)
#pragma unroll
            for (int cb = 0; cb < 4; ++cb) acc[rbk][cb] = (f32x4){0.f, 0.f, 0.f, 0.f};
#define P3_YSTEP(it_, RN, ISV) do { const int it = (it_); \
            const LAS unsigned char* ring = lds + RINGO + (it & 1) * RB; \
            { const int kk = (ISV) ? it - ntb - nsb : it; \
                bf16x8 vf[4]; \
                _Pragma("unroll") for (int cb = 0; cb < 4; ++cb) vf[cb] = tr_frag(ring + (4 * g + q4) * 1056 + (64 * w + 16 * cb + 4 * p4) * 2, 16 * 1056); \
                _Pragma("unroll") for (int rbk = 0; rbk < 8; ++rbk) { \
                    if ((ISV) && 32 * kk > 128 * hf + 16 * rbk + 15) continue; \
                    const bf16x8 pf = *(const LAS bf16x8*)(lds + (16 * rbk + i16) * PP + (32 * kk + 8 * g) * 2); \
                    _Pragma("unroll") for (int cb = 0; cb < 4; ++cb) acc[rbk][cb] = __builtin_amdgcn_mfma_f32_16x16x32_bf16(vf[cb], pf, acc[rbk][cb], 0, 0, 0); \
                } } \
            P3_STORE(RN, it + 1); P3_LOAD(RN, it + 3); \
            __syncthreads(); } while (0)
        for (int it2 = 0; it2 < ntb; it2 += 2) { P3_YSTEP(it2, rb, false); P3_YSTEP(it2 + 1, ra, false); }
        {
            bf16x8 qf[8];
#pragma unroll
            for (int ds = 0; ds < 8; ++ds) qf[ds] = *(const bf16x8*)(qd + (size_t)(rowbase + 16 * w + i16) * DM + h * 256 + 32 * ds + 8 * g);
#define P3_SSTEP(it_, RN) do { const int it = (it_), sbk = it - ntb; \
                const LAS unsigned char* ring = lds + RINGO + (it & 1) * RB; \
                _Pragma("unroll") for (int sb = 0; sb < 4; ++sb) { \
                    const int j0 = 64 * sbk + 16 * sb, i0 = 128 * hf + 16 * w; \
                    LAS unsigned char* dst = lds + (16 * w + i16) * PP + (32 * (2 * sbk + (sb >> 1)) + 8 * g + 4 * (sb & 1)) * 2; \
                    if (j0 > i0) { *(LAS u32x2*)dst = (u32x2){0u, 0u}; } \
                    else { \
                        f32x4 s4 = {0.f, 0.f, 0.f, 0.f}; \
                        _Pragma("unroll") for (int ds = 0; ds < 8; ++ds) { const bf16x8 kf = *(const LAS bf16x8*)(ring + (16 * sb + i16) * 528 + (32 * ds + 8 * g) * 2); \
                            s4 = __builtin_amdgcn_mfma_f32_16x16x32_bf16(kf, qf[ds], s4, 0, 0, 0); } \
                        if (j0 == i0) { _Pragma("unroll") for (int r = 0; r < 4; ++r) if (4 * g + r > i16) s4[r] = 0.f; } \
                        u32x2 wv; wv.x = cvt_pk_bf16(s4[0], s4[1]); wv.y = cvt_pk_bf16(s4[2], s4[3]); *(LAS u32x2*)dst = wv; \
                    } \
                } \
                P3_STORE(RN, it + 1); P3_LOAD(RN, it + 3); \
                __syncthreads(); } while (0)
            for (int it2 = ntb; it2 < ntb + nsb; it2 += 2) { P3_SSTEP(it2, rb); P3_SSTEP(it2 + 1, ra); }
#undef P3_SSTEP
        }
        for (int it2 = ntb + nsb; it2 < nblk; it2 += 2) { P3_YSTEP(it2, rb, true); P3_YSTEP(it2 + 1, ra, true); }
#undef P3_YSTEP
#undef P3_LOAD
#undef P3_STORE
        LAS f32x2* S1 = (LAS f32x2*)(lds + ST1); LAS f32x2* S2 = (LAS f32x2*)(lds + ST2);
#pragma unroll
        for (int rbk = 0; rbk < 8; ++rbk) { float s1 = 0.f, s2 = 0.f;
#pragma unroll
            for (int cb = 0; cb < 4; ++cb) { const f32x4 y = acc[rbk][cb]; s1 += (y[0] + y[1]) + (y[2] + y[3]); s2 += (y[0] * y[0] + y[1] * y[1]) + (y[2] * y[2] + y[3] * y[3]); }
            s1 += __shfl_xor(s1, 16); s1 += __shfl_xor(s1, 32); s2 += __shfl_xor(s2, 16); s2 += __shfl_xor(s2, 32);
            if (g == 0) S1[(16 * rbk + i16) * 8 + w] = (f32x2){s1, s2}; }
        __syncthreads();
        if (tid < 128) { float s1 = 0.f, s2 = 0.f;
#pragma unroll
            for (int k = 0; k < 8; ++k) { const f32x2 t = S1[tid * 8 + k]; s1 += t.x; s2 += t.y; }
            const float mean = s1 * (1.0f / 512.0f), var = s2 * (1.0f / 512.0f) - mean * mean;
            S2[tid] = (f32x2){mean, __builtin_amdgcn_rsqf(fmaxf(var, 0.f) + GN_EPS)}; }
        __syncthreads();
#pragma unroll
        for (int rbk = 0; rbk < 8; ++rbk) { const f32x2 ms = S2[16 * rbk + i16];
            const size_t off = (size_t)(rowbase + 16 * rbk + i16) * PW + h * 512 + 64 * w + 4 * g;
#pragma unroll
            for (int cb = 0; cb < 4; ++cb) { const u32x2 gw = __builtin_nontemporal_load((const u32x2*)(sg + off + 16 * cb)); const f32x4 y = acc[rbk][cb];
                u32x2 o; o.x = cvt_pk_bf16((y[0] - ms.x) * ms.y * bf_lo(gw.x), (y[1] - ms.x) * ms.y * bf_hi(gw.x)); o.y = cvt_pk_bf16((y[2] - ms.x) * ms.y * bf_lo(gw.y), (y[3] - ms.x) * ms.y * bf_hi(gw.y));
                *(u32x2*)(z + off + 16 * cb) = o; } }
        __syncthreads();
    }
}

__device__ __forceinline__ void p_pool(const Args& a, const int wave) {
    const int tid = wave * 64 + lane_id();
    const bf16_t* u = (const bf16_t*)(a.ws + WS_U); const bf16_t* sg = (const bf16_t*)(a.ws + WS_SG1); bf16_t* d = (bf16_t*)(a.ws + WS_ZZ);
    for (int task = blockIdx.x * 512 + tid; task < 512 * 256; task += gridDim.x * 512) {
        const int chunk = task & 511, run = task >> 9, w = 2 << (chunk >> 7), t0 = run * 32;
        const bf16_t* uc = u + chunk * 8; const bf16_t* gc = sg + chunk * 8; bf16_t* dc = d + chunk * 8;
        f32x4 s0 = {0.f, 0.f, 0.f, 0.f}, s1 = {0.f, 0.f, 0.f, 0.f};
        for (int t = (t0 - w > 0 ? t0 - w : 0); t < t0; ++t) { f32x4 x0, x1; unpack8(*(const u32x4*)(uc + (size_t)t * PW), x0, x1); s0 += x0; s1 += x1; }
        for (int t = t0; t < t0 + 32; ++t) {
            f32x4 x0, x1, g0, g1; unpack8(*(const u32x4*)(uc + (size_t)t * PW), x0, x1); unpack8(*(const u32x4*)(gc + (size_t)t * PW), g0, g1); s0 += x0; s1 += x1;
            if (t - w >= 0) { f32x4 y0, y1; unpack8(*(const u32x4*)(uc + (size_t)(t - w) * PW), y0, y1); s0 -= y0; s1 -= y1; }
            const float inv = 1.0f / (float)(t + 1 < w ? t + 1 : w);
            *(u32x4*)(dc + (size_t)t * PW) = pack8((s0 * inv - x0) * g0, (s1 * inv - x1) * g1);
        }
    }
}
__device__ __forceinline__ void p_final(const Args& a, const int wave) {
    const int lane = lane_id();
    const float* rp = (const float*)(a.ws + WS_RP + 3 * MiB); const float* gain = a.in[13]; float* out = a.out;
    for (int m = blockIdx.x * 8 + wave; m < SEQ; m += gridDim.x * 8) {
        const float part = lane < 32 ? rp[(size_t)m * 32 + lane] : 0.f;
        const float rstd = __builtin_amdgcn_rsqf(wave_sum(part) * (1.0f / DM) + NORM_EPS);
        f32x4* o = (f32x4*)(out + (size_t)m * DM) + lane;
#pragma unroll
        for (int j = 0; j < 8; ++j) { const f32x4 g = *((const f32x4*)gain + lane + 64 * j); o[64 * j] = o[64 * j] * rstd * g; }
    }
}

__global__ void __launch_bounds__(512, 2) trunk_fwd(Args args) {
    extern __shared__ __attribute__((aligned(16))) unsigned char lds_raw[];
    LAS unsigned char* lds = (LAS unsigned char*)lds_raw;
    const int wave = __builtin_amdgcn_readfirstlane(threadIdx.x >> 6);
    unsigned char* ws = args.ws;
    volatile LAS unsigned* MISC = (volatile LAS unsigned*)(lds + MISC_OFF);
    if (threadIdx.x < 64) MISC[threadIdx.x] = 0u;
    __syncthreads();
    XcdBarrier bar; bar.bar = (unsigned*)(ws + WS_CTL) + 4096; bar.x = 0; bar.st = nullptr;
    const int lo = args.ph_lo, hi = args.ph_hi;
    if (hi - lo > 1) bar = xcd_barrier_post((unsigned*)(ws + WS_CTL) + 4096, MISC + 8, wave);
#ifndef PH_MASK
#define PH_MASK 0x3FF
#endif
#define IN(k) (((PH_MASK >> (k)) & 1) && lo <= (k) && (k) < hi)
#define SEAM(k) do { if (IN(k) && IN((k) + 1)) xcd_barrier(bar, wave); } while (0)
#ifndef DUP_MASK
#define DUP_MASK 0
#endif
#define NDUP(k) (((DUP_MASK >> (k)) & 1) ? 2 : 1)
    const int G = gridDim.x, c = blockIdx.x;
    float* rp0 = (float*)(ws + WS_RP); float* rp1 = rp0 + SEQ * 32; float* rp2 = rp1 + SEQ * 32; float* rp3 = rp2 + SEQ * 32;

    if (IN(0)) for (int rep_ = 0; rep_ < NDUP(0); ++rep_) { if (rep_) xcd_barrier(bar, wave); p_prologue(args, lds, wave); VM_WAIT(); __syncthreads(); }
    SEAM(0);
    if (IN(1)) for (int rep_ = 0; rep_ < NDUP(1); ++rep_) { if (rep_) xcd_barrier(bar, wave);
        pg8::Gemm g{(const bf16_t*)(ws + WS_XN0), (const bf16_t*)(ws + WS_WT_RI), SEQ, RPROJ, DM, DM, DM}; pg8::StaticOrder S; S.init(SEQ, RPROJ, G, c);
        EpiRet1 E{(bf16_t*)(ws + WS_QD), (bf16_t*)(ws + WS_KD), (bf16_t*)(ws + WS_V), (bf16_t*)(ws + WS_SG), (const float*)(ws + WS_ROPE), args.l2g};
        pg8::gemm_phase(lds, g, S, E, wave);
    }
    SEAM(1);
    if (IN(2)) for (int rep_ = 0; rep_ < NDUP(2); ++rep_) { if (rep_) xcd_barrier(bar, wave); if (c < 128) p_scan(args, lds, wave); else p_weights_big(args, lds, wave);
        VM_WAIT(); __syncthreads(); }
    SEAM(2);
    if (IN(3)) for (int rep_ = 0; rep_ < NDUP(3); ++rep_) { if (rep_) xcd_barrier(bar, wave); p_retention(args, lds, wave); }
    SEAM(3);
    if (IN(4)) for (int rep_ = 0; rep_ < NDUP(4); ++rep_) { if (rep_) xcd_barrier(bar, wave);
        { pg8::Gemm g{(const bf16_t*)(ws + WS_Z), (const bf16_t*)(ws + WS_WT_RO), SEQ, DM, PW, PW, PW}; pg8::StaticOrder S; S.init(SEQ, DM, G, c);
          EpiRes<true> E{args.in[0], nullptr, (bf16_t*)(ws + WS_A1), rp0};
          pg8::gemm_phase(lds, g, S, E, wave); }
        { pg8::Gemm g{(const bf16_t*)(ws + WS_PBF), (const bf16_t*)(ws + WS_WT_P0), SEQ, DM, PLE, PLE, PLE}; pg8::UpperHalfOrder S; S.init(SEQ, DM, G, c);
          EpiPlain E{(bf16_t*)(ws + WS_PE0), DM};
          pg8::gemm_phase(lds, g, S, E, wave); }
        { pg8::Gemm g{(const bf16_t*)(ws + WS_WT_GR), (const bf16_t*)(ws + WS_WU), PW, DM, 1024, 1024, PW}; pg8::CombOrder S; S.init(PW, DM, G, c);
          EpiComb E{(bf16_t*)(ws + WS_WT_PI), DM, args.in[8]};
          pg8::gemm_phase(lds, g, S, E, wave); }
    }
    SEAM(4);
    if (IN(5)) for (int rep_ = 0; rep_ < NDUP(5); ++rep_) { if (rep_) xcd_barrier(bar, wave);
        pg8::Gemm g{(const bf16_t*)(ws + WS_A1), (const bf16_t*)(ws + WS_WT_G0), SEQ, DM, DM, DM, DM}; pg8::StaticOrder S; S.init(SEQ, DM, G, c);
        rstd_table(lds, rp0, S, wave * 64 + lane_id());
        EpiPle E{(const bf16_t*)(ws + WS_A1), (const bf16_t*)(ws + WS_PE0), lds, (bf16_t*)(ws + WS_A2), rp1};
        pg8::gemm_phase(lds, g, S, E, wave);
    }
    SEAM(5);
    if (IN(6)) for (int rep_ = 0; rep_ < NDUP(6); ++rep_) { if (rep_) xcd_barrier(bar, wave);
        pg8::Gemm g{(const bf16_t*)(ws + WS_A2), (const bf16_t*)(ws + WS_WT_PI), SEQ, 2 * PW, DM, DM, DM}; pg8::StaticOrder S; S.init(SEQ, 2 * PW, G, c);
        rstd_table(lds, rp1, S, wave * 64 + lane_id());
        EpiPoolIn E{lds, (bf16_t*)(ws + WS_U), (bf16_t*)(ws + WS_SG1)};
        pg8::gemm_phase(lds, g, S, E, wave);
    }
    SEAM(6);
    if (IN(7)) for (int rep_ = 0; rep_ < NDUP(7); ++rep_) { if (rep_) xcd_barrier(bar, wave); p_pool(args, wave); }
    SEAM(7);
    if (IN(8)) for (int rep_ = 0; rep_ < NDUP(8); ++rep_) { if (rep_) xcd_barrier(bar, wave);
        { pg8::Gemm g{(const bf16_t*)(ws + WS_ZZ), (const bf16_t*)(ws + WS_WT_PO), SEQ, DM, PW, PW, PW}; pg8::StaticOrder S; S.init(SEQ, DM, G, c);
          EpiRes<false> E{nullptr, (const bf16_t*)(ws + WS_A2), (bf16_t*)(ws + WS_A3), rp2};
          pg8::gemm_phase(lds, g, S, E, wave); }
        { pg8::Gemm g{(const bf16_t*)(ws + WS_PBF) + (size_t)SEQ * PLE, (const bf16_t*)(ws + WS_WT_P1), SEQ, DM, PLE, PLE, PLE}; pg8::StaticOrder S; S.init(SEQ, DM, G, c);
          EpiPlain E{(bf16_t*)(ws + WS_PE1), DM};
          pg8::gemm_phase(lds, g, S, E, wave); }
    }
    SEAM(8);
    if (IN(9)) for (int rep_ = 0; rep_ < NDUP(9); ++rep_) { if (rep_) xcd_barrier(bar, wave);
        pg8::Gemm g{(const bf16_t*)(ws + WS_A3), (const bf16_t*)(ws + WS_WT_G1), SEQ, DM, DM, DM, DM}; pg8::StaticOrder S; S.init(SEQ, DM, G, c);
        rstd_table(lds, rp2, S, wave * 64 + lane_id());
        EpiPleFinal E{(const bf16_t*)(ws + WS_A3), (const bf16_t*)(ws + WS_PE1), lds, args.out, args.in[13], (unsigned*)(ws + WS_CTL)};
        pg8::gemm_phase(lds, g, S, E, wave);
    }
#undef IN
#undef SEAM
}

extern "C" void kernel_launch(void* const* d_in, const int* in_sizes, int n_in, void* d_out, int out_size, void* d_ws, size_t ws_size, hipStream_t stream) {
    static int grid = 0;
    if (grid == 0) {
        if (n_in != 14 || out_size != SEQ * DM || ws_size < WS_END) { fprintf(stderr, "kernel_launch: unexpected problem: n_in %d out %d ws %zu (need %zu)\n", n_in, out_size, ws_size, (size_t)WS_END); grid = -1; return; }
        int dev = 0, cus = 0, per_cu = 0;
        if (hipGetDevice(&dev) != hipSuccess || hipDeviceGetAttribute(&cus, hipDeviceAttributeMultiprocessorCount, dev) != hipSuccess) { grid = -1; return; }
        if (hipFuncSetAttribute((const void*)trunk_fwd, hipFuncAttributeMaxDynamicSharedMemorySize, LDS_BYTES) != hipSuccess) { fprintf(stderr, "kernel_launch: hipFuncSetAttribute failed\n"); grid = -1; return; }
        if (hipOccupancyMaxActiveBlocksPerMultiprocessor(&per_cu, (const void*)trunk_fwd, 512, LDS_BYTES) != hipSuccess || per_cu < 1) { fprintf(stderr, "kernel_launch: occupancy query says %d\n", per_cu); (void)hipGetLastError(); }
        grid = cus;
        if (grid != 256) fprintf(stderr, "kernel_launch: %d CUs (built for 256)\n", grid);
    }
    if (grid < 0) return;
    (void)hipMemsetAsync((char*)d_ws + WS_CTL, 0, CTL_ZERO_BYTES, stream);
    Args a{};
    for (int i = 0; i < 14; ++i) a.in[i] = (const float*)d_in[i];
    a.out = (float*)d_out; a.ws = (unsigned char*)d_ws;
    for (int i = 0; i < 128; ++i) { const float lin = (float)i * (1.0f / 127.0f); a.freq[i] = (float)pow(10000.0, -(double)lin); }
    for (int h = 0; h < 8; ++h) { const double lg = log2(1.0 - pow(2.0, -5.0 - (double)h)); a.l2g[h] = (float)lg; a.g256[h] = (float)exp2(256.0 * lg); }
    constexpr int NPH = 10;
    if (MK_N_LAUNCHES == 1) {
        a.ph_lo = 0; a.ph_hi = NPH;
        void* kargs[] = {&a};
        const hipError_t le = hipLaunchCooperativeKernel((const void*)trunk_fwd, dim3(grid), dim3(512), kargs, LDS_BYTES, stream);
        if (le != hipSuccess) fprintf(stderr, "kernel_launch: cooperative launch failed: %s (grid %d)\n", hipGetErrorString(le), grid);
    } else {
        for (int ph = 0; ph < NPH; ++ph) { a.ph_lo = ph; a.ph_hi = ph + 1; hipLaunchKernelGGL(trunk_fwd, dim3(grid), dim3(512), LDS_BYTES, stream, a); }
    }
}
```

```cpp
#include <hip/hip_runtime.h>
#include <cstdio>
#include <cstdint>
#include <cmath>

#ifndef MK_N_LAUNCHES
#define MK_N_LAUNCHES 1
#define CV_BIG 1
#endif

#define LAS __attribute__((address_space(3)))
#define GAS __attribute__((address_space(1)))
typedef unsigned short bf16_t;
typedef short bf16x8 __attribute__((ext_vector_type(8)));
typedef short s16x4 __attribute__((ext_vector_type(4)));
typedef float f32x4 __attribute__((ext_vector_type(4)));
typedef float f32x2 __attribute__((ext_vector_type(2)));
typedef unsigned u32x4 __attribute__((ext_vector_type(4)));
typedef unsigned u32x2 __attribute__((ext_vector_type(2)));

constexpr int SEQ = 8192, DM = 2048, RPROJ = 12288, NH = 8, DKH = 256, DVH = 512, PW = 4096, PLE = 256;
constexpr float NORM_EPS = 1e-6f, GN_EPS = 1e-5f;

constexpr size_t MiB = 1u << 20;
constexpr size_t WS_CTL = 0, CTL_ZERO_BYTES = 128 * 1024;
constexpr size_t WS_RP = 1 * MiB;
constexpr size_t WS_ROPE = 5 * MiB;
constexpr size_t WS_PBF = 13 * MiB;
constexpr size_t WS_WT_RO = 21 * MiB;
constexpr size_t WS_WT_G0 = 37 * MiB;
constexpr size_t WS_WT_P0 = 45 * MiB;
constexpr size_t WS_WT_RI = 46 * MiB;
constexpr size_t WS_XN0 = 94 * MiB;
constexpr size_t WS_QD = 126 * MiB, WS_KD = 158 * MiB, WS_V = 190 * MiB, WS_SG = 254 * MiB;
constexpr size_t WS_Z = WS_SG;
constexpr size_t WS_ST = 318 * MiB;
constexpr size_t WS_WU = 46 * MiB;
constexpr size_t WS_WT_PI = 62 * MiB;
constexpr size_t WS_WT_GR = 94 * MiB, WS_WT_PO = 102 * MiB, WS_WT_G1 = 118 * MiB, WS_WT_P1 = 382 * MiB;
constexpr size_t WS_H1 = 126 * MiB, WS_A1 = 190 * MiB, WS_PE0 = 222 * MiB;
constexpr size_t WS_H2 = 254 * MiB, WS_A2 = 318 * MiB;
constexpr size_t WS_U = 126 * MiB, WS_SG1 = 190 * MiB, WS_ZZ = 254 * MiB;
constexpr size_t WS_H3 = 126 * MiB, WS_A3 = 190 * MiB, WS_PE1 = 222 * MiB;
constexpr size_t WS_END = 383 * MiB;

constexpr int RING_BYTES = 131072;
constexpr int LDS_BYTES = 155648;
constexpr int MISC_OFF = LDS_BYTES - 256;

#define LDS_WAIT() asm volatile("s_waitcnt lgkmcnt(0)" ::: "memory")
#define VM_WAIT() asm volatile("s_waitcnt vmcnt(0)" ::: "memory")

__device__ __forceinline__ unsigned cvt_pk_bf16(float lo, float hi) { unsigned r; asm volatile("v_cvt_pk_bf16_f32 %0, %1, %2" : "=v"(r) : "v"(lo), "v"(hi)); return r; }
__device__ __forceinline__ float bf_lo(unsigned w) { return __uint_as_float(w << 16); }
__device__ __forceinline__ float bf_hi(unsigned w) { return __uint_as_float(w & 0xffff0000u); }
__device__ __forceinline__ float fsigmoid(float x) { return __builtin_amdgcn_rcpf(1.0f + __builtin_amdgcn_exp2f(-1.44269504089f * x)); }
__device__ __forceinline__ float fsilu(float x) { return x * fsigmoid(x); }
__device__ __forceinline__ int lane_id() { int l; asm volatile("v_mbcnt_lo_u32_b32 %0, -1, 0\n\tv_mbcnt_hi_u32_b32 %0, -1, %0" : "=v"(l)); return l; }
__device__ __forceinline__ float wave_sum(float v) {
#pragma unroll
    for (int o = 1; o < 64; o <<= 1) v += __shfl_xor(v, o);
    return v;
}

namespace pg8 {
constexpr int BM = 256, BK = 64, HALF = 128, HTB = HALF * BK * 2, STAGE_BYTES = 8 * HTB, NXCD = 8, WGM = 4;
__host__ __device__ __forceinline__ int lds_byte(int r, int c) { const int st = (r >> 4) * 2 + (c >> 5), rr = r & 15, cc = c & 31, ob = rr * 64 + cc * 2; return st * 1024 + (ob ^ (((ob >> 9) & 1) << 5)); }
__host__ __device__ __forceinline__ void stage_rc(int b, int& R, int& C) { const int st = b / 1024, sb = b % 1024, swz = sb ^ (((sb >> 9) & 1) << 5); R = (st >> 1) * 16 + swz / 64; C = (st & 1) * 32 + (swz % 64) / 2; }
__host__ __device__ __forceinline__ int perm32(int rho) { const int n = rho >> 4, i = rho & 15; return 8 * (i >> 2) + 4 * n + (i & 3); }

struct Unit { int pm, pn, slot; };
struct Gemm { const bf16_t* A; const bf16_t* Bt; int M, N, K, lda, ldb; };

struct StaticOrder {
    int nM, nN, nwg, G, c;
    __host__ __device__ void init(int M, int N, int G_, int c_) { nM = M / BM; nN = N / BM; nwg = nM * nN; G = G_; c = c_; }
    __host__ __device__ bool next(int i, Unit& u) const {
        const long L = (long)i * G + c; if (L >= nwg) return false;
        int wgid = (int)L; { const int q = nwg / NXCD, r = nwg % NXCD, xcd = wgid % NXCD, off = wgid / NXCD; wgid = (xcd < r ? xcd * (q + 1) : r * (q + 1) + (xcd - r) * q) + off; }
        const int nig = WGM * nN, gid = wgid / nig, fm = gid * WGM, gsz = (nM - fm) < WGM ? (nM - fm) : WGM;
        u.pm = fm + ((wgid % nig) % gsz); u.pn = (wgid % nig) / gsz; u.slot = i; return true;
    }
    __device__ __forceinline__ size_t a_off(const Unit&) const { return 0; }
    __device__ __forceinline__ size_t b_off(const Unit&) const { return 0; }
};
struct UpperHalfOrder : StaticOrder {
    __host__ __device__ bool next(int i, Unit& u) const { const int hw = G >> 1, per = nwg / hw; if (c < hw || i >= per) return false; const int L = (c - hw) * per + i; u.pm = L / nN; u.pn = L - u.pm * nN; u.slot = i; return true; }
};
struct CombOrder : StaticOrder {
    __device__ __forceinline__ size_t b_off(const Unit& u) const { return (size_t)(u.pm >> 2) * 2048; }
};

template <class Epi, class Sched, int EPI_REPS = 1>
__device__ __forceinline__ void gemm_phase(LAS unsigned char* lds, const Gemm g, const Sched& S, const Epi& E, const int wid) {
    int lane_ = lane_id(); asm volatile("" : "+v"(lane_));
    const int lane = lane_, tid = wid * 64 + lane, wr = wid >> 2, wc = wid & 3, fr = lane & 15, fq = lane >> 4;
    const int K = g.K, nt = K / BK;
    unsigned voffA[2], voffB[2];
#pragma unroll
    for (int i = 0; i < 2; ++i) { int R, C; stage_rc(tid * 16 + i * 8192, R, C); const int Rb = (R & ~31) + perm32(R & 31);
        voffA[i] = (unsigned)(R * g.lda + C) * 2u; voffB[i] = (unsigned)(Rb * g.ldb + C) * 2u; }
    const size_t kstep = (size_t)(BK * 2);
    const size_t hstepA = (size_t)HALF * g.lda * 2, hstepB = (size_t)HALF * g.ldb * 2;
    const size_t tstepA = 2 * hstepA, tstepB = 2 * hstepB;
    const unsigned ldsw = (unsigned)wid * 1024u;
    const int aoff = lds_byte(wr * 64 + fr, fq * 8), boff = lds_byte(wc * 32 + fr, fq * 8);
#define PG8_SA(b, h) (((b) * 2 + (h)) * HTB)
#define PG8_SB(b, h) ((4 + (b) * 2 + (h)) * HTB)
#define PG8_STAGE(bufoff, gbase, voff) do { _Pragma("unroll") for (int _i = 0; _i < 2; ++_i) \
        __builtin_amdgcn_global_load_lds((const unsigned*)((const char*)(gbase) + (voff)[_i]), (LAS unsigned*)(lds + (bufoff) + ldsw + _i * 8192), 16, 0, 0); } while (0)
#define PG8_LDA(dst, b, h) do { _Pragma("unroll") for (int m = 0; m < 4; ++m) _Pragma("unroll") for (int k = 0; k < 2; ++k) dst[m][k] = *(const LAS bf16x8*)(lds + PG8_SA(b, h) + aoff + m * 2048 + k * 1024); } while (0)
#define PG8_LDB(dst, b, h) do { _Pragma("unroll") for (int n = 0; n < 2; ++n) _Pragma("unroll") for (int k = 0; k < 2; ++k) dst[n][k] = *(const LAS bf16x8*)(lds + PG8_SB(b, h) + boff + n * 2048 + k * 1024); } while (0)
#define PG8_MMA(ai, bj, At, Bt) do { __builtin_amdgcn_s_setprio(1); _Pragma("unroll") for (int m = 0; m < 4; ++m) _Pragma("unroll") for (int n = 0; n < 2; ++n) _Pragma("unroll") for (int k = 0; k < 2; ++k) \
        acc[ai][bj][m][n] = __builtin_amdgcn_mfma_f32_16x16x32_bf16(Bt[n][k], At[m][k], acc[ai][bj][m][n], 0, 0, 0); __builtin_amdgcn_s_setprio(0); } while (0)
#define PG8_WAIT_V(n) asm volatile("s_waitcnt vmcnt(" #n ")" ::: "memory")
#define PG8_WAIT_L(n) asm volatile("s_waitcnt lgkmcnt(" #n ")" ::: "memory")
#define PG8_BAR __builtin_amdgcn_s_barrier()
#define PG8_SCHED __builtin_amdgcn_sched_barrier(0)
    Unit cur, nxt; int ui = 0;
    if (!S.next(0, cur)) return;
    f32x4 acc[2][2][4][2];
#pragma unroll
    for (int a = 0; a < 2; ++a)
#pragma unroll
        for (int b = 0; b < 2; ++b)
#pragma unroll
            for (int m = 0; m < 4; ++m)
#pragma unroll
                for (int n = 0; n < 2; ++n) acc[a][b][m][n] = (f32x4){0.f, 0.f, 0.f, 0.f};
    bf16x8 At[4][2], B0[2][2], B1[2][2];
    const char* cA = (const char*)g.A + (size_t)cur.pm * tstepA + S.a_off(cur); const char* cB = (const char*)g.Bt + (size_t)cur.pn * tstepB + S.b_off(cur);
    PG8_STAGE(PG8_SB(0, 0), cB, voffB); PG8_STAGE(PG8_SB(0, 1), cB + hstepB, voffB); PG8_STAGE(PG8_SA(0, 0), cA, voffA); PG8_STAGE(PG8_SA(0, 1), cA + hstepA, voffA);
    if (wr == 1) PG8_BAR;
    PG8_WAIT_V(2); PG8_BAR;
    PG8_STAGE(PG8_SB(1, 0), cB + kstep, voffB); PG8_STAGE(PG8_SA(1, 0), cA + kstep, voffA); PG8_STAGE(PG8_SB(1, 1), cB + hstepB + kstep, voffB);
    PG8_WAIT_V(6); PG8_BAR;
    for (;;) {
        const bool has_next = S.next(ui + 1, nxt);
        const char* nA = has_next ? (const char*)g.A + (size_t)nxt.pm * tstepA + S.a_off(nxt) : cA; const char* nB = has_next ? (const char*)g.Bt + (size_t)nxt.pn * tstepB + S.b_off(nxt) : cB;
        for (int t = 0; t < nt; t += 2) {
            const bool last = (t == nt - 2);
            const char* a1 = cA + (size_t)(t + 1) * kstep;
            const char* a2 = last ? nA : cA + (size_t)(t + 2) * kstep; const char* b2 = last ? nB : cB + (size_t)(t + 2) * kstep;
            const char* a3 = a2 + kstep; const char* b3 = b2 + kstep;
            PG8_LDB(B0, 0, 0); PG8_LDB(B1, 0, 1); PG8_SCHED; PG8_LDA(At, 0, 0); PG8_STAGE(PG8_SA(1, 1), a1 + hstepA, voffA);
            PG8_WAIT_V(8); PG8_WAIT_L(0); PG8_BAR; PG8_MMA(0, 0, At, B0); PG8_MMA(0, 1, At, B1); PG8_BAR; PG8_SCHED;
            PG8_LDA(At, 0, 1); PG8_STAGE(PG8_SB(0, 0), b2, voffB); PG8_STAGE(PG8_SB(0, 1), b2 + hstepB, voffB); PG8_STAGE(PG8_SA(0, 0), a2, voffA);
            PG8_WAIT_V(8); PG8_WAIT_L(0); PG8_BAR; PG8_MMA(1, 0, At, B0); PG8_MMA(1, 1, At, B1); PG8_BAR; PG8_SCHED;
            PG8_LDB(B0, 1, 0); PG8_LDB(B1, 1, 1); PG8_SCHED; PG8_LDA(At, 1, 0); PG8_STAGE(PG8_SA(0, 1), a2 + hstepA, voffA);
            PG8_WAIT_V(8); PG8_WAIT_L(0); PG8_BAR; PG8_MMA(0, 0, At, B0); PG8_MMA(0, 1, At, B1); PG8_BAR; PG8_SCHED;
            PG8_LDA(At, 1, 1); PG8_STAGE(PG8_SB(1, 0), b3, voffB); PG8_STAGE(PG8_SB(1, 1), b3 + hstepB, voffB); PG8_STAGE(PG8_SA(1, 0), a3, voffA);
            PG8_WAIT_V(8); PG8_WAIT_L(0); PG8_BAR; PG8_MMA(1, 0, At, B0); PG8_MMA(1, 1, At, B1); PG8_BAR; PG8_SCHED;
        }
        if (wr == 0) PG8_BAR;
        for (int er_ = 0; er_ < EPI_REPS; ++er_) { int fr2 = fr, fq2 = fq; asm volatile("" : "+v"(fr2), "+v"(fq2)); E(acc, cur, wr, wc, fr2, fq2); }
        if (!has_next) break;
#pragma unroll
        for (int a = 0; a < 2; ++a)
#pragma unroll
            for (int b = 0; b < 2; ++b)
#pragma unroll
                for (int m = 0; m < 4; ++m)
#pragma unroll
                    for (int n = 0; n < 2; ++n) acc[a][b][m][n] = (f32x4){0.f, 0.f, 0.f, 0.f};
        cur = nxt; cA = nA; cB = nB; ++ui;
        if (wr == 1) PG8_BAR;
    }
    PG8_WAIT_V(0);
    PG8_BAR;
#undef PG8_SA
#undef PG8_SB
#undef PG8_STAGE
#undef PG8_LDA
#undef PG8_LDB
#undef PG8_MMA
#undef PG8_WAIT_V
#undef PG8_WAIT_L
#undef PG8_BAR
#undef PG8_SCHED
}
}
using pg8::Unit;

#define EPI_ARGS f32x4 (&acc)[2][2][4][2], const Unit& u, int wr, int wc, int fr, int fq
__device__ __forceinline__ u32x4 pack8(const f32x4 a, const f32x4 b) { u32x4 w; w.x = cvt_pk_bf16(a[0], a[1]); w.y = cvt_pk_bf16(a[2], a[3]); w.z = cvt_pk_bf16(b[0], b[1]); w.w = cvt_pk_bf16(b[2], b[3]); return w; }
__device__ __forceinline__ void unpack8(const u32x4 w, f32x4& a, f32x4& b) { a = (f32x4){bf_lo(w.x), bf_hi(w.x), bf_lo(w.y), bf_hi(w.y)}; b = (f32x4){bf_lo(w.z), bf_hi(w.z), bf_lo(w.w), bf_hi(w.w)}; }
__device__ __forceinline__ float row_rstd(const float* rp, int row) {
    const f32x4* q = (const f32x4*)(rp + (size_t)row * 32); f32x4 s = q[0];
#pragma unroll
    for (int i = 1; i < 8; ++i) s += q[i];
    return __builtin_amdgcn_rsqf(((s[0] + s[1]) + (s[2] + s[3])) * (1.0f / DM) + NORM_EPS);
}
constexpr int RSTD_OFF = RING_BYTES;
template <class Sched> __device__ __forceinline__ void rstd_table(LAS unsigned char* lds, const float* rp, const Sched& S, int tid) {
    LAS float* tab = (LAS float*)(lds + RSTD_OFF); Unit u;
    for (int i = 0; i < 8 && S.next(i, u); ++i) if (tid < 256) tab[i * 256 + tid] = row_rstd(rp, u.pm * 256 + tid);
    __syncthreads();
}
__device__ __forceinline__ float rstd_lds(const LAS unsigned char* lds, int slot, int r) { return ((const LAS float*)(lds + RSTD_OFF))[slot * 256 + r]; }

struct EpiRet1 {
    bf16_t *qd, *kd, *v, *sg; const float* rope; const float* l2g;
    __device__ __forceinline__ void operator()(EPI_ARGS) const {
        const int pn = u.pn, row0 = u.pm * 256 + wr * 64 + fr, c0 = wc * 32 + 8 * fq;
        if (pn < 16) {
            const int head = pn & 7; const bool isk = pn >= 8;
            bf16_t* out = (isk ? kd : qd) + head * 256; const float lg = l2g[head];
#pragma unroll
            for (int ai = 0; ai < 2; ++ai)
#pragma unroll
                for (int m = 0; m < 4; ++m) { const int row = row0 + ai * 128 + m * 16, r = row & 255;
                    const float dec = isk ? __builtin_amdgcn_exp2f(lg * (float)(255 - r)) * 0.0625f : __builtin_amdgcn_exp2f(lg * (float)(r - 255));
#pragma unroll
                    for (int bj = 0; bj < 2; ++bj) { const int c = c0 + bj * 128;
                        const f32x4* rp = (const f32x4*)(rope + ((size_t)row * 128 + (c >> 1)) * 2); const f32x4 t0 = rp[0], t1 = rp[1];
                        const f32x4 x = acc[ai][bj][m][0], y = acc[ai][bj][m][1]; f32x4 o0, o1;
                        o0[0] = (x[0] * t0[0] - x[1] * t0[1]) * dec; o0[1] = (x[1] * t0[0] + x[0] * t0[1]) * dec;
                        o0[2] = (x[2] * t0[2] - x[3] * t0[3]) * dec; o0[3] = (x[3] * t0[2] + x[2] * t0[3]) * dec;
                        o1[0] = (y[0] * t1[0] - y[1] * t1[1]) * dec; o1[1] = (y[1] * t1[0] + y[0] * t1[1]) * dec;
                        o1[2] = (y[2] * t1[2] - y[3] * t1[3]) * dec; o1[3] = (y[3] * t1[2] + y[2] * t1[3]) * dec;
                        *(u32x4*)(out + (size_t)row * DM + c) = pack8(o0, o1); } }
        } else if (pn < 32) {
            bf16_t* out = v + (pn - 16) * 256 + c0;
#pragma unroll
            for (int ai = 0; ai < 2; ++ai)
#pragma unroll
                for (int m = 0; m < 4; ++m) { const int row = row0 + ai * 128 + m * 16;
#pragma unroll
                    for (int bj = 0; bj < 2; ++bj) *(u32x4*)(out + (size_t)row * PW + bj * 128) = pack8(acc[ai][bj][m][0], acc[ai][bj][m][1]); }
        } else {
            bf16_t* out = sg + (pn - 32) * 256 + c0;
#pragma unroll
            for (int ai = 0; ai < 2; ++ai)
#pragma unroll
                for (int m = 0; m < 4; ++m) { const int row = row0 + ai * 128 + m * 16;
#pragma unroll
                    for (int bj = 0; bj < 2; ++bj) { f32x4 a = acc[ai][bj][m][0], b = acc[ai][bj][m][1];
#pragma unroll
                        for (int e = 0; e < 4; ++e) { a[e] = fsilu(a[e]); b[e] = fsilu(b[e]); }
                        *(u32x4*)(out + (size_t)row * PW + bj * 128) = pack8(a, b); } }
        }
    }
};
struct EpiPlain {
    bf16_t* O; int ldc;
    __device__ __forceinline__ void operator()(EPI_ARGS) const {
        bf16_t* out = O + (size_t)(u.pm * 256 + wr * 64 + fr) * ldc + u.pn * 256 + wc * 32 + 8 * fq;
#pragma unroll
        for (int ai = 0; ai < 2; ++ai)
#pragma unroll
            for (int m = 0; m < 4; ++m)
#pragma unroll
                for (int bj = 0; bj < 2; ++bj) *(u32x4*)(out + (size_t)(ai * 128 + m * 16) * ldc + bj * 128) = pack8(acc[ai][bj][m][0], acc[ai][bj][m][1]);
    }
};
template <bool RESF> struct EpiRes {
    const float* resf; const bf16_t* resb; bf16_t* aout; float* rpo;
    __device__ __forceinline__ void operator()(EPI_ARGS) const {
        const int row0 = u.pm * 256 + wr * 64 + fr, col0 = u.pn * 256 + wc * 32 + 8 * fq;
#pragma unroll
        for (int ai = 0; ai < 2; ++ai) {
            f32x4 rv[4][2][2];
#pragma unroll
            for (int m = 0; m < 4; ++m)
#pragma unroll
                for (int bj = 0; bj < 2; ++bj) { const size_t o = (size_t)(row0 + ai * 128 + m * 16) * DM + col0 + bj * 128;
                    if (RESF) { rv[m][bj][0] = __builtin_nontemporal_load((const f32x4*)(resf + o)); rv[m][bj][1] = __builtin_nontemporal_load((const f32x4*)(resf + o + 4)); }
                    else unpack8(*(const u32x4*)(resb + o), rv[m][bj][0], rv[m][bj][1]); }
#pragma unroll
            for (int m = 0; m < 4; ++m) { const int row = row0 + ai * 128 + m * 16; const size_t off = (size_t)row * DM + col0; float ss = 0.f;
#pragma unroll
                for (int bj = 0; bj < 2; ++bj) { const size_t o = off + bj * 128;
                    const f32x4 h0 = rv[m][bj][0] + acc[ai][bj][m][0], h1 = rv[m][bj][1] + acc[ai][bj][m][1];
                    ss += (h0[0] * h0[0] + h0[1] * h0[1]) + (h0[2] * h0[2] + h0[3] * h0[3]) + (h1[0] * h1[0] + h1[1] * h1[1]) + (h1[2] * h1[2] + h1[3] * h1[3]);
                    *(u32x4*)(aout + o) = pack8(h0, h1); }
                ss += __shfl_xor(ss, 16); ss += __shfl_xor(ss, 32);
                if (fq == 0) rpo[(size_t)row * 32 + u.pn * 4 + wc] = ss; }
            asm volatile("" ::: "memory"); }
    }
};
struct EpiPle {
    const bf16_t* hin; const bf16_t* pe; const LAS unsigned char* lds; bf16_t* aout; float* rpo;
    __device__ __forceinline__ void operator()(EPI_ARGS) const {
        const int row0 = u.pm * 256 + wr * 64 + fr, col0 = u.pn * 256 + wc * 32 + 8 * fq;
#pragma unroll
        for (int ai = 0; ai < 2; ++ai) {
            u32x4 hv[4][2], pv[4][2];
#pragma unroll
            for (int m = 0; m < 4; ++m)
#pragma unroll
                for (int bj = 0; bj < 2; ++bj) { const size_t o = (size_t)(row0 + ai * 128 + m * 16) * DM + col0 + bj * 128; hv[m][bj] = *(const u32x4*)(hin + o); pv[m][bj] = *(const u32x4*)(pe + o); }
#pragma unroll
            for (int m = 0; m < 4; ++m) { const int row = row0 + ai * 128 + m * 16; const size_t off = (size_t)row * DM + col0; float ss = 0.f;
                const float rstd = rstd_lds(lds, u.slot, row & 255);
#pragma unroll
                for (int bj = 0; bj < 2; ++bj) { const size_t o = off + bj * 128;
                    f32x4 h0, h1, p0, p1; unpack8(hv[m][bj], h0, h1); unpack8(pv[m][bj], p0, p1);
                    const f32x4 a0 = acc[ai][bj][m][0], a1 = acc[ai][bj][m][1];
#pragma unroll
                    for (int e = 0; e < 4; ++e) { h0[e] += fsigmoid(a0[e] * rstd) * p0[e]; h1[e] += fsigmoid(a1[e] * rstd) * p1[e]; }
                    ss += (h0[0] * h0[0] + h0[1] * h0[1]) + (h0[2] * h0[2] + h0[3] * h0[3]) + (h1[0] * h1[0] + h1[1] * h1[1]) + (h1[2] * h1[2] + h1[3] * h1[3]);
                    *(u32x4*)(aout + o) = pack8(h0, h1); }
                ss += __shfl_xor(ss, 16); ss += __shfl_xor(ss, 32);
                if (fq == 0) rpo[(size_t)row * 32 + u.pn * 4 + wc] = ss; }
            asm volatile("" ::: "memory"); }
    }
};
constexpr int FN_P_OFF = RING_BYTES + 8192, FN_S_OFF = FN_P_OFF + 4096;
constexpr int CW_FN_CNT = 16384, CW_FN_X = 32768;
struct EpiPleFinal {
    const bf16_t* hin; const bf16_t* pe; LAS unsigned char* lds; float* out; const float* gain; unsigned* ctl;
    __device__ __forceinline__ void operator()(EPI_ARGS) const {
        const int row0 = u.pm * 256 + wr * 64 + fr, col0 = u.pn * 256 + wc * 32 + 8 * fq;
        const int wid = wr * 4 + wc, tid = wid * 64 + fq * 16 + fr;
        LAS float* P = (LAS float*)(lds + FN_P_OFF); LAS float* S = (LAS float*)(lds + FN_S_OFF);
#pragma unroll
        for (int ai = 0; ai < 2; ++ai)
#pragma unroll
            for (int mp = 0; mp < 2; ++mp) {
                u32x4 hv[2][2], pv[2][2];
#pragma unroll
                for (int mm = 0; mm < 2; ++mm)
#pragma unroll
                    for (int bj = 0; bj < 2; ++bj) { const size_t o = (size_t)(row0 + ai * 128 + (2 * mp + mm) * 16) * DM + col0 + bj * 128;
                        hv[mm][bj] = *(const u32x4*)(hin + o); pv[mm][bj] = *(const u32x4*)(pe + o); }
#pragma unroll
                for (int mm = 0; mm < 2; ++mm) { const int m = 2 * mp + mm, row = row0 + ai * 128 + m * 16; float ss = 0.f;
                    const float rstd = rstd_lds(lds, u.slot, row & 255);
#pragma unroll
                    for (int bj = 0; bj < 2; ++bj) {
                        f32x4 h0, h1, p0, p1; unpack8(hv[mm][bj], h0, h1); unpack8(pv[mm][bj], p0, p1);
                        const f32x4 a0 = acc[ai][bj][m][0], a1 = acc[ai][bj][m][1];
#pragma unroll
                        for (int e = 0; e < 4; ++e) { h0[e] += fsigmoid(a0[e] * rstd) * p0[e]; h1[e] += fsigmoid(a1[e] * rstd) * p1[e]; }
                        acc[ai][bj][m][0] = h0; acc[ai][bj][m][1] = h1;
                        ss += (h0[0] * h0[0] + h0[1] * h0[1]) + (h0[2] * h0[2] + h0[3] * h0[3]) + (h1[0] * h1[0] + h1[1] * h1[1]) + (h1[2] * h1[2] + h1[3] * h1[3]); }
                    ss += __shfl_xor(ss, 16); ss += __shfl_xor(ss, 32);
                    if (fq == 0) P[(row & 255) * 4 + wc] = ss; }
                asm volatile("" ::: "memory"); }
        asm volatile("s_waitcnt lgkmcnt(0)" ::: "memory"); __builtin_amdgcn_s_barrier(); asm volatile("" ::: "memory");
        float* X = (float*)(ctl + CW_FN_X); unsigned* cnt = ctl + CW_FN_CNT + 64 * u.pm;
        if (tid < 256) { const float t = (P[tid * 4 + 0] + P[tid * 4 + 1]) + (P[tid * 4 + 2] + P[tid * 4 + 3]);
            __hip_atomic_store(X + ((size_t)(u.pm * 256 + tid) * 8 + u.pn), t, __ATOMIC_RELAXED, __HIP_MEMORY_SCOPE_AGENT);
            asm volatile("s_waitcnt vmcnt(0)" ::: "memory");
            if ((tid & 63) == 0) __hip_atomic_fetch_add(cnt, 1u, __ATOMIC_RELAXED, __HIP_MEMORY_SCOPE_AGENT); }
        if (wid == 0) {
            unsigned spins = 0;
            while ((unsigned)__builtin_amdgcn_readfirstlane(__hip_atomic_load(cnt, __ATOMIC_RELAXED, __HIP_MEMORY_SCOPE_AGENT)) < 32u) { __builtin_amdgcn_s_sleep(2); if (++spins > (1u << 22)) break; }
            __builtin_amdgcn_fence(__ATOMIC_ACQUIRE, "agent");
            asm volatile("s_waitcnt vmcnt(0)" ::: "memory"); }
        asm volatile("s_waitcnt vmcnt(0) lgkmcnt(0)" ::: "memory"); __builtin_amdgcn_s_barrier(); asm volatile("" ::: "memory");
        if (tid < 256) { const float* xs = X + (size_t)(u.pm * 256 + tid) * 8; float s = 0.f;
#pragma unroll
            for (int t = 0; t < 8; ++t) s += __hip_atomic_load(xs + t, __ATOMIC_RELAXED, __HIP_MEMORY_SCOPE_AGENT);
            S[tid] = __builtin_amdgcn_rsqf(s * (1.0f / DM) + NORM_EPS); }
        asm volatile("s_waitcnt lgkmcnt(0)" ::: "memory"); __builtin_amdgcn_s_barrier(); asm volatile("" ::: "memory");
        f32x4 gv[2][2];
#pragma unroll
        for (int bj = 0; bj < 2; ++bj) { gv[bj][0] = *(const f32x4*)(gain + col0 + bj * 128); gv[bj][1] = *(const f32x4*)(gain + col0 + bj * 128 + 4); }
#pragma unroll
        for (int ai = 0; ai < 2; ++ai)
#pragma unroll
            for (int m = 0; m < 4; ++m) { const int row = row0 + ai * 128 + m * 16; const float rs = S[row & 255]; const size_t off = (size_t)row * DM + col0;
#pragma unroll
                for (int bj = 0; bj < 2; ++bj) { *(f32x4*)(out + off + bj * 128) = acc[ai][bj][m][0] * rs * gv[bj][0]; *(f32x4*)(out + off + bj * 128 + 4) = acc[ai][bj][m][1] * rs * gv[bj][1]; } }
    }
};
struct EpiPoolIn {
    const LAS unsigned char* lds; bf16_t* uo; bf16_t* sgo;
    __device__ __forceinline__ void operator()(EPI_ARGS) const {
        const int row0 = u.pm * 256 + wr * 64 + fr; const bool isg = u.pn >= 16;
        bf16_t* out = (isg ? sgo : uo) + (u.pn & 15) * 256 + wc * 32 + 8 * fq;
#pragma unroll
        for (int ai = 0; ai < 2; ++ai)
#pragma unroll
            for (int m = 0; m < 4; ++m) { const int row = row0 + ai * 128 + m * 16; const float rstd = rstd_lds(lds, u.slot, row & 255);
#pragma unroll
                for (int bj = 0; bj < 2; ++bj) { f32x4 a = acc[ai][bj][m][0] * rstd, b = acc[ai][bj][m][1] * rstd;
                    if (isg) {
#pragma unroll
                        for (int e = 0; e < 4; ++e) { a[e] = fsilu(a[e]); b[e] = fsilu(b[e]); } }
                    *(u32x4*)(out + (size_t)row * PW + bj * 128) = pack8(a, b); } }
    }
};
struct EpiComb {
    bf16_t* O; int ldc; const float* scale;
    __device__ __forceinline__ void operator()(EPI_ARGS) const {
        const int row0 = u.pm * 256 + wr * 64 + fr;
        bf16_t* out = O + (size_t)row0 * ldc + u.pn * 256 + wc * 32 + 8 * fq;
#pragma unroll
        for (int ai = 0; ai < 2; ++ai)
#pragma unroll
            for (int m = 0; m < 4; ++m) { const float sc = scale[row0 + ai * 128 + m * 16];
#pragma unroll
                for (int bj = 0; bj < 2; ++bj) *(u32x4*)(out + (size_t)(ai * 128 + m * 16) * ldc + bj * 128) = pack8(acc[ai][bj][m][0] * sc, acc[ai][bj][m][1] * sc); }
    }
};

typedef GAS unsigned gu32;
#define RLX_AGENT __ATOMIC_RELAXED, __HIP_MEMORY_SCOPE_AGENT
#define XB_TMO      128
#define XB_XCNT(j)  (256  + 64 * (j))
#define XB_XSUB(j)  (1280 + 64 * (j))
#define XB_XGEN(j)  (2304 + 64 * (j))
#define XB_TOP      3328
#define XB_TOPGEN   3392
#define XCD_BAR_WORDS 3456
#define XB_SPIN_CAP (1u << 20)
__device__ __forceinline__ unsigned xb_ld(unsigned* p)              { return __hip_atomic_load(p, __ATOMIC_RELAXED, __HIP_MEMORY_SCOPE_AGENT); }
__device__ __forceinline__ unsigned xb_add(unsigned* p, unsigned v) { return __hip_atomic_fetch_add(p, v, __ATOMIC_RELAXED, __HIP_MEMORY_SCOPE_AGENT); }
__device__ __forceinline__ unsigned xb_xcc_id() { return (unsigned)__builtin_amdgcn_s_getreg((3 << 11) | 20) & 0xFu; }
#define XB_SPIN(cond, bar) do { unsigned _sp = 0; while (cond) { __builtin_amdgcn_s_sleep(1); \
    if ((++_sp & 255u) == 0u) { if (xb_ld(&(bar)[XB_TMO])) break; if (_sp > XB_SPIN_CAP) { atomicAdd(&(bar)[XB_TMO], 1u); break; } } } } while (0)
struct XcdBarrier { unsigned* bar; unsigned x; volatile LAS unsigned* st; };
__device__ __forceinline__ XcdBarrier xcd_barrier_post(unsigned* bar, volatile LAS unsigned* st, const int wave) {
    XcdBarrier b; b.bar = bar; b.x = xb_xcc_id(); b.st = st;
    if (wave == 0 && lane_id() == 0) (void)xb_add(&bar[XB_XCNT(b.x)], 1u);
    return b;
}
__device__ __forceinline__ void xcd_barrier_complete(unsigned* bar, unsigned x, unsigned& nloc, unsigned& nx) {
    const unsigned G = gridDim.x * gridDim.y * gridDim.z;
    unsigned sum, cnt, mine, sp = 0u;
    for (;;) {
        sum = 0u; cnt = 0u; mine = 0u;
#pragma unroll
        for (unsigned j = 0; j < 16; ++j) { const unsigned c = xb_ld(&bar[XB_XCNT(j)]); sum += c; cnt += (c > 0u) ? 1u : 0u; mine = (j == x) ? c : mine; }
        if (sum == G) break;
        __builtin_amdgcn_s_sleep(1);
        if ((++sp & 255u) == 0u) { if (xb_ld(&bar[XB_TMO])) break; if (sp > XB_SPIN_CAP) { atomicAdd(&bar[XB_TMO], 1u); break; } }
    }
    nloc = mine > 0u ? mine : 1u; nx = cnt > 0u ? cnt : 1u;
}
__device__ __forceinline__ void xcd_barrier(const XcdBarrier& b, const int wave) {
    asm volatile("s_waitcnt vmcnt(0)" ::: "memory");
    __syncthreads();
    if (wave == 0 && lane_id() == 0) {
        unsigned* bar = b.bar;
        __builtin_amdgcn_s_waitcnt(0);
        unsigned nloc = b.st[0], nx = b.st[1];
        if (nloc == 0u) { xcd_barrier_complete(bar, b.x, nloc, nx); b.st[0] = nloc; b.st[1] = nx; }
        const unsigned old = xb_add(&bar[XB_XSUB(b.x)], 1u);
        const unsigned gen = old / nloc;
        if (old + 1u == (gen + 1u) * nloc) {
            __builtin_amdgcn_fence(__ATOMIC_RELEASE, "agent");
            asm volatile("s_waitcnt vmcnt(0)" ::: "memory");
            const unsigned og = xb_add(&bar[XB_TOP], 1u);
            const unsigned tg = og / nx;
            if (og + 1u == (tg + 1u) * nx) xb_add(&bar[XB_TOPGEN], 1u);
            else XB_SPIN(xb_ld(&bar[XB_TOPGEN]) == tg, bar);
            __builtin_amdgcn_fence(__ATOMIC_ACQUIRE, "agent");
            xb_add(&bar[XB_XGEN(b.x)], 1u);
            asm volatile("s_waitcnt vmcnt(0)" ::: "memory");
        } else {
            XB_SPIN(xb_ld(&bar[XB_XGEN(b.x)]) == gen, bar);
            __builtin_amdgcn_fence(__ATOMIC_ACQUIRE, "agent");
            asm volatile("s_waitcnt vmcnt(0)" ::: "memory");
        }
    }
    __syncthreads();
}

__device__ __forceinline__ void tr_item(const float* W, int N, bf16_t* WT, int Kt, LAS float* scr, int item, int lane) {
    const int nblk = N >> 6, kb = item / nblk, nb = item - kb * nblk, k0 = kb << 6, n0 = nb << 6;
    const int c = lane & 15, rr = lane >> 4;
    f32x4 v[16];
#pragma unroll
    for (int i = 0; i < 16; ++i) v[i] = __builtin_nontemporal_load((const f32x4*)(W + (size_t)(k0 + 4 * i + rr) * N + n0 + 4 * c));
#pragma unroll
    for (int i = 0; i < 16; ++i) { LAS float* s = scr + (4 * i + rr) * 65 + 4 * c; s[0] = v[i][0]; s[1] = v[i][1]; s[2] = v[i][2]; s[3] = v[i][3]; }
    LDS_WAIT();
    const int kc = lane & 7;
#pragma unroll
    for (int jj = 0; jj < 8; ++jj) { const int n = (lane >> 3) + 8 * jj; const LAS float* s = scr + (8 * kc) * 65 + n;
        u32x4 o; o.x = cvt_pk_bf16(s[0], s[65]); o.y = cvt_pk_bf16(s[130], s[195]); o.z = cvt_pk_bf16(s[260], s[325]); o.w = cvt_pk_bf16(s[390], s[455]);
        *(u32x4*)(WT + (size_t)(n0 + n) * Kt + k0 + 8 * kc) = o; }
    LDS_WAIT();
}
__device__ __forceinline__ double sin2pi(double r) {
    r -= rint(r);
    if (r > 0.25) r = 0.5 - r; else if (r < -0.25) r = -0.5 - r;
    const double x = r * 6.283185307179586476925, x2 = x * x;
    double p = -1.0 / 1307674368000.0;
    p = p * x2 + 1.0 / 6227020800.0; p = p * x2 - 1.0 / 39916800.0; p = p * x2 + 1.0 / 362880.0; p = p * x2 - 1.0 / 5040.0;
    p = p * x2 + 1.0 / 120.0; p = p * x2 - 1.0 / 6.0; p = p * x2 + 1.0;
    return x * p;
}

struct Args { const float* in[14]; float* out; unsigned char* ws; float freq[128]; float l2g[8]; float g256[8]; int ph_lo, ph_hi; };

__device__ __forceinline__ void p_prologue(const Args& a, LAS unsigned char* lds, const int wave) {
    const int lane = lane_id(), tid = wave * 64 + lane;
    unsigned char* ws = a.ws;
    LAS float* scr = (LAS float*)(lds + wave * 16640);
    const int gw = blockIdx.x * 8 + wave, NGW = gridDim.x * 8;
    constexpr int I_RI = (DM / 64) * (RPROJ / 64);
    for (int it = gw; it < I_RI; it += NGW) tr_item(a.in[3], RPROJ, (bf16_t*)(ws + WS_WT_RI), DM, scr, it, lane);
    const float* x = a.in[0]; const float* gain = a.in[2]; bf16_t* xn = (bf16_t*)(ws + WS_XN0);
    for (int m = gw; m < SEQ; m += NGW) {
        const f32x4* xr = (const f32x4*)(x + (size_t)m * DM) + lane; f32x4 v[8]; float s = 0.f;
#pragma unroll
        for (int j = 0; j < 8; ++j) { v[j] = __builtin_nontemporal_load(xr + 64 * j); s += (v[j][0] * v[j][0] + v[j][1] * v[j][1]) + (v[j][2] * v[j][2] + v[j][3] * v[j][3]); }
        const float rstd = __builtin_amdgcn_rsqf(wave_sum(s) * (1.0f / DM) + NORM_EPS);
        u32x2* o = (u32x2*)(xn + (size_t)m * DM) + lane;
#pragma unroll
        for (int j = 0; j < 8; ++j) { const f32x4 g = *((const f32x4*)gain + lane + 64 * j); const f32x4 y = v[j] * rstd * g; u32x2 w; w.x = cvt_pk_bf16(y[0], y[1]); w.y = cvt_pk_bf16(y[2], y[3]); o[64 * j] = w; }
    }
    const int gt = blockIdx.x * 512 + tid, NGT = gridDim.x * 512;
    { const float* p = a.in[1]; bf16_t* pb = (bf16_t*)(ws + WS_PBF);
      for (int i = gt; i < 2 * SEQ * PLE / 8; i += NGT) { const f32x4 a0 = __builtin_nontemporal_load((const f32x4*)(p + (size_t)i * 8)), a1 = __builtin_nontemporal_load((const f32x4*)(p + (size_t)i * 8 + 4)); *(u32x4*)(pb + (size_t)i * 8) = pack8(a0, a1); } }
    { f32x2* rope = (f32x2*)(ws + WS_ROPE);
      for (int i = gt; i < SEQ * 128; i += NGT) { const int pos = i >> 7, fi = i & 127; const float ang = (float)pos * a.freq[fi];
          const double rev = (double)ang * 0.15915494309189533577; f32x2 cs; cs.x = (float)sin2pi(rev + 0.25); cs.y = (float)sin2pi(rev); rope[i] = cs; } }
}
struct CvDesc { const float* src; bf16_t* dst; const float* kg; int N, Kt, plain; };
constexpr int CV_RO = (PW / 64) * (DM / 32), CV_G = (DM / 64) * (DM / 32), CV_P = (PLE / 64) * (DM / 32), CV_PIG = (DM / 64) * (PW / 32), CV_GR = (1024 / 64) * (1024 / 32), CV_WU = DM * PW / 2048;
constexpr int CV_ITEMS = CV_RO + 2 * CV_G + 2 * CV_P + CV_PIG + 4 * CV_GR + CV_RO + CV_WU;
__device__ __forceinline__ CvDesc cv_tr(const float* W, int N, int ncols, bf16_t* WT, int Kt, int r, const float* kg = nullptr) {
    const int nblk = ncols >> 5, kb = r / nblk, nb = r - kb * nblk; CvDesc d; d.src = W + (size_t)(kb * 64) * N + nb * 32; d.dst = WT + (size_t)(nb * 32) * Kt + kb * 64; d.kg = kg ? kg + kb * 64 : nullptr; d.N = N; d.Kt = Kt; d.plain = 0; return d; }
__device__ __forceinline__ CvDesc cv_decode(const Args& a, int r) {
    unsigned char* ws = a.ws;
    if (r < CV_RO) return cv_tr(a.in[4], DM, DM, (bf16_t*)(ws + WS_WT_RO), PW, r); r -= CV_RO;
    if (r < CV_G) return cv_tr(a.in[11], DM, DM, (bf16_t*)(ws + WS_WT_G0), DM, r, a.in[10]); r -= CV_G;
    if (r < CV_G) return cv_tr(a.in[11] + (size_t)DM * DM, DM, DM, (bf16_t*)(ws + WS_WT_G1), DM, r, a.in[10] + DM); r -= CV_G;
    if (r < CV_P) return cv_tr(a.in[12], DM, DM, (bf16_t*)(ws + WS_WT_P0), PLE, r); r -= CV_P;
    if (r < CV_P) return cv_tr(a.in[12] + (size_t)PLE * DM, DM, DM, (bf16_t*)(ws + WS_WT_P1), PLE, r); r -= CV_P;
    if (r < CV_PIG) return cv_tr(a.in[6] + PW, 2 * PW, PW, (bf16_t*)(ws + WS_WT_PI) + (size_t)PW * DM, DM, r, a.in[5]); r -= CV_PIG;
    if (r < 4 * CV_GR) { const int g = r / CV_GR; return cv_tr(a.in[7] + (size_t)g * 1024 * 1024, 1024, 1024, (bf16_t*)(ws + WS_WT_GR) + (size_t)g * 1024 * 1024, 1024, r - g * CV_GR); } r -= 4 * CV_GR;
    if (r < CV_RO) return cv_tr(a.in[9], DM, DM, (bf16_t*)(ws + WS_WT_PO), PW, r); r -= CV_RO;
    CvDesc d; const int row = r >> 1, c0 = (r & 1) * 2048; d.src = a.in[6] + (size_t)row * (2 * PW) + c0; d.dst = (bf16_t*)(ws + WS_WU) + (size_t)row * PW + c0; d.kg = a.in[5] + row; d.N = 0; d.Kt = 0; d.plain = 1; return d;
}
__device__ __forceinline__ void cv_load(const CvDesc& d, f32x4 (&cv)[8], int lane) {
    if (d.plain) {
#pragma unroll
        for (int j = 0; j < 4; ++j) { cv[2 * j] = __builtin_nontemporal_load((const f32x4*)(d.src + lane * 8 + 512 * j)); cv[2 * j + 1] = __builtin_nontemporal_load((const f32x4*)(d.src + lane * 8 + 512 * j + 4)); }
    } else {
#pragma unroll
        for (int i = 0; i < 8; ++i) cv[i] = __builtin_nontemporal_load((const f32x4*)(d.src + (size_t)(8 * i + (lane >> 3)) * d.N + 4 * (lane & 7)));
    }
}
__device__ __forceinline__ void cv_store(const CvDesc& d, const f32x4 (&cv)[8], LAS float* scr, int lane) {
    if (d.plain) {
        const float kgv = d.kg[0];
#pragma unroll
        for (int j = 0; j < 4; ++j) *(u32x4*)(d.dst + lane * 8 + 512 * j) = pack8(cv[2 * j] * kgv, cv[2 * j + 1] * kgv);
    } else {
#pragma unroll
        for (int i = 0; i < 8; ++i) { const float kgv = d.kg ? d.kg[8 * i + (lane >> 3)] : 1.0f; LAS float* s = scr + (8 * i + (lane >> 3)) * 33 + 4 * (lane & 7); s[0] = cv[i][0] * kgv; s[1] = cv[i][1] * kgv; s[2] = cv[i][2] * kgv; s[3] = cv[i][3] * kgv; }
        LDS_WAIT();
        const int kc = lane & 7;
#pragma unroll
        for (int j = 0; j < 4; ++j) { const int n = (lane >> 3) + 8 * j; const LAS float* s = scr + (8 * kc) * 33 + n;
            u32x4 o; o.x = cvt_pk_bf16(s[0], s[33]); o.y = cvt_pk_bf16(s[66], s[99]); o.z = cvt_pk_bf16(s[132], s[165]); o.w = cvt_pk_bf16(s[198], s[231]);
            *(u32x4*)(d.dst + (size_t)n * d.Kt + 8 * kc) = o; }
        LDS_WAIT();
    }
}

__device__ __forceinline__ void tr_item_g(const float* W, int N, int ncols, bf16_t* WT, int Kt, LAS float* scr, int item, int lane, const float* kg) {
    const int nblk = ncols >> 6, kb = item / nblk, nb = item - kb * nblk, k0 = kb << 6, n0 = nb << 6;
    const int c = lane & 15, rr = lane >> 4;
    f32x4 v[16];
#pragma unroll
    for (int i = 0; i < 16; ++i) v[i] = __builtin_nontemporal_load((const f32x4*)(W + (size_t)(k0 + 4 * i + rr) * N + n0 + 4 * c));
#pragma unroll
    for (int i = 0; i < 16; ++i) { const float g = kg ? kg[k0 + 4 * i + rr] : 1.0f; LAS float* s = scr + (4 * i + rr) * 65 + 4 * c; s[0] = v[i][0] * g; s[1] = v[i][1] * g; s[2] = v[i][2] * g; s[3] = v[i][3] * g; }
    LDS_WAIT();
    const int kc = lane & 7;
#pragma unroll
    for (int jj = 0; jj < 8; ++jj) { const int n = (lane >> 3) + 8 * jj; const LAS float* s = scr + (8 * kc) * 65 + n;
        u32x4 o; o.x = cvt_pk_bf16(s[0], s[65]); o.y = cvt_pk_bf16(s[130], s[195]); o.z = cvt_pk_bf16(s[260], s[325]); o.w = cvt_pk_bf16(s[390], s[455]);
        *(u32x4*)(WT + (size_t)(n0 + n) * Kt + k0 + 8 * kc) = o; }
    LDS_WAIT();
}
__device__ __forceinline__ void p_weights_big(const Args& a, LAS unsigned char* lds, const int wave) {
    const int lane = lane_id();
    unsigned char* ws = a.ws;
    LAS float* scr = (LAS float*)(lds + wave * 16640);
    const int gw = (blockIdx.x - 128) * 8 + wave, NGW = (gridDim.x - 128) * 8;
    constexpr int I_RO = (PW / 64) * (DM / 64), I_G = (DM / 64) * (DM / 64), I_P = (PLE / 64) * (DM / 64), I_PIG = (DM / 64) * (PW / 64), I_GR = (1024 / 64) * (1024 / 64), I_WU = DM * PW / 2048;
    for (int it = gw; it < I_RO + 2 * I_G + 2 * I_P + I_PIG + 4 * I_GR + I_RO + I_WU; it += NGW) {
        int r = it;
        if (r < I_RO) { tr_item_g(a.in[4], DM, DM, (bf16_t*)(ws + WS_WT_RO), PW, scr, r, lane, nullptr); continue; } r -= I_RO;
        if (r < I_G) { tr_item_g(a.in[11], DM, DM, (bf16_t*)(ws + WS_WT_G0), DM, scr, r, lane, a.in[10]); continue; } r -= I_G;
        if (r < I_G) { tr_item_g(a.in[11] + (size_t)DM * DM, DM, DM, (bf16_t*)(ws + WS_WT_G1), DM, scr, r, lane, a.in[10] + DM); continue; } r -= I_G;
        if (r < I_P) { tr_item_g(a.in[12], DM, DM, (bf16_t*)(ws + WS_WT_P0), PLE, scr, r, lane, nullptr); continue; } r -= I_P;
        if (r < I_P) { tr_item_g(a.in[12] + (size_t)PLE * DM, DM, DM, (bf16_t*)(ws + WS_WT_P1), PLE, scr, r, lane, nullptr); continue; } r -= I_P;
        if (r < I_PIG) { tr_item_g(a.in[6] + PW, 2 * PW, PW, (bf16_t*)(ws + WS_WT_PI) + (size_t)PW * DM, DM, scr, r, lane, a.in[5]); continue; } r -= I_PIG;
        if (r < 4 * I_GR) { const int g = r / I_GR; tr_item_g(a.in[7] + (size_t)g * 1024 * 1024, 1024, 1024, (bf16_t*)(ws + WS_WT_GR) + (size_t)g * 1024 * 1024, 1024, scr, r - g * I_GR, lane, nullptr); continue; } r -= 4 * I_GR;
        if (r < I_RO) { tr_item_g(a.in[9], DM, DM, (bf16_t*)(ws + WS_WT_PO), PW, scr, r, lane, nullptr); continue; } r -= I_RO;
        { const int row = r >> 1, c0 = (r & 1) * 2048 + lane * 8; const float* srcp = a.in[6] + (size_t)row * (2 * PW) + c0; bf16_t* dstp = (bf16_t*)(ws + WS_WU) + (size_t)row * PW + c0; const float g = a.in[5][row];
#pragma unroll
            for (int j = 0; j < 4; ++j) { const f32x4 x0 = __builtin_nontemporal_load((const f32x4*)(srcp + 512 * j)), x1 = __builtin_nontemporal_load((const f32x4*)(srcp + 512 * j + 4)); *(u32x4*)(dstp + 512 * j) = pack8(x0 * g, x1 * g); } }
    }
}

__device__ __forceinline__ bf16x8 tr_frag(const LAS unsigned char* p, int pitch16) {
    const s16x4 lo = __builtin_amdgcn_ds_read_tr16_b64_v4i16((LAS s16x4*)p), hi = __builtin_amdgcn_ds_read_tr16_b64_v4i16((LAS s16x4*)(p + pitch16));
    return (bf16x8){lo[0], lo[1], lo[2], lo[3], hi[0], hi[1], hi[2], hi[3]};
}

__device__ __forceinline__ void p_scan(const Args& a, LAS unsigned char* lds, const int w) {
    const int lane = lane_id();
    const int tid = w * 64 + lane, b = blockIdx.x, h = b & 7, tt = b >> 3, dt = tt >> 2, vt = tt & 3;
    const int db = w >> 1, vbp = w & 1, g = lane >> 4, i16 = lane & 15, q4 = i16 >> 2, p4 = i16 & 3;
    const float g256 = a.g256[h];
    constexpr int PK = 160, PV = 288, TK = 128 * PK, TV = 128 * PV, BUF = TK + TV;
    const bf16_t* kbase = (const bf16_t*)(a.ws + WS_KD) + h * 256 + dt * 64;
    const bf16_t* vbase = (const bf16_t*)(a.ws + WS_V) + h * 512 + vt * 128;
    bf16_t* st = (bf16_t*)(a.ws + WS_ST);
    u32x4 rk0[2], rv0[4], rk1[2], rv1[4], rk2[2], rv2[4], rk3[2], rv3[4];
#define P2_LOAD(RK, RV, hs) do { const int _hs = (hs) < 62 ? (hs) : 61; \
        _Pragma("unroll") for (int _i = 0; _i < 2; ++_i) { const int _p = tid + 512 * _i; RK[_i] = *(const u32x4*)(kbase + (size_t)(_hs * 128 + (_p >> 3)) * DM + (_p & 7) * 8); } \
        _Pragma("unroll") for (int _i = 0; _i < 4; ++_i) { const int _p = tid + 512 * _i; RV[_i] = *(const u32x4*)(vbase + (size_t)(_hs * 128 + (_p >> 4)) * PW + (_p & 15) * 8); } } while (0)
#define P2_STORE(RK, RV, s) do { \
        _Pragma("unroll") for (int _i = 0; _i < 2; ++_i) { const int _p = tid + 512 * _i; *(LAS u32x4*)(lds + (s) * BUF + (_p >> 3) * PK + (_p & 7) * 16) = RK[_i]; } \
        _Pragma("unroll") for (int _i = 0; _i < 4; ++_i) { const int _p = tid + 512 * _i; *(LAS u32x4*)(lds + (s) * BUF + TK + (_p >> 4) * PV + (_p & 15) * 16) = RV[_i]; } } while (0)
    f32x4 acc[4];
#pragma unroll
    for (int j = 0; j < 4; ++j) acc[j] = (f32x4){0.f, 0.f, 0.f, 0.f};
    const int lk = (4 * g + q4) * PK + 8 * p4 + db * 32, lv = (4 * g + q4) * PV + 8 * p4 + vbp * 128;
#define P2_STEP(hs, RKN, RVN) do { const int _h = (hs); if (_h < 62) { \
        const LAS unsigned char* kt = lds + (_h & 1) * BUF + lk; const LAS unsigned char* vtp = lds + (_h & 1) * BUF + TK + lv; \
        _Pragma("unroll") for (int ks = 0; ks < 4; ++ks) { \
            const bf16x8 kf = tr_frag(kt + ks * 32 * PK, 16 * PK); \
            _Pragma("unroll") for (int j = 0; j < 4; ++j) { const bf16x8 vf = tr_frag(vtp + ks * 32 * PV + 32 * j, 16 * PV); acc[j] = __builtin_amdgcn_mfma_f32_16x16x32_bf16(vf, kf, acc[j], 0, 0, 0); } } \
        if (_h & 1) { const int n = _h >> 1; \
            bf16_t* o = st + ((size_t)(n * 8 + h) * 256 + dt * 64 + db * 16 + i16) * 512 + vt * 128 + vbp * 64 + 4 * g; \
            _Pragma("unroll") for (int j = 0; j < 4; ++j) { acc[j] *= g256; u32x2 w0; w0.x = cvt_pk_bf16(acc[j][0], acc[j][1]); w0.y = cvt_pk_bf16(acc[j][2], acc[j][3]); *(u32x2*)(o + 16 * j) = w0; } } \
        if (_h + 1 < 62) { P2_STORE(RKN, RVN, (_h + 1) & 1); P2_LOAD(RKN, RVN, _h + 5); } \
        __syncthreads(); } } while (0)
    P2_LOAD(rk0, rv0, 0); P2_LOAD(rk1, rv1, 1); P2_LOAD(rk2, rv2, 2); P2_LOAD(rk3, rv3, 3);
    P2_STORE(rk0, rv0, 0); P2_LOAD(rk0, rv0, 4); __syncthreads();
    for (int hs = 0; hs < 62; hs += 4) {
        P2_STEP(hs, rk1, rv1); P2_STEP(hs + 1, rk2, rv2); P2_STEP(hs + 2, rk3, rv3); P2_STEP(hs + 3, rk0, rv0);
    }
#undef P2_STEP
#undef P2_LOAD
#undef P2_STORE
}

__device__ __forceinline__ void p_retention(const Args& a, LAS unsigned char* lds, const int w) {
    const int lane = lane_id();
    const int tid = w * 64 + lane, b = blockIdx.x;
    const int g = lane >> 4, i16 = lane & 15, q4 = i16 >> 2, p4 = i16 & 3;
    constexpr int PP = 528, RINGO = 128 * PP, RB = 33792, ST1 = RINGO + 2 * RB, ST2 = ST1 + 8192;
    const bf16_t* qd = (const bf16_t*)(a.ws + WS_QD); const bf16_t* kd = (const bf16_t*)(a.ws + WS_KD); const bf16_t* v = (const bf16_t*)(a.ws + WS_V);
    const bf16_t* sg = (const bf16_t*)(a.ws + WS_SG); const bf16_t* st = (const bf16_t*)(a.ws + WS_ST); bf16_t* z = (bf16_t*)(a.ws + WS_Z);
    const unsigned offk = (unsigned)(((tid >> 5) * DM + (tid & 31) * 8) * 2), offv = (unsigned)(((tid >> 6) * PW + (tid & 63) * 8) * 2), offt = (unsigned)(((tid >> 6) * 512 + (tid & 63) * 8) * 2);
    const int xs = b & 7, kq = b >> 3, pair = kq >> 1, member = kq & 1;
    for (int rnd = 0; rnd < 2; ++rnd) {
        const int nh = (pair * 2 + rnd) * 8 + xs, n = nh >> 3, h = nh & 7, hf = member ^ rnd;
        const int nsb = 2 * (hf + 1), nvb = 4 * (hf + 1), ntb = n > 0 ? 8 : 0, nblk = nsb + nvb + ntb;
        const int rowbase = 256 * n + 128 * hf;
        u32x4 ra[4], rb[4];
#define P3_LOAD(R, it) do { const int _it = (it) < nblk ? (it) : nblk - 1; \
        if (_it < ntb) { const char* _b = (const char*)(st + ((size_t)((n - 1) * 8 + h) * 256 + 32 * _it) * 512); unsigned _o = offt; asm volatile("" : "+v"(_o)); \
            _Pragma("unroll") for (int _i = 0; _i < 4; ++_i) R[_i] = *(const u32x4*)(_b + (size_t)_i * (8 * 512 * 2) + _o); } \
        else if (_it < ntb + nsb) { const char* _b = (const char*)(kd + (size_t)(256 * n + 64 * (_it - ntb)) * DM + h * 256); unsigned _o = offk; asm volatile("" : "+v"(_o)); \
            _Pragma("unroll") for (int _i = 0; _i < 4; ++_i) R[_i] = *(const u32x4*)(_b + (size_t)_i * (16 * DM * 2) + _o); } \
        else { const char* _b = (const char*)(v + (size_t)(256 * n + 32 * (_it - ntb - nsb)) * PW + h * 512); unsigned _o = offv; asm volatile("" : "+v"(_o)); \
            _Pragma("unroll") for (int _i = 0; _i < 4; ++_i) R[_i] = *(const u32x4*)(_b + (size_t)_i * (8 * PW * 2) + _o); } } while (0)
#define P3_STORE(R, it) do { const int _it = (it); if (_it < nblk) { LAS unsigned char* _d = lds + RINGO + (_it & 1) * RB; \
        if (_it >= ntb && _it < ntb + nsb) { _Pragma("unroll") for (int _i = 0; _i < 4; ++_i) { const int _p = tid + 512 * _i; *(LAS u32x4*)(_d + (_p >> 5) * 528 + (_p & 31) * 16) = R[_i]; } } \
        else { _Pragma("unroll") for (int _i = 0; _i < 4; ++_i) { const int _p = tid + 512 * _i; *(LAS u32x4*)(_d + (_p >> 6) * 1056 + (_p & 63) * 16) = R[_i]; } } } } while (0)
        P3_LOAD(ra, 0); P3_LOAD(rb, 1);
        if (ntb) {
#pragma unroll 2
            for (int i = 0; i < 8; ++i) { const int p = tid + 512 * i, row = p >> 5, c = p & 31, G = c >> 2, cc = c & 3;
                const u32x4 x = *(const u32x4*)(qd + (size_t)(rowbase + row) * DM + h * 256 + c * 8);
                const int s = cc >> 1, glo = (2 * cc) & 3, ghi = (2 * cc + 1) & 3;
                LAS unsigned char* d = lds + row * PP + 64 * G;
                *(LAS u32x2*)(d + 8 * (2 * glo + s)) = (u32x2){x.x, x.y}; *(LAS u32x2*)(d + 8 * (2 * ghi + s)) = (u32x2){x.z, x.w}; }
        }
        P3_STORE(ra, 0); P3_LOAD(ra, 2); __syncthreads();
        f32x4 acc[8][4];
#pragma unroll
        for (int rbk = 0; rbk < 8; ++rbk)
#pragma unroll
            for (int cb = 0; cb < 4; ++cb) acc[rbk][cb] = (f32x4){0.f, 0.f, 0.f, 0.f};
#define P3_YSTEP(it_, RN, ISV) do { const int it = (it_); \
            const LAS unsigned char* ring = lds + RINGO + (it & 1) * RB; \
            { const int kk = (ISV) ? it - ntb - nsb : it; \
                bf16x8 vf[4]; \
                _Pragma("unroll") for (int cb = 0; cb < 4; ++cb) vf[cb] = tr_frag(ring + (4 * g + q4) * 1056 + (64 * w + 16 * cb + 4 * p4) * 2, 16 * 1056); \
                _Pragma("unroll") for (int rbk = 0; rbk < 8; ++rbk) { \
                    if ((ISV) && 32 * kk > 128 * hf + 16 * rbk + 15) continue; \
                    const bf16x8 pf = *(const LAS bf16x8*)(lds + (16 * rbk + i16) * PP + (32 * kk + 8 * g) * 2); \
                    _Pragma("unroll") for (int cb = 0; cb < 4; ++cb) acc[rbk][cb] = __builtin_amdgcn_mfma_f32_16x16x32_bf16(vf[cb], pf, acc[rbk][cb], 0, 0, 0); \
                } } \
            P3_STORE(RN, it + 1); P3_LOAD(RN, it + 3); \
            __syncthreads(); } while (0)
        for (int it2 = 0; it2 < ntb; it2 += 2) { P3_YSTEP(it2, rb, false); P3_YSTEP(it2 + 1, ra, false); }
        {
            bf16x8 qf[8];
#pragma unroll
            for (int ds = 0; ds < 8; ++ds) qf[ds] = *(const bf16x8*)(qd + (size_t)(rowbase + 16 * w + i16) * DM + h * 256 + 32 * ds + 8 * g);
#define P3_SSTEP(it_, RN) do { const int it = (it_), sbk = it - ntb; \
                const LAS unsigned char* ring = lds + RINGO + (it & 1) * RB; \
                _Pragma("unroll") for (int sb = 0; sb < 4; ++sb) { \
                    const int j0 = 64 * sbk + 16 * sb, i0 = 128 * hf + 16 * w; \
                    LAS unsigned char* dst = lds + (16 * w + i16) * PP + (32 * (2 * sbk + (sb >> 1)) + 8 * g + 4 * (sb & 1)) * 2; \
                    if (j0 > i0) { *(LAS u32x2*)dst = (u32x2){0u, 0u}; } \
                    else { \
                        f32x4 s4 = {0.f, 0.f, 0.f, 0.f}; \
                        _Pragma("unroll") for (int ds = 0; ds < 8; ++ds) { const bf16x8 kf = *(const LAS bf16x8*)(ring + (16 * sb + i16) * 528 + (32 * ds + 8 * g) * 2); \
                            s4 = __builtin_amdgcn_mfma_f32_16x16x32_bf16(kf, qf[ds], s4, 0, 0, 0); } \
                        if (j0 == i0) { _Pragma("unroll") for (int r = 0; r < 4; ++r) if (4 * g + r > i16) s4[r] = 0.f; } \
                        u32x2 wv; wv.x = cvt_pk_bf16(s4[0], s4[1]); wv.y = cvt_pk_bf16(s4[2], s4[3]); *(LAS u32x2*)dst = wv; \
                    } \
                } \
                P3_STORE(RN, it + 1); P3_LOAD(RN, it + 3); \
                __syncthreads(); } while (0)
            for (int it2 = ntb; it2 < ntb + nsb; it2 += 2) { P3_SSTEP(it2, rb); P3_SSTEP(it2 + 1, ra); }
#undef P3_SSTEP
        }
        for (int it2 = ntb + nsb; it2 < nblk; it2 += 2) { P3_YSTEP(it2, rb, true); P3_YSTEP(it2 + 1, ra, true); }
#undef P3_YSTEP
#undef P3_LOAD
#undef P3_STORE
        LAS f32x2* S1 = (LAS f32x2*)(lds + ST1); LAS f32x2* S2 = (LAS f32x2*)(lds + ST2);
#pragma unroll
        for (int rbk = 0; rbk < 8; ++rbk) { float s1 = 0.f, s2 = 0.f;
#pragma unroll
            for (int cb = 0; cb < 4; ++cb) { const f32x4 y = acc[rbk][cb]; s1 += (y[0] + y[1]) + (y[2] + y[3]); s2 += (y[0] * y[0] + y[1] * y[1]) + (y[2] * y[2] + y[3] * y[3]); }
            s1 += __shfl_xor(s1, 16); s1 += __shfl_xor(s1, 32); s2 += __shfl_xor(s2, 16); s2 += __shfl_xor(s2, 32);
            if (g == 0) S1[(16 * rbk + i16) * 8 + w] = (f32x2){s1, s2}; }
        __syncthreads();
        if (tid < 128) { float s1 = 0.f, s2 = 0.f;
#pragma unroll
            for (int k = 0; k < 8; ++k) { const f32x2 t = S1[tid * 8 + k]; s1 += t.x; s2 += t.y; }
            const float mean = s1 * (1.0f / 512.0f), var = s2 * (1.0f / 512.0f) - mean * mean;
            S2[tid] = (f32x2){mean, __builtin_amdgcn_rsqf(fmaxf(var, 0.f) + GN_EPS)}; }
        __syncthreads();
#pragma unroll
        for (int rbk = 0; rbk < 8; ++rbk) { const f32x2 ms = S2[16 * rbk + i16];
            const size_t off = (size_t)(rowbase + 16 * rbk + i16) * PW + h * 512 + 64 * w + 4 * g;
#pragma unroll
            for (int cb = 0; cb < 4; ++cb) { const u32x2 gw = __builtin_nontemporal_load((const u32x2*)(sg + off + 16 * cb)); const f32x4 y = acc[rbk][cb];
                u32x2 o; o.x = cvt_pk_bf16((y[0] - ms.x) * ms.y * bf_lo(gw.x), (y[1] - ms.x) * ms.y * bf_hi(gw.x)); o.y = cvt_pk_bf16((y[2] - ms.x) * ms.y * bf_lo(gw.y), (y[3] - ms.x) * ms.y * bf_hi(gw.y));
                *(u32x2*)(z + off + 16 * cb) = o; } }
        __syncthreads();
    }
}

__device__ __forceinline__ void p_pool(const Args& a, const int wave) {
    const int tid = wave * 64 + lane_id();
    const bf16_t* u = (const bf16_t*)(a.ws + WS_U); const bf16_t* sg = (const bf16_t*)(a.ws + WS_SG1); bf16_t* d = (bf16_t*)(a.ws + WS_ZZ);
    for (int task = blockIdx.x * 512 + tid; task < 512 * 256; task += gridDim.x * 512) {
        const int chunk = task & 511, run = task >> 9, w = 2 << (chunk >> 7), t0 = run * 32;
        const bf16_t* uc = u + chunk * 8; const bf16_t* gc = sg + chunk * 8; bf16_t* dc = d + chunk * 8;
        f32x4 s0 = {0.f, 0.f, 0.f, 0.f}, s1 = {0.f, 0.f, 0.f, 0.f};
        for (int t = (t0 - w > 0 ? t0 - w : 0); t < t0; ++t) { f32x4 x0, x1; unpack8(*(const u32x4*)(uc + (size_t)t * PW), x0, x1); s0 += x0; s1 += x1; }
        for (int t = t0; t < t0 + 32; ++t) {
            f32x4 x0, x1, g0, g1; unpack8(*(const u32x4*)(uc + (size_t)t * PW), x0, x1); unpack8(*(const u32x4*)(gc + (size_t)t * PW), g0, g1); s0 += x0; s1 += x1;
            if (t - w >= 0) { f32x4 y0, y1; unpack8(*(const u32x4*)(uc + (size_t)(t - w) * PW), y0, y1); s0 -= y0; s1 -= y1; }
            const float inv = 1.0f / (float)(t + 1 < w ? t + 1 : w);
            *(u32x4*)(dc + (size_t)t * PW) = pack8((s0 * inv - x0) * g0, (s1 * inv - x1) * g1);
        }
    }
}
__device__ __forceinline__ void p_final(const Args& a, const int wave) {
    const int lane = lane_id();
    const float* rp = (const float*)(a.ws + WS_RP + 3 * MiB); const float* gain = a.in[13]; float* out = a.out;
    for (int m = blockIdx.x * 8 + wave; m < SEQ; m += gridDim.x * 8) {
        const float part = lane < 32 ? rp[(size_t)m * 32 + lane] : 0.f;
        const float rstd = __builtin_amdgcn_rsqf(wave_sum(part) * (1.0f / DM) + NORM_EPS);
        f32x4* o = (f32x4*)(out + (size_t)m * DM) + lane;
#pragma unroll
        for (int j = 0; j < 8; ++j) { const f32x4 g = *((const f32x4*)gain + lane + 64 * j); o[64 * j] = o[64 * j] * rstd * g; }
    }
}

__global__ void __launch_bounds__(512, 2) trunk_fwd(Args args) {
    extern __shared__ __attribute__((aligned(16))) unsigned char lds_raw[];
    LAS unsigned char* lds = (LAS unsigned char*)lds_raw;
    const int wave = __builtin_amdgcn_readfirstlane(threadIdx.x >> 6);
    unsigned char* ws = args.ws;
    volatile LAS unsigned* MISC = (volatile LAS unsigned*)(lds + MISC_OFF);
    if (threadIdx.x < 64) MISC[threadIdx.x] = 0u;
    __syncthreads();
    XcdBarrier bar; bar.bar = (unsigned*)(ws + WS_CTL) + 4096; bar.x = 0; bar.st = nullptr;
    const int lo = args.ph_lo, hi = args.ph_hi;
    if (hi - lo > 1) bar = xcd_barrier_post((unsigned*)(ws + WS_CTL) + 4096, MISC + 8, wave);
#ifndef PH_MASK
#define PH_MASK 0x3FF
#endif
#define IN(k) (((PH_MASK >> (k)) & 1) && lo <= (k) && (k) < hi)
#define SEAM(k) do { if (IN(k) && IN((k) + 1)) xcd_barrier(bar, wave); } while (0)
#ifndef DUP_MASK
#define DUP_MASK 0
#endif
#define NDUP(k) (((DUP_MASK >> (k)) & 1) ? 2 : 1)
    const int G = gridDim.x, c = blockIdx.x;
    float* rp0 = (float*)(ws + WS_RP); float* rp1 = rp0 + SEQ * 32; float* rp2 = rp1 + SEQ * 32; float* rp3 = rp2 + SEQ * 32;

    if (IN(0)) for (int rep_ = 0; rep_ < NDUP(0); ++rep_) { if (rep_) xcd_barrier(bar, wave); p_prologue(args, lds, wave); VM_WAIT(); __syncthreads(); }
    SEAM(0);
    if (IN(1)) for (int rep_ = 0; rep_ < NDUP(1); ++rep_) { if (rep_) xcd_barrier(bar, wave);
        pg8::Gemm g{(const bf16_t*)(ws + WS_XN0), (const bf16_t*)(ws + WS_WT_RI), SEQ, RPROJ, DM, DM, DM}; pg8::StaticOrder S; S.init(SEQ, RPROJ, G, c);
        EpiRet1 E{(bf16_t*)(ws + WS_QD), (bf16_t*)(ws + WS_KD), (bf16_t*)(ws + WS_V), (bf16_t*)(ws + WS_SG), (const float*)(ws + WS_ROPE), args.l2g};
        pg8::gemm_phase(lds, g, S, E, wave);
    }
    SEAM(1);
    if (IN(2)) for (int rep_ = 0; rep_ < NDUP(2); ++rep_) { if (rep_) xcd_barrier(bar, wave); if (c < 128) p_scan(args, lds, wave); else p_weights_big(args, lds, wave);
        VM_WAIT(); __syncthreads(); }
    SEAM(2);
    if (IN(3)) for (int rep_ = 0; rep_ < NDUP(3); ++rep_) { if (rep_) xcd_barrier(bar, wave); p_retention(args, lds, wave); }
    SEAM(3);
    if (IN(4)) for (int rep_ = 0; rep_ < NDUP(4); ++rep_) { if (rep_) xcd_barrier(bar, wave);
        { pg8::Gemm g{(const bf16_t*)(ws + WS_Z), (const bf16_t*)(ws + WS_WT_RO), SEQ, DM, PW, PW, PW}; pg8::StaticOrder S; S.init(SEQ, DM, G, c);
          EpiRes<true> E{args.in[0], nullptr, (bf16_t*)(ws + WS_A1), rp0};
          pg8::gemm_phase(lds, g, S, E, wave); }
        { pg8::Gemm g{(const bf16_t*)(ws + WS_PBF), (const bf16_t*)(ws + WS_WT_P0), SEQ, DM, PLE, PLE, PLE}; pg8::UpperHalfOrder S; S.init(SEQ, DM, G, c);
          EpiPlain E{(bf16_t*)(ws + WS_PE0), DM};
          pg8::gemm_phase(lds, g, S, E, wave); }
        { pg8::Gemm g{(const bf16_t*)(ws + WS_WT_GR), (const bf16_t*)(ws + WS_WU), PW, DM, 1024, 1024, PW}; pg8::CombOrder S; S.init(PW, DM, G, c);
          EpiComb E{(bf16_t*)(ws + WS_WT_PI), DM, args.in[8]};
          pg8::gemm_phase(lds, g, S, E, wave); }
    }
    SEAM(4);
    if (IN(5)) for (int rep_ = 0; rep_ < NDUP(5); ++rep_) { if (rep_) xcd_barrier(bar, wave);
        pg8::Gemm g{(const bf16_t*)(ws + WS_A1), (const bf16_t*)(ws + WS_WT_G0), SEQ, DM, DM, DM, DM}; pg8::StaticOrder S; S.init(SEQ, DM, G, c);
        rstd_table(lds, rp0, S, wave * 64 + lane_id());
        EpiPle E{(const bf16_t*)(ws + WS_A1), (const bf16_t*)(ws + WS_PE0), lds, (bf16_t*)(ws + WS_A2), rp1};
        pg8::gemm_phase(lds, g, S, E, wave);
    }
    SEAM(5);
    if (IN(6)) for (int rep_ = 0; rep_ < NDUP(6); ++rep_) { if (rep_) xcd_barrier(bar, wave);
        pg8::Gemm g{(const bf16_t*)(ws + WS_A2), (const bf16_t*)(ws + WS_WT_PI), SEQ, 2 * PW, DM, DM, DM}; pg8::StaticOrder S; S.init(SEQ, 2 * PW, G, c);
        rstd_table(lds, rp1, S, wave * 64 + lane_id());
        EpiPoolIn E{lds, (bf16_t*)(ws + WS_U), (bf16_t*)(ws + WS_SG1)};
        pg8::gemm_phase(lds, g, S, E, wave);
    }
    SEAM(6);
    if (IN(7)) for (int rep_ = 0; rep_ < NDUP(7); ++rep_) { if (rep_) xcd_barrier(bar, wave); p_pool(args, wave); }
    SEAM(7);
    if (IN(8)) for (int rep_ = 0; rep_ < NDUP(8); ++rep_) { if (rep_) xcd_barrier(bar, wave);
        { pg8::Gemm g{(const bf16_t*)(ws + WS_ZZ), (const bf16_t*)(ws + WS_WT_PO), SEQ, DM, PW, PW, PW}; pg8::StaticOrder S; S.init(SEQ, DM, G, c);
          EpiRes<false> E{nullptr, (const bf16_t*)(ws + WS_A2), (bf16_t*)(ws + WS_A3), rp2};
          pg8::gemm_phase(lds, g, S, E, wave); }
        { pg8::Gemm g{(const bf16_t*)(ws + WS_PBF) + (size_t)SEQ * PLE, (const bf16_t*)(ws + WS_WT_P1), SEQ, DM, PLE, PLE, PLE}; pg8::StaticOrder S; S.init(SEQ, DM, G, c);
          EpiPlain E{(bf16_t*)(ws + WS_PE1), DM};
          pg8::gemm_phase(lds, g, S, E, wave); }
    }
    SEAM(8);
    if (IN(9)) for (int rep_ = 0; rep_ < NDUP(9); ++rep_) { if (rep_) xcd_barrier(bar, wave);
        pg8::Gemm g{(const bf16_t*)(ws + WS_A3), (const bf16_t*)(ws + WS_WT_G1), SEQ, DM, DM, DM, DM}; pg8::StaticOrder S; S.init(SEQ, DM, G, c);
        rstd_table(lds, rp2, S, wave * 64 + lane_id());
        EpiPleFinal E{(const bf16_t*)(ws + WS_A3), (const bf16_t*)(ws + WS_PE1), lds, args.out, args.in[13], (unsigned*)(ws + WS_CTL)};
        pg8::gemm_phase(lds, g, S, E, wave);
    }
#undef IN
#undef SEAM
}

extern "C" void kernel_launch(void* const* d_in, const int* in_sizes, int n_in, void* d_out, int out_size, void* d_ws, size_t ws_size, hipStream_t stream) {
    static int grid = 0;
    if (grid == 0) {
        if (n_in != 14 || out_size != SEQ * DM || ws_size < WS_END) { fprintf(stderr, "kernel_launch: unexpected problem: n_in %d out %d ws %zu (need %zu)\n", n_in, out_size, ws_size, (size_t)WS_END); grid = -1; return; }
        int dev = 0, cus = 0, per_cu = 0;
        if (hipGetDevice(&dev) != hipSuccess || hipDeviceGetAttribute(&cus, hipDeviceAttributeMultiprocessorCount, dev) != hipSuccess) { grid = -1; return; }
        if (hipFuncSetAttribute((const void*)trunk_fwd, hipFuncAttributeMaxDynamicSharedMemorySize, LDS_BYTES) != hipSuccess) { fprintf(stderr, "kernel_launch: hipFuncSetAttribute failed\n"); grid = -1; return; }
        if (hipOccupancyMaxActiveBlocksPerMultiprocessor(&per_cu, (const void*)trunk_fwd, 512, LDS_BYTES) != hipSuccess || per_cu < 1) { fprintf(stderr, "kernel_launch: occupancy query says %d\n", per_cu); (void)hipGetLastError(); }
        grid = cus;
        if (grid != 256) fprintf(stderr, "kernel_launch: %d CUs (built for 256)\n", grid);
    }
    if (grid < 0) return;
    (void)hipMemsetAsync((char*)d_ws + WS_CTL, 0, CTL_ZERO_BYTES, stream);
    Args a{};
    for (int i = 0; i < 14; ++i) a.in[i] = (const float*)d_in[i];
    a.out = (float*)d_out; a.ws = (unsigned char*)d_ws;
    for (int i = 0; i < 128; ++i) { const float lin = (float)i * (1.0f / 127.0f); a.freq[i] = (float)pow(10000.0, -(double)lin); }
    for (int h = 0; h < 8; ++h) { const double lg = log2(1.0 - pow(2.0, -5.0 - (double)h)); a.l2g[h] = (float)lg; a.g256[h] = (float)exp2(256.0 * lg); }
    constexpr int NPH = 10;
    if (MK_N_LAUNCHES == 1) {
        a.ph_lo = 0; a.ph_hi = NPH;
        void* kargs[] = {&a};
        const hipError_t le = hipLaunchCooperativeKernel((const void*)trunk_fwd, dim3(grid), dim3(512), kargs, LDS_BYTES, stream);
        if (le != hipSuccess) fprintf(stderr, "kernel_launch: cooperative launch failed: %s (grid %d)\n", hipGetErrorString(le), grid);
    } else {
        for (int ph = 0; ph < NPH; ++ph) { a.ph_lo = ph; a.ph_hi = ph + 1; hipLaunchKernelGGL(trunk_fwd, dim3(grid), dim3(512), LDS_BYTES, stream, a); }
    }
}
```

```cpp
#include <hip/hip_runtime.h>
#include <cstdio>
#include <cstdint>
#include <cmath>

#ifndef MK_N_LAUNCHES
#define MK_N_LAUNCHES 1
#define CV_BIG 1
#endif

#define LAS __attribute__((address_space(3)))
#define GAS __attribute__((address_space(1)))
typedef unsigned short bf16_t;
typedef short bf16x8 __attribute__((ext_vector_type(8)));
typedef short s16x4 __attribute__((ext_vector_type(4)));
typedef float f32x4 __attribute__((ext_vector_type(4)));
typedef float f32x2 __attribute__((ext_vector_type(2)));
typedef unsigned u32x4 __attribute__((ext_vector_type(4)));
typedef unsigned u32x2 __attribute__((ext_vector_type(2)));

constexpr int SEQ = 8192, DM = 2048, RPROJ = 12288, NH = 8, DKH = 256, DVH = 512, PW = 4096, PLE = 256;
constexpr float NORM_EPS = 1e-6f, GN_EPS = 1e-5f;

constexpr size_t MiB = 1u << 20;
constexpr size_t WS_CTL = 0, CTL_ZERO_BYTES = 128 * 1024;
constexpr size_t WS_RP = 1 * MiB;
constexpr size_t WS_ROPE = 5 * MiB;
constexpr size_t WS_PBF = 13 * MiB;
constexpr size_t WS_WT_RO = 21 * MiB;
constexpr size_t WS_WT_G0 = 37 * MiB;
constexpr size_t WS_WT_P0 = 45 * MiB;
constexpr size_t WS_WT_RI = 46 * MiB;
constexpr size_t WS_XN0 = 94 * MiB;
constexpr size_t WS_QD = 126 * MiB, WS_KD = 158 * MiB, WS_V = 190 * MiB, WS_SG = 254 * MiB;
constexpr size_t WS_Z = WS_SG;
constexpr size_t WS_ST = 318 * MiB;
constexpr size_t WS_WU = 46 * MiB;
constexpr size_t WS_WT_PI = 62 * MiB;
constexpr size_t WS_WT_GR = 94 * MiB, WS_WT_PO = 102 * MiB, WS_WT_G1 = 118 * MiB, WS_WT_P1 = 382 * MiB;
constexpr size_t WS_H1 = 126 * MiB, WS_A1 = 190 * MiB, WS_PE0 = 222 * MiB;
constexpr size_t WS_H2 = 254 * MiB, WS_A2 = 318 * MiB;
constexpr size_t WS_U = 126 * MiB, WS_SG1 = 190 * MiB, WS_ZZ = 254 * MiB;
constexpr size_t WS_H3 = 126 * MiB, WS_A3 = 190 * MiB, WS_PE1 = 222 * MiB;
constexpr size_t WS_END = 383 * MiB;

constexpr int RING_BYTES = 131072;
constexpr int LDS_BYTES = 155648;
constexpr int MISC_OFF = LDS_BYTES - 256;

#define LDS_WAIT() asm volatile("s_waitcnt lgkmcnt(0)" ::: "memory")
#define VM_WAIT() asm volatile("s_waitcnt vmcnt(0)" ::: "memory")

__device__ __forceinline__ unsigned cvt_pk_bf16(float lo, float hi) { unsigned r; asm volatile("v_cvt_pk_bf16_f32 %0, %1, %2" : "=v"(r) : "v"(lo), "v"(hi)); return r; }
__device__ __forceinline__ float bf_lo(unsigned w) { return __uint_as_float(w << 16); }
__device__ __forceinline__ float bf_hi(unsigned w) { return __uint_as_float(w & 0xffff0000u); }
__device__ __forceinline__ float fsigmoid(float x) { return __builtin_amdgcn_rcpf(1.0f + __builtin_amdgcn_exp2f(-1.44269504089f * x)); }
__device__ __forceinline__ float fsilu(float x) { return x * fsigmoid(x); }
__device__ __forceinline__ int lane_id() { int l; asm volatile("v_mbcnt_lo_u32_b32 %0, -1, 0\n\tv_mbcnt_hi_u32_b32 %0, -1, %0" : "=v"(l)); return l; }
__device__ __forceinline__ float wave_sum(float v) {
#pragma unroll
    for (int o = 1; o < 64; o <<= 1) v += __shfl_xor(v, o);
    return v;
}

namespace pg8 {
constexpr int BM = 256, BK = 64, HALF = 128, HTB = HALF * BK * 2, STAGE_BYTES = 8 * HTB, NXCD = 8, WGM = 4;
__host__ __device__ __forceinline__ int lds_byte(int r, int c) { const int st = (r >> 4) * 2 + (c >> 5), rr = r & 15, cc = c & 31, ob = rr * 64 + cc * 2; return st * 1024 + (ob ^ (((ob >> 9) & 1) << 5)); }
__host__ __device__ __forceinline__ void stage_rc(int b, int& R, int& C) { const int st = b / 1024, sb = b % 1024, swz = sb ^ (((sb >> 9) & 1) << 5); R = (st >> 1) * 16 + swz / 64; C = (st & 1) * 32 + (swz % 64) / 2; }
__host__ __device__ __forceinline__ int perm32(int rho) { const int n = rho >> 4, i = rho & 15; return 8 * (i >> 2) + 4 * n + (i & 3); }

struct Unit { int pm, pn, slot; };
struct Gemm { const bf16_t* A; const bf16_t* Bt; int M, N, K, lda, ldb; };

struct StaticOrder {
    int nM, nN, nwg, G, c;
    __host__ __device__ void init(int M, int N, int G_, int c_) { nM = M / BM; nN = N / BM; nwg = nM * nN; G = G_; c = c_; }
    __host__ __device__ bool next(int i, Unit& u) const {
        const long L = (long)i * G + c; if (L >= nwg) return false;
        int wgid = (int)L; { const int q = nwg / NXCD, r = nwg % NXCD, xcd = wgid % NXCD, off = wgid / NXCD; wgid = (xcd < r ? xcd * (q + 1) : r * (q + 1) + (xcd - r) * q) + off; }
        const int nig = WGM * nN, gid = wgid / nig, fm = gid * WGM, gsz = (nM - fm) < WGM ? (nM - fm) : WGM;
        u.pm = fm + ((wgid % nig) % gsz); u.pn = (wgid % nig) / gsz; u.slot = i; return true;
    }
    __device__ __forceinline__ size_t a_off(const Unit&) const { return 0; }
    __device__ __forceinline__ size_t b_off(const Unit&) const { return 0; }
};
struct UpperHalfOrder : StaticOrder {
    __host__ __device__ bool next(int i, Unit& u) const { const int hw = G >> 1, per = nwg / hw; if (c < hw || i >= per) return false; const int L = (c - hw) * per + i; u.pm = L / nN; u.pn = L - u.pm * nN; u.slot = i; return true; }
};
struct CombOrder : StaticOrder {
    __device__ __forceinline__ size_t b_off(const Unit& u) const { return (size_t)(u.pm >> 2) * 2048; }
};

template <class Epi, class Sched, int EPI_REPS = 1>
__device__ __forceinline__ void gemm_phase(LAS unsigned char* lds, const Gemm g, const Sched& S, const Epi& E, const int wid) {
    int lane_ = lane_id(); asm volatile("" : "+v"(lane_));
    const int lane = lane_, tid = wid * 64 + lane, wr = wid >> 2, wc = wid & 3, fr = lane & 15, fq = lane >> 4;
    const int K = g.K, nt = K / BK;
    unsigned voffA[2], voffB[2];
#pragma unroll
    for (int i = 0; i < 2; ++i) { int R, C; stage_rc(tid * 16 + i * 8192, R, C); const int Rb = (R & ~31) + perm32(R & 31);
        voffA[i] = (unsigned)(R * g.lda + C) * 2u; voffB[i] = (unsigned)(Rb * g.ldb + C) * 2u; }
    const size_t kstep = (size_t)(BK * 2);
    const size_t hstepA = (size_t)HALF * g.lda * 2, hstepB = (size_t)HALF * g.ldb * 2;
    const size_t tstepA = 2 * hstepA, tstepB = 2 * hstepB;
    const unsigned ldsw = (unsigned)wid * 1024u;
    const int aoff = lds_byte(wr * 64 + fr, fq * 8), boff = lds_byte(wc * 32 + fr, fq * 8);
#define PG8_SA(b, h) (((b) * 2 + (h)) * HTB)
#define PG8_SB(b, h) ((4 + (b) * 2 + (h)) * HTB)
#define PG8_STAGE(bufoff, gbase, voff) do { _Pragma("unroll") for (int _i = 0; _i < 2; ++_i) \
        __builtin_amdgcn_global_load_lds((const unsigned*)((const char*)(gbase) + (voff)[_i]), (LAS unsigned*)(lds + (bufoff) + ldsw + _i * 8192), 16, 0, 0); } while (0)
#define PG8_LDA(dst, b, h) do { _Pragma("unroll") for (int m = 0; m < 4; ++m) _Pragma("unroll") for (int k = 0; k < 2; ++k) dst[m][k] = *(const LAS bf16x8*)(lds + PG8_SA(b, h) + aoff + m * 2048 + k * 1024); } while (0)
#define PG8_LDB(dst, b, h) do { _Pragma("unroll") for (int n = 0; n < 2; ++n) _Pragma("unroll") for (int k = 0; k < 2; ++k) dst[n][k] = *(const LAS bf16x8*)(lds + PG8_SB(b, h) + boff + n * 2048 + k * 1024); } while (0)
#define PG8_MMA(ai, bj, At, Bt) do { __builtin_amdgcn_s_setprio(1); _Pragma("unroll") for (int m = 0; m < 4; ++m) _Pragma("unroll") for (int n = 0; n < 2; ++n) _Pragma("unroll") for (int k = 0; k < 2; ++k) \
        acc[ai][bj][m][n] = __builtin_amdgcn_mfma_f32_16x16x32_bf16(Bt[n][k], At[m][k], acc[ai][bj][m][n], 0, 0, 0); __builtin_amdgcn_s_setprio(0); } while (0)
#define PG8_WAIT_V(n) asm volatile("s_waitcnt vmcnt(" #n ")" ::: "memory")
#define PG8_WAIT_L(n) asm volatile("s_waitcnt lgkmcnt(" #n ")" ::: "memory")
#define PG8_BAR __builtin_amdgcn_s_barrier()
#define PG8_SCHED __builtin_amdgcn_sched_barrier(0)
    Unit cur, nxt; int ui = 0;
    if (!S.next(0, cur)) return;
    f32x4 acc[2][2][4][2];
#pragma unroll
    for (int a = 0; a < 2; ++a)
#pragma unroll
        for (int b = 0; b < 2; ++b)
#pragma unroll
            for (int m = 0; m < 4; ++m)
#pragma unroll
                for (int n = 0; n < 2; ++n) acc[a][b][m][n] = (f32x4){0.f, 0.f, 0.f, 0.f};
    bf16x8 At[4][2], B0[2][2], B1[2][2];
    const char* cA = (const char*)g.A + (size_t)cur.pm * tstepA + S.a_off(cur); const char* cB = (const char*)g.Bt + (size_t)cur.pn * tstepB + S.b_off(cur);
    PG8_STAGE(PG8_SB(0, 0), cB, voffB); PG8_STAGE(PG8_SB(0, 1), cB + hstepB, voffB); PG8_STAGE(PG8_SA(0, 0), cA, voffA); PG8_STAGE(PG8_SA(0, 1), cA + hstepA, voffA);
    if (wr == 1) PG8_BAR;
    PG8_WAIT_V(2); PG8_BAR;
    PG8_STAGE(PG8_SB(1, 0), cB + kstep, voffB); PG8_STAGE(PG8_SA(1, 0), cA + kstep, voffA); PG8_STAGE(PG8_SB(1, 1), cB + hstepB + kstep, voffB);
    PG8_WAIT_V(6); PG8_BAR;
    for (;;) {
        const bool has_next = S.next(ui + 1, nxt);
        const char* nA = has_next ? (const char*)g.A + (size_t)nxt.pm * tstepA + S.a_off(nxt) : cA; const char* nB = has_next ? (const char*)g.Bt + (size_t)nxt.pn * tstepB + S.b_off(nxt) : cB;
        for (int t = 0; t < nt; t += 2) {
            const bool last = (t == nt - 2);
            const char* a1 = cA + (size_t)(t + 1) * kstep;
            const char* a2 = last ? nA : cA + (size_t)(t + 2) * kstep; const char* b2 = last ? nB : cB + (size_t)(t + 2) * kstep;
            const char* a3 = a2 + kstep; const char* b3 = b2 + kstep;
            PG8_LDB(B0, 0, 0); PG8_LDB(B1, 0, 1); PG8_SCHED; PG8_LDA(At, 0, 0); PG8_STAGE(PG8_SA(1, 1), a1 + hstepA, voffA);
            PG8_WAIT_V(8); PG8_WAIT_L(0); PG8_BAR; PG8_MMA(0, 0, At, B0); PG8_MMA(0, 1, At, B1); PG8_BAR; PG8_SCHED;
            PG8_LDA(At, 0, 1); PG8_STAGE(PG8_SB(0, 0), b2, voffB); PG8_STAGE(PG8_SB(0, 1), b2 + hstepB, voffB); PG8_STAGE(PG8_SA(0, 0), a2, voffA);
            PG8_WAIT_V(8); PG8_WAIT_L(0); PG8_BAR; PG8_MMA(1, 0, At, B0); PG8_MMA(1, 1, At, B1); PG8_BAR; PG8_SCHED;
            PG8_LDB(B0, 1, 0); PG8_LDB(B1, 1, 1); PG8_SCHED; PG8_LDA(At, 1, 0); PG8_STAGE(PG8_SA(0, 1), a2 + hstepA, voffA);
            PG8_WAIT_V(8); PG8_WAIT_L(0); PG8_BAR; PG8_MMA(0, 0, At, B0); PG8_MMA(0, 1, At, B1); PG8_BAR; PG8_SCHED;
            PG8_LDA(At, 1, 1); PG8_STAGE(PG8_SB(1, 0), b3, voffB); PG8_STAGE(PG8_SB(1, 1), b3 + hstepB, voffB); PG8_STAGE(PG8_SA(1, 0), a3, voffA);
            PG8_WAIT_V(8); PG8_WAIT_L(0); PG8_BAR; PG8_MMA(1, 0, At, B0); PG8_MMA(1, 1, At, B1); PG8_BAR; PG8_SCHED;
        }
        if (wr == 0) PG8_BAR;
        for (int er_ = 0; er_ < EPI_REPS; ++er_) { int fr2 = fr, fq2 = fq; asm volatile("" : "+v"(fr2), "+v"(fq2)); E(acc, cur, wr, wc, fr2, fq2); }
        if (!has_next) break;
#pragma unroll
        for (int a = 0; a < 2; ++a)
#pragma unroll
            for (int b = 0; b < 2; ++b)
#pragma unroll
                for (int m = 0; m < 4; ++m)
#pragma unroll
                    for (int n = 0; n < 2; ++n) acc[a][b][m][n] = (f32x4){0.f, 0.f, 0.f, 0.f};
        cur = nxt; cA = nA; cB = nB; ++ui;
        if (wr == 1) PG8_BAR;
    }
    PG8_WAIT_V(0);
    PG8_BAR;
#undef PG8_SA
#undef PG8_SB
#undef PG8_STAGE
#undef PG8_LDA
#undef PG8_LDB
#undef PG8_MMA
#undef PG8_WAIT_V
#undef PG8_WAIT_L
#undef PG8_BAR
#undef PG8_SCHED
}
}
using pg8::Unit;

#define EPI_ARGS f32x4 (&acc)[2][2][4][2], const Unit& u, int wr, int wc, int fr, int fq
__device__ __forceinline__ u32x4 pack8(const f32x4 a, const f32x4 b) { u32x4 w; w.x = cvt_pk_bf16(a[0], a[1]); w.y = cvt_pk_bf16(a[2], a[3]); w.z = cvt_pk_bf16(b[0], b[1]); w.w = cvt_pk_bf16(b[2], b[3]); return w; }
__device__ __forceinline__ void unpack8(const u32x4 w, f32x4& a, f32x4& b) { a = (f32x4){bf_lo(w.x), bf_hi(w.x), bf_lo(w.y), bf_hi(w.y)}; b = (f32x4){bf_lo(w.z), bf_hi(w.z), bf_lo(w.w), bf_hi(w.w)}; }
__device__ __forceinline__ float row_rstd(const float* rp, int row) {
    const f32x4* q = (const f32x4*)(rp + (size_t)row * 32); f32x4 s = q[0];
#pragma unroll
    for (int i = 1; i < 8; ++i) s += q[i];
    return __builtin_amdgcn_rsqf(((s[0] + s[1]) + (s[2] + s[3])) * (1.0f / DM) + NORM_EPS);
}
constexpr int RSTD_OFF = RING_BYTES;
template <class Sched> __device__ __forceinline__ void rstd_table(LAS unsigned char* lds, const float* rp, const Sched& S, int tid) {
    LAS float* tab = (LAS float*)(lds + RSTD_OFF); Unit u;
    for (int i = 0; i < 8 && S.next(i, u); ++i) if (tid < 256) tab[i * 256 + tid] = row_rstd(rp, u.pm * 256 + tid);
    __syncthreads();
}
__device__ __forceinline__ float rstd_lds(const LAS unsigned char* lds, int slot, int r) { return ((const LAS float*)(lds + RSTD_OFF))[slot * 256 + r]; }

struct EpiRet1 {
    bf16_t *qd, *kd, *v, *sg; const float* rope; const float* l2g;
    __device__ __forceinline__ void operator()(EPI_ARGS) const {
        const int pn = u.pn, row0 = u.pm * 256 + wr * 64 + fr, c0 = wc * 32 + 8 * fq;
        if (pn < 16) {
            const int head = pn & 7; const bool isk = pn >= 8;
            bf16_t* out = (isk ? kd : qd) + head * 256; const float lg = l2g[head];
#pragma unroll
            for (int ai = 0; ai < 2; ++ai)
#pragma unroll
                for (int m = 0; m < 4; ++m) { const int row = row0 + ai * 128 + m * 16, r = row & 255;
                    const float dec = isk ? __builtin_amdgcn_exp2f(lg * (float)(255 - r)) * 0.0625f : __builtin_amdgcn_exp2f(lg * (float)(r - 255));
#pragma unroll
                    for (int bj = 0; bj < 2; ++bj) { const int c = c0 + bj * 128;
                        const f32x4* rp = (const f32x4*)(rope + ((size_t)row * 128 + (c >> 1)) * 2); const f32x4 t0 = rp[0], t1 = rp[1];
                        const f32x4 x = acc[ai][bj][m][0], y = acc[ai][bj][m][1]; f32x4 o0, o1;
                        o0[0] = (x[0] * t0[0] - x[1] * t0[1]) * dec; o0[1] = (x[1] * t0[0] + x[0] * t0[1]) * dec;
                        o0[2] = (x[2] * t0[2] - x[3] * t0[3]) * dec; o0[3] = (x[3] * t0[2] + x[2] * t0[3]) * dec;
                        o1[0] = (y[0] * t1[0] - y[1] * t1[1]) * dec; o1[1] = (y[1] * t1[0] + y[0] * t1[1]) * dec;
                        o1[2] = (y[2] * t1[2] - y[3] * t1[3]) * dec; o1[3] = (y[3] * t1[2] + y[2] * t1[3]) * dec;
                        *(u32x4*)(out + (size_t)row * DM + c) = pack8(o0, o1); } }
        } else if (pn < 32) {
            bf16_t* out = v + (pn - 16) * 256 + c0;
#pragma unroll
            for (int ai = 0; ai < 2; ++ai)
#pragma unroll
                for (int m = 0; m < 4; ++m) { const int row = row0 + ai * 128 + m * 16;
#pragma unroll
                    for (int bj = 0; bj < 2; ++bj) *(u32x4*)(out + (size_t)row * PW + bj * 128) = pack8(acc[ai][bj][m][0], acc[ai][bj][m][1]); }
        } else {
            bf16_t* out = sg + (pn - 32) * 256 + c0;
#pragma unroll
            for (int ai = 0; ai < 2; ++ai)
#pragma unroll
                for (int m = 0; m < 4; ++m) { const int row = row0 + ai * 128 + m * 16;
#pragma unroll
                    for (int bj = 0; bj < 2; ++bj) { f32x4 a = acc[ai][bj][m][0], b = acc[ai][bj][m][1];
#pragma unroll
                        for (int e = 0; e < 4; ++e) { a[e] = fsilu(a[e]); b[e] = fsilu(b[e]); }
                        *(u32x4*)(out + (size_t)row * PW + bj * 128) = pack8(a, b); } }
        }
    }
};
struct EpiPlain {
    bf16_t* O; int ldc;
    __device__ __forceinline__ void operator()(EPI_ARGS) const {
        bf16_t* out = O + (size_t)(u.pm * 256 + wr * 64 + fr) * ldc + u.pn * 256 + wc * 32 + 8 * fq;
#pragma unroll
        for (int ai = 0; ai < 2; ++ai)
#pragma unroll
            for (int m = 0; m < 4; ++m)
#pragma unroll
                for (int bj = 0; bj < 2; ++bj) *(u32x4*)(out + (size_t)(ai * 128 + m * 16) * ldc + bj * 128) = pack8(acc[ai][bj][m][0], acc[ai][bj][m][1]);
    }
};
template <bool RESF> struct EpiRes {
    const float* resf; const bf16_t* resb; bf16_t* aout; float* rpo;
    __device__ __forceinline__ void operator()(EPI_ARGS) const {
        const int row0 = u.pm * 256 + wr * 64 + fr, col0 = u.pn * 256 + wc * 32 + 8 * fq;
#pragma unroll
        for (int ai = 0; ai < 2; ++ai) {
            f32x4 rv[4][2][2];
#pragma unroll
            for (int m = 0; m < 4; ++m)
#pragma unroll
                for (int bj = 0; bj < 2; ++bj) { const size_t o = (size_t)(row0 + ai * 128 + m * 16) * DM + col0 + bj * 128;
                    if (RESF) { rv[m][bj][0] = __builtin_nontemporal_load((const f32x4*)(resf + o)); rv[m][bj][1] = __builtin_nontemporal_load((const f32x4*)(resf + o + 4)); }
                    else unpack8(*(const u32x4*)(resb + o), rv[m][bj][0], rv[m][bj][1]); }
#pragma unroll
            for (int m = 0; m < 4; ++m) { const int row = row0 + ai * 128 + m * 16; const size_t off = (size_t)row * DM + col0; float ss = 0.f;
#pragma unroll
                for (int bj = 0; bj < 2; ++bj) { const size_t o = off + bj * 128;
                    const f32x4 h0 = rv[m][bj][0] + acc[ai][bj][m][0], h1 = rv[m][bj][1] + acc[ai][bj][m][1];
                    ss += (h0[0] * h0[0] + h0[1] * h0[1]) + (h0[2] * h0[2] + h0[3] * h0[3]) + (h1[0] * h1[0] + h1[1] * h1[1]) + (h1[2] * h1[2] + h1[3] * h1[3]);
                    *(u32x4*)(aout + o) = pack8(h0, h1); }
                ss += __shfl_xor(ss, 16); ss += __shfl_xor(ss, 32);
                if (fq == 0) rpo[(size_t)row * 32 + u.pn * 4 + wc] = ss; }
            asm volatile("" ::: "memory"); }
    }
};
struct EpiPle {
    const bf16_t* hin; const bf16_t* pe; const LAS unsigned char* lds; bf16_t* aout; float* rpo;
    __device__ __forceinline__ void operator()(EPI_ARGS) const {
        const int row0 = u.pm * 256 + wr * 64 + fr, col0 = u.pn * 256 + wc * 32 + 8 * fq;
#pragma unroll
        for (int ai = 0; ai < 2; ++ai) {
            u32x4 hv[4][2], pv[4][2];
#pragma unroll
            for (int m = 0; m < 4; ++m)
#pragma unroll
                for (int bj = 0; bj < 2; ++bj) { const size_t o = (size_t)(row0 + ai * 128 + m * 16) * DM + col0 + bj * 128; hv[m][bj] = *(const u32x4*)(hin + o); pv[m][bj] = *(const u32x4*)(pe + o); }
#pragma unroll
            for (int m = 0; m < 4; ++m) { const int row = row0 + ai * 128 + m * 16; const size_t off = (size_t)row * DM + col0; float ss = 0.f;
                const float rstd = rstd_lds(lds, u.slot, row & 255);
#pragma unroll
                for (int bj = 0; bj < 2; ++bj) { const size_t o = off + bj * 128;
                    f32x4 h0, h1, p0, p1; unpack8(hv[m][bj], h0, h1); unpack8(pv[m][bj], p0, p1);
                    const f32x4 a0 = acc[ai][bj][m][0], a1 = acc[ai][bj][m][1];
#pragma unroll
                    for (int e = 0; e < 4; ++e) { h0[e] += fsigmoid(a0[e] * rstd) * p0[e]; h1[e] += fsigmoid(a1[e] * rstd) * p1[e]; }
                    ss += (h0[0] * h0[0] + h0[1] * h0[1]) + (h0[2] * h0[2] + h0[3] * h0[3]) + (h1[0] * h1[0] + h1[1] * h1[1]) + (h1[2] * h1[2] + h1[3] * h1[3]);
                    *(u32x4*)(aout + o) = pack8(h0, h1); }
                ss += __shfl_xor(ss, 16); ss += __shfl_xor(ss, 32);
                if (fq == 0) rpo[(size_t)row * 32 + u.pn * 4 + wc] = ss; }
            asm volatile("" ::: "memory"); }
    }
};
constexpr int FN_P_OFF = RING_BYTES + 8192, FN_S_OFF = FN_P_OFF + 4096;
constexpr int CW_FN_CNT = 16384, CW_FN_X = 32768;
struct EpiPleFinal {
    const bf16_t* hin; const bf16_t* pe; LAS unsigned char* lds; float* out; const float* gain; unsigned* ctl;
    __device__ __forceinline__ void operator()(EPI_ARGS) const {
        const int row0 = u.pm * 256 + wr * 64 + fr, col0 = u.pn * 256 + wc * 32 + 8 * fq;
        const int wid = wr * 4 + wc, tid = wid * 64 + fq * 16 + fr;
        LAS float* P = (LAS float*)(lds + FN_P_OFF); LAS float* S = (LAS float*)(lds + FN_S_OFF);
#pragma unroll
        for (int ai = 0; ai < 2; ++ai)
#pragma unroll
            for (int mp = 0; mp < 2; ++mp) {
                u32x4 hv[2][2], pv[2][2];
#pragma unroll
                for (int mm = 0; mm < 2; ++mm)
#pragma unroll
                    for (int bj = 0; bj < 2; ++bj) { const size_t o = (size_t)(row0 + ai * 128 + (2 * mp + mm) * 16) * DM + col0 + bj * 128;
                        hv[mm][bj] = *(const u32x4*)(hin + o); pv[mm][bj] = *(const u32x4*)(pe + o); }
#pragma unroll
                for (int mm = 0; mm < 2; ++mm) { const int m = 2 * mp + mm, row = row0 + ai * 128 + m * 16; float ss = 0.f;
                    const float rstd = rstd_lds(lds, u.slot, row & 255);
#pragma unroll
                    for (int bj = 0; bj < 2; ++bj) {
                        f32x4 h0, h1, p0, p1; unpack8(hv[mm][bj], h0, h1); unpack8(pv[mm][bj], p0, p1);
                        const f32x4 a0 = acc[ai][bj][m][0], a1 = acc[ai][bj][m][1];
#pragma unroll
                        for (int e = 0; e < 4; ++e) { h0[e] += fsigmoid(a0[e] * rstd) * p0[e]; h1[e] += fsigmoid(a1[e] * rstd) * p1[e]; }
                        acc[ai][bj][m][0] = h0; acc[ai][bj][m][1] = h1;
                        ss += (h0[0] * h0[0] + h0[1] * h0[1]) + (h0[2] * h0[2] + h0[3] * h0[3]) + (h1[0] * h1[0] + h1[1] * h1[1]) + (h1[2] * h1[2] + h1[3] * h1[3]); }
                    ss += __shfl_xor(ss, 16); ss += __shfl_xor(ss, 32);
                    if (fq == 0) P[(row & 255) * 4 + wc] = ss; }
                asm volatile("" ::: "memory"); }
        asm volatile("s_waitcnt lgkmcnt(0)" ::: "memory"); __builtin_amdgcn_s_barrier(); asm volatile("" ::: "memory");
        float* X = (float*)(ctl + CW_FN_X); unsigned* cnt = ctl + CW_FN_CNT + 64 * u.pm;
        if (tid < 256) { const float t = (P[tid * 4 + 0] + P[tid * 4 + 1]) + (P[tid * 4 + 2] + P[tid * 4 + 3]);
            __hip_atomic_store(X + ((size_t)(u.pm * 256 + tid) * 8 + u.pn), t, __ATOMIC_RELAXED, __HIP_MEMORY_SCOPE_AGENT);
            asm volatile("s_waitcnt vmcnt(0)" ::: "memory");
            if ((tid & 63) == 0) __hip_atomic_fetch_add(cnt, 1u, __ATOMIC_RELAXED, __HIP_MEMORY_SCOPE_AGENT); }
        if (wid == 0) {
            unsigned spins = 0;
            while ((unsigned)__builtin_amdgcn_readfirstlane(__hip_atomic_load(cnt, __ATOMIC_RELAXED, __HIP_MEMORY_SCOPE_AGENT)) < 32u) { __builtin_amdgcn_s_sleep(2); if (++spins > (1u << 22)) break; }
            __builtin_amdgcn_fence(__ATOMIC_ACQUIRE, "agent");
            asm volatile("s_waitcnt vmcnt(0)" ::: "memory"); }
        asm volatile("s_waitcnt vmcnt(0) lgkmcnt(0)" ::: "memory"); __builtin_amdgcn_s_barrier(); asm volatile("" ::: "memory");
        if (tid < 256) { const float* xs = X + (size_t)(u.pm * 256 + tid) * 8; float s = 0.f;
#pragma unroll
            for (int t = 0; t < 8; ++t) s += __hip_atomic_load(xs + t, __ATOMIC_RELAXED, __HIP_MEMORY_SCOPE_AGENT);
            S[tid] = __builtin_amdgcn_rsqf(s * (1.0f / DM) + NORM_EPS); }
        asm volatile("s_waitcnt lgkmcnt(0)" ::: "memory"); __builtin_amdgcn_s_barrier(); asm volatile("" ::: "memory");
        f32x4 gv[2][2];
#pragma unroll
        for (int bj = 0; bj < 2; ++bj) { gv[bj][0] = *(const f32x4*)(gain + col0 + bj * 128); gv[bj][1] = *(const f32x4*)(gain + col0 + bj * 128 + 4); }
#pragma unroll
        for (int ai = 0; ai < 2; ++ai)
#pragma unroll
            for (int m = 0; m < 4; ++m) { const int row = row0 + ai * 128 + m * 16; const float rs = S[row & 255]; const size_t off = (size_t)row * DM + col0;
#pragma unroll
                for (int bj = 0; bj < 2; ++bj) { *(f32x4*)(out + off + bj * 128) = acc[ai][bj][m][0] * rs * gv[bj][0]; *(f32x4*)(out + off + bj * 128 + 4) = acc[ai][bj][m][1] * rs * gv[bj][1]; } }
    }
};
struct EpiPoolIn {
    const LAS unsigned char* lds; bf16_t* uo; bf16_t* sgo;
    __device__ __forceinline__ void operator()(EPI_ARGS) const {
        const int row0 = u.pm * 256 + wr * 64 + fr; const bool isg = u.pn >= 16;
        bf16_t* out = (isg ? sgo : uo) + (u.pn & 15) * 256 + wc * 32 + 8 * fq;
#pragma unroll
        for (int ai = 0; ai < 2; ++ai)
#pragma unroll
            for (int m = 0; m < 4; ++m) { const int row = row0 + ai * 128 + m * 16; const float rstd = rstd_lds(lds, u.slot, row & 255);
#pragma unroll
                for (int bj = 0; bj < 2; ++bj) { f32x4 a = acc[ai][bj][m][0] * rstd, b = acc[ai][bj][m][1] * rstd;
                    if (isg) {
#pragma unroll
                        for (int e = 0; e < 4; ++e) { a[e] = fsilu(a[e]); b[e] = fsilu(b[e]); } }
                    *(u32x4*)(out + (size_t)row * PW + bj * 128) = pack8(a, b); } }
    }
};
struct EpiComb {
    bf16_t* O; int ldc; const float* scale;
    __device__ __forceinline__ void operator()(EPI_ARGS) const {
        const int row0 = u.pm * 256 + wr * 64 + fr;
        bf16_t* out = O + (size_t)row0 * ldc + u.pn * 256 + wc * 32 + 8 * fq;
#pragma unroll
        for (int ai = 0; ai < 2; ++ai)
#pragma unroll
            for (int m = 0; m < 4; ++m) { const float sc = scale[row0 + ai * 128 + m * 16];
#pragma unroll
                for (int bj = 0; bj < 2; ++bj) *(u32x4*)(out + (size_t)(ai * 128 + m * 16) * ldc + bj * 128) = pack8(acc[ai][bj][m][0] * sc, acc[ai][bj][m][1] * sc); }
    }
};

typedef GAS unsigned gu32;
#define RLX_AGENT __ATOMIC_RELAXED, __HIP_MEMORY_SCOPE_AGENT
#define XB_TMO      128
#define XB_XCNT(j)  (256  + 64 * (j))
#define XB_XSUB(j)  (1280 + 64 * (j))
#define XB_XGEN(j)  (2304 + 64 * (j))
#define XB_TOP      3328
#define XB_TOPGEN   3392
#define XCD_BAR_WORDS 3456
#define XB_SPIN_CAP (1u << 20)
__device__ __forceinline__ unsigned xb_ld(unsigned* p)              { return __hip_atomic_load(p, __ATOMIC_RELAXED, __HIP_MEMORY_SCOPE_AGENT); }
__device__ __forceinline__ unsigned xb_add(unsigned* p, unsigned v) { return __hip_atomic_fetch_add(p, v, __ATOMIC_RELAXED, __HIP_MEMORY_SCOPE_AGENT); }
__device__ __forceinline__ unsigned xb_xcc_id() { return (unsigned)__builtin_amdgcn_s_getreg((3 << 11) | 20) & 0xFu; }
#define XB_SPIN(cond, bar) do { unsigned _sp = 0; while (cond) { __builtin_amdgcn_s_sleep(1); \
    if ((++_sp & 255u) == 0u) { if (xb_ld(&(bar)[XB_TMO])) break; if (_sp > XB_SPIN_CAP) { atomicAdd(&(bar)[XB_TMO], 1u); break; } } } } while (0)
struct XcdBarrier { unsigned* bar; unsigned x; volatile LAS unsigned* st; };
__device__ __forceinline__ XcdBarrier xcd_barrier_post(unsigned* bar, volatile LAS unsigned* st, const int wave) {
    XcdBarrier b; b.bar = bar; b.x = xb_xcc_id(); b.st = st;
    if (wave == 0 && lane_id() == 0) (void)xb_add(&bar[XB_XCNT(b.x)], 1u);
    return b;
}
__device__ __forceinline__ void xcd_barrier_complete(unsigned* bar, unsigned x, unsigned& nloc, unsigned& nx) {
    const unsigned G = gridDim.x * gridDim.y * gridDim.z;
    unsigned sum, cnt, mine, sp = 0u;
    for (;;) {
        sum = 0u; cnt = 0u; mine = 0u;
#pragma unroll
        for (unsigned j = 0; j < 16; ++j) { const unsigned c = xb_ld(&bar[XB_XCNT(j)]); sum += c; cnt += (c > 0u) ? 1u : 0u; mine = (j == x) ? c : mine; }
        if (sum == G) break;
        __builtin_amdgcn_s_sleep(1);
        if ((++sp & 255u) == 0u) { if (xb_ld(&bar[XB_TMO])) break; if (sp > XB_SPIN_CAP) { atomicAdd(&bar[XB_TMO], 1u); break; } }
    }
    nloc = mine > 0u ? mine : 1u; nx = cnt > 0u ? cnt : 1u;
}
__device__ __forceinline__ void xcd_barrier(const XcdBarrier& b, const int wave) {
    asm volatile("s_waitcnt vmcnt(0)" ::: "memory");
    __syncthreads();
    if (wave == 0 && lane_id() == 0) {
        unsigned* bar = b.bar;
        __builtin_amdgcn_s_waitcnt(0);
        unsigned nloc = b.st[0], nx = b.st[1];
        if (nloc == 0u) { xcd_barrier_complete(bar, b.x, nloc, nx); b.st[0] = nloc; b.st[1] = nx; }
        const unsigned old = xb_add(&bar[XB_XSUB(b.x)], 1u);
        const unsigned gen = old / nloc;
        if (old + 1u == (gen + 1u) * nloc) {
            __builtin_amdgcn_fence(__ATOMIC_RELEASE, "agent");
            asm volatile("s_waitcnt vmcnt(0)" ::: "memory");
            const unsigned og = xb_add(&bar[XB_TOP], 1u);
            const unsigned tg = og / nx;
            if (og + 1u == (tg + 1u) * nx) xb_add(&bar[XB_TOPGEN], 1u);
            else XB_SPIN(xb_ld(&bar[XB_TOPGEN]) == tg, bar);
            __builtin_amdgcn_fence(__ATOMIC_ACQUIRE, "agent");
            xb_add(&bar[XB_XGEN(b.x)], 1u);
            asm volatile("s_waitcnt vmcnt(0)" ::: "memory");
        } else {
            XB_SPIN(xb_ld(&bar[XB_XGEN(b.x)]) == gen, bar);
            __builtin_amdgcn_fence(__ATOMIC_ACQUIRE, "agent");
            asm volatile("s_waitcnt vmcnt(0)" ::: "memory");
        }
    }
    __syncthreads();
}

__device__ __forceinline__ void tr_item(const float* W, int N, bf16_t* WT, int Kt, LAS float* scr, int item, int lane) {
    const int nblk = N >> 6, kb = item / nblk, nb = item - kb * nblk, k0 = kb << 6, n0 = nb << 6;
    const int c = lane & 15, rr = lane >> 4;
    f32x4 v[16];
#pragma unroll
    for (int i = 0; i < 16; ++i) v[i] = __builtin_nontemporal_load((const f32x4*)(W + (size_t)(k0 + 4 * i + rr) * N + n0 + 4 * c));
#pragma unroll
    for (int i = 0; i < 16; ++i) { LAS float* s = scr + (4 * i + rr) * 65 + 4 * c; s[0] = v[i][0]; s[1] = v[i][1]; s[2] = v[i][2]; s[3] = v[i][3]; }
    LDS_WAIT();
    const int kc = lane & 7;
#pragma unroll
    for (int jj = 0; jj < 8; ++jj) { const int n = (lane >> 3) + 8 * jj; const LAS float* s = scr + (8 * kc) * 65 + n;
        u32x4 o; o.x = cvt_pk_bf16(s[0], s[65]); o.y = cvt_pk_bf16(s[130], s[195]); o.z = cvt_pk_bf16(s[260], s[325]); o.w = cvt_pk_bf16(s[390], s[455]);
        *(u32x4*)(WT + (size_t)(n0 + n) * Kt + k0 + 8 * kc) = o; }
    LDS_WAIT();
}
__device__ __forceinline__ double sin2pi(double r) {
    r -= rint(r);
    if (r > 0.25) r = 0.5 - r; else if (r < -0.25) r = -0.5 - r;
    const double x = r * 6.283185307179586476925, x2 = x * x;
    double p = -1.0 / 1307674368000.0;
    p = p * x2 + 1.0 / 6227020800.0; p = p * x2 - 1.0 / 39916800.0; p = p * x2 + 1.0 / 362880.0; p = p * x2 - 1.0 / 5040.0;
    p = p * x2 + 1.0 / 120.0; p = p * x2 - 1.0 / 6.0; p = p * x2 + 1.0;
    return x * p;
}

struct Args { const float* in[14]; float* out; unsigned char* ws; float freq[128]; float l2g[8]; float g256[8]; int ph_lo, ph_hi; };

__device__ __forceinline__ void p_prologue(const Args& a, LAS unsigned char* lds, const int wave) {
    const int lane = lane_id(), tid = wave * 64 + lane;
    unsigned char* ws = a.ws;
    LAS float* scr = (LAS float*)(lds + wave * 16640);
    const int gw = blockIdx.x * 8 + wave, NGW = gridDim.x * 8;
    constexpr int I_RI = (DM / 64) * (RPROJ / 64);
    for (int it = gw; it < I_RI; it += NGW) tr_item(a.in[3], RPROJ, (bf16_t*)(ws + WS_WT_RI), DM, scr, it, lane);
    const float* x = a.in[0]; const float* gain = a.in[2]; bf16_t* xn = (bf16_t*)(ws + WS_XN0);
    for (int m = gw; m < SEQ; m += NGW) {
        const f32x4* xr = (const f32x4*)(x + (size_t)m * DM) + 2 * lane; f32x4 v[8]; float s = 0.f;
#pragma unroll
        for (int j = 0; j < 8; ++j) { v[j] = __builtin_nontemporal_load(xr + 128 * (j >> 1) + (j & 1)); s += (v[j][0] * v[j][0] + v[j][1] * v[j][1]) + (v[j][2] * v[j][2] + v[j][3] * v[j][3]); }
        const float rstd = __builtin_amdgcn_rsqf(wave_sum(s) * (1.0f / DM) + NORM_EPS);
        u32x4* o = (u32x4*)(xn + (size_t)m * DM) + lane;
#pragma unroll
        for (int j = 0; j < 4; ++j) { const f32x4 g0 = *((const f32x4*)gain + 2 * lane + 128 * j), g1 = *((const f32x4*)gain + 2 * lane + 128 * j + 1); o[64 * j] = pack8(v[2 * j] * rstd * g0, v[2 * j + 1] * rstd * g1); }
    }
    const int gt = blockIdx.x * 512 + tid, NGT = gridDim.x * 512;
    { const float* p = a.in[1]; bf16_t* pb = (bf16_t*)(ws + WS_PBF);
      for (int i = gt; i < 2 * SEQ * PLE / 8; i += NGT) { const f32x4 a0 = __builtin_nontemporal_load((const f32x4*)(p + (size_t)i * 8)), a1 = __builtin_nontemporal_load((const f32x4*)(p + (size_t)i * 8 + 4)); *(u32x4*)(pb + (size_t)i * 8) = pack8(a0, a1); } }
    { f32x4* rope = (f32x4*)(ws + WS_ROPE);
      for (int i = gt; i < SEQ * 64; i += NGT) { const int pos = i >> 6, fi = (i & 63) * 2; const float a0 = (float)pos * a.freq[fi], a1 = (float)pos * a.freq[fi + 1];
          const double r0 = (double)a0 * 0.15915494309189533577, r1 = (double)a1 * 0.15915494309189533577;
          rope[i] = (f32x4){(float)sin2pi(r0 + 0.25), (float)sin2pi(r0), (float)sin2pi(r1 + 0.25), (float)sin2pi(r1)}; } }
}
struct CvDesc { const float* src; bf16_t* dst; const float* kg; int N, Kt, plain; };
constexpr int CV_RO = (PW / 64) * (DM / 32), CV_G = (DM / 64) * (DM / 32), CV_P = (PLE / 64) * (DM / 32), CV_PIG = (DM / 64) * (PW / 32), CV_GR = (1024 / 64) * (1024 / 32), CV_WU = DM * PW / 2048;
constexpr int CV_ITEMS = CV_RO + 2 * CV_G + 2 * CV_P + CV_PIG + 4 * CV_GR + CV_RO + CV_WU;
__device__ __forceinline__ CvDesc cv_tr(const float* W, int N, int ncols, bf16_t* WT, int Kt, int r, const float* kg = nullptr) {
    const int nblk = ncols >> 5, kb = r / nblk, nb = r - kb * nblk; CvDesc d; d.src = W + (size_t)(kb * 64) * N + nb * 32; d.dst = WT + (size_t)(nb * 32) * Kt + kb * 64; d.kg = kg ? kg + kb * 64 : nullptr; d.N = N; d.Kt = Kt; d.plain = 0; return d; }
__device__ __forceinline__ CvDesc cv_decode(const Args& a, int r) {
    unsigned char* ws = a.ws;
    if (r < CV_RO) return cv_tr(a.in[4], DM, DM, (bf16_t*)(ws + WS_WT_RO), PW, r); r -= CV_RO;
    if (r < CV_G) return cv_tr(a.in[11], DM, DM, (bf16_t*)(ws + WS_WT_G0), DM, r, a.in[10]); r -= CV_G;
    if (r < CV_G) return cv_tr(a.in[11] + (size_t)DM * DM, DM, DM, (bf16_t*)(ws + WS_WT_G1), DM, r, a.in[10] + DM); r -= CV_G;
    if (r < CV_P) return cv_tr(a.in[12], DM, DM, (bf16_t*)(ws + WS_WT_P0), PLE, r); r -= CV_P;
    if (r < CV_P) return cv_tr(a.in[12] + (size_t)PLE * DM, DM, DM, (bf16_t*)(ws + WS_WT_P1), PLE, r); r -= CV_P;
    if (r < CV_PIG) return cv_tr(a.in[6] + PW, 2 * PW, PW, (bf16_t*)(ws + WS_WT_PI) + (size_t)PW * DM, DM, r, a.in[5]); r -= CV_PIG;
    if (r < 4 * CV_GR) { const int g = r / CV_GR; return cv_tr(a.in[7] + (size_t)g * 1024 * 1024, 1024, 1024, (bf16_t*)(ws + WS_WT_GR) + (size_t)g * 1024 * 1024, 1024, r - g * CV_GR); } r -= 4 * CV_GR;
    if (r < CV_RO) return cv_tr(a.in[9], DM, DM, (bf16_t*)(ws + WS_WT_PO), PW, r); r -= CV_RO;
    CvDesc d; const int row = r >> 1, c0 = (r & 1) * 2048; d.src = a.in[6] + (size_t)row * (2 * PW) + c0; d.dst = (bf16_t*)(ws + WS_WU) + (size_t)row * PW + c0; d.kg = a.in[5] + row; d.N = 0; d.Kt = 0; d.plain = 1; return d;
}
__device__ __forceinline__ void cv_load(const CvDesc& d, f32x4 (&cv)[8], int lane) {
    if (d.plain) {
#pragma unroll
        for (int j = 0; j < 4; ++j) { cv[2 * j] = __builtin_nontemporal_load((const f32x4*)(d.src + lane * 8 + 512 * j)); cv[2 * j + 1] = __builtin_nontemporal_load((const f32x4*)(d.src + lane * 8 + 512 * j + 4)); }
    } else {
#pragma unroll
        for (int i = 0; i < 8; ++i) cv[i] = __builtin_nontemporal_load((const f32x4*)(d.src + (size_t)(8 * i + (lane >> 3)) * d.N + 4 * (lane & 7)));
    }
}
__device__ __forceinline__ void cv_store(const CvDesc& d, const f32x4 (&cv)[8], LAS float* scr, int lane) {
    if (d.plain) {
        const float kgv = d.kg[0];
#pragma unroll
        for (int j = 0; j < 4; ++j) *(u32x4*)(d.dst + lane * 8 + 512 * j) = pack8(cv[2 * j] * kgv, cv[2 * j + 1] * kgv);
    } else {
#pragma unroll
        for (int i = 0; i < 8; ++i) { const float kgv = d.kg ? d.kg[8 * i + (lane >> 3)] : 1.0f; LAS float* s = scr + (8 * i + (lane >> 3)) * 33 + 4 * (lane & 7); s[0] = cv[i][0] * kgv; s[1] = cv[i][1] * kgv; s[2] = cv[i][2] * kgv; s[3] = cv[i][3] * kgv; }
        LDS_WAIT();
        const int kc = lane & 7;
#pragma unroll
        for (int j = 0; j < 4; ++j) { const int n = (lane >> 3) + 8 * j; const LAS float* s = scr + (8 * kc) * 33 + n;
            u32x4 o; o.x = cvt_pk_bf16(s[0], s[33]); o.y = cvt_pk_bf16(s[66], s[99]); o.z = cvt_pk_bf16(s[132], s[165]); o.w = cvt_pk_bf16(s[198], s[231]);
            *(u32x4*)(d.dst + (size_t)n * d.Kt + 8 * kc) = o; }
        LDS_WAIT();
    }
}

__device__ __forceinline__ void tr_item_g(const float* W, int N, int ncols, bf16_t* WT, int Kt, LAS float* scr, int item, int lane, const float* kg) {
    const int nblk = ncols >> 6, kb = item / nblk, nb = item - kb * nblk, k0 = kb << 6, n0 = nb << 6;
    const int c = lane & 15, rr = lane >> 4;
    f32x4 v[16];
#pragma unroll
    for (int i = 0; i < 16; ++i) v[i] = __builtin_nontemporal_load((const f32x4*)(W + (size_t)(k0 + 4 * i + rr) * N + n0 + 4 * c));
#pragma unroll
    for (int i = 0; i < 16; ++i) { const float g = kg ? kg[k0 + 4 * i + rr] : 1.0f; LAS float* s = scr + (4 * i + rr) * 65 + 4 * c; s[0] = v[i][0] * g; s[1] = v[i][1] * g; s[2] = v[i][2] * g; s[3] = v[i][3] * g; }
    LDS_WAIT();
    const int kc = lane & 7;
#pragma unroll
    for (int jj = 0; jj < 8; ++jj) { const int n = (lane >> 3) + 8 * jj; const LAS float* s = scr + (8 * kc) * 65 + n;
        u32x4 o; o.x = cvt_pk_bf16(s[0], s[65]); o.y = cvt_pk_bf16(s[130], s[195]); o.z = cvt_pk_bf16(s[260], s[325]); o.w = cvt_pk_bf16(s[390], s[455]);
        *(u32x4*)(WT + (size_t)(n0 + n) * Kt + k0 + 8 * kc) = o; }
    LDS_WAIT();
}
__device__ __forceinline__ void p_weights_big(const Args& a, LAS unsigned char* lds, const int wave) {
    const int lane = lane_id();
    unsigned char* ws = a.ws;
    LAS float* scr = (LAS float*)(lds + wave * 16640);
    const int gw = (blockIdx.x - 128) * 8 + wave, NGW = (gridDim.x - 128) * 8;
    constexpr int I_RO = (PW / 64) * (DM / 64), I_G = (DM / 64) * (DM / 64), I_P = (PLE / 64) * (DM / 64), I_PIG = (DM / 64) * (PW / 64), I_GR = (1024 / 64) * (1024 / 64), I_WU = DM * PW / 2048;
    for (int it = gw; it < I_RO + 2 * I_G + 2 * I_P + I_PIG + 4 * I_GR + I_RO + I_WU; it += NGW) {
        int r = it;
        if (r < I_RO) { tr_item_g(a.in[4], DM, DM, (bf16_t*)(ws + WS_WT_RO), PW, scr, r, lane, nullptr); continue; } r -= I_RO;
        if (r < I_G) { tr_item_g(a.in[11], DM, DM, (bf16_t*)(ws + WS_WT_G0), DM, scr, r, lane, a.in[10]); continue; } r -= I_G;
        if (r < I_G) { tr_item_g(a.in[11] + (size_t)DM * DM, DM, DM, (bf16_t*)(ws + WS_WT_G1), DM, scr, r, lane, a.in[10] + DM); continue; } r -= I_G;
        if (r < I_P) { tr_item_g(a.in[12], DM, DM, (bf16_t*)(ws + WS_WT_P0), PLE, scr, r, lane, nullptr); continue; } r -= I_P;
        if (r < I_P) { tr_item_g(a.in[12] + (size_t)PLE * DM, DM, DM, (bf16_t*)(ws + WS_WT_P1), PLE, scr, r, lane, nullptr); continue; } r -= I_P;
        if (r < I_PIG) { tr_item_g(a.in[6] + PW, 2 * PW, PW, (bf16_t*)(ws + WS_WT_PI) + (size_t)PW * DM, DM, scr, r, lane, a.in[5]); continue; } r -= I_PIG;
        if (r < 4 * I_GR) { const int g = r / I_GR; tr_item_g(a.in[7] + (size_t)g * 1024 * 1024, 1024, 1024, (bf16_t*)(ws + WS_WT_GR) + (size_t)g * 1024 * 1024, 1024, scr, r - g * I_GR, lane, nullptr); continue; } r -= 4 * I_GR;
        if (r < I_RO) { tr_item_g(a.in[9], DM, DM, (bf16_t*)(ws + WS_WT_PO), PW, scr, r, lane, nullptr); continue; } r -= I_RO;
        { const int row = r >> 1, c0 = (r & 1) * 2048 + lane * 8; const float* srcp = a.in[6] + (size_t)row * (2 * PW) + c0; bf16_t* dstp = (bf16_t*)(ws + WS_WU) + (size_t)row * PW + c0; const float g = a.in[5][row];
#pragma unroll
            for (int j = 0; j < 4; ++j) { const f32x4 x0 = __builtin_nontemporal_load((const f32x4*)(srcp + 512 * j)), x1 = __builtin_nontemporal_load((const f32x4*)(srcp + 512 * j + 4)); *(u32x4*)(dstp + 512 * j) = pack8(x0 * g, x1 * g); } }
    }
}

__device__ __forceinline__ bf16x8 tr_frag(const LAS unsigned char* p, int pitch16) {
    const s16x4 lo = __builtin_amdgcn_ds_read_tr16_b64_v4i16((LAS s16x4*)p), hi = __builtin_amdgcn_ds_read_tr16_b64_v4i16((LAS s16x4*)(p + pitch16));
    return (bf16x8){lo[0], lo[1], lo[2], lo[3], hi[0], hi[1], hi[2], hi[3]};
}

__device__ __forceinline__ void p_scan(const Args& a, LAS unsigned char* lds, const int w) {
    const int lane = lane_id();
    const int tid = w * 64 + lane, b = blockIdx.x, h = b & 7, tt = b >> 3, dt = tt >> 2, vt = tt & 3;
    const int db = w >> 1, vbp = w & 1, g = lane >> 4, i16 = lane & 15, q4 = i16 >> 2, p4 = i16 & 3;
    const float g256 = a.g256[h];
    constexpr int PK = 160, PV = 288, TK = 128 * PK, TV = 128 * PV, BUF = TK + TV;
    const bf16_t* kbase = (const bf16_t*)(a.ws + WS_KD) + h * 256 + dt * 64;
    const bf16_t* vbase = (const bf16_t*)(a.ws + WS_V) + h * 512 + vt * 128;
    bf16_t* st = (bf16_t*)(a.ws + WS_ST);
    u32x4 rk0[2], rv0[4], rk1[2], rv1[4], rk2[2], rv2[4], rk3[2], rv3[4];
#define P2_LOAD(RK, RV, hs) do { const int _hs = (hs) < 62 ? (hs) : 61; \
        _Pragma("unroll") for (int _i = 0; _i < 2; ++_i) { const int _p = tid + 512 * _i; RK[_i] = *(const u32x4*)(kbase + (size_t)(_hs * 128 + (_p >> 3)) * DM + (_p & 7) * 8); } \
        _Pragma("unroll") for (int _i = 0; _i < 4; ++_i) { const int _p = tid + 512 * _i; RV[_i] = *(const u32x4*)(vbase + (size_t)(_hs * 128 + (_p >> 4)) * PW + (_p & 15) * 8); } } while (0)
#define P2_STORE(RK, RV, s) do { \
        _Pragma("unroll") for (int _i = 0; _i < 2; ++_i) { const int _p = tid + 512 * _i; *(LAS u32x4*)(lds + (s) * BUF + (_p >> 3) * PK + (_p & 7) * 16) = RK[_i]; } \
        _Pragma("unroll") for (int _i = 0; _i < 4; ++_i) { const int _p = tid + 512 * _i; *(LAS u32x4*)(lds + (s) * BUF + TK + (_p >> 4) * PV + (_p & 15) * 16) = RV[_i]; } } while (0)
    f32x4 acc[4];
#pragma unroll
    for (int j = 0; j < 4; ++j) acc[j] = (f32x4){0.f, 0.f, 0.f, 0.f};
    const int lk = (4 * g + q4) * PK + 8 * p4 + db * 32, lv = (4 * g + q4) * PV + 16 * p4 + vbp * 128;
#define P2_STEP(hs, RKN, RVN) do { const int _h = (hs); if (_h < 62) { \
        const LAS unsigned char* kt = lds + (_h & 1) * BUF + lk; const LAS unsigned char* vtp = lds + (_h & 1) * BUF + TK + lv; \
        _Pragma("unroll") for (int ks = 0; ks < 4; ++ks) { \
            const bf16x8 kf = tr_frag(kt + ks * 32 * PK, 16 * PK); \
            _Pragma("unroll") for (int j = 0; j < 4; ++j) { const bf16x8 vf = tr_frag(vtp + ks * 32 * PV + 64 * (j >> 1) + 8 * (j & 1), 16 * PV); acc[j] = __builtin_amdgcn_mfma_f32_16x16x32_bf16(vf, kf, acc[j], 0, 0, 0); } } \
        if (_h & 1) { const int n = _h >> 1; \
            bf16_t* o = st + ((size_t)(n * 8 + h) * 256 + dt * 64 + db * 16 + i16) * 512 + vt * 128 + vbp * 64 + 8 * g; \
            _Pragma("unroll") for (int j = 0; j < 4; ++j) acc[j] *= g256; \
            _Pragma("unroll") for (int k = 0; k < 2; ++k) *(u32x4*)(o + 32 * k) = pack8(acc[2 * k], acc[2 * k + 1]); } \
        if (_h + 1 < 62) { P2_STORE(RKN, RVN, (_h + 1) & 1); P2_LOAD(RKN, RVN, _h + 5); } \
        __syncthreads(); } } while (0)
    P2_LOAD(rk0, rv0, 0); P2_LOAD(rk1, rv1, 1); P2_LOAD(rk2, rv2, 2); P2_LOAD(rk3, rv3, 3);
    P2_STORE(rk0, rv0, 0); P2_LOAD(rk0, rv0, 4); __syncthreads();
    for (int hs = 0; hs < 62; hs += 4) {
        P2_STEP(hs, rk1, rv1); P2_STEP(hs + 1, rk2, rv2); P2_STEP(hs + 2, rk3, rv3); P2_STEP(hs + 3, rk0, rv0);
    }
#undef P2_STEP
#undef P2_LOAD
#undef P2_STORE
}

__device__ __forceinline__ void p_retention(const Args& a, LAS unsigned char* lds, const int w) {
    const int lane = lane_id();
    const int tid = w * 64 + lane, b = blockIdx.x;
    const int g = lane >> 4, i16 = lane & 15, q4 = i16 >> 2, p4 = i16 & 3;
    constexpr int PP = 528, RINGO = 128 * PP, RB = 33792, ST1 = RINGO + 2 * RB, ST2 = ST1 + 8192;
    const bf16_t* qd = (const bf16_t*)(a.ws + WS_QD); const bf16_t* kd = (const bf16_t*)(a.ws + WS_KD); const bf16_t* v = (const bf16_t*)(a.ws + WS_V);
    const bf16_t* sg = (const bf16_t*)(a.ws + WS_SG); const bf16_t* st = (const bf16_t*)(a.ws + WS_ST); bf16_t* z = (bf16_t*)(a.ws + WS_Z);
    const unsigned offk = (unsigned)(((tid >> 5) * DM + (tid & 31) * 8) * 2), offv = (unsigned)(((tid >> 6) * PW + (tid & 63) * 8) * 2), offt = (unsigned)(((tid >> 6) * 512 + (tid & 63) * 8) * 2);
    const int xs = b & 7, kq = b >> 3, pair = kq >> 1, member = kq & 1;
    for (int rnd = 0; rnd < 2; ++rnd) {
        const int nh = (pair * 2 + rnd) * 8 + xs, n = nh >> 3, h = nh & 7, hf = member ^ rnd;
        const int nsb = 2 * (hf + 1), nvb = 4 * (hf + 1), ntb = n > 0 ? 8 : 0, nblk = nsb + nvb + ntb;
        const int rowbase = 256 * n + 128 * hf;
        u32x4 ra[4], rb[4];
#define P3_LOAD(R, it) do { const int _it = (it) < nblk ? (it) : nblk - 1; \
        if (_it < ntb) { const char* _b = (const char*)(st + ((size_t)((n - 1) * 8 + h) * 256 + 32 * _it) * 512); unsigned _o = offt; asm volatile("" : "+v"(_o)); \
            _Pragma("unroll") for (int _i = 0; _i < 4; ++_i) R[_i] = *(const u32x4*)(_b + (size_t)_i * (8 * 512 * 2) + _o); } \
        else if (_it < ntb + nsb) { const char* _b = (const char*)(kd + (size_t)(256 * n + 64 * (_it - ntb)) * DM + h * 256); unsigned _o = offk; asm volatile("" : "+v"(_o)); \
            _Pragma("unroll") for (int _i = 0; _i < 4; ++_i) R[_i] = *(const u32x4*)(_b + (size_t)_i * (16 * DM * 2) + _o); } \
        else { const char* _b = (const char*)(v + (size_t)(256 * n + 32 * (_it - ntb - nsb)) * PW + h * 512); unsigned _o = offv; asm volatile("" : "+v"(_o)); \
            _Pragma("unroll") for (int _i = 0; _i < 4; ++_i) R[_i] = *(const u32x4*)(_b + (size_t)_i * (8 * PW * 2) + _o); } } while (0)
#define P3_STORE(R, it) do { const int _it = (it); if (_it < nblk) { LAS unsigned char* _d = lds + RINGO + (_it & 1) * RB; \
        if (_it >= ntb && _it < ntb + nsb) { _Pragma("unroll") for (int _i = 0; _i < 4; ++_i) { const int _p = tid + 512 * _i; *(LAS u32x4*)(_d + (_p >> 5) * 528 + (_p & 31) * 16) = R[_i]; } } \
        else { _Pragma("unroll") for (int _i = 0; _i < 4; ++_i) { const int _p = tid + 512 * _i; *(LAS u32x4*)(_d + (_p >> 6) * 1056 + (_p & 63) * 16) = R[_i]; } } } } while (0)
        P3_LOAD(ra, 0); P3_LOAD(rb, 1);
        if (ntb) {
#pragma unroll 2
            for (int i = 0; i < 8; ++i) { const int p = tid + 512 * i, row = p >> 5, c = p & 31, G = c >> 2, cc = c & 3;
                const u32x4 x = *(const u32x4*)(qd + (size_t)(rowbase + row) * DM + h * 256 + c * 8);
                const int s = cc >> 1, glo = (2 * cc) & 3, ghi = (2 * cc + 1) & 3;
                LAS unsigned char* d = lds + row * PP + 64 * G;
                *(LAS u32x2*)(d + 8 * (2 * glo + s)) = (u32x2){x.x, x.y}; *(LAS u32x2*)(d + 8 * (2 * ghi + s)) = (u32x2){x.z, x.w}; }
        }
        P3_STORE(ra, 0); P3_LOAD(ra, 2); __syncthreads();
        f32x4 acc[8][4];
#pragma unroll
        for (int rbk = 0; rbk < 8; ++rbk)
#pragma unroll
            for (int cb = 0; cb < 4; ++cb) acc[rbk][cb] = (f32x4){0.f, 0.f, 0.f, 0.f};
#define P3_YSTEP(it_, RN, ISV) do { const int it = (it_); \
            const LAS unsigned char* ring = lds + RINGO + (it & 1) * RB; \
            { const int kk = (ISV) ? it - ntb - nsb : it; \
                bf16x8 vf[4]; \
                _Pragma("unroll") for (int cb = 0; cb < 4; ++cb) vf[cb] = tr_frag(ring + (4 * g + q4) * 1056 + (64 * w + 32 * (cb >> 1) + 8 * p4 + 4 * (cb & 1)) * 2, 16 * 1056);   \
                _Pragma("unroll") for (int rbk = 0; rbk < 8; ++rbk) { \
                    if ((ISV) && 32 * kk > 128 * hf + 16 * rbk + 15) continue; \
                    const bf16x8 pf = *(const LAS bf16x8*)(lds + (16 * rbk + i16) * PP + (32 * kk + 8 * g) * 2); \
                    _Pragma("unroll") for (int cb = 0; cb < 4; ++cb) acc[rbk][cb] = __builtin_amdgcn_mfma_f32_16x16x32_bf16(vf[cb], pf, acc[rbk][cb], 0, 0, 0); \
                } } \
            P3_STORE(RN, it + 1); P3_LOAD(RN, it + 3); \
            __syncthreads(); } while (0)
        for (int it2 = 0; it2 < ntb; it2 += 2) { P3_YSTEP(it2, rb, false); P3_YSTEP(it2 + 1, ra, false); }
        {
            bf16x8 qf[8];
#pragma unroll
            for (int ds = 0; ds < 8; ++ds) qf[ds] = *(const bf16x8*)(qd + (size_t)(rowbase + 16 * w + i16) * DM + h * 256 + 32 * ds + 8 * g);
#define P3_SSTEP(it_, RN) do { const int it = (it_), sbk = it - ntb; \
                const LAS unsigned char* ring = lds + RINGO + (it & 1) * RB; \
                _Pragma("unroll") for (int sb = 0; sb < 4; ++sb) { \
                    const int j0 = 64 * sbk + 16 * sb, i0 = 128 * hf + 16 * w; \
                    LAS unsigned char* dst = lds + (16 * w + i16) * PP + (32 * (2 * sbk + (sb >> 1)) + 8 * g + 4 * (sb & 1)) * 2; \
                    if (j0 > i0) { *(LAS u32x2*)dst = (u32x2){0u, 0u}; } \
                    else { \
                        f32x4 s4 = {0.f, 0.f, 0.f, 0.f}; \
                        _Pragma("unroll") for (int ds = 0; ds < 8; ++ds) { const bf16x8 kf = *(const LAS bf16x8*)(ring + (16 * sb + i16) * 528 + (32 * ds + 8 * g) * 2); \
                            s4 = __builtin_amdgcn_mfma_f32_16x16x32_bf16(kf, qf[ds], s4, 0, 0, 0); } \
                        if (j0 == i0) { _Pragma("unroll") for (int r = 0; r < 4; ++r) if (4 * g + r > i16) s4[r] = 0.f; } \
                        u32x2 wv; wv.x = cvt_pk_bf16(s4[0], s4[1]); wv.y = cvt_pk_bf16(s4[2], s4[3]); *(LAS u32x2*)dst = wv; \
                    } \
                } \
                P3_STORE(RN, it + 1); P3_LOAD(RN, it + 3); \
                __syncthreads(); } while (0)
            for (int it2 = ntb; it2 < ntb + nsb; it2 += 2) { P3_SSTEP(it2, rb); P3_SSTEP(it2 + 1, ra); }
#undef P3_SSTEP
        }
        for (int it2 = ntb + nsb; it2 < nblk; it2 += 2) { P3_YSTEP(it2, rb, true); P3_YSTEP(it2 + 1, ra, true); }
#undef P3_YSTEP
#undef P3_LOAD
#undef P3_STORE
        LAS f32x2* S1 = (LAS f32x2*)(lds + ST1); LAS f32x2* S2 = (LAS f32x2*)(lds + ST2);
#pragma unroll
        for (int rbk = 0; rbk < 8; ++rbk) { float s1 = 0.f, s2 = 0.f;
#pragma unroll
            for (int cb = 0; cb < 4; ++cb) { const f32x4 y = acc[rbk][cb]; s1 += (y[0] + y[1]) + (y[2] + y[3]); s2 += (y[0] * y[0] + y[1] * y[1]) + (y[2] * y[2] + y[3] * y[3]); }
            s1 += __shfl_xor(s1, 16); s1 += __shfl_xor(s1, 32); s2 += __shfl_xor(s2, 16); s2 += __shfl_xor(s2, 32);
            if (g == 0) S1[(16 * rbk + i16) * 8 + w] = (f32x2){s1, s2}; }
        __syncthreads();
        if (tid < 128) { float s1 = 0.f, s2 = 0.f;
#pragma unroll
            for (int k = 0; k < 8; ++k) { const f32x2 t = S1[tid * 8 + k]; s1 += t.x; s2 += t.y; }
            const float mean = s1 * (1.0f / 512.0f), var = s2 * (1.0f / 512.0f) - mean * mean;
            S2[tid] = (f32x2){mean, __builtin_amdgcn_rsqf(fmaxf(var, 0.f) + GN_EPS)}; }
        __syncthreads();
#pragma unroll
        for (int rbk = 0; rbk < 8; ++rbk) { const f32x2 ms = S2[16 * rbk + i16];
            const size_t off = (size_t)(rowbase + 16 * rbk + i16) * PW + h * 512 + 64 * w + 8 * g;
#pragma unroll
            for (int k = 0; k < 2; ++k) { const u32x4 gw = __builtin_nontemporal_load((const u32x4*)(sg + off + 32 * k)); f32x4 g0, g1; unpack8(gw, g0, g1);
                const f32x4 y0 = (acc[rbk][2 * k] - ms.x) * ms.y * g0, y1 = (acc[rbk][2 * k + 1] - ms.x) * ms.y * g1;
                *(u32x4*)(z + off + 32 * k) = pack8(y0, y1); } }
        __syncthreads();
    }
}

__device__ __forceinline__ void p_pool(const Args& a, const int wave) {
    const int tid = wave * 64 + lane_id();
    const bf16_t* u = (const bf16_t*)(a.ws + WS_U); const bf16_t* sg = (const bf16_t*)(a.ws + WS_SG1); bf16_t* d = (bf16_t*)(a.ws + WS_ZZ);
    for (int task = blockIdx.x * 512 + tid; task < 512 * 256; task += gridDim.x * 512) {
        const int chunk = task & 511, run = task >> 9, w = 2 << (chunk >> 7), t0 = run * 32;
        const bf16_t* uc = u + chunk * 8; const bf16_t* gc = sg + chunk * 8; bf16_t* dc = d + chunk * 8;
        f32x4 s0 = {0.f, 0.f, 0.f, 0.f}, s1 = {0.f, 0.f, 0.f, 0.f};
        for (int t = (t0 - w > 0 ? t0 - w : 0); t < t0; ++t) { f32x4 x0, x1; unpack8(*(const u32x4*)(uc + (size_t)t * PW), x0, x1); s0 += x0; s1 += x1; }
        for (int t = t0; t < t0 + 32; ++t) {
            f32x4 x0, x1, g0, g1; unpack8(*(const u32x4*)(uc + (size_t)t * PW), x0, x1); unpack8(*(const u32x4*)(gc + (size_t)t * PW), g0, g1); s0 += x0; s1 += x1;
            if (t - w >= 0) { f32x4 y0, y1; unpack8(*(const u32x4*)(uc + (size_t)(t - w) * PW), y0, y1); s0 -= y0; s1 -= y1; }
            const float inv = 1.0f / (float)(t + 1 < w ? t + 1 : w);
            *(u32x4*)(dc + (size_t)t * PW) = pack8((s0 * inv - x0) * g0, (s1 * inv - x1) * g1);
        }
    }
}
__device__ __forceinline__ void p_final(const Args& a, const int wave) {
    const int lane = lane_id();
    const float* rp = (const float*)(a.ws + WS_RP + 3 * MiB); const float* gain = a.in[13]; float* out = a.out;
    for (int m = blockIdx.x * 8 + wave; m < SEQ; m += gridDim.x * 8) {
        const float part = lane < 32 ? rp[(size_t)m * 32 + lane] : 0.f;
        const float rstd = __builtin_amdgcn_rsqf(wave_sum(part) * (1.0f / DM) + NORM_EPS);
        f32x4* o = (f32x4*)(out + (size_t)m * DM) + lane;
#pragma unroll
        for (int j = 0; j < 8; ++j) { const f32x4 g = *((const f32x4*)gain + lane + 64 * j); o[64 * j] = o[64 * j] * rstd * g; }
    }
}

__global__ void __launch_bounds__(512, 2) trunk_fwd(Args args) {
    extern __shared__ __attribute__((aligned(16))) unsigned char lds_raw[];
    LAS unsigned char* lds = (LAS unsigned char*)lds_raw;
    const int wave = __builtin_amdgcn_readfirstlane(threadIdx.x >> 6);
    unsigned char* ws = args.ws;
    volatile LAS unsigned* MISC = (volatile LAS unsigned*)(lds + MISC_OFF);
    if (threadIdx.x < 64) MISC[threadIdx.x] = 0u;
    __syncthreads();
    XcdBarrier bar; bar.bar = (unsigned*)(ws + WS_CTL) + 4096; bar.x = 0; bar.st = nullptr;
    const int lo = args.ph_lo, hi = args.ph_hi;
    if (hi - lo > 1) bar = xcd_barrier_post((unsigned*)(ws + WS_CTL) + 4096, MISC + 8, wave);
#ifndef PH_MASK
#define PH_MASK 0x3FF
#endif
#define IN(k) (((PH_MASK >> (k)) & 1) && lo <= (k) && (k) < hi)
#define SEAM(k) do { if (IN(k) && IN((k) + 1)) xcd_barrier(bar, wave); } while (0)
#ifndef DUP_MASK
#define DUP_MASK 0
#endif
#define NDUP(k) (((DUP_MASK >> (k)) & 1) ? 2 : 1)
    const int G = gridDim.x, c = blockIdx.x;
    float* rp0 = (float*)(ws + WS_RP); float* rp1 = rp0 + SEQ * 32; float* rp2 = rp1 + SEQ * 32; float* rp3 = rp2 + SEQ * 32;

    if (IN(0)) for (int rep_ = 0; rep_ < NDUP(0); ++rep_) { if (rep_) xcd_barrier(bar, wave); p_prologue(args, lds, wave); VM_WAIT(); __syncthreads(); }
    SEAM(0);
    if (IN(1)) for (int rep_ = 0; rep_ < NDUP(1); ++rep_) { if (rep_) xcd_barrier(bar, wave);
        pg8::Gemm g{(const bf16_t*)(ws + WS_XN0), (const bf16_t*)(ws + WS_WT_RI), SEQ, RPROJ, DM, DM, DM}; pg8::StaticOrder S; S.init(SEQ, RPROJ, G, c);
        EpiRet1 E{(bf16_t*)(ws + WS_QD), (bf16_t*)(ws + WS_KD), (bf16_t*)(ws + WS_V), (bf16_t*)(ws + WS_SG), (const float*)(ws + WS_ROPE), args.l2g};
        pg8::gemm_phase(lds, g, S, E, wave);
    }
    SEAM(1);
    if (IN(2)) for (int rep_ = 0; rep_ < NDUP(2); ++rep_) { if (rep_) xcd_barrier(bar, wave); if (c < 128) p_scan(args, lds, wave); else p_weights_big(args, lds, wave);
        VM_WAIT(); __syncthreads(); }
    SEAM(2);
    if (IN(3)) for (int rep_ = 0; rep_ < NDUP(3); ++rep_) { if (rep_) xcd_barrier(bar, wave); p_retention(args, lds, wave); }
    SEAM(3);
    if (IN(4)) for (int rep_ = 0; rep_ < NDUP(4); ++rep_) { if (rep_) xcd_barrier(bar, wave);
        { pg8::Gemm g{(const bf16_t*)(ws + WS_Z), (const bf16_t*)(ws + WS_WT_RO), SEQ, DM, PW, PW, PW}; pg8::StaticOrder S; S.init(SEQ, DM, G, c);
          EpiRes<true> E{args.in[0], nullptr, (bf16_t*)(ws + WS_A1), rp0};
          pg8::gemm_phase(lds, g, S, E, wave); }
        { pg8::Gemm g{(const bf16_t*)(ws + WS_PBF), (const bf16_t*)(ws + WS_WT_P0), SEQ, DM, PLE, PLE, PLE}; pg8::UpperHalfOrder S; S.init(SEQ, DM, G, c);
          EpiPlain E{(bf16_t*)(ws + WS_PE0), DM};
          pg8::gemm_phase(lds, g, S, E, wave); }
        { pg8::Gemm g{(const bf16_t*)(ws + WS_WT_GR), (const bf16_t*)(ws + WS_WU), PW, DM, 1024, 1024, PW}; pg8::CombOrder S; S.init(PW, DM, G, c);
          EpiComb E{(bf16_t*)(ws + WS_WT_PI), DM, args.in[8]};
          pg8::gemm_phase(lds, g, S, E, wave); }
    }
    SEAM(4);
    if (IN(5)) for (int rep_ = 0; rep_ < NDUP(5); ++rep_) { if (rep_) xcd_barrier(bar, wave);
        pg8::Gemm g{(const bf16_t*)(ws + WS_A1), (const bf16_t*)(ws + WS_WT_G0), SEQ, DM, DM, DM, DM}; pg8::StaticOrder S; S.init(SEQ, DM, G, c);
        rstd_table(lds, rp0, S, wave * 64 + lane_id());
        EpiPle E{(const bf16_t*)(ws + WS_A1), (const bf16_t*)(ws + WS_PE0), lds, (bf16_t*)(ws + WS_A2), rp1};
        pg8::gemm_phase(lds, g, S, E, wave);
    }
    SEAM(5);
    if (IN(6)) for (int rep_ = 0; rep_ < NDUP(6); ++rep_) { if (rep_) xcd_barrier(bar, wave);
        pg8::Gemm g{(const bf16_t*)(ws + WS_A2), (const bf16_t*)(ws + WS_WT_PI), SEQ, 2 * PW, DM, DM, DM}; pg8::StaticOrder S; S.init(SEQ, 2 * PW, G, c);
        rstd_table(lds, rp1, S, wave * 64 + lane_id());
        EpiPoolIn E{lds, (bf16_t*)(ws + WS_U), (bf16_t*)(ws + WS_SG1)};
        pg8::gemm_phase(lds, g, S, E, wave);
    }
    SEAM(6);
    if (IN(7)) for (int rep_ = 0; rep_ < NDUP(7); ++rep_) { if (rep_) xcd_barrier(bar, wave); p_pool(args, wave); }
    SEAM(7);
    if (IN(8)) for (int rep_ = 0; rep_ < NDUP(8); ++rep_) { if (rep_) xcd_barrier(bar, wave);
        { pg8::Gemm g{(const bf16_t*)(ws + WS_ZZ), (const bf16_t*)(ws + WS_WT_PO), SEQ, DM, PW, PW, PW}; pg8::StaticOrder S; S.init(SEQ, DM, G, c);
          EpiRes<false> E{nullptr, (const bf16_t*)(ws + WS_A2), (bf16_t*)(ws + WS_A3), rp2};
          pg8::gemm_phase(lds, g, S, E, wave); }
        { pg8::Gemm g{(const bf16_t*)(ws + WS_PBF) + (size_t)SEQ * PLE, (const bf16_t*)(ws + WS_WT_P1), SEQ, DM, PLE, PLE, PLE}; pg8::StaticOrder S; S.init(SEQ, DM, G, c);
          EpiPlain E{(bf16_t*)(ws + WS_PE1), DM};
          pg8::gemm_phase(lds, g, S, E, wave); }
    }
    SEAM(8);
    if (IN(9)) for (int rep_ = 0; rep_ < NDUP(9); ++rep_) { if (rep_) xcd_barrier(bar, wave);
        pg8::Gemm g{(const bf16_t*)(ws + WS_A3), (const bf16_t*)(ws + WS_WT_G1), SEQ, DM, DM, DM, DM}; pg8::StaticOrder S; S.init(SEQ, DM, G, c);
        rstd_table(lds, rp2, S, wave * 64 + lane_id());
        EpiPleFinal E{(const bf16_t*)(ws + WS_A3), (const bf16_t*)(ws + WS_PE1), lds, args.out, args.in[13], (unsigned*)(ws + WS_CTL)};
        pg8::gemm_phase(lds, g, S, E, wave);
    }
#undef IN
#undef SEAM
}

extern "C" void kernel_launch(void* const* d_in, const int* in_sizes, int n_in, void* d_out, int out_size, void* d_ws, size_t ws_size, hipStream_t stream) {
    static int grid = 0;
    if (grid == 0) {
        if (n_in != 14 || out_size != SEQ * DM || ws_size < WS_END) { fprintf(stderr, "kernel_launch: unexpected problem: n_in %d out %d ws %zu (need %zu)\n", n_in, out_size, ws_size, (size_t)WS_END); grid = -1; return; }
        int dev = 0, cus = 0, per_cu = 0;
        if (hipGetDevice(&dev) != hipSuccess || hipDeviceGetAttribute(&cus, hipDeviceAttributeMultiprocessorCount, dev) != hipSuccess) { grid = -1; return; }
        if (hipFuncSetAttribute((const void*)trunk_fwd, hipFuncAttributeMaxDynamicSharedMemorySize, LDS_BYTES) != hipSuccess) { fprintf(stderr, "kernel_launch: hipFuncSetAttribute failed\n"); grid = -1; return; }
        if (hipOccupancyMaxActiveBlocksPerMultiprocessor(&per_cu, (const void*)trunk_fwd, 512, LDS_BYTES) != hipSuccess || per_cu < 1) { fprintf(stderr, "kernel_launch: occupancy query says %d\n", per_cu); (void)hipGetLastError(); }
        grid = cus;
        if (grid != 256) fprintf(stderr, "kernel_launch: %d CUs (built for 256)\n", grid);
    }
    if (grid < 0) return;
    (void)hipMemsetAsync((char*)d_ws + WS_CTL, 0, CTL_ZERO_BYTES, stream);
    Args a{};
    for (int i = 0; i < 14; ++i) a.in[i] = (const float*)d_in[i];
    a.out = (float*)d_out; a.ws = (unsigned char*)d_ws;
    for (int i = 0; i < 128; ++i) { const float lin = (float)i * (1.0f / 127.0f); a.freq[i] = (float)pow(10000.0, -(double)lin); }
    for (int h = 0; h < 8; ++h) { const double lg = log2(1.0 - pow(2.0, -5.0 - (double)h)); a.l2g[h] = (float)lg; a.g256[h] = (float)exp2(256.0 * lg); }
    constexpr int NPH = 10;
    if (MK_N_LAUNCHES == 1) {
        a.ph_lo = 0; a.ph_hi = NPH;
        void* kargs[] = {&a};
        const hipError_t le = hipLaunchCooperativeKernel((const void*)trunk_fwd, dim3(grid), dim3(512), kargs, LDS_BYTES, stream);
        if (le != hipSuccess) fprintf(stderr, "kernel_launch: cooperative launch failed: %s (grid %d)\n", hipGetErrorString(le), grid);
    } else {
        for (int ph = 0; ph < NPH; ++ph) { a.ph_lo = ph; a.ph_hi = ph + 1; hipLaunchKernelGGL(trunk_fwd, dim3(grid), dim3(512), LDS_BYTES, stream, a); }
    }
}
```

```cpp
#include <hip/hip_runtime.h>
#include <cstdio>
#include <cstdint>
#include <cmath>

#ifndef MK_N_LAUNCHES
#define MK_N_LAUNCHES 1
#define CV_BIG 1
#endif

#define LAS __attribute__((address_space(3)))
#define GAS __attribute__((address_space(1)))
typedef unsigned short bf16_t;
typedef short bf16x8 __attribute__((ext_vector_type(8)));
typedef short s16x4 __attribute__((ext_vector_type(4)));
typedef float f32x4 __attribute__((ext_vector_type(4)));
typedef float f32x2 __attribute__((ext_vector_type(2)));
typedef unsigned u32x4 __attribute__((ext_vector_type(4)));
typedef unsigned u32x2 __attribute__((ext_vector_type(2)));

constexpr int SEQ = 8192, DM = 2048, RPROJ = 12288, NH = 8, DKH = 256, DVH = 512, PW = 4096, PLE = 256;
constexpr float NORM_EPS = 1e-6f, GN_EPS = 1e-5f;

constexpr size_t MiB = 1u << 20;
constexpr size_t WS_CTL = 0, CTL_ZERO_BYTES = 128 * 1024;
constexpr size_t WS_RP = 1 * MiB;
constexpr size_t WS_ROPE = 5 * MiB;
constexpr size_t WS_PBF = 13 * MiB;
constexpr size_t WS_WT_RO = 21 * MiB;
constexpr size_t WS_WT_G0 = 37 * MiB;
constexpr size_t WS_WT_P0 = 45 * MiB;
constexpr size_t WS_WT_RI = 46 * MiB;
constexpr size_t WS_XN0 = 94 * MiB;
constexpr size_t WS_QD = 126 * MiB, WS_KD = 158 * MiB, WS_V = 190 * MiB, WS_SG = 254 * MiB;
constexpr size_t WS_Z = WS_SG;
constexpr size_t WS_ST = 318 * MiB;
constexpr size_t WS_WU = 46 * MiB;
constexpr size_t WS_WT_PI = 62 * MiB;
constexpr size_t WS_WT_GR = 94 * MiB, WS_WT_PO = 102 * MiB, WS_WT_G1 = 118 * MiB, WS_WT_P1 = 382 * MiB;
constexpr size_t WS_H1 = 126 * MiB, WS_A1 = 190 * MiB, WS_PE0 = 222 * MiB;
constexpr size_t WS_H2 = 254 * MiB, WS_A2 = 318 * MiB;
constexpr size_t WS_U = 126 * MiB, WS_SG1 = 190 * MiB, WS_ZZ = 254 * MiB;
constexpr size_t WS_H3 = 126 * MiB, WS_A3 = 190 * MiB, WS_PE1 = 222 * MiB;
constexpr size_t WS_END = 383 * MiB;

constexpr int RING_BYTES = 131072;
constexpr int LDS_BYTES = 155648;
constexpr int MISC_OFF = LDS_BYTES - 256;

#define LDS_WAIT() asm volatile("s_waitcnt lgkmcnt(0)" ::: "memory")
#define VM_WAIT() asm volatile("s_waitcnt vmcnt(0)" ::: "memory")

__device__ __forceinline__ unsigned cvt_pk_bf16(float lo, float hi) { unsigned r; asm volatile("v_cvt_pk_bf16_f32 %0, %1, %2" : "=v"(r) : "v"(lo), "v"(hi)); return r; }
__device__ __forceinline__ float bf_lo(unsigned w) { return __uint_as_float(w << 16); }
__device__ __forceinline__ float bf_hi(unsigned w) { return __uint_as_float(w & 0xffff0000u); }
__device__ __forceinline__ float fsigmoid(float x) { return __builtin_amdgcn_rcpf(1.0f + __builtin_amdgcn_exp2f(-1.44269504089f * x)); }
__device__ __forceinline__ float fsilu(float x) { return x * fsigmoid(x); }
__device__ __forceinline__ int lane_id() { int l; asm volatile("v_mbcnt_lo_u32_b32 %0, -1, 0\n\tv_mbcnt_hi_u32_b32 %0, -1, %0" : "=v"(l)); return l; }
__device__ __forceinline__ float wave_sum(float v) {
#pragma unroll
    for (int o = 1; o < 64; o <<= 1) v += __shfl_xor(v, o);
    return v;
}

namespace pg8 {
constexpr int BM = 256, BK = 64, HALF = 128, HTB = HALF * BK * 2, STAGE_BYTES = 8 * HTB, NXCD = 8, WGM = 4;
__host__ __device__ __forceinline__ int lds_byte(int r, int c) { const int st = (r >> 4) * 2 + (c >> 5), rr = r & 15, cc = c & 31, ob = rr * 64 + cc * 2; return st * 1024 + (ob ^ (((ob >> 9) & 1) << 5)); }
__host__ __device__ __forceinline__ void stage_rc(int b, int& R, int& C) { const int st = b / 1024, sb = b % 1024, swz = sb ^ (((sb >> 9) & 1) << 5); R = (st >> 1) * 16 + swz / 64; C = (st & 1) * 32 + (swz % 64) / 2; }
__host__ __device__ __forceinline__ int perm32(int rho) { const int n = rho >> 4, i = rho & 15; return 8 * (i >> 2) + 4 * n + (i & 3); }

struct Unit { int pm, pn, slot; };
struct Gemm { const bf16_t* A; const bf16_t* Bt; int M, N, K, lda, ldb; };

struct StaticOrder {
    int nM, nN, nwg, G, c;
    __host__ __device__ void init(int M, int N, int G_, int c_) { nM = M / BM; nN = N / BM; nwg = nM * nN; G = G_; c = c_; }
    __host__ __device__ bool next(int i, Unit& u) const {
        const long L = (long)i * G + c; if (L >= nwg) return false;
        int wgid = (int)L; { const int q = nwg / NXCD, r = nwg % NXCD, xcd = wgid % NXCD, off = wgid / NXCD; wgid = (xcd < r ? xcd * (q + 1) : r * (q + 1) + (xcd - r) * q) + off; }
        const int nig = WGM * nN, gid = wgid / nig, fm = gid * WGM, gsz = (nM - fm) < WGM ? (nM - fm) : WGM;
        u.pm = fm + ((wgid % nig) % gsz); u.pn = (wgid % nig) / gsz; u.slot = i; return true;
    }
    __device__ __forceinline__ size_t a_off(const Unit&) const { return 0; }
    __device__ __forceinline__ size_t b_off(const Unit&) const { return 0; }
};
struct UpperHalfOrder : StaticOrder {
    __host__ __device__ bool next(int i, Unit& u) const { const int hw = G >> 1, per = nwg / hw; if (c < hw || i >= per) return false; const int L = (c - hw) * per + i; u.pm = L / nN; u.pn = L - u.pm * nN; u.slot = i; return true; }
};
struct CombOrder : StaticOrder {
    __device__ __forceinline__ size_t b_off(const Unit& u) const { return (size_t)(u.pm >> 2) * 2048; }
};

template <class Epi, class Sched, int EPI_REPS = 1>
__device__ __forceinline__ void gemm_phase(LAS unsigned char* lds, const Gemm g, const Sched& S, const Epi& E, const int wid) {
    int lane_ = lane_id(); asm volatile("" : "+v"(lane_));
    const int lane = lane_, tid = wid * 64 + lane, wr = wid >> 2, wc = wid & 3, fr = lane & 15, fq = lane >> 4;
    const int K = g.K, nt = K / BK;
    unsigned voffA[2], voffB[2];
#pragma unroll
    for (int i = 0; i < 2; ++i) { int R, C; stage_rc(tid * 16 + i * 8192, R, C); const int Rb = (R & ~31) + perm32(R & 31);
        voffA[i] = (unsigned)(R * g.lda + C) * 2u; voffB[i] = (unsigned)(Rb * g.ldb + C) * 2u; }
    const size_t kstep = (size_t)(BK * 2);
    const size_t hstepA = (size_t)HALF * g.lda * 2, hstepB = (size_t)HALF * g.ldb * 2;
    const size_t tstepA = 2 * hstepA, tstepB = 2 * hstepB;
    const unsigned ldsw = (unsigned)wid * 1024u;
    const int aoff = lds_byte(wr * 64 + fr, fq * 8), boff = lds_byte(wc * 32 + fr, fq * 8);
#define PG8_SA(b, h) (((b) * 2 + (h)) * HTB)
#define PG8_SB(b, h) ((4 + (b) * 2 + (h)) * HTB)
#define PG8_STAGE(bufoff, gbase, voff) do { _Pragma("unroll") for (int _i = 0; _i < 2; ++_i) \
        __builtin_amdgcn_global_load_lds((const unsigned*)((const char*)(gbase) + (voff)[_i]), (LAS unsigned*)(lds + (bufoff) + ldsw + _i * 8192), 16, 0, 0); } while (0)
#define PG8_LDA(dst, b, h) do { _Pragma("unroll") for (int m = 0; m < 4; ++m) _Pragma("unroll") for (int k = 0; k < 2; ++k) dst[m][k] = *(const LAS bf16x8*)(lds + PG8_SA(b, h) + aoff + m * 2048 + k * 1024); } while (0)
#define PG8_LDB(dst, b, h) do { _Pragma("unroll") for (int n = 0; n < 2; ++n) _Pragma("unroll") for (int k = 0; k < 2; ++k) dst[n][k] = *(const LAS bf16x8*)(lds + PG8_SB(b, h) + boff + n * 2048 + k * 1024); } while (0)
#define PG8_MMA(ai, bj, At, Bt) do { __builtin_amdgcn_s_setprio(1); _Pragma("unroll") for (int m = 0; m < 4; ++m) _Pragma("unroll") for (int n = 0; n < 2; ++n) _Pragma("unroll") for (int k = 0; k < 2; ++k) \
        acc[ai][bj][m][n] = __builtin_amdgcn_mfma_f32_16x16x32_bf16(Bt[n][k], At[m][k], acc[ai][bj][m][n], 0, 0, 0); __builtin_amdgcn_s_setprio(0); } while (0)
#define PG8_WAIT_V(n) asm volatile("s_waitcnt vmcnt(" #n ")" ::: "memory")
#define PG8_WAIT_L(n) asm volatile("s_waitcnt lgkmcnt(" #n ")" ::: "memory")
#define PG8_BAR __builtin_amdgcn_s_barrier()
#define PG8_SCHED __builtin_amdgcn_sched_barrier(0)
    Unit cur, nxt; int ui = 0;
    if (!S.next(0, cur)) return;
    f32x4 acc[2][2][4][2];
#pragma unroll
    for (int a = 0; a < 2; ++a)
#pragma unroll
        for (int b = 0; b < 2; ++b)
#pragma unroll
            for (int m = 0; m < 4; ++m)
#pragma unroll
                for (int n = 0; n < 2; ++n) acc[a][b][m][n] = (f32x4){0.f, 0.f, 0.f, 0.f};
    bf16x8 At[4][2], B0[2][2], B1[2][2];
    const char* cA = (const char*)g.A + (size_t)cur.pm * tstepA + S.a_off(cur); const char* cB = (const char*)g.Bt + (size_t)cur.pn * tstepB + S.b_off(cur);
    PG8_STAGE(PG8_SB(0, 0), cB, voffB); PG8_STAGE(PG8_SB(0, 1), cB + hstepB, voffB); PG8_STAGE(PG8_SA(0, 0), cA, voffA); PG8_STAGE(PG8_SA(0, 1), cA + hstepA, voffA);
    if (wr == 1) PG8_BAR;
    PG8_WAIT_V(2); PG8_BAR;
    PG8_STAGE(PG8_SB(1, 0), cB + kstep, voffB); PG8_STAGE(PG8_SA(1, 0), cA + kstep, voffA); PG8_STAGE(PG8_SB(1, 1), cB + hstepB + kstep, voffB);
    PG8_WAIT_V(6); PG8_BAR;
    for (;;) {
        const bool has_next = S.next(ui + 1, nxt);
        const char* nA = has_next ? (const char*)g.A + (size_t)nxt.pm * tstepA + S.a_off(nxt) : cA; const char* nB = has_next ? (const char*)g.Bt + (size_t)nxt.pn * tstepB + S.b_off(nxt) : cB;
        for (int t = 0; t < nt; t += 2) {
            const bool last = (t == nt - 2);
            const char* a1 = cA + (size_t)(t + 1) * kstep;
            const char* a2 = last ? nA : cA + (size_t)(t + 2) * kstep; const char* b2 = last ? nB : cB + (size_t)(t + 2) * kstep;
            const char* a3 = a2 + kstep; const char* b3 = b2 + kstep;
            PG8_LDB(B0, 0, 0); PG8_LDB(B1, 0, 1); PG8_SCHED; PG8_LDA(At, 0, 0); PG8_STAGE(PG8_SA(1, 1), a1 + hstepA, voffA);
            PG8_WAIT_V(8); PG8_WAIT_L(0); PG8_BAR; PG8_MMA(0, 0, At, B0); PG8_MMA(0, 1, At, B1); PG8_BAR; PG8_SCHED;
            PG8_LDA(At, 0, 1); PG8_STAGE(PG8_SB(0, 0), b2, voffB); PG8_STAGE(PG8_SB(0, 1), b2 + hstepB, voffB); PG8_STAGE(PG8_SA(0, 0), a2, voffA);
            PG8_WAIT_V(8); PG8_WAIT_L(0); PG8_BAR; PG8_MMA(1, 0, At, B0); PG8_MMA(1, 1, At, B1); PG8_BAR; PG8_SCHED;
            PG8_LDB(B0, 1, 0); PG8_LDB(B1, 1, 1); PG8_SCHED; PG8_LDA(At, 1, 0); PG8_STAGE(PG8_SA(0, 1), a2 + hstepA, voffA);
            PG8_WAIT_V(8); PG8_WAIT_L(0); PG8_BAR; PG8_MMA(0, 0, At, B0); PG8_MMA(0, 1, At, B1); PG8_BAR; PG8_SCHED;
            PG8_LDA(At, 1, 1); PG8_STAGE(PG8_SB(1, 0), b3, voffB); PG8_STAGE(PG8_SB(1, 1), b3 + hstepB, voffB); PG8_STAGE(PG8_SA(1, 0), a3, voffA);
            PG8_WAIT_V(8); PG8_WAIT_L(0); PG8_BAR; PG8_MMA(1, 0, At, B0); PG8_MMA(1, 1, At, B1); PG8_BAR; PG8_SCHED;
        }
        if (wr == 0) PG8_BAR;
        for (int er_ = 0; er_ < EPI_REPS; ++er_) { const int l2 = lane_id(); E(acc, cur, wr, wc, l2 & 15, l2 >> 4); }
        if (!has_next) break;
#pragma unroll
        for (int a = 0; a < 2; ++a)
#pragma unroll
            for (int b = 0; b < 2; ++b)
#pragma unroll
                for (int m = 0; m < 4; ++m)
#pragma unroll
                    for (int n = 0; n < 2; ++n) acc[a][b][m][n] = (f32x4){0.f, 0.f, 0.f, 0.f};
        cur = nxt; cA = nA; cB = nB; ++ui;
        if (wr == 1) PG8_BAR;
    }
    PG8_WAIT_V(0);
    PG8_BAR;
#undef PG8_SA
#undef PG8_SB
#undef PG8_STAGE
#undef PG8_LDA
#undef PG8_LDB
#undef PG8_MMA
#undef PG8_WAIT_V
#undef PG8_WAIT_L
#undef PG8_BAR
#undef PG8_SCHED
}
}
using pg8::Unit;

#define EPI_ARGS f32x4 (&acc)[2][2][4][2], const Unit& u, int wr, int wc, int fr, int fq
__device__ __forceinline__ u32x4 pack8(const f32x4 a, const f32x4 b) { u32x4 w; w.x = cvt_pk_bf16(a[0], a[1]); w.y = cvt_pk_bf16(a[2], a[3]); w.z = cvt_pk_bf16(b[0], b[1]); w.w = cvt_pk_bf16(b[2], b[3]); return w; }
__device__ __forceinline__ void unpack8(const u32x4 w, f32x4& a, f32x4& b) { a = (f32x4){bf_lo(w.x), bf_hi(w.x), bf_lo(w.y), bf_hi(w.y)}; b = (f32x4){bf_lo(w.z), bf_hi(w.z), bf_lo(w.w), bf_hi(w.w)}; }
__device__ __forceinline__ float row_rstd(const float* rp, int row) {
    const f32x4* q = (const f32x4*)(rp + (size_t)row * 32); f32x4 s = q[0];
#pragma unroll
    for (int i = 1; i < 8; ++i) s += q[i];
    return __builtin_amdgcn_rsqf(((s[0] + s[1]) + (s[2] + s[3])) * (1.0f / DM) + NORM_EPS);
}
constexpr int RSTD_OFF = RING_BYTES;
template <class Sched> __device__ __forceinline__ void rstd_table(LAS unsigned char* lds, const float* rp, const Sched& S, int tid) {
    LAS float* tab = (LAS float*)(lds + RSTD_OFF); Unit u;
    for (int i = 0; i < 8 && S.next(i, u); ++i) if (tid < 256) tab[i * 256 + tid] = row_rstd(rp, u.pm * 256 + tid);
    __syncthreads();
}
__device__ __forceinline__ float rstd_lds(const LAS unsigned char* lds, int slot, int r) { return ((const LAS float*)(lds + RSTD_OFF))[slot * 256 + r]; }

struct EpiRet1 {
    bf16_t *qd, *kd, *v, *sg; const float* rope; const float* l2g;
    __device__ __forceinline__ void operator()(EPI_ARGS) const {
        const int pn = u.pn, row0 = u.pm * 256 + wr * 64 + fr, c0 = wc * 32 + 8 * fq;
        if (pn < 16) {
            const int head = pn & 7; const bool isk = pn >= 8;
            bf16_t* out = (isk ? kd : qd) + head * 256; const float lg = l2g[head];
#pragma unroll
            for (int ai = 0; ai < 2; ++ai)
#pragma unroll
                for (int m = 0; m < 4; ++m) { const int row = row0 + ai * 128 + m * 16, r = row & 255;
                    const float dec = isk ? __builtin_amdgcn_exp2f(lg * (float)(255 - r)) * 0.0625f : __builtin_amdgcn_exp2f(lg * (float)(r - 255));
#pragma unroll
                    for (int bj = 0; bj < 2; ++bj) { const int c = c0 + bj * 128;
                        const f32x4* rp = (const f32x4*)(rope + ((size_t)row * 128 + (c >> 1)) * 2); const f32x4 t0 = rp[0], t1 = rp[1];
                        const f32x4 x = acc[ai][bj][m][0], y = acc[ai][bj][m][1]; f32x4 o0, o1;
                        o0[0] = (x[0] * t0[0] - x[1] * t0[1]) * dec; o0[1] = (x[1] * t0[0] + x[0] * t0[1]) * dec;
                        o0[2] = (x[2] * t0[2] - x[3] * t0[3]) * dec; o0[3] = (x[3] * t0[2] + x[2] * t0[3]) * dec;
                        o1[0] = (y[0] * t1[0] - y[1] * t1[1]) * dec; o1[1] = (y[1] * t1[0] + y[0] * t1[1]) * dec;
                        o1[2] = (y[2] * t1[2] - y[3] * t1[3]) * dec; o1[3] = (y[3] * t1[2] + y[2] * t1[3]) * dec;
                        *(u32x4*)(out + (size_t)row * DM + c) = pack8(o0, o1); } }
        } else if (pn < 32) {
            bf16_t* out = v + (pn - 16) * 256 + c0;
#pragma unroll
            for (int ai = 0; ai < 2; ++ai)
#pragma unroll
                for (int m = 0; m < 4; ++m) { const int row = row0 + ai * 128 + m * 16;
#pragma unroll
                    for (int bj = 0; bj < 2; ++bj) *(u32x4*)(out + (size_t)row * PW + bj * 128) = pack8(acc[ai][bj][m][0], acc[ai][bj][m][1]); }
        } else {
            bf16_t* out = sg + (pn - 32) * 256 + c0;
#pragma unroll
            for (int ai = 0; ai < 2; ++ai)
#pragma unroll
                for (int m = 0; m < 4; ++m) { const int row = row0 + ai * 128 + m * 16;
#pragma unroll
                    for (int bj = 0; bj < 2; ++bj) { f32x4 a = acc[ai][bj][m][0], b = acc[ai][bj][m][1];
#pragma unroll
                        for (int e = 0; e < 4; ++e) { a[e] = fsilu(a[e]); b[e] = fsilu(b[e]); }
                        *(u32x4*)(out + (size_t)row * PW + bj * 128) = pack8(a, b); } }
        }
    }
};
struct EpiPlain {
    bf16_t* O; int ldc;
    __device__ __forceinline__ void operator()(EPI_ARGS) const {
        bf16_t* out = O + (size_t)(u.pm * 256 + wr * 64 + fr) * ldc + u.pn * 256 + wc * 32 + 8 * fq;
#pragma unroll
        for (int ai = 0; ai < 2; ++ai)
#pragma unroll
            for (int m = 0; m < 4; ++m)
#pragma unroll
                for (int bj = 0; bj < 2; ++bj) *(u32x4*)(out + (size_t)(ai * 128 + m * 16) * ldc + bj * 128) = pack8(acc[ai][bj][m][0], acc[ai][bj][m][1]);
    }
};
template <bool RESF> struct EpiRes {
    const float* resf; const bf16_t* resb; bf16_t* aout; float* rpo;
    __device__ __forceinline__ void operator()(EPI_ARGS) const {
        const int row0 = u.pm * 256 + wr * 64 + fr, col0 = u.pn * 256 + wc * 32 + 8 * fq;
#pragma unroll
        for (int ai = 0; ai < 2; ++ai) {
            f32x4 rv[4][2][2];
#pragma unroll
            for (int m = 0; m < 4; ++m)
#pragma unroll
                for (int bj = 0; bj < 2; ++bj) { const size_t o = (size_t)(row0 + ai * 128 + m * 16) * DM + col0 + bj * 128;
                    if (RESF) { rv[m][bj][0] = __builtin_nontemporal_load((const f32x4*)(resf + o)); rv[m][bj][1] = __builtin_nontemporal_load((const f32x4*)(resf + o + 4)); }
                    else unpack8(*(const u32x4*)(resb + o), rv[m][bj][0], rv[m][bj][1]); }
#pragma unroll
            for (int m = 0; m < 4; ++m) { const int row = row0 + ai * 128 + m * 16; const size_t off = (size_t)row * DM + col0; float ss = 0.f;
#pragma unroll
                for (int bj = 0; bj < 2; ++bj) { const size_t o = off + bj * 128;
                    const f32x4 h0 = rv[m][bj][0] + acc[ai][bj][m][0], h1 = rv[m][bj][1] + acc[ai][bj][m][1];
                    ss += (h0[0] * h0[0] + h0[1] * h0[1]) + (h0[2] * h0[2] + h0[3] * h0[3]) + (h1[0] * h1[0] + h1[1] * h1[1]) + (h1[2] * h1[2] + h1[3] * h1[3]);
                    *(u32x4*)(aout + o) = pack8(h0, h1); }
                ss += __shfl_xor(ss, 16); ss += __shfl_xor(ss, 32);
                if (fq == 0) rpo[(size_t)row * 32 + u.pn * 4 + wc] = ss; }
            asm volatile("" ::: "memory"); }
    }
};
struct EpiPle {
    const bf16_t* hin; const bf16_t* pe; const LAS unsigned char* lds; bf16_t* aout; float* rpo;
    __device__ __forceinline__ void operator()(EPI_ARGS) const {
        const int row0 = u.pm * 256 + wr * 64 + fr, col0 = u.pn * 256 + wc * 32 + 8 * fq;
#pragma unroll
        for (int ai = 0; ai < 2; ++ai) {
            u32x4 hv[4][2], pv[4][2];
#pragma unroll
            for (int m = 0; m < 4; ++m)
#pragma unroll
                for (int bj = 0; bj < 2; ++bj) { const size_t o = (size_t)(row0 + ai * 128 + m * 16) * DM + col0 + bj * 128; hv[m][bj] = *(const u32x4*)(hin + o); pv[m][bj] = *(const u32x4*)(pe + o); }
#pragma unroll
            for (int m = 0; m < 4; ++m) { const int row = row0 + ai * 128 + m * 16; const size_t off = (size_t)row * DM + col0; float ss = 0.f;
                const float rstd = rstd_lds(lds, u.slot, row & 255);
#pragma unroll
                for (int bj = 0; bj < 2; ++bj) { const size_t o = off + bj * 128;
                    f32x4 h0, h1, p0, p1; unpack8(hv[m][bj], h0, h1); unpack8(pv[m][bj], p0, p1);
                    const f32x4 a0 = acc[ai][bj][m][0], a1 = acc[ai][bj][m][1];
#pragma unroll
                    for (int e = 0; e < 4; ++e) { h0[e] += fsigmoid(a0[e] * rstd) * p0[e]; h1[e] += fsigmoid(a1[e] * rstd) * p1[e]; }
                    ss += (h0[0] * h0[0] + h0[1] * h0[1]) + (h0[2] * h0[2] + h0[3] * h0[3]) + (h1[0] * h1[0] + h1[1] * h1[1]) + (h1[2] * h1[2] + h1[3] * h1[3]);
                    *(u32x4*)(aout + o) = pack8(h0, h1); }
                ss += __shfl_xor(ss, 16); ss += __shfl_xor(ss, 32);
                if (fq == 0) rpo[(size_t)row * 32 + u.pn * 4 + wc] = ss; }
            asm volatile("" ::: "memory"); }
    }
};
constexpr int FN_P_OFF = RING_BYTES + 8192, FN_S_OFF = FN_P_OFF + 4096;
constexpr int CW_FN_CNT = 16384, CW_FN_X = 32768;
struct EpiPleFinal {
    const bf16_t* hin; const bf16_t* pe; LAS unsigned char* lds; float* out; const float* gain; unsigned* ctl;
    __device__ __forceinline__ void operator()(EPI_ARGS) const {
        const int row0 = u.pm * 256 + wr * 64 + fr, col0 = u.pn * 256 + wc * 32 + 8 * fq;
        const int wid = wr * 4 + wc, tid = wid * 64 + fq * 16 + fr;
        LAS float* P = (LAS float*)(lds + FN_P_OFF); LAS float* S = (LAS float*)(lds + FN_S_OFF);
#pragma unroll
        for (int ai = 0; ai < 2; ++ai)
#pragma unroll
            for (int mp = 0; mp < 2; ++mp) {
                u32x4 hv[2][2], pv[2][2];
#pragma unroll
                for (int mm = 0; mm < 2; ++mm)
#pragma unroll
                    for (int bj = 0; bj < 2; ++bj) { const size_t o = (size_t)(row0 + ai * 128 + (2 * mp + mm) * 16) * DM + col0 + bj * 128;
                        hv[mm][bj] = *(const u32x4*)(hin + o); pv[mm][bj] = *(const u32x4*)(pe + o); }
#pragma unroll
                for (int mm = 0; mm < 2; ++mm) { const int m = 2 * mp + mm, row = row0 + ai * 128 + m * 16; float ss = 0.f;
                    const float rstd = rstd_lds(lds, u.slot, row & 255);
#pragma unroll
                    for (int bj = 0; bj < 2; ++bj) {
                        f32x4 h0, h1, p0, p1; unpack8(hv[mm][bj], h0, h1); unpack8(pv[mm][bj], p0, p1);
                        const f32x4 a0 = acc[ai][bj][m][0], a1 = acc[ai][bj][m][1];
#pragma unroll
                        for (int e = 0; e < 4; ++e) { h0[e] += fsigmoid(a0[e] * rstd) * p0[e]; h1[e] += fsigmoid(a1[e] * rstd) * p1[e]; }
                        acc[ai][bj][m][0] = h0; acc[ai][bj][m][1] = h1;
                        ss += (h0[0] * h0[0] + h0[1] * h0[1]) + (h0[2] * h0[2] + h0[3] * h0[3]) + (h1[0] * h1[0] + h1[1] * h1[1]) + (h1[2] * h1[2] + h1[3] * h1[3]); }
                    ss += __shfl_xor(ss, 16); ss += __shfl_xor(ss, 32);
                    if (fq == 0) P[(row & 255) * 4 + wc] = ss; }
                asm volatile("" ::: "memory"); }
        asm volatile("s_waitcnt lgkmcnt(0)" ::: "memory"); __builtin_amdgcn_s_barrier(); asm volatile("" ::: "memory");
        float* X = (float*)(ctl + CW_FN_X); unsigned* cnt = ctl + CW_FN_CNT + 64 * u.pm;
        if (tid < 256) { const float t = (P[tid * 4 + 0] + P[tid * 4 + 1]) + (P[tid * 4 + 2] + P[tid * 4 + 3]);
            __hip_atomic_store(X + ((size_t)(u.pm * 256 + tid) * 8 + u.pn), t, __ATOMIC_RELAXED, __HIP_MEMORY_SCOPE_AGENT);
            asm volatile("s_waitcnt vmcnt(0)" ::: "memory");
            if ((tid & 63) == 0) __hip_atomic_fetch_add(cnt, 1u, __ATOMIC_RELAXED, __HIP_MEMORY_SCOPE_AGENT); }
        if (wid == 0) {
            unsigned spins = 0;
            while ((unsigned)__builtin_amdgcn_readfirstlane(__hip_atomic_load(cnt, __ATOMIC_RELAXED, __HIP_MEMORY_SCOPE_AGENT)) < 32u) { __builtin_amdgcn_s_sleep(2); if (++spins > (1u << 22)) break; }
            __builtin_amdgcn_fence(__ATOMIC_ACQUIRE, "agent");
            asm volatile("s_waitcnt vmcnt(0)" ::: "memory"); }
        asm volatile("s_waitcnt vmcnt(0) lgkmcnt(0)" ::: "memory"); __builtin_amdgcn_s_barrier(); asm volatile("" ::: "memory");
        if (tid < 256) { const float* xs = X + (size_t)(u.pm * 256 + tid) * 8; float s = 0.f;
#pragma unroll
            for (int t = 0; t < 8; ++t) s += __hip_atomic_load(xs + t, __ATOMIC_RELAXED, __HIP_MEMORY_SCOPE_AGENT);
            S[tid] = __builtin_amdgcn_rsqf(s * (1.0f / DM) + NORM_EPS); }
        asm volatile("s_waitcnt lgkmcnt(0)" ::: "memory"); __builtin_amdgcn_s_barrier(); asm volatile("" ::: "memory");
        f32x4 gv[2][2];
#pragma unroll
        for (int bj = 0; bj < 2; ++bj) { gv[bj][0] = *(const f32x4*)(gain + col0 + bj * 128); gv[bj][1] = *(const f32x4*)(gain + col0 + bj * 128 + 4); }
#pragma unroll
        for (int ai = 0; ai < 2; ++ai)
#pragma unroll
            for (int m = 0; m < 4; ++m) { const int row = row0 + ai * 128 + m * 16; const float rs = S[row & 255]; const size_t off = (size_t)row * DM + col0;
#pragma unroll
                for (int bj = 0; bj < 2; ++bj) { *(f32x4*)(out + off + bj * 128) = acc[ai][bj][m][0] * rs * gv[bj][0]; *(f32x4*)(out + off + bj * 128 + 4) = acc[ai][bj][m][1] * rs * gv[bj][1]; } }
    }
};
struct EpiPoolIn {
    const LAS unsigned char* lds; bf16_t* uo; bf16_t* sgo;
    __device__ __forceinline__ void operator()(EPI_ARGS) const {
        const int row0 = u.pm * 256 + wr * 64 + fr; const bool isg = u.pn >= 16;
        bf16_t* out = (isg ? sgo : uo) + (u.pn & 15) * 256 + wc * 32 + 8 * fq;
#pragma unroll
        for (int ai = 0; ai < 2; ++ai)
#pragma unroll
            for (int m = 0; m < 4; ++m) { const int row = row0 + ai * 128 + m * 16; const float rstd = rstd_lds(lds, u.slot, row & 255);
#pragma unroll
                for (int bj = 0; bj < 2; ++bj) { f32x4 a = acc[ai][bj][m][0] * rstd, b = acc[ai][bj][m][1] * rstd;
                    if (isg) {
#pragma unroll
                        for (int e = 0; e < 4; ++e) { a[e] = fsilu(a[e]); b[e] = fsilu(b[e]); } }
                    *(u32x4*)(out + (size_t)row * PW + bj * 128) = pack8(a, b); } }
    }
};
struct EpiComb {
    bf16_t* O; int ldc; const float* scale;
    __device__ __forceinline__ void operator()(EPI_ARGS) const {
        const int row0 = u.pm * 256 + wr * 64 + fr;
        bf16_t* out = O + (size_t)row0 * ldc + u.pn * 256 + wc * 32 + 8 * fq;
#pragma unroll
        for (int ai = 0; ai < 2; ++ai)
#pragma unroll
            for (int m = 0; m < 4; ++m) { const float sc = scale[row0 + ai * 128 + m * 16];
#pragma unroll
                for (int bj = 0; bj < 2; ++bj) *(u32x4*)(out + (size_t)(ai * 128 + m * 16) * ldc + bj * 128) = pack8(acc[ai][bj][m][0] * sc, acc[ai][bj][m][1] * sc); }
    }
};

typedef GAS unsigned gu32;
#define RLX_AGENT __ATOMIC_RELAXED, __HIP_MEMORY_SCOPE_AGENT
#define XB_TMO      128
#define XB_XCNT(j)  (256  + 64 * (j))
#define XB_XSUB(j)  (1280 + 64 * (j))
#define XB_XGEN(j)  (2304 + 64 * (j))
#define XB_TOP      3328
#define XB_TOPGEN   3392
#define XCD_BAR_WORDS 3456
#define XB_SPIN_CAP (1u << 20)
__device__ __forceinline__ unsigned xb_ld(unsigned* p)              { return __hip_atomic_load(p, __ATOMIC_RELAXED, __HIP_MEMORY_SCOPE_AGENT); }
__device__ __forceinline__ unsigned xb_add(unsigned* p, unsigned v) { return __hip_atomic_fetch_add(p, v, __ATOMIC_RELAXED, __HIP_MEMORY_SCOPE_AGENT); }
__device__ __forceinline__ unsigned xb_xcc_id() { return (unsigned)__builtin_amdgcn_s_getreg((3 << 11) | 20) & 0xFu; }
#define XB_SPIN(cond, bar) do { unsigned _sp = 0; while (cond) { __builtin_amdgcn_s_sleep(1); \
    if ((++_sp & 255u) == 0u) { if (xb_ld(&(bar)[XB_TMO])) break; if (_sp > XB_SPIN_CAP) { atomicAdd(&(bar)[XB_TMO], 1u); break; } } } } while (0)
struct XcdBarrier { unsigned* bar; unsigned x; volatile LAS unsigned* st; };
__device__ __forceinline__ XcdBarrier xcd_barrier_post(unsigned* bar, volatile LAS unsigned* st, const int wave) {
    XcdBarrier b; b.bar = bar; b.x = xb_xcc_id(); b.st = st;
    if (wave == 0 && lane_id() == 0) (void)xb_add(&bar[XB_XCNT(b.x)], 1u);
    return b;
}
__device__ __forceinline__ void xcd_barrier_complete(unsigned* bar, unsigned x, unsigned& nloc, unsigned& nx) {
    const unsigned G = gridDim.x * gridDim.y * gridDim.z;
    unsigned sum, cnt, mine, sp = 0u;
    for (;;) {
        sum = 0u; cnt = 0u; mine = 0u;
#pragma unroll
        for (unsigned j = 0; j < 16; ++j) { const unsigned c = xb_ld(&bar[XB_XCNT(j)]); sum += c; cnt += (c > 0u) ? 1u : 0u; mine = (j == x) ? c : mine; }
        if (sum == G) break;
        __builtin_amdgcn_s_sleep(1);
        if ((++sp & 255u) == 0u) { if (xb_ld(&bar[XB_TMO])) break; if (sp > XB_SPIN_CAP) { atomicAdd(&bar[XB_TMO], 1u); break; } }
    }
    nloc = mine > 0u ? mine : 1u; nx = cnt > 0u ? cnt : 1u;
}
__device__ __forceinline__ void xcd_barrier(const XcdBarrier& b, const int wave) {
    asm volatile("s_waitcnt vmcnt(0)" ::: "memory");
    __syncthreads();
    if (wave == 0 && lane_id() == 0) {
        unsigned* bar = b.bar;
        __builtin_amdgcn_s_waitcnt(0);
        unsigned nloc = b.st[0], nx = b.st[1];
        if (nloc == 0u) { xcd_barrier_complete(bar, b.x, nloc, nx); b.st[0] = nloc; b.st[1] = nx; }
        const unsigned old = xb_add(&bar[XB_XSUB(b.x)], 1u);
        const unsigned gen = old / nloc;
        if (old + 1u == (gen + 1u) * nloc) {
            __builtin_amdgcn_fence(__ATOMIC_RELEASE, "agent");
            asm volatile("s_waitcnt vmcnt(0)" ::: "memory");
            const unsigned og = xb_add(&bar[XB_TOP], 1u);
            const unsigned tg = og / nx;
            if (og + 1u == (tg + 1u) * nx) xb_add(&bar[XB_TOPGEN], 1u);
            else XB_SPIN(xb_ld(&bar[XB_TOPGEN]) == tg, bar);
            __builtin_amdgcn_fence(__ATOMIC_ACQUIRE, "agent");
            xb_add(&bar[XB_XGEN(b.x)], 1u);
            asm volatile("s_waitcnt vmcnt(0)" ::: "memory");
        } else {
            XB_SPIN(xb_ld(&bar[XB_XGEN(b.x)]) == gen, bar);
            __builtin_amdgcn_fence(__ATOMIC_ACQUIRE, "agent");
            asm volatile("s_waitcnt vmcnt(0)" ::: "memory");
        }
    }
    __syncthreads();
}

__device__ __forceinline__ void tr_item(const float* W, int N, bf16_t* WT, int Kt, LAS float* scr, int item, int lane) {
    const int nblk = N >> 6, kb = item / nblk, nb = item - kb * nblk, k0 = kb << 6, n0 = nb << 6;
    const int c = lane & 15, rr = lane >> 4;
    f32x4 v[16];
#pragma unroll
    for (int i = 0; i < 16; ++i) v[i] = __builtin_nontemporal_load((const f32x4*)(W + (size_t)(k0 + 4 * i + rr) * N + n0 + 4 * c));
#pragma unroll
    for (int i = 0; i < 16; ++i) { LAS float* s = scr + (4 * i + rr) * 65 + 4 * c; s[0] = v[i][0]; s[1] = v[i][1]; s[2] = v[i][2]; s[3] = v[i][3]; }
    LDS_WAIT();
    const int kc = lane & 7;
#pragma unroll
    for (int jj = 0; jj < 8; ++jj) { const int n = (lane >> 3) + 8 * jj; const LAS float* s = scr + (8 * kc) * 65 + n;
        u32x4 o; o.x = cvt_pk_bf16(s[0], s[65]); o.y = cvt_pk_bf16(s[130], s[195]); o.z = cvt_pk_bf16(s[260], s[325]); o.w = cvt_pk_bf16(s[390], s[455]);
        *(u32x4*)(WT + (size_t)(n0 + n) * Kt + k0 + 8 * kc) = o; }
    LDS_WAIT();
}
__device__ __forceinline__ double sin2pi(double r) {
    r -= rint(r);
    if (r > 0.25) r = 0.5 - r; else if (r < -0.25) r = -0.5 - r;
    const double x = r * 6.283185307179586476925, x2 = x * x;
    double p = -1.0 / 1307674368000.0;
    p = p * x2 + 1.0 / 6227020800.0; p = p * x2 - 1.0 / 39916800.0; p = p * x2 + 1.0 / 362880.0; p = p * x2 - 1.0 / 5040.0;
    p = p * x2 + 1.0 / 120.0; p = p * x2 - 1.0 / 6.0; p = p * x2 + 1.0;
    return x * p;
}

struct Args { const float* in[14]; float* out; unsigned char* ws; float freq[128]; float l2g[8]; float g256[8]; int ph_lo, ph_hi; };

__device__ __forceinline__ void p_prologue(const Args& a, LAS unsigned char* lds, const int wave) {
    const int lane = lane_id(), tid = wave * 64 + lane;
    unsigned char* ws = a.ws;
    LAS float* scr = (LAS float*)(lds + wave * 16640);
    const int gw = blockIdx.x * 8 + wave, NGW = gridDim.x * 8;
    constexpr int I_RI = (DM / 64) * (RPROJ / 64);
    for (int it = gw; it < I_RI; it += NGW) tr_item(a.in[3], RPROJ, (bf16_t*)(ws + WS_WT_RI), DM, scr, it, lane);
    const float* x = a.in[0]; const float* gain = a.in[2]; bf16_t* xn = (bf16_t*)(ws + WS_XN0);
    for (int m = gw; m < SEQ; m += NGW) {
        const f32x4* xr = (const f32x4*)(x + (size_t)m * DM) + 2 * lane; f32x4 v[8]; float s = 0.f;
#pragma unroll
        for (int j = 0; j < 8; ++j) { v[j] = __builtin_nontemporal_load(xr + 128 * (j >> 1) + (j & 1)); s += (v[j][0] * v[j][0] + v[j][1] * v[j][1]) + (v[j][2] * v[j][2] + v[j][3] * v[j][3]); }
        const float rstd = __builtin_amdgcn_rsqf(wave_sum(s) * (1.0f / DM) + NORM_EPS);
        u32x4* o = (u32x4*)(xn + (size_t)m * DM) + lane;
#pragma unroll
        for (int j = 0; j < 4; ++j) { const f32x4 g0 = *((const f32x4*)gain + 2 * lane + 128 * j), g1 = *((const f32x4*)gain + 2 * lane + 128 * j + 1); o[64 * j] = pack8(v[2 * j] * rstd * g0, v[2 * j + 1] * rstd * g1); }
    }
    const int gt = blockIdx.x * 512 + tid, NGT = gridDim.x * 512;
    { const float* p = a.in[1]; bf16_t* pb = (bf16_t*)(ws + WS_PBF);
      for (int i = gt; i < 2 * SEQ * PLE / 8; i += NGT) { const f32x4 a0 = __builtin_nontemporal_load((const f32x4*)(p + (size_t)i * 8)), a1 = __builtin_nontemporal_load((const f32x4*)(p + (size_t)i * 8 + 4)); *(u32x4*)(pb + (size_t)i * 8) = pack8(a0, a1); } }
    { f32x4* rope = (f32x4*)(ws + WS_ROPE);
      for (int i = gt; i < SEQ * 64; i += NGT) { const int pos = i >> 6, fi = (i & 63) * 2; const float a0 = (float)pos * a.freq[fi], a1 = (float)pos * a.freq[fi + 1];
          const double r0 = (double)a0 * 0.15915494309189533577, r1 = (double)a1 * 0.15915494309189533577;
          rope[i] = (f32x4){(float)sin2pi(r0 + 0.25), (float)sin2pi(r0), (float)sin2pi(r1 + 0.25), (float)sin2pi(r1)}; } }
}
struct CvDesc { const float* src; bf16_t* dst; const float* kg; int N, Kt, plain; };
constexpr int CV_RO = (PW / 64) * (DM / 32), CV_G = (DM / 64) * (DM / 32), CV_P = (PLE / 64) * (DM / 32), CV_PIG = (DM / 64) * (PW / 32), CV_GR = (1024 / 64) * (1024 / 32), CV_WU = DM * PW / 2048;
constexpr int CV_ITEMS = CV_RO + 2 * CV_G + 2 * CV_P + CV_PIG + 4 * CV_GR + CV_RO + CV_WU;
__device__ __forceinline__ CvDesc cv_tr(const float* W, int N, int ncols, bf16_t* WT, int Kt, int r, const float* kg = nullptr) {
    const int nblk = ncols >> 5, kb = r / nblk, nb = r - kb * nblk; CvDesc d; d.src = W + (size_t)(kb * 64) * N + nb * 32; d.dst = WT + (size_t)(nb * 32) * Kt + kb * 64; d.kg = kg ? kg + kb * 64 : nullptr; d.N = N; d.Kt = Kt; d.plain = 0; return d; }
__device__ __forceinline__ CvDesc cv_decode(const Args& a, int r) {
    unsigned char* ws = a.ws;
    if (r < CV_RO) return cv_tr(a.in[4], DM, DM, (bf16_t*)(ws + WS_WT_RO), PW, r); r -= CV_RO;
    if (r < CV_G) return cv_tr(a.in[11], DM, DM, (bf16_t*)(ws + WS_WT_G0), DM, r, a.in[10]); r -= CV_G;
    if (r < CV_G) return cv_tr(a.in[11] + (size_t)DM * DM, DM, DM, (bf16_t*)(ws + WS_WT_G1), DM, r, a.in[10] + DM); r -= CV_G;
    if (r < CV_P) return cv_tr(a.in[12], DM, DM, (bf16_t*)(ws + WS_WT_P0), PLE, r); r -= CV_P;
    if (r < CV_P) return cv_tr(a.in[12] + (size_t)PLE * DM, DM, DM, (bf16_t*)(ws + WS_WT_P1), PLE, r); r -= CV_P;
    if (r < CV_PIG) return cv_tr(a.in[6] + PW, 2 * PW, PW, (bf16_t*)(ws + WS_WT_PI) + (size_t)PW * DM, DM, r, a.in[5]); r -= CV_PIG;
    if (r < 4 * CV_GR) { const int g = r / CV_GR; return cv_tr(a.in[7] + (size_t)g * 1024 * 1024, 1024, 1024, (bf16_t*)(ws + WS_WT_GR) + (size_t)g * 1024 * 1024, 1024, r - g * CV_GR); } r -= 4 * CV_GR;
    if (r < CV_RO) return cv_tr(a.in[9], DM, DM, (bf16_t*)(ws + WS_WT_PO), PW, r); r -= CV_RO;
    CvDesc d; const int row = r >> 1, c0 = (r & 1) * 2048; d.src = a.in[6] + (size_t)row * (2 * PW) + c0; d.dst = (bf16_t*)(ws + WS_WU) + (size_t)row * PW + c0; d.kg = a.in[5] + row; d.N = 0; d.Kt = 0; d.plain = 1; return d;
}
__device__ __forceinline__ void cv_load(const CvDesc& d, f32x4 (&cv)[8], int lane) {
    if (d.plain) {
#pragma unroll
        for (int j = 0; j < 4; ++j) { cv[2 * j] = __builtin_nontemporal_load((const f32x4*)(d.src + lane * 8 + 512 * j)); cv[2 * j + 1] = __builtin_nontemporal_load((const f32x4*)(d.src + lane * 8 + 512 * j + 4)); }
    } else {
#pragma unroll
        for (int i = 0; i < 8; ++i) cv[i] = __builtin_nontemporal_load((const f32x4*)(d.src + (size_t)(8 * i + (lane >> 3)) * d.N + 4 * (lane & 7)));
    }
}
__device__ __forceinline__ void cv_store(const CvDesc& d, const f32x4 (&cv)[8], LAS float* scr, int lane) {
    if (d.plain) {
        const float kgv = d.kg[0];
#pragma unroll
        for (int j = 0; j < 4; ++j) *(u32x4*)(d.dst + lane * 8 + 512 * j) = pack8(cv[2 * j] * kgv, cv[2 * j + 1] * kgv);
    } else {
#pragma unroll
        for (int i = 0; i < 8; ++i) { const float kgv = d.kg ? d.kg[8 * i + (lane >> 3)] : 1.0f; LAS float* s = scr + (8 * i + (lane >> 3)) * 33 + 4 * (lane & 7); s[0] = cv[i][0] * kgv; s[1] = cv[i][1] * kgv; s[2] = cv[i][2] * kgv; s[3] = cv[i][3] * kgv; }
        LDS_WAIT();
        const int kc = lane & 7;
#pragma unroll
        for (int j = 0; j < 4; ++j) { const int n = (lane >> 3) + 8 * j; const LAS float* s = scr + (8 * kc) * 33 + n;
            u32x4 o; o.x = cvt_pk_bf16(s[0], s[33]); o.y = cvt_pk_bf16(s[66], s[99]); o.z = cvt_pk_bf16(s[132], s[165]); o.w = cvt_pk_bf16(s[198], s[231]);
            *(u32x4*)(d.dst + (size_t)n * d.Kt + 8 * kc) = o; }
        LDS_WAIT();
    }
}

__device__ __forceinline__ void tr_item_g(const float* W, int N, int ncols, bf16_t* WT, int Kt, LAS float* scr, int item, int lane, const float* kg) {
    const int nblk = ncols >> 6, kb = item / nblk, nb = item - kb * nblk, k0 = kb << 6, n0 = nb << 6;
    const int c = lane & 15, rr = lane >> 4;
    f32x4 v[16];
#pragma unroll
    for (int i = 0; i < 16; ++i) v[i] = __builtin_nontemporal_load((const f32x4*)(W + (size_t)(k0 + 4 * i + rr) * N + n0 + 4 * c));
#pragma unroll
    for (int i = 0; i < 16; ++i) { const float g = kg ? kg[k0 + 4 * i + rr] : 1.0f; LAS float* s = scr + (4 * i + rr) * 65 + 4 * c; s[0] = v[i][0] * g; s[1] = v[i][1] * g; s[2] = v[i][2] * g; s[3] = v[i][3] * g; }
    LDS_WAIT();
    const int kc = lane & 7;
#pragma unroll
    for (int jj = 0; jj < 8; ++jj) { const int n = (lane >> 3) + 8 * jj; const LAS float* s = scr + (8 * kc) * 65 + n;
        u32x4 o; o.x = cvt_pk_bf16(s[0], s[65]); o.y = cvt_pk_bf16(s[130], s[195]); o.z = cvt_pk_bf16(s[260], s[325]); o.w = cvt_pk_bf16(s[390], s[455]);
        *(u32x4*)(WT + (size_t)(n0 + n) * Kt + k0 + 8 * kc) = o; }
    LDS_WAIT();
}
__device__ __forceinline__ void p_weights_big(const Args& a, LAS unsigned char* lds, const int wave) {
    const int lane = lane_id();
    unsigned char* ws = a.ws;
    LAS float* scr = (LAS float*)(lds + wave * 16640);
    const int gw = (blockIdx.x - 128) * 8 + wave, NGW = (gridDim.x - 128) * 8;
    constexpr int I_RO = (PW / 64) * (DM / 64), I_G = (DM / 64) * (DM / 64), I_P = (PLE / 64) * (DM / 64), I_PIG = (DM / 64) * (PW / 64), I_GR = (1024 / 64) * (1024 / 64), I_WU = DM * PW / 2048;
    for (int it = gw; it < I_RO + 2 * I_G + 2 * I_P + I_PIG + 4 * I_GR + I_RO + I_WU; it += NGW) {
        int r = it;
        if (r < I_RO) { tr_item_g(a.in[4], DM, DM, (bf16_t*)(ws + WS_WT_RO), PW, scr, r, lane, nullptr); continue; } r -= I_RO;
        if (r < I_G) { tr_item_g(a.in[11], DM, DM, (bf16_t*)(ws + WS_WT_G0), DM, scr, r, lane, a.in[10]); continue; } r -= I_G;
        if (r < I_G) { tr_item_g(a.in[11] + (size_t)DM * DM, DM, DM, (bf16_t*)(ws + WS_WT_G1), DM, scr, r, lane, a.in[10] + DM); continue; } r -= I_G;
        if (r < I_P) { tr_item_g(a.in[12], DM, DM, (bf16_t*)(ws + WS_WT_P0), PLE, scr, r, lane, nullptr); continue; } r -= I_P;
        if (r < I_P) { tr_item_g(a.in[12] + (size_t)PLE * DM, DM, DM, (bf16_t*)(ws + WS_WT_P1), PLE, scr, r, lane, nullptr); continue; } r -= I_P;
        if (r < I_PIG) { tr_item_g(a.in[6] + PW, 2 * PW, PW, (bf16_t*)(ws + WS_WT_PI) + (size_t)PW * DM, DM, scr, r, lane, a.in[5]); continue; } r -= I_PIG;
        if (r < 4 * I_GR) { const int g = r / I_GR; tr_item_g(a.in[7] + (size_t)g * 1024 * 1024, 1024, 1024, (bf16_t*)(ws + WS_WT_GR) + (size_t)g * 1024 * 1024, 1024, scr, r - g * I_GR, lane, nullptr); continue; } r -= 4 * I_GR;
        if (r < I_RO) { tr_item_g(a.in[9], DM, DM, (bf16_t*)(ws + WS_WT_PO), PW, scr, r, lane, nullptr); continue; } r -= I_RO;
        { const int row = r >> 1, c0 = (r & 1) * 2048 + lane * 8; const float* srcp = a.in[6] + (size_t)row * (2 * PW) + c0; bf16_t* dstp = (bf16_t*)(ws + WS_WU) + (size_t)row * PW + c0; const float g = a.in[5][row];
#pragma unroll
            for (int j = 0; j < 4; ++j) { const f32x4 x0 = __builtin_nontemporal_load((const f32x4*)(srcp + 512 * j)), x1 = __builtin_nontemporal_load((const f32x4*)(srcp + 512 * j + 4)); *(u32x4*)(dstp + 512 * j) = pack8(x0 * g, x1 * g); } }
    }
}

__device__ __forceinline__ bf16x8 tr_frag(const LAS unsigned char* p, int pitch16) {
    const s16x4 lo = __builtin_amdgcn_ds_read_tr16_b64_v4i16((LAS s16x4*)p), hi = __builtin_amdgcn_ds_read_tr16_b64_v4i16((LAS s16x4*)(p + pitch16));
    return (bf16x8){lo[0], lo[1], lo[2], lo[3], hi[0], hi[1], hi[2], hi[3]};
}

__device__ __forceinline__ void p_scan(const Args& a, LAS unsigned char* lds, const int w) {
    const int lane = lane_id();
    const int tid = w * 64 + lane, b = blockIdx.x, h = b & 7, tt = b >> 3, dt = tt >> 2, vt = tt & 3;
    const int db = w >> 1, vbp = w & 1, g = lane >> 4, i16 = lane & 15, q4 = i16 >> 2, p4 = i16 & 3;
    const float g256 = a.g256[h];
    constexpr int PK = 160, PV = 288, TK = 128 * PK, TV = 128 * PV, BUF = TK + TV;
    const bf16_t* kbase = (const bf16_t*)(a.ws + WS_KD) + h * 256 + dt * 64;
    const bf16_t* vbase = (const bf16_t*)(a.ws + WS_V) + h * 512 + vt * 128;
    bf16_t* st = (bf16_t*)(a.ws + WS_ST);
    u32x4 rk0[2], rv0[4], rk1[2], rv1[4], rk2[2], rv2[4], rk3[2], rv3[4];
#define P2_LOAD(RK, RV, hs) do { const int _hs = (hs) < 62 ? (hs) : 61; \
        _Pragma("unroll") for (int _i = 0; _i < 2; ++_i) { const int _p = tid + 512 * _i; RK[_i] = *(const u32x4*)(kbase + (size_t)(_hs * 128 + (_p >> 3)) * DM + (_p & 7) * 8); } \
        _Pragma("unroll") for (int _i = 0; _i < 4; ++_i) { const int _p = tid + 512 * _i; RV[_i] = *(const u32x4*)(vbase + (size_t)(_hs * 128 + (_p >> 4)) * PW + (_p & 15) * 8); } } while (0)
#define P2_STORE(RK, RV, s) do { \
        _Pragma("unroll") for (int _i = 0; _i < 2; ++_i) { const int _p = tid + 512 * _i; *(LAS u32x4*)(lds + (s) * BUF + (_p >> 3) * PK + (_p & 7) * 16) = RK[_i]; } \
        _Pragma("unroll") for (int _i = 0; _i < 4; ++_i) { const int _p = tid + 512 * _i; *(LAS u32x4*)(lds + (s) * BUF + TK + (_p >> 4) * PV + (_p & 15) * 16) = RV[_i]; } } while (0)
    f32x4 acc[4];
#pragma unroll
    for (int j = 0; j < 4; ++j) acc[j] = (f32x4){0.f, 0.f, 0.f, 0.f};
    const int lk = (4 * g + q4) * PK + 8 * p4 + db * 32, lv = (4 * g + q4) * PV + 16 * p4 + vbp * 128;
#define P2_STEP(hs, RKN, RVN) do { const int _h = (hs); if (_h < 62) { \
        const LAS unsigned char* kt = lds + (_h & 1) * BUF + lk; const LAS unsigned char* vtp = lds + (_h & 1) * BUF + TK + lv; \
        _Pragma("unroll") for (int ks = 0; ks < 4; ++ks) { \
            const bf16x8 kf = tr_frag(kt + ks * 32 * PK, 16 * PK); \
            _Pragma("unroll") for (int j = 0; j < 4; ++j) { const bf16x8 vf = tr_frag(vtp + ks * 32 * PV + 64 * (j >> 1) + 8 * (j & 1), 16 * PV); acc[j] = __builtin_amdgcn_mfma_f32_16x16x32_bf16(vf, kf, acc[j], 0, 0, 0); } } \
        if (_h & 1) { const int n = _h >> 1; \
            bf16_t* o = st + ((size_t)(n * 8 + h) * 256 + dt * 64 + db * 16 + i16) * 512 + vt * 128 + vbp * 64 + 8 * g; \
            _Pragma("unroll") for (int j = 0; j < 4; ++j) acc[j] *= g256; \
            _Pragma("unroll") for (int k = 0; k < 2; ++k) *(u32x4*)(o + 32 * k) = pack8(acc[2 * k], acc[2 * k + 1]); } \
        if (_h + 1 < 62) { P2_STORE(RKN, RVN, (_h + 1) & 1); P2_LOAD(RKN, RVN, _h + 5); } \
        __syncthreads(); } } while (0)
    P2_LOAD(rk0, rv0, 0); P2_LOAD(rk1, rv1, 1); P2_LOAD(rk2, rv2, 2); P2_LOAD(rk3, rv3, 3);
    P2_STORE(rk0, rv0, 0); P2_LOAD(rk0, rv0, 4); __syncthreads();
    for (int hs = 0; hs < 62; hs += 4) {
        P2_STEP(hs, rk1, rv1); P2_STEP(hs + 1, rk2, rv2); P2_STEP(hs + 2, rk3, rv3); P2_STEP(hs + 3, rk0, rv0);
    }
#undef P2_STEP
#undef P2_LOAD
#undef P2_STORE
}

__device__ __forceinline__ void p_retention(const Args& a, LAS unsigned char* lds, const int w) {
    const int lane = lane_id();
    const int tid = w * 64 + lane, b = blockIdx.x;
    const int g = lane >> 4, i16 = lane & 15, q4 = i16 >> 2, p4 = i16 & 3;
    constexpr int PP = 528, RINGO = 128 * PP, RB = 33792, ST1 = RINGO + 2 * RB, ST2 = ST1 + 8192;
    const bf16_t* qd = (const bf16_t*)(a.ws + WS_QD); const bf16_t* kd = (const bf16_t*)(a.ws + WS_KD); const bf16_t* v = (const bf16_t*)(a.ws + WS_V);
    const bf16_t* sg = (const bf16_t*)(a.ws + WS_SG); const bf16_t* st = (const bf16_t*)(a.ws + WS_ST); bf16_t* z = (bf16_t*)(a.ws + WS_Z);
    const unsigned offk = (unsigned)(((tid >> 5) * DM + (tid & 31) * 8) * 2), offv = (unsigned)(((tid >> 6) * PW + (tid & 63) * 8) * 2), offt = (unsigned)(((tid >> 6) * 512 + (tid & 63) * 8) * 2);
    const int xs = b & 7, kq = b >> 3, pair = kq >> 1, member = kq & 1;
    for (int rnd = 0; rnd < 2; ++rnd) {
        const int nh = (pair * 2 + rnd) * 8 + xs, n = nh >> 3, h = nh & 7, hf = member ^ rnd;
        const int nsb = 2 * (hf + 1), nvb = 4 * (hf + 1), ntb = n > 0 ? 8 : 0, nblk = nsb + nvb + ntb;
        const int rowbase = 256 * n + 128 * hf;
        u32x4 ra[4], rb[4];
#define P3_LOAD(R, it) do { const int _it = (it) < nblk ? (it) : nblk - 1; \
        if (_it < ntb) { const char* _b = (const char*)(st + ((size_t)((n - 1) * 8 + h) * 256 + 32 * _it) * 512); unsigned _o = offt; asm volatile("" : "+v"(_o)); \
            _Pragma("unroll") for (int _i = 0; _i < 4; ++_i) R[_i] = *(const u32x4*)(_b + (size_t)_i * (8 * 512 * 2) + _o); } \
        else if (_it < ntb + nsb) { const char* _b = (const char*)(kd + (size_t)(256 * n + 64 * (_it - ntb)) * DM + h * 256); unsigned _o = offk; asm volatile("" : "+v"(_o)); \
            _Pragma("unroll") for (int _i = 0; _i < 4; ++_i) R[_i] = *(const u32x4*)(_b + (size_t)_i * (16 * DM * 2) + _o); } \
        else { const char* _b = (const char*)(v + (size_t)(256 * n + 32 * (_it - ntb - nsb)) * PW + h * 512); unsigned _o = offv; asm volatile("" : "+v"(_o)); \
            _Pragma("unroll") for (int _i = 0; _i < 4; ++_i) R[_i] = *(const u32x4*)(_b + (size_t)_i * (8 * PW * 2) + _o); } } while (0)
#define P3_STORE(R, it) do { const int _it = (it); if (_it < nblk) { LAS unsigned char* _d = lds + RINGO + (_it & 1) * RB; \
        if (_it >= ntb && _it < ntb + nsb) { _Pragma("unroll") for (int _i = 0; _i < 4; ++_i) { const int _p = tid + 512 * _i; *(LAS u32x4*)(_d + (_p >> 5) * 528 + (_p & 31) * 16) = R[_i]; } } \
        else { _Pragma("unroll") for (int _i = 0; _i < 4; ++_i) { const int _p = tid + 512 * _i; *(LAS u32x4*)(_d + (_p >> 6) * 1056 + (_p & 63) * 16) = R[_i]; } } } } while (0)
        P3_LOAD(ra, 0); P3_LOAD(rb, 1);
        if (ntb) {
#pragma unroll 2
            for (int i = 0; i < 8; ++i) { const int p = tid + 512 * i, row = p >> 5, c = p & 31, G = c >> 2, cc = c & 3;
                const u32x4 x = *(const u32x4*)(qd + (size_t)(rowbase + row) * DM + h * 256 + c * 8);
                const int s = cc >> 1, glo = (2 * cc) & 3, ghi = (2 * cc + 1) & 3;
                LAS unsigned char* d = lds + row * PP + 64 * G;
                *(LAS u32x2*)(d + 8 * (2 * glo + s)) = (u32x2){x.x, x.y}; *(LAS u32x2*)(d + 8 * (2 * ghi + s)) = (u32x2){x.z, x.w}; }
        }
        P3_STORE(ra, 0); P3_LOAD(ra, 2); __syncthreads();
        f32x4 acc[8][4];
#pragma unroll
        for (int rbk = 0; rbk < 8; ++rbk)
#pragma unroll
            for (int cb = 0; cb < 4; ++cb) acc[rbk][cb] = (f32x4){0.f, 0.f, 0.f, 0.f};
#define P3_YSTEP(it_, RN, ISV) do { const int it = (it_); \
            const LAS unsigned char* ring = lds + RINGO + (it & 1) * RB; \
            { const int kk = (ISV) ? it - ntb - nsb : it; \
                bf16x8 vf[4]; \
                _Pragma("unroll") for (int cb = 0; cb < 4; ++cb) vf[cb] = tr_frag(ring + (4 * g + q4) * 1056 + (64 * w + 32 * (cb >> 1) + 8 * p4 + 4 * (cb & 1)) * 2, 16 * 1056);   \
                _Pragma("unroll") for (int rbk = 0; rbk < 8; ++rbk) { \
                    if ((ISV) && 32 * kk > 128 * hf + 16 * rbk + 15) continue; \
                    const bf16x8 pf = *(const LAS bf16x8*)(lds + (16 * rbk + i16) * PP + (32 * kk + 8 * g) * 2); \
                    _Pragma("unroll") for (int cb = 0; cb < 4; ++cb) acc[rbk][cb] = __builtin_amdgcn_mfma_f32_16x16x32_bf16(vf[cb], pf, acc[rbk][cb], 0, 0, 0); \
                } } \
            P3_STORE(RN, it + 1); P3_LOAD(RN, it + 3); \
            __syncthreads(); } while (0)
        for (int it2 = 0; it2 < ntb; it2 += 2) { P3_YSTEP(it2, rb, false); P3_YSTEP(it2 + 1, ra, false); }
        {
            bf16x8 qf[8];
#pragma unroll
            for (int ds = 0; ds < 8; ++ds) qf[ds] = *(const bf16x8*)(qd + (size_t)(rowbase + 16 * w + i16) * DM + h * 256 + 32 * ds + 8 * g);
#define P3_SSTEP(it_, RN) do { const int it = (it_), sbk = it - ntb; \
                const LAS unsigned char* ring = lds + RINGO + (it & 1) * RB; \
                _Pragma("unroll") for (int sb = 0; sb < 4; ++sb) { \
                    const int j0 = 64 * sbk + 16 * sb, i0 = 128 * hf + 16 * w; \
                    LAS unsigned char* dst = lds + (16 * w + i16) * PP + (32 * (2 * sbk + (sb >> 1)) + 8 * g + 4 * (sb & 1)) * 2; \
                    if (j0 > i0) { *(LAS u32x2*)dst = (u32x2){0u, 0u}; } \
                    else { \
                        f32x4 s4 = {0.f, 0.f, 0.f, 0.f}; \
                        _Pragma("unroll") for (int ds = 0; ds < 8; ++ds) { const bf16x8 kf = *(const LAS bf16x8*)(ring + (16 * sb + i16) * 528 + (32 * ds + 8 * g) * 2); \
                            s4 = __builtin_amdgcn_mfma_f32_16x16x32_bf16(kf, qf[ds], s4, 0, 0, 0); } \
                        if (j0 == i0) { _Pragma("unroll") for (int r = 0; r < 4; ++r) if (4 * g + r > i16) s4[r] = 0.f; } \
                        u32x2 wv; wv.x = cvt_pk_bf16(s4[0], s4[1]); wv.y = cvt_pk_bf16(s4[2], s4[3]); *(LAS u32x2*)dst = wv; \
                    } \
                } \
                P3_STORE(RN, it + 1); P3_LOAD(RN, it + 3); \
                __syncthreads(); } while (0)
            for (int it2 = ntb; it2 < ntb + nsb; it2 += 2) { P3_SSTEP(it2, rb); P3_SSTEP(it2 + 1, ra); }
#undef P3_SSTEP
        }
        for (int it2 = ntb + nsb; it2 < nblk; it2 += 2) { P3_YSTEP(it2, rb, true); P3_YSTEP(it2 + 1, ra, true); }
#undef P3_YSTEP
#undef P3_LOAD
#undef P3_STORE
        LAS f32x2* S1 = (LAS f32x2*)(lds + ST1); LAS f32x2* S2 = (LAS f32x2*)(lds + ST2);
#pragma unroll
        for (int rbk = 0; rbk < 8; ++rbk) { float s1 = 0.f, s2 = 0.f;
#pragma unroll
            for (int cb = 0; cb < 4; ++cb) { const f32x4 y = acc[rbk][cb]; s1 += (y[0] + y[1]) + (y[2] + y[3]); s2 += (y[0] * y[0] + y[1] * y[1]) + (y[2] * y[2] + y[3] * y[3]); }
            s1 += __shfl_xor(s1, 16); s1 += __shfl_xor(s1, 32); s2 += __shfl_xor(s2, 16); s2 += __shfl_xor(s2, 32);
            if (g == 0) S1[(16 * rbk + i16) * 8 + w] = (f32x2){s1, s2}; }
        __syncthreads();
        if (tid < 128) { float s1 = 0.f, s2 = 0.f;
#pragma unroll
            for (int k = 0; k < 8; ++k) { const f32x2 t = S1[tid * 8 + k]; s1 += t.x; s2 += t.y; }
            const float mean = s1 * (1.0f / 512.0f), var = s2 * (1.0f / 512.0f) - mean * mean;
            S2[tid] = (f32x2){mean, __builtin_amdgcn_rsqf(fmaxf(var, 0.f) + GN_EPS)}; }
        __syncthreads();
#pragma unroll
        for (int rbk = 0; rbk < 8; ++rbk) { const f32x2 ms = S2[16 * rbk + i16];
            const size_t off = (size_t)(rowbase + 16 * rbk + i16) * PW + h * 512 + 64 * w + 8 * g;
#pragma unroll
            for (int k = 0; k < 2; ++k) { const u32x4 gw = __builtin_nontemporal_load((const u32x4*)(sg + off + 32 * k)); f32x4 g0, g1; unpack8(gw, g0, g1);
                const f32x4 y0 = (acc[rbk][2 * k] - ms.x) * ms.y * g0, y1 = (acc[rbk][2 * k + 1] - ms.x) * ms.y * g1;
                *(u32x4*)(z + off + 32 * k) = pack8(y0, y1); } }
        __syncthreads();
    }
}

__device__ __forceinline__ void p_pool(const Args& a, const int wave) {
    const int tid = wave * 64 + lane_id();
    const bf16_t* u = (const bf16_t*)(a.ws + WS_U); const bf16_t* sg = (const bf16_t*)(a.ws + WS_SG1); bf16_t* d = (bf16_t*)(a.ws + WS_ZZ);
    for (int task = blockIdx.x * 512 + tid; task < 512 * 256; task += gridDim.x * 512) {
        const int chunk = task & 511, run = task >> 9, w = 2 << (chunk >> 7), t0 = run * 32;
        const bf16_t* uc = u + chunk * 8; const bf16_t* gc = sg + chunk * 8; bf16_t* dc = d + chunk * 8;
        f32x4 s0 = {0.f, 0.f, 0.f, 0.f}, s1 = {0.f, 0.f, 0.f, 0.f};
        for (int t = (t0 - w > 0 ? t0 - w : 0); t < t0; ++t) { f32x4 x0, x1; unpack8(*(const u32x4*)(uc + (size_t)t * PW), x0, x1); s0 += x0; s1 += x1; }
        for (int t = t0; t < t0 + 32; ++t) {
            f32x4 x0, x1, g0, g1; unpack8(*(const u32x4*)(uc + (size_t)t * PW), x0, x1); unpack8(*(const u32x4*)(gc + (size_t)t * PW), g0, g1); s0 += x0; s1 += x1;
            if (t - w >= 0) { f32x4 y0, y1; unpack8(*(const u32x4*)(uc + (size_t)(t - w) * PW), y0, y1); s0 -= y0; s1 -= y1; }
            const float inv = 1.0f / (float)(t + 1 < w ? t + 1 : w);
            *(u32x4*)(dc + (size_t)t * PW) = pack8((s0 * inv - x0) * g0, (s1 * inv - x1) * g1);
        }
    }
}
__device__ __forceinline__ void p_final(const Args& a, const int wave) {
    const int lane = lane_id();
    const float* rp = (const float*)(a.ws + WS_RP + 3 * MiB); const float* gain = a.in[13]; float* out = a.out;
    for (int m = blockIdx.x * 8 + wave; m < SEQ; m += gridDim.x * 8) {
        const float part = lane < 32 ? rp[(size_t)m * 32 + lane] : 0.f;
        const float rstd = __builtin_amdgcn_rsqf(wave_sum(part) * (1.0f / DM) + NORM_EPS);
        f32x4* o = (f32x4*)(out + (size_t)m * DM) + lane;
#pragma unroll
        for (int j = 0; j < 8; ++j) { const f32x4 g = *((const f32x4*)gain + lane + 64 * j); o[64 * j] = o[64 * j] * rstd * g; }
    }
}

__global__ void __launch_bounds__(512, 2) trunk_fwd(Args args) {
    extern __shared__ __attribute__((aligned(16))) unsigned char lds_raw[];
    LAS unsigned char* lds = (LAS unsigned char*)lds_raw;
    const int wave = __builtin_amdgcn_readfirstlane(threadIdx.x >> 6);
    unsigned char* ws = args.ws;
    volatile LAS unsigned* MISC = (volatile LAS unsigned*)(lds + MISC_OFF);
    if (threadIdx.x < 64) MISC[threadIdx.x] = 0u;
    __syncthreads();
    XcdBarrier bar; bar.bar = (unsigned*)(ws + WS_CTL) + 4096; bar.x = 0; bar.st = nullptr;
    const int lo = args.ph_lo, hi = args.ph_hi;
    if (hi - lo > 1) bar = xcd_barrier_post((unsigned*)(ws + WS_CTL) + 4096, MISC + 8, wave);
#ifndef PH_MASK
#define PH_MASK 0x3FF
#endif
#define IN(k) (((PH_MASK >> (k)) & 1) && lo <= (k) && (k) < hi)
#define SEAM(k) do { if (IN(k) && IN((k) + 1)) xcd_barrier(bar, wave); } while (0)
#ifndef DUP_MASK
#define DUP_MASK 0
#endif
#define NDUP(k) (((DUP_MASK >> (k)) & 1) ? 2 : 1)
    const int G = gridDim.x, c = blockIdx.x;
    float* rp0 = (float*)(ws + WS_RP); float* rp1 = rp0 + SEQ * 32; float* rp2 = rp1 + SEQ * 32; float* rp3 = rp2 + SEQ * 32;

    if (IN(0)) for (int rep_ = 0; rep_ < NDUP(0); ++rep_) { if (rep_) xcd_barrier(bar, wave); p_prologue(args, lds, wave); VM_WAIT(); __syncthreads(); }
    SEAM(0);
    if (IN(1)) for (int rep_ = 0; rep_ < NDUP(1); ++rep_) { if (rep_) xcd_barrier(bar, wave);
        pg8::Gemm g{(const bf16_t*)(ws + WS_XN0), (const bf16_t*)(ws + WS_WT_RI), SEQ, RPROJ, DM, DM, DM}; pg8::StaticOrder S; S.init(SEQ, RPROJ, G, c);
        EpiRet1 E{(bf16_t*)(ws + WS_QD), (bf16_t*)(ws + WS_KD), (bf16_t*)(ws + WS_V), (bf16_t*)(ws + WS_SG), (const float*)(ws + WS_ROPE), args.l2g};
        pg8::gemm_phase(lds, g, S, E, wave);
    }
    SEAM(1);
    if (IN(2)) for (int rep_ = 0; rep_ < NDUP(2); ++rep_) { if (rep_) xcd_barrier(bar, wave); if (c < 128) p_scan(args, lds, wave); else p_weights_big(args, lds, wave);
        VM_WAIT(); __syncthreads(); }
    SEAM(2);
    if (IN(3)) for (int rep_ = 0; rep_ < NDUP(3); ++rep_) { if (rep_) xcd_barrier(bar, wave); p_retention(args, lds, wave); }
    SEAM(3);
    if (IN(4)) for (int rep_ = 0; rep_ < NDUP(4); ++rep_) { if (rep_) xcd_barrier(bar, wave);
        { pg8::Gemm g{(const bf16_t*)(ws + WS_Z), (const bf16_t*)(ws + WS_WT_RO), SEQ, DM, PW, PW, PW}; pg8::StaticOrder S; S.init(SEQ, DM, G, c);
          EpiRes<true> E{args.in[0], nullptr, (bf16_t*)(ws + WS_A1), rp0};
          pg8::gemm_phase(lds, g, S, E, wave); }
        { pg8::Gemm g{(const bf16_t*)(ws + WS_PBF), (const bf16_t*)(ws + WS_WT_P0), SEQ, DM, PLE, PLE, PLE}; pg8::UpperHalfOrder S; S.init(SEQ, DM, G, c);
          EpiPlain E{(bf16_t*)(ws + WS_PE0), DM};
          pg8::gemm_phase(lds, g, S, E, wave); }
        { pg8::Gemm g{(const bf16_t*)(ws + WS_WT_GR), (const bf16_t*)(ws + WS_WU), PW, DM, 1024, 1024, PW}; pg8::CombOrder S; S.init(PW, DM, G, c);
          EpiComb E{(bf16_t*)(ws + WS_WT_PI), DM, args.in[8]};
          pg8::gemm_phase(lds, g, S, E, wave); }
    }
    SEAM(4);
    if (IN(5)) for (int rep_ = 0; rep_ < NDUP(5); ++rep_) { if (rep_) xcd_barrier(bar, wave);
        pg8::Gemm g{(const bf16_t*)(ws + WS_A1), (const bf16_t*)(ws + WS_WT_G0), SEQ, DM, DM, DM, DM}; pg8::StaticOrder S; S.init(SEQ, DM, G, c);
        rstd_table(lds, rp0, S, wave * 64 + lane_id());
        EpiPle E{(const bf16_t*)(ws + WS_A1), (const bf16_t*)(ws + WS_PE0), lds, (bf16_t*)(ws + WS_A2), rp1};
        pg8::gemm_phase(lds, g, S, E, wave);
    }
    SEAM(5);
    if (IN(6)) for (int rep_ = 0; rep_ < NDUP(6); ++rep_) { if (rep_) xcd_barrier(bar, wave);
        pg8::Gemm g{(const bf16_t*)(ws + WS_A2), (const bf16_t*)(ws + WS_WT_PI), SEQ, 2 * PW, DM, DM, DM}; pg8::StaticOrder S; S.init(SEQ, 2 * PW, G, c);
        rstd_table(lds, rp1, S, wave * 64 + lane_id());
        EpiPoolIn E{lds, (bf16_t*)(ws + WS_U), (bf16_t*)(ws + WS_SG1)};
        pg8::gemm_phase(lds, g, S, E, wave);
    }
    SEAM(6);
    if (IN(7)) for (int rep_ = 0; rep_ < NDUP(7); ++rep_) { if (rep_) xcd_barrier(bar, wave); p_pool(args, wave); }
    SEAM(7);
    if (IN(8)) for (int rep_ = 0; rep_ < NDUP(8); ++rep_) { if (rep_) xcd_barrier(bar, wave);
        { pg8::Gemm g{(const bf16_t*)(ws + WS_ZZ), (const bf16_t*)(ws + WS_WT_PO), SEQ, DM, PW, PW, PW}; pg8::StaticOrder S; S.init(SEQ, DM, G, c);
          EpiRes<false> E{nullptr, (const bf16_t*)(ws + WS_A2), (bf16_t*)(ws + WS_A3), rp2};
          pg8::gemm_phase(lds, g, S, E, wave); }
        { pg8::Gemm g{(const bf16_t*)(ws + WS_PBF) + (size_t)SEQ * PLE, (const bf16_t*)(ws + WS_WT_P1), SEQ, DM, PLE, PLE, PLE}; pg8::StaticOrder S; S.init(SEQ, DM, G, c);
          EpiPlain E{(bf16_t*)(ws + WS_PE1), DM};
          pg8::gemm_phase(lds, g, S, E, wave); }
    }
    SEAM(8);
    if (IN(9)) for (int rep_ = 0; rep_ < NDUP(9); ++rep_) { if (rep_) xcd_barrier(bar, wave);
        pg8::Gemm g{(const bf16_t*)(ws + WS_A3), (const bf16_t*)(ws + WS_WT_G1), SEQ, DM, DM, DM, DM}; pg8::StaticOrder S; S.init(SEQ, DM, G, c);
        rstd_table(lds, rp2, S, wave * 64 + lane_id());
        EpiPleFinal E{(const bf16_t*)(ws + WS_A3), (const bf16_t*)(ws + WS_PE1), lds, args.out, args.in[13], (unsigned*)(ws + WS_CTL)};
        pg8::gemm_phase(lds, g, S, E, wave);
    }
#undef IN
#undef SEAM
}

extern "C" void kernel_launch(void* const* d_in, const int* in_sizes, int n_in, void* d_out, int out_size, void* d_ws, size_t ws_size, hipStream_t stream) {
    static int grid = 0;
    if (grid == 0) {
        if (n_in != 14 || out_size != SEQ * DM || ws_size < WS_END) { fprintf(stderr, "kernel_launch: unexpected problem: n_in %d out %d ws %zu (need %zu)\n", n_in, out_size, ws_size, (size_t)WS_END); grid = -1; return; }
        int dev = 0, cus = 0, per_cu = 0;
        if (hipGetDevice(&dev) != hipSuccess || hipDeviceGetAttribute(&cus, hipDeviceAttributeMultiprocessorCount, dev) != hipSuccess) { grid = -1; return; }
        if (hipFuncSetAttribute((const void*)trunk_fwd, hipFuncAttributeMaxDynamicSharedMemorySize, LDS_BYTES) != hipSuccess) { fprintf(stderr, "kernel_launch: hipFuncSetAttribute failed\n"); grid = -1; return; }
        if (hipOccupancyMaxActiveBlocksPerMultiprocessor(&per_cu, (const void*)trunk_fwd, 512, LDS_BYTES) != hipSuccess || per_cu < 1) { fprintf(stderr, "kernel_launch: occupancy query says %d\n", per_cu); (void)hipGetLastError(); }
        grid = cus;
        if (grid != 256) fprintf(stderr, "kernel_launch: %d CUs (built for 256)\n", grid);
    }
    if (grid < 0) return;
    (void)hipMemsetAsync((char*)d_ws + WS_CTL, 0, CTL_ZERO_BYTES, stream);
    Args a{};
    for (int i = 0; i < 14; ++i) a.in[i] = (const float*)d_in[i];
    a.out = (float*)d_out; a.ws = (unsigned char*)d_ws;
    for (int i = 0; i < 128; ++i) { const float lin = (float)i * (1.0f / 127.0f); a.freq[i] = (float)pow(10000.0, -(double)lin); }
    for (int h = 0; h < 8; ++h) { const double lg = log2(1.0 - pow(2.0, -5.0 - (double)h)); a.l2g[h] = (float)lg; a.g256[h] = (float)exp2(256.0 * lg); }
    constexpr int NPH = 10;
    if (MK_N_LAUNCHES == 1) {
        a.ph_lo = 0; a.ph_hi = NPH;
        void* kargs[] = {&a};
        const hipError_t le = hipLaunchCooperativeKernel((const void*)trunk_fwd, dim3(grid), dim3(512), kargs, LDS_BYTES, stream);
        if (le != hipSuccess) fprintf(stderr, "kernel_launch: cooperative launch failed: %s (grid %d)\n", hipGetErrorString(le), grid);
    } else {
        for (int ph = 0; ph < NPH; ++ph) { a.ph_lo = ph; a.ph_hi = ph + 1; hipLaunchKernelGGL(trunk_fwd, dim3(grid), dim3(512), LDS_BYTES, stream, a); }
    }
}
```

```cpp
#include <hip/hip_runtime.h>
#include <cstdio>
#include <cstdint>
#include <cmath>

#ifndef MK_N_LAUNCHES
#define MK_N_LAUNCHES 1
#define CV_BIG 1
#endif

#define LAS __attribute__((address_space(3)))
#define GAS __attribute__((address_space(1)))
typedef unsigned short bf16_t;
typedef short bf16x8 __attribute__((ext_vector_type(8)));
typedef short s16x4 __attribute__((ext_vector_type(4)));
typedef float f32x4 __attribute__((ext_vector_type(4)));
typedef float f32x2 __attribute__((ext_vector_type(2)));
typedef unsigned u32x4 __attribute__((ext_vector_type(4)));
typedef unsigned u32x2 __attribute__((ext_vector_type(2)));

constexpr int SEQ = 8192, DM = 2048, RPROJ = 12288, NH = 8, DKH = 256, DVH = 512, PW = 4096, PLE = 256;
constexpr float NORM_EPS = 1e-6f, GN_EPS = 1e-5f;

constexpr size_t MiB = 1u << 20;
constexpr size_t WS_CTL = 0, CTL_ZERO_BYTES = 128 * 1024;
constexpr size_t WS_RP = 1 * MiB;
constexpr size_t WS_ROPE = 5 * MiB;
constexpr size_t WS_PBF = 13 * MiB;
constexpr size_t WS_WT_RO = 21 * MiB;
constexpr size_t WS_WT_G0 = 37 * MiB;
constexpr size_t WS_WT_P0 = 45 * MiB;
constexpr size_t WS_WT_RI = 46 * MiB;
constexpr size_t WS_XN0 = 94 * MiB;
constexpr size_t WS_QD = 126 * MiB, WS_KD = 158 * MiB, WS_V = 190 * MiB, WS_SG = 254 * MiB;
constexpr size_t WS_Z = WS_SG;
constexpr size_t WS_ST = 318 * MiB;
constexpr size_t WS_WU = 46 * MiB;
constexpr size_t WS_WT_PI = 62 * MiB;
constexpr size_t WS_WT_GR = 94 * MiB, WS_WT_PO = 102 * MiB, WS_WT_G1 = 118 * MiB, WS_WT_P1 = 382 * MiB;
constexpr size_t WS_H1 = 126 * MiB, WS_A1 = 190 * MiB, WS_PE0 = 222 * MiB;
constexpr size_t WS_H2 = 254 * MiB, WS_A2 = 318 * MiB;
constexpr size_t WS_U = 126 * MiB, WS_SG1 = 190 * MiB, WS_ZZ = 254 * MiB;
constexpr size_t WS_H3 = 126 * MiB, WS_A3 = 190 * MiB, WS_PE1 = 222 * MiB;
constexpr size_t WS_END = 383 * MiB;

constexpr int RING_BYTES = 131072;
constexpr int LDS_BYTES = 155648;
constexpr int MISC_OFF = LDS_BYTES - 256;

#define LDS_WAIT() asm volatile("s_waitcnt lgkmcnt(0)" ::: "memory")
#define VM_WAIT() asm volatile("s_waitcnt vmcnt(0)" ::: "memory")

__device__ __forceinline__ unsigned cvt_pk_bf16(float lo, float hi) { unsigned r; asm volatile("v_cvt_pk_bf16_f32 %0, %1, %2" : "=v"(r) : "v"(lo), "v"(hi)); return r; }
__device__ __forceinline__ float bf_lo(unsigned w) { return __uint_as_float(w << 16); }
__device__ __forceinline__ float bf_hi(unsigned w) { return __uint_as_float(w & 0xffff0000u); }
__device__ __forceinline__ float fsigmoid(float x) { return __builtin_amdgcn_rcpf(1.0f + __builtin_amdgcn_exp2f(-1.44269504089f * x)); }
__device__ __forceinline__ float fsilu(float x) { return x * fsigmoid(x); }
__device__ __forceinline__ int lane_id() { int l; asm volatile("v_mbcnt_lo_u32_b32 %0, -1, 0\n\tv_mbcnt_hi_u32_b32 %0, -1, %0" : "=v"(l)); return l; }
__device__ __forceinline__ float wave_sum(float v) {
#pragma unroll
    for (int o = 1; o < 64; o <<= 1) v += __shfl_xor(v, o);
    return v;
}

namespace pg8 {
constexpr int BM = 256, BK = 64, HALF = 128, HTB = HALF * BK * 2, STAGE_BYTES = 8 * HTB, NXCD = 8, WGM = 4;
__host__ __device__ __forceinline__ int lds_byte(int r, int c) { const int st = (r >> 4) * 2 + (c >> 5), rr = r & 15, cc = c & 31, ob = rr * 64 + cc * 2; return st * 1024 + (ob ^ (((ob >> 9) & 1) << 5)); }
__host__ __device__ __forceinline__ void stage_rc(int b, int& R, int& C) { const int st = b / 1024, sb = b % 1024, swz = sb ^ (((sb >> 9) & 1) << 5); R = (st >> 1) * 16 + swz / 64; C = (st & 1) * 32 + (swz % 64) / 2; }
__host__ __device__ __forceinline__ int perm32(int rho) { const int n = rho >> 4, i = rho & 15; return 8 * (i >> 2) + 4 * n + (i & 3); }

struct Unit { int pm, pn, slot; };
struct Gemm { const bf16_t* A; const bf16_t* Bt; int M, N, K, lda, ldb; };

struct StaticOrder {
    int nM, nN, nwg, G, c;
    __host__ __device__ void init(int M, int N, int G_, int c_) { nM = M / BM; nN = N / BM; nwg = nM * nN; G = G_; c = c_; }
    __host__ __device__ bool next(int i, Unit& u) const {
        const long L = (long)i * G + c; if (L >= nwg) return false;
        int wgid = (int)L; { const int q = nwg / NXCD, r = nwg % NXCD, xcd = wgid % NXCD, off = wgid / NXCD; wgid = (xcd < r ? xcd * (q + 1) : r * (q + 1) + (xcd - r) * q) + off; }
        const int nig = WGM * nN, gid = wgid / nig, fm = gid * WGM, gsz = (nM - fm) < WGM ? (nM - fm) : WGM;
        u.pm = fm + ((wgid % nig) % gsz); u.pn = (wgid % nig) / gsz; u.slot = i; return true;
    }
    __device__ __forceinline__ size_t a_off(const Unit&) const { return 0; }
    __device__ __forceinline__ size_t b_off(const Unit&) const { return 0; }
};
struct UpperHalfOrder : StaticOrder {
    __host__ __device__ bool next(int i, Unit& u) const { const int hw = G >> 1, per = nwg / hw; if (c < hw || i >= per) return false; const int L = (c - hw) * per + i; u.pm = L / nN; u.pn = L - u.pm * nN; u.slot = i; return true; }
};
struct CombOrder : StaticOrder {
    __device__ __forceinline__ size_t b_off(const Unit& u) const { return (size_t)(u.pm >> 2) * 2048; }
};

template <class Epi, class Sched, int EPI_REPS = 1>
__device__ __forceinline__ void gemm_phase(LAS unsigned char* lds, const Gemm g, const Sched& S, const Epi& E, const int wid) {
    int lane_ = lane_id(); asm volatile("" : "+v"(lane_));
    const int lane = lane_, tid = wid * 64 + lane, wr = wid >> 2, wc = wid & 3, fr = lane & 15, fq = lane >> 4;
    const int K = g.K, nt = K / BK;
    unsigned voffA[2], voffB[2];
#pragma unroll
    for (int i = 0; i < 2; ++i) { int R, C; stage_rc(tid * 16 + i * 8192, R, C); const int Rb = (R & ~31) + perm32(R & 31);
        voffA[i] = (unsigned)(R * g.lda + C) * 2u; voffB[i] = (unsigned)(Rb * g.ldb + C) * 2u; }
    const size_t kstep = (size_t)(BK * 2);
    const size_t hstepA = (size_t)HALF * g.lda * 2, hstepB = (size_t)HALF * g.ldb * 2;
    const size_t tstepA = 2 * hstepA, tstepB = 2 * hstepB;
    const unsigned ldsw = (unsigned)wid * 1024u;
    const int aoff = lds_byte(wr * 64 + fr, fq * 8), boff = lds_byte(wc * 32 + fr, fq * 8);
#define PG8_SA(b, h) (((b) * 2 + (h)) * HTB)
#define PG8_SB(b, h) ((4 + (b) * 2 + (h)) * HTB)
#define PG8_STAGE(bufoff, gbase, voff) do { _Pragma("unroll") for (int _i = 0; _i < 2; ++_i) \
        __builtin_amdgcn_global_load_lds((const unsigned*)((const char*)(gbase) + (voff)[_i]), (LAS unsigned*)(lds + (bufoff) + ldsw + _i * 8192), 16, 0, 0); } while (0)
#define PG8_LDA(dst, b, h) do { _Pragma("unroll") for (int m = 0; m < 4; ++m) _Pragma("unroll") for (int k = 0; k < 2; ++k) dst[m][k] = *(const LAS bf16x8*)(lds + PG8_SA(b, h) + aoff + m * 2048 + k * 1024); } while (0)
#define PG8_LDB(dst, b, h) do { _Pragma("unroll") for (int n = 0; n < 2; ++n) _Pragma("unroll") for (int k = 0; k < 2; ++k) dst[n][k] = *(const LAS bf16x8*)(lds + PG8_SB(b, h) + boff + n * 2048 + k * 1024); } while (0)
#define PG8_MMA(ai, bj, At, Bt) do { __builtin_amdgcn_s_setprio(1); _Pragma("unroll") for (int m = 0; m < 4; ++m) _Pragma("unroll") for (int n = 0; n < 2; ++n) _Pragma("unroll") for (int k = 0; k < 2; ++k) \
        acc[ai][bj][m][n] = __builtin_amdgcn_mfma_f32_16x16x32_bf16(Bt[n][k], At[m][k], acc[ai][bj][m][n], 0, 0, 0); __builtin_amdgcn_s_setprio(0); } while (0)
#define PG8_WAIT_V(n) asm volatile("s_waitcnt vmcnt(" #n ")" ::: "memory")
#define PG8_WAIT_L(n) asm volatile("s_waitcnt lgkmcnt(" #n ")" ::: "memory")
#define PG8_BAR __builtin_amdgcn_s_barrier()
#define PG8_SCHED __builtin_amdgcn_sched_barrier(0)
    Unit cur, nxt; int ui = 0;
    if (!S.next(0, cur)) return;
    f32x4 acc[2][2][4][2];
#pragma unroll
    for (int a = 0; a < 2; ++a)
#pragma unroll
        for (int b = 0; b < 2; ++b)
#pragma unroll
            for (int m = 0; m < 4; ++m)
#pragma unroll
                for (int n = 0; n < 2; ++n) acc[a][b][m][n] = (f32x4){0.f, 0.f, 0.f, 0.f};
    bf16x8 At[4][2], B0[2][2], B1[2][2];
    const char* cA = (const char*)g.A + (size_t)cur.pm * tstepA + S.a_off(cur); const char* cB = (const char*)g.Bt + (size_t)cur.pn * tstepB + S.b_off(cur);
    PG8_STAGE(PG8_SB(0, 0), cB, voffB); PG8_STAGE(PG8_SB(0, 1), cB + hstepB, voffB); PG8_STAGE(PG8_SA(0, 0), cA, voffA); PG8_STAGE(PG8_SA(0, 1), cA + hstepA, voffA);
    if (wr == 1) PG8_BAR;
    PG8_WAIT_V(2); PG8_BAR;
    PG8_STAGE(PG8_SB(1, 0), cB + kstep, voffB); PG8_STAGE(PG8_SA(1, 0), cA + kstep, voffA); PG8_STAGE(PG8_SB(1, 1), cB + hstepB + kstep, voffB);
    PG8_WAIT_V(6); PG8_BAR;
    for (;;) {
        const bool has_next = S.next(ui + 1, nxt);
        const char* nA = has_next ? (const char*)g.A + (size_t)nxt.pm * tstepA + S.a_off(nxt) : cA; const char* nB = has_next ? (const char*)g.Bt + (size_t)nxt.pn * tstepB + S.b_off(nxt) : cB;
        for (int t = 0; t < nt; t += 2) {
            const bool last = (t == nt - 2);
            const char* a1 = cA + (size_t)(t + 1) * kstep;
            const char* a2 = last ? nA : cA + (size_t)(t + 2) * kstep; const char* b2 = last ? nB : cB + (size_t)(t + 2) * kstep;
            const char* a3 = a2 + kstep; const char* b3 = b2 + kstep;
            PG8_LDB(B0, 0, 0); PG8_LDB(B1, 0, 1); PG8_SCHED; PG8_LDA(At, 0, 0); PG8_STAGE(PG8_SA(1, 1), a1 + hstepA, voffA);
            PG8_WAIT_V(8); PG8_WAIT_L(0); PG8_BAR; PG8_MMA(0, 0, At, B0); PG8_MMA(0, 1, At, B1); PG8_BAR; PG8_SCHED;
            PG8_LDA(At, 0, 1); PG8_STAGE(PG8_SB(0, 0), b2, voffB); PG8_STAGE(PG8_SB(0, 1), b2 + hstepB, voffB); PG8_STAGE(PG8_SA(0, 0), a2, voffA);
            PG8_WAIT_V(8); PG8_WAIT_L(0); PG8_BAR; PG8_MMA(1, 0, At, B0); PG8_MMA(1, 1, At, B1); PG8_BAR; PG8_SCHED;
            PG8_LDB(B0, 1, 0); PG8_LDB(B1, 1, 1); PG8_SCHED; PG8_LDA(At, 1, 0); PG8_STAGE(PG8_SA(0, 1), a2 + hstepA, voffA);
            PG8_WAIT_V(8); PG8_WAIT_L(0); PG8_BAR; PG8_MMA(0, 0, At, B0); PG8_MMA(0, 1, At, B1); PG8_BAR; PG8_SCHED;
            PG8_LDA(At, 1, 1); PG8_STAGE(PG8_SB(1, 0), b3, voffB); PG8_STAGE(PG8_SB(1, 1), b3 + hstepB, voffB); PG8_STAGE(PG8_SA(1, 0), a3, voffA);
            PG8_WAIT_V(8); PG8_WAIT_L(0); PG8_BAR; PG8_MMA(1, 0, At, B0); PG8_MMA(1, 1, At, B1); PG8_BAR; PG8_SCHED;
        }
        if (wr == 0) PG8_BAR;
        for (int er_ = 0; er_ < EPI_REPS; ++er_) { const int l2 = lane_id(); E(acc, cur, wr, wc, l2 & 15, l2 >> 4); }
        if (!has_next) break;
#pragma unroll
        for (int a = 0; a < 2; ++a)
#pragma unroll
            for (int b = 0; b < 2; ++b)
#pragma unroll
                for (int m = 0; m < 4; ++m)
#pragma unroll
                    for (int n = 0; n < 2; ++n) acc[a][b][m][n] = (f32x4){0.f, 0.f, 0.f, 0.f};
        cur = nxt; cA = nA; cB = nB; ++ui;
        if (wr == 1) PG8_BAR;
    }
    PG8_WAIT_V(0);
    PG8_BAR;
#undef PG8_SA
#undef PG8_SB
#undef PG8_STAGE
#undef PG8_LDA
#undef PG8_LDB
#undef PG8_MMA
#undef PG8_WAIT_V
#undef PG8_WAIT_L
#undef PG8_BAR
#undef PG8_SCHED
}
}
using pg8::Unit;

#define EPI_ARGS f32x4 (&acc)[2][2][4][2], const Unit& u, int wr, int wc, int fr, int fq
__device__ __forceinline__ u32x4 pack8(const f32x4 a, const f32x4 b) { u32x4 w; w.x = cvt_pk_bf16(a[0], a[1]); w.y = cvt_pk_bf16(a[2], a[3]); w.z = cvt_pk_bf16(b[0], b[1]); w.w = cvt_pk_bf16(b[2], b[3]); return w; }
__device__ __forceinline__ void unpack8(const u32x4 w, f32x4& a, f32x4& b) { a = (f32x4){bf_lo(w.x), bf_hi(w.x), bf_lo(w.y), bf_hi(w.y)}; b = (f32x4){bf_lo(w.z), bf_hi(w.z), bf_lo(w.w), bf_hi(w.w)}; }
__device__ __forceinline__ float row_rstd(const float* rp, int row) {
    const f32x4* q = (const f32x4*)(rp + (size_t)row * 32); f32x4 s = q[0];
#pragma unroll
    for (int i = 1; i < 8; ++i) s += q[i];
    return __builtin_amdgcn_rsqf(((s[0] + s[1]) + (s[2] + s[3])) * (1.0f / DM) + NORM_EPS);
}
constexpr int RSTD_OFF = RING_BYTES;
template <class Sched> __device__ __forceinline__ void rstd_table(LAS unsigned char* lds, const float* rp, const Sched& S, int tid) {
    LAS float* tab = (LAS float*)(lds + RSTD_OFF); Unit u;
    for (int i = 0; i < 8 && S.next(i, u); ++i) if (tid < 256) tab[i * 256 + tid] = row_rstd(rp, u.pm * 256 + tid);
    __syncthreads();
}
__device__ __forceinline__ float rstd_lds(const LAS unsigned char* lds, int slot, int r) { return ((const LAS float*)(lds + RSTD_OFF))[slot * 256 + r]; }

struct EpiRet1 {
    bf16_t *qd, *kd, *v, *sg; const float* rope; const float* l2g;
    __device__ __forceinline__ void operator()(EPI_ARGS) const {
        const int pn = u.pn, row0 = u.pm * 256 + wr * 64 + fr, c0 = wc * 32 + 8 * fq;
        if (pn < 16) {
            const int head = pn & 7; const bool isk = pn >= 8;
            bf16_t* out = (isk ? kd : qd) + head * 256; const float lg = l2g[head];
#pragma unroll
            for (int ai = 0; ai < 2; ++ai)
#pragma unroll
                for (int m = 0; m < 4; ++m) { const int row = row0 + ai * 128 + m * 16, r = row & 255;
                    const float dec = isk ? __builtin_amdgcn_exp2f(lg * (float)(255 - r)) * 0.0625f : __builtin_amdgcn_exp2f(lg * (float)(r - 255));
#pragma unroll
                    for (int bj = 0; bj < 2; ++bj) { const int c = c0 + bj * 128;
                        const f32x4* rp = (const f32x4*)(rope + ((size_t)row * 128 + (c >> 1)) * 2); const f32x4 t0 = rp[0], t1 = rp[1];
                        const f32x4 x = acc[ai][bj][m][0], y = acc[ai][bj][m][1]; f32x4 o0, o1;
                        o0[0] = (x[0] * t0[0] - x[1] * t0[1]) * dec; o0[1] = (x[1] * t0[0] + x[0] * t0[1]) * dec;
                        o0[2] = (x[2] * t0[2] - x[3] * t0[3]) * dec; o0[3] = (x[3] * t0[2] + x[2] * t0[3]) * dec;
                        o1[0] = (y[0] * t1[0] - y[1] * t1[1]) * dec; o1[1] = (y[1] * t1[0] + y[0] * t1[1]) * dec;
                        o1[2] = (y[2] * t1[2] - y[3] * t1[3]) * dec; o1[3] = (y[3] * t1[2] + y[2] * t1[3]) * dec;
                        *(u32x4*)(out + (size_t)row * DM + c) = pack8(o0, o1); } }
        } else if (pn < 32) {
            bf16_t* out = v + (pn - 16) * 256 + c0;
#pragma unroll
            for (int ai = 0; ai < 2; ++ai)
#pragma unroll
                for (int m = 0; m < 4; ++m) { const int row = row0 + ai * 128 + m * 16;
#pragma unroll
                    for (int bj = 0; bj < 2; ++bj) *(u32x4*)(out + (size_t)row * PW + bj * 128) = pack8(acc[ai][bj][m][0], acc[ai][bj][m][1]); }
        } else {
            bf16_t* out = sg + (pn - 32) * 256 + c0;
#pragma unroll
            for (int ai = 0; ai < 2; ++ai)
#pragma unroll
                for (int m = 0; m < 4; ++m) { const int row = row0 + ai * 128 + m * 16;
#pragma unroll
                    for (int bj = 0; bj < 2; ++bj) { f32x4 a = acc[ai][bj][m][0], b = acc[ai][bj][m][1];
#pragma unroll
                        for (int e = 0; e < 4; ++e) { a[e] = fsilu(a[e]); b[e] = fsilu(b[e]); }
                        *(u32x4*)(out + (size_t)row * PW + bj * 128) = pack8(a, b); } }
        }
    }
};
struct EpiPlain {
    bf16_t* O; int ldc;
    __device__ __forceinline__ void operator()(EPI_ARGS) const {
        bf16_t* out = O + (size_t)(u.pm * 256 + wr * 64 + fr) * ldc + u.pn * 256 + wc * 32 + 8 * fq;
#pragma unroll
        for (int ai = 0; ai < 2; ++ai)
#pragma unroll
            for (int m = 0; m < 4; ++m)
#pragma unroll
                for (int bj = 0; bj < 2; ++bj) *(u32x4*)(out + (size_t)(ai * 128 + m * 16) * ldc + bj * 128) = pack8(acc[ai][bj][m][0], acc[ai][bj][m][1]);
    }
};
template <bool RESF> struct EpiRes {
    const float* resf; const bf16_t* resb; bf16_t* aout; float* rpo;
    __device__ __forceinline__ void operator()(EPI_ARGS) const {
        const int row0 = u.pm * 256 + wr * 64 + fr, col0 = u.pn * 256 + wc * 32 + 8 * fq;
#pragma unroll
        for (int ai = 0; ai < 2; ++ai) {
            f32x4 rv[4][2][2];
#pragma unroll
            for (int m = 0; m < 4; ++m)
#pragma unroll
                for (int bj = 0; bj < 2; ++bj) { const size_t o = (size_t)(row0 + ai * 128 + m * 16) * DM + col0 + bj * 128;
                    if (RESF) { rv[m][bj][0] = __builtin_nontemporal_load((const f32x4*)(resf + o)); rv[m][bj][1] = __builtin_nontemporal_load((const f32x4*)(resf + o + 4)); }
                    else unpack8(*(const u32x4*)(resb + o), rv[m][bj][0], rv[m][bj][1]); }
#pragma unroll
            for (int m = 0; m < 4; ++m) { const int row = row0 + ai * 128 + m * 16; const size_t off = (size_t)row * DM + col0; float ss = 0.f;
#pragma unroll
                for (int bj = 0; bj < 2; ++bj) { const size_t o = off + bj * 128;
                    const f32x4 h0 = rv[m][bj][0] + acc[ai][bj][m][0], h1 = rv[m][bj][1] + acc[ai][bj][m][1];
                    ss += (h0[0] * h0[0] + h0[1] * h0[1]) + (h0[2] * h0[2] + h0[3] * h0[3]) + (h1[0] * h1[0] + h1[1] * h1[1]) + (h1[2] * h1[2] + h1[3] * h1[3]);
                    *(u32x4*)(aout + o) = pack8(h0, h1); }
                ss += __shfl_xor(ss, 16); ss += __shfl_xor(ss, 32);
                if (fq == 0) rpo[(size_t)row * 32 + u.pn * 4 + wc] = ss; }
            asm volatile("" ::: "memory"); }
    }
};
struct EpiPle {
    const bf16_t* hin; const bf16_t* pe; const LAS unsigned char* lds; bf16_t* aout; float* rpo;
    __device__ __forceinline__ void operator()(EPI_ARGS) const {
        const int row0 = u.pm * 256 + wr * 64 + fr, col0 = u.pn * 256 + wc * 32 + 8 * fq;
#pragma unroll
        for (int ai = 0; ai < 2; ++ai) {
            u32x4 hv[4][2], pv[4][2];
#pragma unroll
            for (int m = 0; m < 4; ++m)
#pragma unroll
                for (int bj = 0; bj < 2; ++bj) { const size_t o = (size_t)(row0 + ai * 128 + m * 16) * DM + col0 + bj * 128; hv[m][bj] = *(const u32x4*)(hin + o); pv[m][bj] = *(const u32x4*)(pe + o); }
#pragma unroll
            for (int m = 0; m < 4; ++m) { const int row = row0 + ai * 128 + m * 16; const size_t off = (size_t)row * DM + col0; float ss = 0.f;
                const float rstd = rstd_lds(lds, u.slot, row & 255);
#pragma unroll
                for (int bj = 0; bj < 2; ++bj) { const size_t o = off + bj * 128;
                    f32x4 h0, h1, p0, p1; unpack8(hv[m][bj], h0, h1); unpack8(pv[m][bj], p0, p1);
                    const f32x4 a0 = acc[ai][bj][m][0], a1 = acc[ai][bj][m][1];
#pragma unroll
                    for (int e = 0; e < 4; ++e) { h0[e] += fsigmoid(a0[e] * rstd) * p0[e]; h1[e] += fsigmoid(a1[e] * rstd) * p1[e]; }
                    ss += (h0[0] * h0[0] + h0[1] * h0[1]) + (h0[2] * h0[2] + h0[3] * h0[3]) + (h1[0] * h1[0] + h1[1] * h1[1]) + (h1[2] * h1[2] + h1[3] * h1[3]);
                    *(u32x4*)(aout + o) = pack8(h0, h1); }
                ss += __shfl_xor(ss, 16); ss += __shfl_xor(ss, 32);
                if (fq == 0) rpo[(size_t)row * 32 + u.pn * 4 + wc] = ss; }
            asm volatile("" ::: "memory"); }
    }
};
constexpr int FN_P_OFF = RING_BYTES + 8192, FN_S_OFF = FN_P_OFF + 4096;
constexpr int CW_FN_CNT = 16384, CW_FN_X = 32768;
struct EpiPleFinal {
    const bf16_t* hin; const bf16_t* pe; LAS unsigned char* lds; float* out; const float* gain; unsigned* ctl;
    __device__ __forceinline__ void operator()(EPI_ARGS) const {
        const int row0 = u.pm * 256 + wr * 64 + fr, col0 = u.pn * 256 + wc * 32 + 8 * fq;
        const int wid = wr * 4 + wc, tid = wid * 64 + fq * 16 + fr;
        LAS float* P = (LAS float*)(lds + FN_P_OFF); LAS float* S = (LAS float*)(lds + FN_S_OFF);
#pragma unroll
        for (int ai = 0; ai < 2; ++ai)
#pragma unroll
            for (int mp = 0; mp < 2; ++mp) {
                u32x4 hv[2][2], pv[2][2];
#pragma unroll
                for (int mm = 0; mm < 2; ++mm)
#pragma unroll
                    for (int bj = 0; bj < 2; ++bj) { const size_t o = (size_t)(row0 + ai * 128 + (2 * mp + mm) * 16) * DM + col0 + bj * 128;
                        hv[mm][bj] = *(const u32x4*)(hin + o); pv[mm][bj] = *(const u32x4*)(pe + o); }
#pragma unroll
                for (int mm = 0; mm < 2; ++mm) { const int m = 2 * mp + mm, row = row0 + ai * 128 + m * 16; float ss = 0.f;
                    const float rstd = rstd_lds(lds, u.slot, row & 255);
#pragma unroll
                    for (int bj = 0; bj < 2; ++bj) {
                        f32x4 h0, h1, p0, p1; unpack8(hv[mm][bj], h0, h1); unpack8(pv[mm][bj], p0, p1);
                        const f32x4 a0 = acc[ai][bj][m][0], a1 = acc[ai][bj][m][1];
#pragma unroll
                        for (int e = 0; e < 4; ++e) { h0[e] += fsigmoid(a0[e] * rstd) * p0[e]; h1[e] += fsigmoid(a1[e] * rstd) * p1[e]; }
                        acc[ai][bj][m][0] = h0; acc[ai][bj][m][1] = h1;
                        ss += (h0[0] * h0[0] + h0[1] * h0[1]) + (h0[2] * h0[2] + h0[3] * h0[3]) + (h1[0] * h1[0] + h1[1] * h1[1]) + (h1[2] * h1[2] + h1[3] * h1[3]); }
                    ss += __shfl_xor(ss, 16); ss += __shfl_xor(ss, 32);
                    if (fq == 0) P[(row & 255) * 4 + wc] = ss; }
                asm volatile("" ::: "memory"); }
        asm volatile("s_waitcnt lgkmcnt(0)" ::: "memory"); __builtin_amdgcn_s_barrier(); asm volatile("" ::: "memory");
        float* X = (float*)(ctl + CW_FN_X); unsigned* cnt = ctl + CW_FN_CNT + 64 * u.pm;
        if (tid < 256) { const float t = (P[tid * 4 + 0] + P[tid * 4 + 1]) + (P[tid * 4 + 2] + P[tid * 4 + 3]);
            __hip_atomic_store(X + ((size_t)(u.pm * 256 + tid) * 8 + u.pn), t, __ATOMIC_RELAXED, __HIP_MEMORY_SCOPE_AGENT);
            asm volatile("s_waitcnt vmcnt(0)" ::: "memory");
            if ((tid & 63) == 0) __hip_atomic_fetch_add(cnt, 1u, __ATOMIC_RELAXED, __HIP_MEMORY_SCOPE_AGENT); }
        if (wid == 0) {
            unsigned spins = 0;
            while ((unsigned)__builtin_amdgcn_readfirstlane(__hip_atomic_load(cnt, __ATOMIC_RELAXED, __HIP_MEMORY_SCOPE_AGENT)) < 32u) { __builtin_amdgcn_s_sleep(2); if (++spins > (1u << 22)) break; }
            __builtin_amdgcn_fence(__ATOMIC_ACQUIRE, "agent");
            asm volatile("s_waitcnt vmcnt(0)" ::: "memory"); }
        asm volatile("s_waitcnt vmcnt(0) lgkmcnt(0)" ::: "memory"); __builtin_amdgcn_s_barrier(); asm volatile("" ::: "memory");
        if (tid < 256) { const float* xs = X + (size_t)(u.pm * 256 + tid) * 8; float s = 0.f;
#pragma unroll
            for (int t = 0; t < 8; ++t) s += __hip_atomic_load(xs + t, __ATOMIC_RELAXED, __HIP_MEMORY_SCOPE_AGENT);
            S[tid] = __builtin_amdgcn_rsqf(s * (1.0f / DM) + NORM_EPS); }
        asm volatile("s_waitcnt lgkmcnt(0)" ::: "memory"); __builtin_amdgcn_s_barrier(); asm volatile("" ::: "memory");
        f32x4 gv[2][2];
#pragma unroll
        for (int bj = 0; bj < 2; ++bj) { gv[bj][0] = *(const f32x4*)(gain + col0 + bj * 128); gv[bj][1] = *(const f32x4*)(gain + col0 + bj * 128 + 4); }
#pragma unroll
        for (int ai = 0; ai < 2; ++ai)
#pragma unroll
            for (int m = 0; m < 4; ++m) { const int row = row0 + ai * 128 + m * 16; const float rs = S[row & 255]; const size_t off = (size_t)row * DM + col0;
#pragma unroll
                for (int bj = 0; bj < 2; ++bj) { *(f32x4*)(out + off + bj * 128) = acc[ai][bj][m][0] * rs * gv[bj][0]; *(f32x4*)(out + off + bj * 128 + 4) = acc[ai][bj][m][1] * rs * gv[bj][1]; } }
    }
};
struct EpiPoolIn {
    const LAS unsigned char* lds; bf16_t* uo; bf16_t* sgo;
    __device__ __forceinline__ void operator()(EPI_ARGS) const {
        const int row0 = u.pm * 256 + wr * 64 + fr; const bool isg = u.pn >= 16;
        bf16_t* out = (isg ? sgo : uo) + (u.pn & 15) * 256 + wc * 32 + 8 * fq;
#pragma unroll
        for (int ai = 0; ai < 2; ++ai)
#pragma unroll
            for (int m = 0; m < 4; ++m) { const int row = row0 + ai * 128 + m * 16; const float rstd = rstd_lds(lds, u.slot, row & 255);
#pragma unroll
                for (int bj = 0; bj < 2; ++bj) { f32x4 a = acc[ai][bj][m][0] * rstd, b = acc[ai][bj][m][1] * rstd;
                    if (isg) {
#pragma unroll
                        for (int e = 0; e < 4; ++e) { a[e] = fsilu(a[e]); b[e] = fsilu(b[e]); } }
                    *(u32x4*)(out + (size_t)row * PW + bj * 128) = pack8(a, b); } }
    }
};
struct EpiComb {
    bf16_t* O; int ldc; const float* scale;
    __device__ __forceinline__ void operator()(EPI_ARGS) const {
        const int row0 = u.pm * 256 + wr * 64 + fr;
        bf16_t* out = O + (size_t)row0 * ldc + u.pn * 256 + wc * 32 + 8 * fq;
#pragma unroll
        for (int ai = 0; ai < 2; ++ai)
#pragma unroll
            for (int m = 0; m < 4; ++m) { const float sc = scale[row0 + ai * 128 + m * 16];
#pragma unroll
                for (int bj = 0; bj < 2; ++bj) *(u32x4*)(out + (size_t)(ai * 128 + m * 16) * ldc + bj * 128) = pack8(acc[ai][bj][m][0] * sc, acc[ai][bj][m][1] * sc); }
    }
};

typedef GAS unsigned gu32;
#define RLX_AGENT __ATOMIC_RELAXED, __HIP_MEMORY_SCOPE_AGENT
#define XB_TMO      128
#define XB_XCNT(j)  (256  + 64 * (j))
#define XB_XSUB(j)  (1280 + 64 * (j))
#define XB_XGEN(j)  (2304 + 64 * (j))
#define XB_TOP      3328
#define XB_TOPGEN   3392
#define XCD_BAR_WORDS 3456
#define XB_SPIN_CAP (1u << 20)
__device__ __forceinline__ unsigned xb_ld(unsigned* p)              { return __hip_atomic_load(p, __ATOMIC_RELAXED, __HIP_MEMORY_SCOPE_AGENT); }
__device__ __forceinline__ unsigned xb_add(unsigned* p, unsigned v) { return __hip_atomic_fetch_add(p, v, __ATOMIC_RELAXED, __HIP_MEMORY_SCOPE_AGENT); }
__device__ __forceinline__ unsigned xb_xcc_id() { return (unsigned)__builtin_amdgcn_s_getreg((3 << 11) | 20) & 0xFu; }
#define XB_SPIN(cond, bar) do { unsigned _sp = 0; while (cond) { __builtin_amdgcn_s_sleep(1); \
    if ((++_sp & 255u) == 0u) { if (xb_ld(&(bar)[XB_TMO])) break; if (_sp > XB_SPIN_CAP) { atomicAdd(&(bar)[XB_TMO], 1u); break; } } } } while (0)
struct XcdBarrier { unsigned* bar; unsigned x; volatile LAS unsigned* st; };
__device__ __forceinline__ XcdBarrier xcd_barrier_post(unsigned* bar, volatile LAS unsigned* st, const int wave) {
    XcdBarrier b; b.bar = bar; b.x = xb_xcc_id(); b.st = st;
    if (wave == 0 && lane_id() == 0) (void)xb_add(&bar[XB_XCNT(b.x)], 1u);
    return b;
}
__device__ __forceinline__ void xcd_barrier_complete(unsigned* bar, unsigned x, unsigned& nloc, unsigned& nx) {
    const unsigned G = gridDim.x * gridDim.y * gridDim.z;
    unsigned sum, cnt, mine, sp = 0u;
    for (;;) {
        sum = 0u; cnt = 0u; mine = 0u;
#pragma unroll
        for (unsigned j = 0; j < 16; ++j) { const unsigned c = xb_ld(&bar[XB_XCNT(j)]); sum += c; cnt += (c > 0u) ? 1u : 0u; mine = (j == x) ? c : mine; }
        if (sum == G) break;
        __builtin_amdgcn_s_sleep(1);
        if ((++sp & 255u) == 0u) { if (xb_ld(&bar[XB_TMO])) break; if (sp > XB_SPIN_CAP) { atomicAdd(&bar[XB_TMO], 1u); break; } }
    }
    nloc = mine > 0u ? mine : 1u; nx = cnt > 0u ? cnt : 1u;
}
__device__ __forceinline__ void xcd_barrier(const XcdBarrier& b, const int wave) {
    asm volatile("s_waitcnt vmcnt(0)" ::: "memory");
    __syncthreads();
    if (wave == 0 && lane_id() == 0) {
        unsigned* bar = b.bar;
        __builtin_amdgcn_s_waitcnt(0);
        unsigned nloc = b.st[0], nx = b.st[1];
        if (nloc == 0u) { xcd_barrier_complete(bar, b.x, nloc, nx); b.st[0] = nloc; b.st[1] = nx; }
        const unsigned old = xb_add(&bar[XB_XSUB(b.x)], 1u);
        const unsigned gen = old / nloc;
        if (old + 1u == (gen + 1u) * nloc) {
            __builtin_amdgcn_fence(__ATOMIC_RELEASE, "agent");
            asm volatile("s_waitcnt vmcnt(0)" ::: "memory");
            const unsigned og = xb_add(&bar[XB_TOP], 1u);
            const unsigned tg = og / nx;
            if (og + 1u == (tg + 1u) * nx) xb_add(&bar[XB_TOPGEN], 1u);
            else XB_SPIN(xb_ld(&bar[XB_TOPGEN]) == tg, bar);
            __builtin_amdgcn_fence(__ATOMIC_ACQUIRE, "agent");
            xb_add(&bar[XB_XGEN(b.x)], 1u);
            asm volatile("s_waitcnt vmcnt(0)" ::: "memory");
        } else {
            XB_SPIN(xb_ld(&bar[XB_XGEN(b.x)]) == gen, bar);
            __builtin_amdgcn_fence(__ATOMIC_ACQUIRE, "agent");
            asm volatile("s_waitcnt vmcnt(0)" ::: "memory");
        }
    }
    __syncthreads();
}

__device__ __forceinline__ void tr_item(const float* W, int N, bf16_t* WT, int Kt, LAS float* scr, int item, int lane) {
    const int nblk = N >> 6, kb = item / nblk, nb = item - kb * nblk, k0 = kb << 6, n0 = nb << 6;
    const int c = lane & 15, rr = lane >> 4;
    f32x4 v[16];
#pragma unroll
    for (int i = 0; i < 16; ++i) v[i] = __builtin_nontemporal_load((const f32x4*)(W + (size_t)(k0 + 4 * i + rr) * N + n0 + 4 * c));
#pragma unroll
    for (int i = 0; i < 16; ++i) { LAS float* s = scr + (4 * i + rr) * 65 + 4 * c; s[0] = v[i][0]; s[1] = v[i][1]; s[2] = v[i][2]; s[3] = v[i][3]; }
    LDS_WAIT();
    const int kc = lane & 7;
#pragma unroll
    for (int jj = 0; jj < 8; ++jj) { const int n = (lane >> 3) + 8 * jj; const LAS float* s = scr + (8 * kc) * 65 + n;
        u32x4 o; o.x = cvt_pk_bf16(s[0], s[65]); o.y = cvt_pk_bf16(s[130], s[195]); o.z = cvt_pk_bf16(s[260], s[325]); o.w = cvt_pk_bf16(s[390], s[455]);
        *(u32x4*)(WT + (size_t)(n0 + n) * Kt + k0 + 8 * kc) = o; }
    LDS_WAIT();
}
__device__ __forceinline__ double sin2pi(double r) {
    r -= rint(r);
    if (r > 0.25) r = 0.5 - r; else if (r < -0.25) r = -0.5 - r;
    const double x = r * 6.283185307179586476925, x2 = x * x;
    double p = -1.0 / 1307674368000.0;
    p = p * x2 + 1.0 / 6227020800.0; p = p * x2 - 1.0 / 39916800.0; p = p * x2 + 1.0 / 362880.0; p = p * x2 - 1.0 / 5040.0;
    p = p * x2 + 1.0 / 120.0; p = p * x2 - 1.0 / 6.0; p = p * x2 + 1.0;
    return x * p;
}

struct Args { const float* in[14]; float* out; unsigned char* ws; float freq[128]; float l2g[8]; float g256[8]; int ph_lo, ph_hi; };

__device__ __forceinline__ void p_prologue(const Args& a, LAS unsigned char* lds, const int wave) {
    const int lane = lane_id(), tid = wave * 64 + lane;
    unsigned char* ws = a.ws;
    LAS float* scr = (LAS float*)(lds + wave * 16640);
    const int gw = blockIdx.x * 8 + wave, NGW = gridDim.x * 8;
    constexpr int I_RI = (DM / 64) * (RPROJ / 64);
    for (int it = gw; it < I_RI; it += NGW) tr_item(a.in[3], RPROJ, (bf16_t*)(ws + WS_WT_RI), DM, scr, it, lane);
    const float* x = a.in[0]; const float* gain = a.in[2]; bf16_t* xn = (bf16_t*)(ws + WS_XN0);
    for (int m = gw; m < SEQ; m += NGW) {
        const f32x4* xr = (const f32x4*)(x + (size_t)m * DM) + 2 * lane; f32x4 v[8]; float s = 0.f;
#pragma unroll
        for (int j = 0; j < 8; ++j) { v[j] = __builtin_nontemporal_load(xr + 128 * (j >> 1) + (j & 1)); s += (v[j][0] * v[j][0] + v[j][1] * v[j][1]) + (v[j][2] * v[j][2] + v[j][3] * v[j][3]); }
        const float rstd = __builtin_amdgcn_rsqf(wave_sum(s) * (1.0f / DM) + NORM_EPS);
        u32x4* o = (u32x4*)(xn + (size_t)m * DM) + lane;
#pragma unroll
        for (int j = 0; j < 4; ++j) { const f32x4 g0 = *((const f32x4*)gain + 2 * lane + 128 * j), g1 = *((const f32x4*)gain + 2 * lane + 128 * j + 1); o[64 * j] = pack8(v[2 * j] * rstd * g0, v[2 * j + 1] * rstd * g1); }
    }
    const int gt = blockIdx.x * 512 + tid, NGT = gridDim.x * 512;
    { const float* p = a.in[1]; bf16_t* pb = (bf16_t*)(ws + WS_PBF);
      for (int i = gt; i < 2 * SEQ * PLE / 8; i += NGT) { const f32x4 a0 = __builtin_nontemporal_load((const f32x4*)(p + (size_t)i * 8)), a1 = __builtin_nontemporal_load((const f32x4*)(p + (size_t)i * 8 + 4)); *(u32x4*)(pb + (size_t)i * 8) = pack8(a0, a1); } }
    { f32x4* rope = (f32x4*)(ws + WS_ROPE);
      for (int i = gt; i < SEQ * 64; i += NGT) { const int pos = i >> 6, fi = (i & 63) * 2; const float a0 = (float)pos * a.freq[fi], a1 = (float)pos * a.freq[fi + 1];
          const double r0 = (double)a0 * 0.15915494309189533577, r1 = (double)a1 * 0.15915494309189533577;
          rope[i] = (f32x4){(float)sin2pi(r0 + 0.25), (float)sin2pi(r0), (float)sin2pi(r1 + 0.25), (float)sin2pi(r1)}; } }
}
struct CvDesc { const float* src; bf16_t* dst; const float* kg; int N, Kt, plain; };
constexpr int CV_RO = (PW / 64) * (DM / 32), CV_G = (DM / 64) * (DM / 32), CV_P = (PLE / 64) * (DM / 32), CV_PIG = (DM / 64) * (PW / 32), CV_GR = (1024 / 64) * (1024 / 32), CV_WU = DM * PW / 2048;
constexpr int CV_ITEMS = CV_RO + 2 * CV_G + 2 * CV_P + CV_PIG + 4 * CV_GR + CV_RO + CV_WU;
__device__ __forceinline__ CvDesc cv_tr(const float* W, int N, int ncols, bf16_t* WT, int Kt, int r, const float* kg = nullptr) {
    const int nblk = ncols >> 5, kb = r / nblk, nb = r - kb * nblk; CvDesc d; d.src = W + (size_t)(kb * 64) * N + nb * 32; d.dst = WT + (size_t)(nb * 32) * Kt + kb * 64; d.kg = kg ? kg + kb * 64 : nullptr; d.N = N; d.Kt = Kt; d.plain = 0; return d; }
__device__ __forceinline__ CvDesc cv_decode(const Args& a, int r) {
    unsigned char* ws = a.ws;
    if (r < CV_RO) return cv_tr(a.in[4], DM, DM, (bf16_t*)(ws + WS_WT_RO), PW, r); r -= CV_RO;
    if (r < CV_G) return cv_tr(a.in[11], DM, DM, (bf16_t*)(ws + WS_WT_G0), DM, r, a.in[10]); r -= CV_G;
    if (r < CV_G) return cv_tr(a.in[11] + (size_t)DM * DM, DM, DM, (bf16_t*)(ws + WS_WT_G1), DM, r, a.in[10] + DM); r -= CV_G;
    if (r < CV_P) return cv_tr(a.in[12], DM, DM, (bf16_t*)(ws + WS_WT_P0), PLE, r); r -= CV_P;
    if (r < CV_P) return cv_tr(a.in[12] + (size_t)PLE * DM, DM, DM, (bf16_t*)(ws + WS_WT_P1), PLE, r); r -= CV_P;
    if (r < CV_PIG) return cv_tr(a.in[6] + PW, 2 * PW, PW, (bf16_t*)(ws + WS_WT_PI) + (size_t)PW * DM, DM, r, a.in[5]); r -= CV_PIG;
    if (r < 4 * CV_GR) { const int g = r / CV_GR; return cv_tr(a.in[7] + (size_t)g * 1024 * 1024, 1024, 1024, (bf16_t*)(ws + WS_WT_GR) + (size_t)g * 1024 * 1024, 1024, r - g * CV_GR); } r -= 4 * CV_GR;
    if (r < CV_RO) return cv_tr(a.in[9], DM, DM, (bf16_t*)(ws + WS_WT_PO), PW, r); r -= CV_RO;
    CvDesc d; const int row = r >> 1, c0 = (r & 1) * 2048; d.src = a.in[6] + (size_t)row * (2 * PW) + c0; d.dst = (bf16_t*)(ws + WS_WU) + (size_t)row * PW + c0; d.kg = a.in[5] + row; d.N = 0; d.Kt = 0; d.plain = 1; return d;
}
__device__ __forceinline__ void cv_load(const CvDesc& d, f32x4 (&cv)[8], int lane) {
    if (d.plain) {
#pragma unroll
        for (int j = 0; j < 4; ++j) { cv[2 * j] = __builtin_nontemporal_load((const f32x4*)(d.src + lane * 8 + 512 * j)); cv[2 * j + 1] = __builtin_nontemporal_load((const f32x4*)(d.src + lane * 8 + 512 * j + 4)); }
    } else {
#pragma unroll
        for (int i = 0; i < 8; ++i) cv[i] = __builtin_nontemporal_load((const f32x4*)(d.src + (size_t)(8 * i + (lane >> 3)) * d.N + 4 * (lane & 7)));
    }
}
__device__ __forceinline__ void cv_store(const CvDesc& d, const f32x4 (&cv)[8], LAS float* scr, int lane) {
    if (d.plain) {
        const float kgv = d.kg[0];
#pragma unroll
        for (int j = 0; j < 4; ++j) *(u32x4*)(d.dst + lane * 8 + 512 * j) = pack8(cv[2 * j] * kgv, cv[2 * j + 1] * kgv);
    } else {
#pragma unroll
        for (int i = 0; i < 8; ++i) { const float kgv = d.kg ? d.kg[8 * i + (lane >> 3)] : 1.0f; LAS float* s = scr + (8 * i + (lane >> 3)) * 33 + 4 * (lane & 7); s[0] = cv[i][0] * kgv; s[1] = cv[i][1] * kgv; s[2] = cv[i][2] * kgv; s[3] = cv[i][3] * kgv; }
        LDS_WAIT();
        const int kc = lane & 7;
#pragma unroll
        for (int j = 0; j < 4; ++j) { const int n = (lane >> 3) + 8 * j; const LAS float* s = scr + (8 * kc) * 33 + n;
            u32x4 o; o.x = cvt_pk_bf16(s[0], s[33]); o.y = cvt_pk_bf16(s[66], s[99]); o.z = cvt_pk_bf16(s[132], s[165]); o.w = cvt_pk_bf16(s[198], s[231]);
            *(u32x4*)(d.dst + (size_t)n * d.Kt + 8 * kc) = o; }
        LDS_WAIT();
    }
}

__device__ __forceinline__ void tr_item_g(const float* W, int N, int ncols, bf16_t* WT, int Kt, LAS float* scr, int item, int lane, const float* kg) {
    const int nblk = ncols >> 6, kb = item / nblk, nb = item - kb * nblk, k0 = kb << 6, n0 = nb << 6;
    const int c = lane & 15, rr = lane >> 4;
    f32x4 v[16];
#pragma unroll
    for (int i = 0; i < 16; ++i) v[i] = __builtin_nontemporal_load((const f32x4*)(W + (size_t)(k0 + 4 * i + rr) * N + n0 + 4 * c));
#pragma unroll
    for (int i = 0; i < 16; ++i) { const float g = kg ? kg[k0 + 4 * i + rr] : 1.0f; LAS float* s = scr + (4 * i + rr) * 65 + 4 * c; s[0] = v[i][0] * g; s[1] = v[i][1] * g; s[2] = v[i][2] * g; s[3] = v[i][3] * g; }
    LDS_WAIT();
    const int kc = lane & 7;
#pragma unroll
    for (int jj = 0; jj < 8; ++jj) { const int n = (lane >> 3) + 8 * jj; const LAS float* s = scr + (8 * kc) * 65 + n;
        u32x4 o; o.x = cvt_pk_bf16(s[0], s[65]); o.y = cvt_pk_bf16(s[130], s[195]); o.z = cvt_pk_bf16(s[260], s[325]); o.w = cvt_pk_bf16(s[390], s[455]);
        *(u32x4*)(WT + (size_t)(n0 + n) * Kt + k0 + 8 * kc) = o; }
    LDS_WAIT();
}
__device__ __forceinline__ void p_weights_big(const Args& a, LAS unsigned char* lds, const int wave) {
    const int lane = lane_id();
    unsigned char* ws = a.ws;
    LAS float* scr = (LAS float*)(lds + wave * 16640);
    const int gw = (blockIdx.x - 128) * 8 + wave, NGW = (gridDim.x - 128) * 8;
    constexpr int I_RO = (PW / 64) * (DM / 64), I_G = (DM / 64) * (DM / 64), I_P = (PLE / 64) * (DM / 64), I_PIG = (DM / 64) * (PW / 64), I_GR = (1024 / 64) * (1024 / 64), I_WU = DM * PW / 2048;
    for (int it = gw; it < I_RO + 2 * I_G + 2 * I_P + I_PIG + 4 * I_GR + I_RO + I_WU; it += NGW) {
        int r = it;
        if (r < I_RO) { tr_item_g(a.in[4], DM, DM, (bf16_t*)(ws + WS_WT_RO), PW, scr, r, lane, nullptr); continue; } r -= I_RO;
        if (r < I_G) { tr_item_g(a.in[11], DM, DM, (bf16_t*)(ws + WS_WT_G0), DM, scr, r, lane, a.in[10]); continue; } r -= I_G;
        if (r < I_G) { tr_item_g(a.in[11] + (size_t)DM * DM, DM, DM, (bf16_t*)(ws + WS_WT_G1), DM, scr, r, lane, a.in[10] + DM); continue; } r -= I_G;
        if (r < I_P) { tr_item_g(a.in[12], DM, DM, (bf16_t*)(ws + WS_WT_P0), PLE, scr, r, lane, nullptr); continue; } r -= I_P;
        if (r < I_P) { tr_item_g(a.in[12] + (size_t)PLE * DM, DM, DM, (bf16_t*)(ws + WS_WT_P1), PLE, scr, r, lane, nullptr); continue; } r -= I_P;
        if (r < I_PIG) { tr_item_g(a.in[6] + PW, 2 * PW, PW, (bf16_t*)(ws + WS_WT_PI) + (size_t)PW * DM, DM, scr, r, lane, a.in[5]); continue; } r -= I_PIG;
        if (r < 4 * I_GR) { const int g = r / I_GR; tr_item_g(a.in[7] + (size_t)g * 1024 * 1024, 1024, 1024, (bf16_t*)(ws + WS_WT_GR) + (size_t)g * 1024 * 1024, 1024, scr, r - g * I_GR, lane, nullptr); continue; } r -= 4 * I_GR;
        if (r < I_RO) { tr_item_g(a.in[9], DM, DM, (bf16_t*)(ws + WS_WT_PO), PW, scr, r, lane, nullptr); continue; } r -= I_RO;
        { const int row = r >> 1, c0 = (r & 1) * 2048 + lane * 8; const float* srcp = a.in[6] + (size_t)row * (2 * PW) + c0; bf16_t* dstp = (bf16_t*)(ws + WS_WU) + (size_t)row * PW + c0; const float g = a.in[5][row];
#pragma unroll
            for (int j = 0; j < 4; ++j) { const f32x4 x0 = __builtin_nontemporal_load((const f32x4*)(srcp + 512 * j)), x1 = __builtin_nontemporal_load((const f32x4*)(srcp + 512 * j + 4)); *(u32x4*)(dstp + 512 * j) = pack8(x0 * g, x1 * g); } }
    }
}

__device__ __forceinline__ bf16x8 tr_frag(const LAS unsigned char* p, int pitch16) {
    const s16x4 lo = __builtin_amdgcn_ds_read_tr16_b64_v4i16((LAS s16x4*)p), hi = __builtin_amdgcn_ds_read_tr16_b64_v4i16((LAS s16x4*)(p + pitch16));
    return (bf16x8){lo[0], lo[1], lo[2], lo[3], hi[0], hi[1], hi[2], hi[3]};
}

__device__ __forceinline__ void p_scan(const Args& a, LAS unsigned char* lds, const int w) {
    const int lane = lane_id();
    const int tid = w * 64 + lane, b = blockIdx.x, h = b & 7, tt = b >> 3, dt = tt >> 2, vt = tt & 3;
    const int db = w >> 1, vbp = w & 1, g = lane >> 4, i16 = lane & 15, q4 = i16 >> 2, p4 = i16 & 3;
    const float g256 = a.g256[h];
    constexpr int PK = 160, PV = 288, TK = 128 * PK, TV = 128 * PV, BUF = TK + TV;
    const bf16_t* kbase = (const bf16_t*)(a.ws + WS_KD) + h * 256 + dt * 64;
    const bf16_t* vbase = (const bf16_t*)(a.ws + WS_V) + h * 512 + vt * 128;
    bf16_t* st = (bf16_t*)(a.ws + WS_ST);
    u32x4 rk0[2], rv0[4], rk1[2], rv1[4], rk2[2], rv2[4], rk3[2], rv3[4];
#define P2_LOAD(RK, RV, hs) do { const int _hs = (hs) < 62 ? (hs) : 61; \
        _Pragma("unroll") for (int _i = 0; _i < 2; ++_i) { const int _p = tid + 512 * _i; RK[_i] = *(const u32x4*)(kbase + (size_t)(_hs * 128 + (_p >> 3)) * DM + (_p & 7) * 8); } \
        _Pragma("unroll") for (int _i = 0; _i < 4; ++_i) { const int _p = tid + 512 * _i; RV[_i] = *(const u32x4*)(vbase + (size_t)(_hs * 128 + (_p >> 4)) * PW + (_p & 15) * 8); } } while (0)
#define P2_STORE(RK, RV, s) do { \
        _Pragma("unroll") for (int _i = 0; _i < 2; ++_i) { const int _p = tid + 512 * _i; *(LAS u32x4*)(lds + (s) * BUF + (_p >> 3) * PK + (_p & 7) * 16) = RK[_i]; } \
        _Pragma("unroll") for (int _i = 0; _i < 4; ++_i) { const int _p = tid + 512 * _i; *(LAS u32x4*)(lds + (s) * BUF + TK + (_p >> 4) * PV + (_p & 15) * 16) = RV[_i]; } } while (0)
    f32x4 acc[4];
#pragma unroll
    for (int j = 0; j < 4; ++j) acc[j] = (f32x4){0.f, 0.f, 0.f, 0.f};
    const int lk = (4 * g + q4) * PK + 8 * p4 + db * 32, lv = (4 * g + q4) * PV + 16 * p4 + vbp * 128;
#define P2_STEP(hs, RKN, RVN) do { const int _h = (hs); if (_h < 62) { \
        const LAS unsigned char* kt = lds + (_h & 1) * BUF + lk; const LAS unsigned char* vtp = lds + (_h & 1) * BUF + TK + lv; \
        _Pragma("unroll") for (int ks = 0; ks < 4; ++ks) { \
            const bf16x8 kf = tr_frag(kt + ks * 32 * PK, 16 * PK); \
            _Pragma("unroll") for (int j = 0; j < 4; ++j) { const bf16x8 vf = tr_frag(vtp + ks * 32 * PV + 64 * (j >> 1) + 8 * (j & 1), 16 * PV); acc[j] = __builtin_amdgcn_mfma_f32_16x16x32_bf16(vf, kf, acc[j], 0, 0, 0); } } \
        if (_h & 1) { const int n = _h >> 1; \
            bf16_t* o = st + ((size_t)(n * 8 + h) * 256 + dt * 64 + db * 16 + i16) * 512 + vt * 128 + vbp * 64 + 8 * g; \
            _Pragma("unroll") for (int j = 0; j < 4; ++j) acc[j] *= g256; \
            _Pragma("unroll") for (int k = 0; k < 2; ++k) *(u32x4*)(o + 32 * k) = pack8(acc[2 * k], acc[2 * k + 1]); } \
        if (_h + 1 < 62) { P2_STORE(RKN, RVN, (_h + 1) & 1); P2_LOAD(RKN, RVN, _h + 5); } \
        __syncthreads(); } } while (0)
    P2_LOAD(rk0, rv0, 0); P2_LOAD(rk1, rv1, 1); P2_LOAD(rk2, rv2, 2); P2_LOAD(rk3, rv3, 3);
    P2_STORE(rk0, rv0, 0); P2_LOAD(rk0, rv0, 4); __syncthreads();
    for (int hs = 0; hs < 62; hs += 4) {
        P2_STEP(hs, rk1, rv1); P2_STEP(hs + 1, rk2, rv2); P2_STEP(hs + 2, rk3, rv3); P2_STEP(hs + 3, rk0, rv0);
    }
#undef P2_STEP
#undef P2_LOAD
#undef P2_STORE
}

__device__ __forceinline__ void p_retention(const Args& a, LAS unsigned char* lds, const int w) {
    const int lane = lane_id();
    const int tid = w * 64 + lane, b = blockIdx.x;
    const int g = lane >> 4, i16 = lane & 15, q4 = i16 >> 2, p4 = i16 & 3;
    constexpr int PP = 528, RINGO = 128 * PP, RB = 33792, ST1 = RINGO + 2 * RB, ST2 = ST1 + 8192;
    const bf16_t* qd = (const bf16_t*)(a.ws + WS_QD); const bf16_t* kd = (const bf16_t*)(a.ws + WS_KD); const bf16_t* v = (const bf16_t*)(a.ws + WS_V);
    const bf16_t* sg = (const bf16_t*)(a.ws + WS_SG); const bf16_t* st = (const bf16_t*)(a.ws + WS_ST); bf16_t* z = (bf16_t*)(a.ws + WS_Z);
    const unsigned offk = (unsigned)(((tid >> 5) * DM + (tid & 31) * 8) * 2), offv = (unsigned)(((tid >> 6) * PW + (tid & 63) * 8) * 2), offt = (unsigned)(((tid >> 6) * 512 + (tid & 63) * 8) * 2);
    const int xs = b & 7, kq = b >> 3, pair = kq >> 1, member = kq & 1;
    for (int rnd = 0; rnd < 2; ++rnd) {
        const int nh = (pair * 2 + rnd) * 8 + xs, n = nh >> 3, h = nh & 7, hf = member ^ rnd;
        const int nsb = 2 * (hf + 1), nvb = 4 * (hf + 1), ntb = n > 0 ? 8 : 0, nblk = nsb + nvb + ntb;
        const int rowbase = 256 * n + 128 * hf;
        u32x4 ra[4], rb[4];
#define P3_LOAD(R, it) do { const int _it = (it) < nblk ? (it) : nblk - 1; \
        if (_it < ntb) { const char* _b = (const char*)(st + ((size_t)((n - 1) * 8 + h) * 256 + 32 * _it) * 512); unsigned _o = offt; asm volatile("" : "+v"(_o)); \
            _Pragma("unroll") for (int _i = 0; _i < 4; ++_i) R[_i] = *(const u32x4*)(_b + (size_t)_i * (8 * 512 * 2) + _o); } \
        else if (_it < ntb + nsb) { const char* _b = (const char*)(kd + (size_t)(256 * n + 64 * (_it - ntb)) * DM + h * 256); unsigned _o = offk; asm volatile("" : "+v"(_o)); \
            _Pragma("unroll") for (int _i = 0; _i < 4; ++_i) R[_i] = *(const u32x4*)(_b + (size_t)_i * (16 * DM * 2) + _o); } \
        else { const char* _b = (const char*)(v + (size_t)(256 * n + 32 * (_it - ntb - nsb)) * PW + h * 512); unsigned _o = offv; asm volatile("" : "+v"(_o)); \
            _Pragma("unroll") for (int _i = 0; _i < 4; ++_i) R[_i] = *(const u32x4*)(_b + (size_t)_i * (8 * PW * 2) + _o); } } while (0)
#define P3_STORE(R, it) do { const int _it = (it); if (_it < nblk) { LAS unsigned char* _d = lds + RINGO + (_it & 1) * RB; \
        if (_it >= ntb && _it < ntb + nsb) { _Pragma("unroll") for (int _i = 0; _i < 4; ++_i) { const int _p = tid + 512 * _i; *(LAS u32x4*)(_d + (_p >> 5) * 528 + (_p & 31) * 16) = R[_i]; } } \
        else { _Pragma("unroll") for (int _i = 0; _i < 4; ++_i) { const int _p = tid + 512 * _i; *(LAS u32x4*)(_d + (_p >> 6) * 1056 + (_p & 63) * 16) = R[_i]; } } } } while (0)
        P3_LOAD(ra, 0); P3_LOAD(rb, 1);
        if (ntb) {
#pragma unroll 2
            for (int i = 0; i < 8; ++i) { const int p = tid + 512 * i, row = p >> 5, c = p & 31, G = c >> 2, cc = c & 3;
                const u32x4 x = *(const u32x4*)(qd + (size_t)(rowbase + row) * DM + h * 256 + c * 8);
                const int s = cc >> 1, glo = (2 * cc) & 3, ghi = (2 * cc + 1) & 3;
                LAS unsigned char* d = lds + row * PP + 64 * G;
                *(LAS u32x2*)(d + 8 * (2 * glo + s)) = (u32x2){x.x, x.y}; *(LAS u32x2*)(d + 8 * (2 * ghi + s)) = (u32x2){x.z, x.w}; }
        }
        P3_STORE(ra, 0); P3_LOAD(ra, 2); __syncthreads();
        f32x4 acc[8][4];
#pragma unroll
        for (int rbk = 0; rbk < 8; ++rbk)
#pragma unroll
            for (int cb = 0; cb < 4; ++cb) acc[rbk][cb] = (f32x4){0.f, 0.f, 0.f, 0.f};
#define P3_YSTEP(it_, RN, ISV) do { const int it = (it_); \
            const LAS unsigned char* ring = lds + RINGO + (it & 1) * RB; \
            { const int kk = (ISV) ? it - ntb - nsb : it; \
                bf16x8 vf[4]; \
                _Pragma("unroll") for (int cb = 0; cb < 4; ++cb) vf[cb] = tr_frag(ring + (4 * g + q4) * 1056 + (64 * w + 32 * (cb >> 1) + 8 * p4 + 4 * (cb & 1)) * 2, 16 * 1056);   \
                _Pragma("unroll") for (int rbk = 0; rbk < 8; ++rbk) { \
                    if ((ISV) && 32 * kk > 128 * hf + 16 * rbk + 15) continue; \
                    const bf16x8 pf = *(const LAS bf16x8*)(lds + (16 * rbk + i16) * PP + (32 * kk + 8 * g) * 2); \
                    _Pragma("unroll") for (int cb = 0; cb < 4; ++cb) acc[rbk][cb] = __builtin_amdgcn_mfma_f32_16x16x32_bf16(vf[cb], pf, acc[rbk][cb], 0, 0, 0); \
                } } \
            P3_STORE(RN, it + 1); P3_LOAD(RN, it + 3); \
            __syncthreads(); } while (0)
        for (int it2 = 0; it2 < ntb; it2 += 2) { P3_YSTEP(it2, rb, false); P3_YSTEP(it2 + 1, ra, false); }
        {
            bf16x8 qf[8];
#pragma unroll
            for (int ds = 0; ds < 8; ++ds) qf[ds] = *(const bf16x8*)(qd + (size_t)(rowbase + 16 * w + i16) * DM + h * 256 + 32 * ds + 8 * g);
#define P3_SSTEP(it_, RN) do { const int it = (it_), sbk = it - ntb; \
                const LAS unsigned char* ring = lds + RINGO + (it & 1) * RB; \
                _Pragma("unroll") for (int sb = 0; sb < 4; ++sb) { \
                    const int j0 = 64 * sbk + 16 * sb, i0 = 128 * hf + 16 * w; \
                    LAS unsigned char* dst = lds + (16 * w + i16) * PP + (32 * (2 * sbk + (sb >> 1)) + 8 * g + 4 * (sb & 1)) * 2; \
                    if (j0 > i0) { *(LAS u32x2*)dst = (u32x2){0u, 0u}; } \
                    else { \
                        f32x4 s4 = {0.f, 0.f, 0.f, 0.f}; \
                        _Pragma("unroll") for (int ds = 0; ds < 8; ++ds) { const bf16x8 kf = *(const LAS bf16x8*)(ring + (16 * sb + i16) * 528 + (32 * ds + 8 * g) * 2); \
                            s4 = __builtin_amdgcn_mfma_f32_16x16x32_bf16(kf, qf[ds], s4, 0, 0, 0); } \
                        if (j0 == i0) { _Pragma("unroll") for (int r = 0; r < 4; ++r) if (4 * g + r > i16) s4[r] = 0.f; } \
                        u32x2 wv; wv.x = cvt_pk_bf16(s4[0], s4[1]); wv.y = cvt_pk_bf16(s4[2], s4[3]); *(LAS u32x2*)dst = wv; \
                    } \
                } \
                P3_STORE(RN, it + 1); P3_LOAD(RN, it + 3); \
                __syncthreads(); } while (0)
            for (int it2 = ntb; it2 < ntb + nsb; it2 += 2) { P3_SSTEP(it2, rb); P3_SSTEP(it2 + 1, ra); }
#undef P3_SSTEP
        }
        for (int it2 = ntb + nsb; it2 < nblk; it2 += 2) { P3_YSTEP(it2, rb, true); P3_YSTEP(it2 + 1, ra, true); }
#undef P3_YSTEP
#undef P3_LOAD
#undef P3_STORE
        LAS f32x2* S1 = (LAS f32x2*)(lds + ST1); LAS f32x2* S2 = (LAS f32x2*)(lds + ST2);
#pragma unroll
        for (int rbk = 0; rbk < 8; ++rbk) { float s1 = 0.f, s2 = 0.f;
#pragma unroll
            for (int cb = 0; cb < 4; ++cb) { const f32x4 y = acc[rbk][cb]; s1 += (y[0] + y[1]) + (y[2] + y[3]); s2 += (y[0] * y[0] + y[1] * y[1]) + (y[2] * y[2] + y[3] * y[3]); }
            s1 += __shfl_xor(s1, 16); s1 += __shfl_xor(s1, 32); s2 += __shfl_xor(s2, 16); s2 += __shfl_xor(s2, 32);
            if (g == 0) S1[(16 * rbk + i16) * 8 + w] = (f32x2){s1, s2}; }
        __syncthreads();
        if (tid < 128) { float s1 = 0.f, s2 = 0.f;
#pragma unroll
            for (int k = 0; k < 8; ++k) { const f32x2 t = S1[tid * 8 + k]; s1 += t.x; s2 += t.y; }
            const float mean = s1 * (1.0f / 512.0f), var = s2 * (1.0f / 512.0f) - mean * mean;
            S2[tid] = (f32x2){mean, __builtin_amdgcn_rsqf(fmaxf(var, 0.f) + GN_EPS)}; }
        __syncthreads();
#pragma unroll
        for (int rbk = 0; rbk < 8; ++rbk) { const f32x2 ms = S2[16 * rbk + i16];
            const size_t off = (size_t)(rowbase + 16 * rbk + i16) * PW + h * 512 + 64 * w + 8 * g;
#pragma unroll
            for (int k = 0; k < 2; ++k) { const u32x4 gw = __builtin_nontemporal_load((const u32x4*)(sg + off + 32 * k)); f32x4 g0, g1; unpack8(gw, g0, g1);
                const f32x4 y0 = (acc[rbk][2 * k] - ms.x) * ms.y * g0, y1 = (acc[rbk][2 * k + 1] - ms.x) * ms.y * g1;
                *(u32x4*)(z + off + 32 * k) = pack8(y0, y1); } }
        __syncthreads();
    }
}

template <int W> __device__ __forceinline__ void pool_run(const bf16_t* uc, const bf16_t* gc, bf16_t* dc, int t0) {
    u32x4 ring[W]; f32x4 s0 = {0.f, 0.f, 0.f, 0.f}, s1 = {0.f, 0.f, 0.f, 0.f};
#pragma unroll
    for (int k = 0; k < W; ++k) { const int t = t0 - W + k; ring[k] = t >= 0 ? *(const u32x4*)(uc + (size_t)t * PW) : (u32x4){0u, 0u, 0u, 0u}; f32x4 x0, x1; unpack8(ring[k], x0, x1); s0 += x0; s1 += x1; }
    for (int tb = t0; tb < t0 + 32; tb += W) {
        u32x4 xr[W], gr[W];
#pragma unroll
        for (int k = 0; k < W; ++k) { xr[k] = *(const u32x4*)(uc + (size_t)(tb + k) * PW); gr[k] = *(const u32x4*)(gc + (size_t)(tb + k) * PW); }
#pragma unroll
        for (int k = 0; k < W; ++k) { const int t = tb + k;
            f32x4 x0, x1, y0, y1, g0, g1; unpack8(xr[k], x0, x1); unpack8(ring[k], y0, y1); unpack8(gr[k], g0, g1);
            s0 += x0 - y0; s1 += x1 - y1; ring[k] = xr[k];
            const float inv = 1.0f / (float)(t + 1 < W ? t + 1 : W);
            *(u32x4*)(dc + (size_t)t * PW) = pack8((s0 * inv - x0) * g0, (s1 * inv - x1) * g1); }
    }
}
__device__ __forceinline__ void p_pool(const Args& a, const int wave) {
    const int tid = wave * 64 + lane_id();
    const bf16_t* u = (const bf16_t*)(a.ws + WS_U); const bf16_t* sg = (const bf16_t*)(a.ws + WS_SG1); bf16_t* d = (bf16_t*)(a.ws + WS_ZZ);
    for (int task = blockIdx.x * 512 + tid; task < 512 * 256; task += gridDim.x * 512) {
        const int chunk = task & 511, run = task >> 9, grp = chunk >> 7, t0 = run * 32;
        const bf16_t* uc = u + chunk * 8; const bf16_t* gc = sg + chunk * 8; bf16_t* dc = d + chunk * 8;
        if (grp == 0) pool_run<2>(uc, gc, dc, t0); else if (grp == 1) pool_run<4>(uc, gc, dc, t0); else if (grp == 2) pool_run<8>(uc, gc, dc, t0); else pool_run<16>(uc, gc, dc, t0);
    }
}
__device__ __forceinline__ void p_final(const Args& a, const int wave) {
    const int lane = lane_id();
    const float* rp = (const float*)(a.ws + WS_RP + 3 * MiB); const float* gain = a.in[13]; float* out = a.out;
    for (int m = blockIdx.x * 8 + wave; m < SEQ; m += gridDim.x * 8) {
        const float part = lane < 32 ? rp[(size_t)m * 32 + lane] : 0.f;
        const float rstd = __builtin_amdgcn_rsqf(wave_sum(part) * (1.0f / DM) + NORM_EPS);
        f32x4* o = (f32x4*)(out + (size_t)m * DM) + lane;
#pragma unroll
        for (int j = 0; j < 8; ++j) { const f32x4 g = *((const f32x4*)gain + lane + 64 * j); o[64 * j] = o[64 * j] * rstd * g; }
    }
}

__global__ void __launch_bounds__(512, 2) trunk_fwd(Args args) {
    extern __shared__ __attribute__((aligned(16))) unsigned char lds_raw[];
    LAS unsigned char* lds = (LAS unsigned char*)lds_raw;
    const int wave = __builtin_amdgcn_readfirstlane(threadIdx.x >> 6);
    unsigned char* ws = args.ws;
    volatile LAS unsigned* MISC = (volatile LAS unsigned*)(lds + MISC_OFF);
    if (threadIdx.x < 64) MISC[threadIdx.x] = 0u;
    __syncthreads();
    XcdBarrier bar; bar.bar = (unsigned*)(ws + WS_CTL) + 4096; bar.x = 0; bar.st = nullptr;
    const int lo = args.ph_lo, hi = args.ph_hi;
    if (hi - lo > 1) bar = xcd_barrier_post((unsigned*)(ws + WS_CTL) + 4096, MISC + 8, wave);
#ifndef PH_MASK
#define PH_MASK 0x3FF
#endif
#define IN(k) (((PH_MASK >> (k)) & 1) && lo <= (k) && (k) < hi)
#define SEAM(k) do { if (IN(k) && IN((k) + 1)) xcd_barrier(bar, wave); } while (0)
#ifndef DUP_MASK
#define DUP_MASK 0
#endif
#define NDUP(k) (((DUP_MASK >> (k)) & 1) ? 2 : 1)
    const int G = gridDim.x, c = blockIdx.x;
    float* rp0 = (float*)(ws + WS_RP); float* rp1 = rp0 + SEQ * 32; float* rp2 = rp1 + SEQ * 32; float* rp3 = rp2 + SEQ * 32;

    if (IN(0)) for (int rep_ = 0; rep_ < NDUP(0); ++rep_) { if (rep_) xcd_barrier(bar, wave); p_prologue(args, lds, wave); VM_WAIT(); __syncthreads(); }
    SEAM(0);
    if (IN(1)) for (int rep_ = 0; rep_ < NDUP(1); ++rep_) { if (rep_) xcd_barrier(bar, wave);
        pg8::Gemm g{(const bf16_t*)(ws + WS_XN0), (const bf16_t*)(ws + WS_WT_RI), SEQ, RPROJ, DM, DM, DM}; pg8::StaticOrder S; S.init(SEQ, RPROJ, G, c);
        EpiRet1 E{(bf16_t*)(ws + WS_QD), (bf16_t*)(ws + WS_KD), (bf16_t*)(ws + WS_V), (bf16_t*)(ws + WS_SG), (const float*)(ws + WS_ROPE), args.l2g};
        pg8::gemm_phase(lds, g, S, E, wave);
    }
    SEAM(1);
    if (IN(2)) for (int rep_ = 0; rep_ < NDUP(2); ++rep_) { if (rep_) xcd_barrier(bar, wave); if (c < 128) p_scan(args, lds, wave); else p_weights_big(args, lds, wave);
        VM_WAIT(); __syncthreads(); }
    SEAM(2);
    if (IN(3)) for (int rep_ = 0; rep_ < NDUP(3); ++rep_) { if (rep_) xcd_barrier(bar, wave); p_retention(args, lds, wave); }
    SEAM(3);
    if (IN(4)) for (int rep_ = 0; rep_ < NDUP(4); ++rep_) { if (rep_) xcd_barrier(bar, wave);
        { pg8::Gemm g{(const bf16_t*)(ws + WS_Z), (const bf16_t*)(ws + WS_WT_RO), SEQ, DM, PW, PW, PW}; pg8::StaticOrder S; S.init(SEQ, DM, G, c);
          EpiRes<true> E{args.in[0], nullptr, (bf16_t*)(ws + WS_A1), rp0};
          pg8::gemm_phase(lds, g, S, E, wave); }
        { pg8::Gemm g{(const bf16_t*)(ws + WS_PBF), (const bf16_t*)(ws + WS_WT_P0), SEQ, DM, PLE, PLE, PLE}; pg8::UpperHalfOrder S; S.init(SEQ, DM, G, c);
          EpiPlain E{(bf16_t*)(ws + WS_PE0), DM};
          pg8::gemm_phase(lds, g, S, E, wave); }
        { pg8::Gemm g{(const bf16_t*)(ws + WS_WT_GR), (const bf16_t*)(ws + WS_WU), PW, DM, 1024, 1024, PW}; pg8::CombOrder S; S.init(PW, DM, G, c);
          EpiComb E{(bf16_t*)(ws + WS_WT_PI), DM, args.in[8]};
          pg8::gemm_phase(lds, g, S, E, wave); }
    }
    SEAM(4);
    if (IN(5)) for (int rep_ = 0; rep_ < NDUP(5); ++rep_) { if (rep_) xcd_barrier(bar, wave);
        pg8::Gemm g{(const bf16_t*)(ws + WS_A1), (const bf16_t*)(ws + WS_WT_G0), SEQ, DM, DM, DM, DM}; pg8::StaticOrder S; S.init(SEQ, DM, G, c);
        rstd_table(lds, rp0, S, wave * 64 + lane_id());
        EpiPle E{(const bf16_t*)(ws + WS_A1), (const bf16_t*)(ws + WS_PE0), lds, (bf16_t*)(ws + WS_A2), rp1};
        pg8::gemm_phase(lds, g, S, E, wave);
    }
    SEAM(5);
    if (IN(6)) for (int rep_ = 0; rep_ < NDUP(6); ++rep_) { if (rep_) xcd_barrier(bar, wave);
        pg8::Gemm g{(const bf16_t*)(ws + WS_A2), (const bf16_t*)(ws + WS_WT_PI), SEQ, 2 * PW, DM, DM, DM}; pg8::StaticOrder S; S.init(SEQ, 2 * PW, G, c);
        rstd_table(lds, rp1, S, wave * 64 + lane_id());
        EpiPoolIn E{lds, (bf16_t*)(ws + WS_U), (bf16_t*)(ws + WS_SG1)};
        pg8::gemm_phase(lds, g, S, E, wave);
    }
    SEAM(6);
    if (IN(7)) for (int rep_ = 0; rep_ < NDUP(7); ++rep_) { if (rep_) xcd_barrier(bar, wave); p_pool(args, wave); }
    SEAM(7);
    if (IN(8)) for (int rep_ = 0; rep_ < NDUP(8); ++rep_) { if (rep_) xcd_barrier(bar, wave);
        { pg8::Gemm g{(const bf16_t*)(ws + WS_ZZ), (const bf16_t*)(ws + WS_WT_PO), SEQ, DM, PW, PW, PW}; pg8::StaticOrder S; S.init(SEQ, DM, G, c);
          EpiRes<false> E{nullptr, (const bf16_t*)(ws + WS_A2), (bf16_t*)(ws + WS_A3), rp2};
          pg8::gemm_phase(lds, g, S, E, wave); }
        { pg8::Gemm g{(const bf16_t*)(ws + WS_PBF) + (size_t)SEQ * PLE, (const bf16_t*)(ws + WS_WT_P1), SEQ, DM, PLE, PLE, PLE}; pg8::StaticOrder S; S.init(SEQ, DM, G, c);
          EpiPlain E{(bf16_t*)(ws + WS_PE1), DM};
          pg8::gemm_phase(lds, g, S, E, wave); }
    }
    SEAM(8);
    if (IN(9)) for (int rep_ = 0; rep_ < NDUP(9); ++rep_) { if (rep_) xcd_barrier(bar, wave);
        pg8::Gemm g{(const bf16_t*)(ws + WS_A3), (const bf16_t*)(ws + WS_WT_G1), SEQ, DM, DM, DM, DM}; pg8::StaticOrder S; S.init(SEQ, DM, G, c);
        rstd_table(lds, rp2, S, wave * 64 + lane_id());
        EpiPleFinal E{(const bf16_t*)(ws + WS_A3), (const bf16_t*)(ws + WS_PE1), lds, args.out, args.in[13], (unsigned*)(ws + WS_CTL)};
        pg8::gemm_phase(lds, g, S, E, wave);
    }
#undef IN
#undef SEAM
}

extern "C" void kernel_launch(void* const* d_in, const int* in_sizes, int n_in, void* d_out, int out_size, void* d_ws, size_t ws_size, hipStream_t stream) {
    static int grid = 0;
    if (grid == 0) {
        if (n_in != 14 || out_size != SEQ * DM || ws_size < WS_END) { fprintf(stderr, "kernel_launch: unexpected problem: n_in %d out %d ws %zu (need %zu)\n", n_in, out_size, ws_size, (size_t)WS_END); grid = -1; return; }
        int dev = 0, cus = 0, per_cu = 0;
        if (hipGetDevice(&dev) != hipSuccess || hipDeviceGetAttribute(&cus, hipDeviceAttributeMultiprocessorCount, dev) != hipSuccess) { grid = -1; return; }
        if (hipFuncSetAttribute((const void*)trunk_fwd, hipFuncAttributeMaxDynamicSharedMemorySize, LDS_BYTES) != hipSuccess) { fprintf(stderr, "kernel_launch: hipFuncSetAttribute failed\n"); grid = -1; return; }
        if (hipOccupancyMaxActiveBlocksPerMultiprocessor(&per_cu, (const void*)trunk_fwd, 512, LDS_BYTES) != hipSuccess || per_cu < 1) { fprintf(stderr, "kernel_launch: occupancy query says %d\n", per_cu); (void)hipGetLastError(); }
        grid = cus;
        if (grid != 256) fprintf(stderr, "kernel_launch: %d CUs (built for 256)\n", grid);
    }
    if (grid < 0) return;
    (void)hipMemsetAsync((char*)d_ws + WS_CTL, 0, CTL_ZERO_BYTES, stream);
    Args a{};
    for (int i = 0; i < 14; ++i) a.in[i] = (const float*)d_in[i];
    a.out = (float*)d_out; a.ws = (unsigned char*)d_ws;
    for (int i = 0; i < 128; ++i) { const float lin = (float)i * (1.0f / 127.0f); a.freq[i] = (float)pow(10000.0, -(double)lin); }
    for (int h = 0; h < 8; ++h) { const double lg = log2(1.0 - pow(2.0, -5.0 - (double)h)); a.l2g[h] = (float)lg; a.g256[h] = (float)exp2(256.0 * lg); }
    constexpr int NPH = 10;
    if (MK_N_LAUNCHES == 1) {
        a.ph_lo = 0; a.ph_hi = NPH;
        void* kargs[] = {&a};
        const hipError_t le = hipLaunchCooperativeKernel((const void*)trunk_fwd, dim3(grid), dim3(512), kargs, LDS_BYTES, stream);
        if (le != hipSuccess) fprintf(stderr, "kernel_launch: cooperative launch failed: %s (grid %d)\n", hipGetErrorString(le), grid);
    } else {
        for (int ph = 0; ph < NPH; ++ph) { a.ph_lo = ph; a.ph_hi = ph + 1; hipLaunchKernelGGL(trunk_fwd, dim3(grid), dim3(512), LDS_BYTES, stream, a); }
    }
}
```

```cpp
#include <hip/hip_runtime.h>
#include <cstdio>
#include <cstdint>
#include <cmath>

#ifndef MK_N_LAUNCHES
#define MK_N_LAUNCHES 1
#define CV_BIG 1
#endif

#define LAS __attribute__((address_space(3)))
#define GAS __attribute__((address_space(1)))
typedef unsigned short bf16_t;
typedef short bf16x8 __attribute__((ext_vector_type(8)));
typedef short s16x4 __attribute__((ext_vector_type(4)));
typedef float f32x4 __attribute__((ext_vector_type(4)));
typedef float f32x2 __attribute__((ext_vector_type(2)));
typedef unsigned u32x4 __attribute__((ext_vector_type(4)));
typedef unsigned u32x2 __attribute__((ext_vector_type(2)));

constexpr int SEQ = 8192, DM = 2048, RPROJ = 12288, NH = 8, DKH = 256, DVH = 512, PW = 4096, PLE = 256;
constexpr float NORM_EPS = 1e-6f, GN_EPS = 1e-5f;

constexpr size_t MiB = 1u << 20;
constexpr size_t WS_CTL = 0, CTL_ZERO_BYTES = 128 * 1024;
constexpr size_t WS_RP = 1 * MiB;
constexpr size_t WS_ROPE = 5 * MiB;
constexpr size_t WS_PBF = 13 * MiB;
constexpr size_t WS_WT_RO = 21 * MiB;
constexpr size_t WS_WT_G0 = 37 * MiB;
constexpr size_t WS_WT_P0 = 45 * MiB;
constexpr size_t WS_WT_RI = 46 * MiB;
constexpr size_t WS_XN0 = 94 * MiB;
constexpr size_t WS_QD = 126 * MiB, WS_KD = 158 * MiB, WS_V = 190 * MiB, WS_SG = 254 * MiB;
constexpr size_t WS_Z = WS_SG;
constexpr size_t WS_ST = 318 * MiB;
constexpr size_t WS_WU = 46 * MiB;
constexpr size_t WS_WT_PI = 62 * MiB;
constexpr size_t WS_WT_GR = 94 * MiB, WS_WT_PO = 102 * MiB, WS_WT_G1 = 118 * MiB, WS_WT_P1 = 382 * MiB;
constexpr size_t WS_H1 = 126 * MiB, WS_A1 = 190 * MiB, WS_PE0 = 222 * MiB;
constexpr size_t WS_H2 = 254 * MiB, WS_A2 = 318 * MiB;
constexpr size_t WS_U = 126 * MiB, WS_SG1 = 190 * MiB, WS_ZZ = 254 * MiB;
constexpr size_t WS_H3 = 126 * MiB, WS_A3 = 190 * MiB, WS_PE1 = 222 * MiB;
constexpr size_t WS_END = 383 * MiB;

constexpr int RING_BYTES = 131072;
constexpr int LDS_BYTES = 155648;
constexpr int MISC_OFF = LDS_BYTES - 256;

#define LDS_WAIT() asm volatile("s_waitcnt lgkmcnt(0)" ::: "memory")
#define VM_WAIT() asm volatile("s_waitcnt vmcnt(0)" ::: "memory")

__device__ __forceinline__ unsigned cvt_pk_bf16(float lo, float hi) { unsigned r; asm volatile("v_cvt_pk_bf16_f32 %0, %1, %2" : "=v"(r) : "v"(lo), "v"(hi)); return r; }
__device__ __forceinline__ float bf_lo(unsigned w) { return __uint_as_float(w << 16); }
__device__ __forceinline__ float bf_hi(unsigned w) { return __uint_as_float(w & 0xffff0000u); }
__device__ __forceinline__ float fsigmoid(float x) { return __builtin_amdgcn_rcpf(1.0f + __builtin_amdgcn_exp2f(-1.44269504089f * x)); }
__device__ __forceinline__ float fsilu(float x) { return x * fsigmoid(x); }
__device__ __forceinline__ int lane_id() { int l; asm volatile("v_mbcnt_lo_u32_b32 %0, -1, 0\n\tv_mbcnt_hi_u32_b32 %0, -1, %0" : "=v"(l)); return l; }
__device__ __forceinline__ float wave_sum(float v) {
#pragma unroll
    for (int o = 1; o < 64; o <<= 1) v += __shfl_xor(v, o);
    return v;
}

namespace pg8 {
constexpr int BM = 256, BK = 64, HALF = 128, HTB = HALF * BK * 2, STAGE_BYTES = 8 * HTB, NXCD = 8, WGM = 4;
__host__ __device__ __forceinline__ int lds_byte(int r, int c) { const int st = (r >> 4) * 2 + (c >> 5), rr = r & 15, cc = c & 31, ob = rr * 64 + cc * 2; return st * 1024 + (ob ^ (((ob >> 9) & 1) << 5)); }
__host__ __device__ __forceinline__ void stage_rc(int b, int& R, int& C) { const int st = b / 1024, sb = b % 1024, swz = sb ^ (((sb >> 9) & 1) << 5); R = (st >> 1) * 16 + swz / 64; C = (st & 1) * 32 + (swz % 64) / 2; }
__host__ __device__ __forceinline__ int perm32(int rho) { const int n = rho >> 4, i = rho & 15; return 8 * (i >> 2) + 4 * n + (i & 3); }

struct Unit { int pm, pn, slot; };
struct Gemm { const bf16_t* A; const bf16_t* Bt; int M, N, K, lda, ldb; };

struct StaticOrder {
    int nM, nN, nwg, G, c;
    __host__ __device__ void init(int M, int N, int G_, int c_) { nM = M / BM; nN = N / BM; nwg = nM * nN; G = G_; c = c_; }
    __host__ __device__ bool next(int i, Unit& u) const {
        const long L = (long)i * G + c; if (L >= nwg) return false;
        int wgid = (int)L; { const int q = nwg / NXCD, r = nwg % NXCD, xcd = wgid % NXCD, off = wgid / NXCD; wgid = (xcd < r ? xcd * (q + 1) : r * (q + 1) + (xcd - r) * q) + off; }
        const int nig = WGM * nN, gid = wgid / nig, fm = gid * WGM, gsz = (nM - fm) < WGM ? (nM - fm) : WGM;
        u.pm = fm + ((wgid % nig) % gsz); u.pn = (wgid % nig) / gsz; u.slot = i; return true;
    }
    __device__ __forceinline__ size_t a_off(const Unit&) const { return 0; }
    __device__ __forceinline__ size_t b_off(const Unit&) const { return 0; }
};
struct UpperHalfOrder : StaticOrder {
    __host__ __device__ bool next(int i, Unit& u) const { const int hw = G >> 1, per = nwg / hw; if (c < hw || i >= per) return false; const int L = (c - hw) * per + i; u.pm = L / nN; u.pn = L - u.pm * nN; u.slot = i; return true; }
};
struct CombOrder : StaticOrder {
    __device__ __forceinline__ size_t b_off(const Unit& u) const { return (size_t)(u.pm >> 2) * 2048; }
};

template <class Epi, class Sched, int EPI_REPS = 1>
__device__ __forceinline__ void gemm_phase(LAS unsigned char* lds, const Gemm g, const Sched& S, const Epi& E, const int wid) {
    int lane_ = lane_id(); asm volatile("" : "+v"(lane_));
    const int lane = lane_, tid = wid * 64 + lane, wr = wid >> 2, wc = wid & 3, fr = lane & 15, fq = lane >> 4;
    const int K = g.K, nt = K / BK;
    unsigned voffA[2], voffB[2];
#pragma unroll
    for (int i = 0; i < 2; ++i) { int R, C; stage_rc(tid * 16 + i * 8192, R, C); const int Rb = (R & ~31) + perm32(R & 31);
        voffA[i] = (unsigned)(R * g.lda + C) * 2u; voffB[i] = (unsigned)(Rb * g.ldb + C) * 2u; }
    const size_t kstep = (size_t)(BK * 2);
    const size_t hstepA = (size_t)HALF * g.lda * 2, hstepB = (size_t)HALF * g.ldb * 2;
    const size_t tstepA = 2 * hstepA, tstepB = 2 * hstepB;
    const unsigned ldsw = (unsigned)wid * 1024u;
    const int aoff = lds_byte(wr * 64 + fr, fq * 8), boff = lds_byte(wc * 32 + fr, fq * 8);
#define PG8_SA(b, h) (((b) * 2 + (h)) * HTB)
#define PG8_SB(b, h) ((4 + (b) * 2 + (h)) * HTB)
#define PG8_STAGE(bufoff, gbase, voff) do { _Pragma("unroll") for (int _i = 0; _i < 2; ++_i) \
        __builtin_amdgcn_global_load_lds((const unsigned*)((const char*)(gbase) + (voff)[_i]), (LAS unsigned*)(lds + (bufoff) + ldsw + _i * 8192), 16, 0, 0); } while (0)
#define PG8_LDA(dst, b, h) do { _Pragma("unroll") for (int m = 0; m < 4; ++m) _Pragma("unroll") for (int k = 0; k < 2; ++k) dst[m][k] = *(const LAS bf16x8*)(lds + PG8_SA(b, h) + aoff + m * 2048 + k * 1024); } while (0)
#define PG8_LDB(dst, b, h) do { _Pragma("unroll") for (int n = 0; n < 2; ++n) _Pragma("unroll") for (int k = 0; k < 2; ++k) dst[n][k] = *(const LAS bf16x8*)(lds + PG8_SB(b, h) + boff + n * 2048 + k * 1024); } while (0)
#define PG8_MMA(ai, bj, At, Bt) do { __builtin_amdgcn_s_setprio(1); _Pragma("unroll") for (int m = 0; m < 4; ++m) _Pragma("unroll") for (int n = 0; n < 2; ++n) _Pragma("unroll") for (int k = 0; k < 2; ++k) \
        acc[ai][bj][m][n] = __builtin_amdgcn_mfma_f32_16x16x32_bf16(Bt[n][k], At[m][k], acc[ai][bj][m][n], 0, 0, 0); __builtin_amdgcn_s_setprio(0); } while (0)
#define PG8_WAIT_V(n) asm volatile("s_waitcnt vmcnt(" #n ")" ::: "memory")
#define PG8_WAIT_L(n) asm volatile("s_waitcnt lgkmcnt(" #n ")" ::: "memory")
#define PG8_BAR __builtin_amdgcn_s_barrier()
#define PG8_SCHED __builtin_amdgcn_sched_barrier(0)
    Unit cur, nxt; int ui = 0;
    if (!S.next(0, cur)) return;
    f32x4 acc[2][2][4][2];
#pragma unroll
    for (int a = 0; a < 2; ++a)
#pragma unroll
        for (int b = 0; b < 2; ++b)
#pragma unroll
            for (int m = 0; m < 4; ++m)
#pragma unroll
                for (int n = 0; n < 2; ++n) acc[a][b][m][n] = (f32x4){0.f, 0.f, 0.f, 0.f};
    bf16x8 At[4][2], B0[2][2], B1[2][2];
    const char* cA = (const char*)g.A + (size_t)cur.pm * tstepA + S.a_off(cur); const char* cB = (const char*)g.Bt + (size_t)cur.pn * tstepB + S.b_off(cur);
    PG8_STAGE(PG8_SB(0, 0), cB, voffB); PG8_STAGE(PG8_SB(0, 1), cB + hstepB, voffB); PG8_STAGE(PG8_SA(0, 0), cA, voffA); PG8_STAGE(PG8_SA(0, 1), cA + hstepA, voffA);
    if (wr == 1) PG8_BAR;
    PG8_WAIT_V(2); PG8_BAR;
    PG8_STAGE(PG8_SB(1, 0), cB + kstep, voffB); PG8_STAGE(PG8_SA(1, 0), cA + kstep, voffA); PG8_STAGE(PG8_SB(1, 1), cB + hstepB + kstep, voffB);
    PG8_WAIT_V(6); PG8_BAR;
    for (;;) {
        const bool has_next = S.next(ui + 1, nxt);
        const char* nA = has_next ? (const char*)g.A + (size_t)nxt.pm * tstepA + S.a_off(nxt) : cA; const char* nB = has_next ? (const char*)g.Bt + (size_t)nxt.pn * tstepB + S.b_off(nxt) : cB;
        for (int t = 0; t < nt; t += 2) {
            const bool last = (t == nt - 2);
            const char* a1 = cA + (size_t)(t + 1) * kstep;
            const char* a2 = last ? nA : cA + (size_t)(t + 2) * kstep; const char* b2 = last ? nB : cB + (size_t)(t + 2) * kstep;
            const char* a3 = a2 + kstep; const char* b3 = b2 + kstep;
            PG8_LDB(B0, 0, 0); PG8_LDB(B1, 0, 1); PG8_SCHED; PG8_LDA(At, 0, 0); PG8_STAGE(PG8_SA(1, 1), a1 + hstepA, voffA);
            PG8_WAIT_V(8); PG8_WAIT_L(0); PG8_BAR; PG8_MMA(0, 0, At, B0); PG8_MMA(0, 1, At, B1); PG8_BAR; PG8_SCHED;
            PG8_LDA(At, 0, 1); PG8_STAGE(PG8_SB(0, 0), b2, voffB); PG8_STAGE(PG8_SB(0, 1), b2 + hstepB, voffB); PG8_STAGE(PG8_SA(0, 0), a2, voffA);
            PG8_WAIT_V(8); PG8_WAIT_L(0); PG8_BAR; PG8_MMA(1, 0, At, B0); PG8_MMA(1, 1, At, B1); PG8_BAR; PG8_SCHED;
            PG8_LDB(B0, 1, 0); PG8_LDB(B1, 1, 1); PG8_SCHED; PG8_LDA(At, 1, 0); PG8_STAGE(PG8_SA(0, 1), a2 + hstepA, voffA);
            PG8_WAIT_V(8); PG8_WAIT_L(0); PG8_BAR; PG8_MMA(0, 0, At, B0); PG8_MMA(0, 1, At, B1); PG8_BAR; PG8_SCHED;
            PG8_LDA(At, 1, 1); PG8_STAGE(PG8_SB(1, 0), b3, voffB); PG8_STAGE(PG8_SB(1, 1), b3 + hstepB, voffB); PG8_STAGE(PG8_SA(1, 0), a3, voffA);
            PG8_WAIT_V(8); PG8_WAIT_L(0); PG8_BAR; PG8_MMA(1, 0, At, B0); PG8_MMA(1, 1, At, B1); PG8_BAR; PG8_SCHED;
        }
        if (wr == 0) PG8_BAR;
        for (int er_ = 0; er_ < EPI_REPS; ++er_) { const int l2 = lane_id(); E(acc, cur, wr, wc, l2 & 15, l2 >> 4); }
        if (!has_next) break;
#pragma unroll
        for (int a = 0; a < 2; ++a)
#pragma unroll
            for (int b = 0; b < 2; ++b)
#pragma unroll
                for (int m = 0; m < 4; ++m)
#pragma unroll
                    for (int n = 0; n < 2; ++n) acc[a][b][m][n] = (f32x4){0.f, 0.f, 0.f, 0.f};
        cur = nxt; cA = nA; cB = nB; ++ui;
        if (wr == 1) PG8_BAR;
    }
    PG8_WAIT_V(0);
    PG8_BAR;
#undef PG8_SA
#undef PG8_SB
#undef PG8_STAGE
#undef PG8_LDA
#undef PG8_LDB
#undef PG8_MMA
#undef PG8_WAIT_V
#undef PG8_WAIT_L
#undef PG8_BAR
#undef PG8_SCHED
}
}
using pg8::Unit;

#define EPI_ARGS f32x4 (&acc)[2][2][4][2], const Unit& u, int wr, int wc, int fr, int fq
__device__ __forceinline__ u32x4 pack8(const f32x4 a, const f32x4 b) { u32x4 w; w.x = cvt_pk_bf16(a[0], a[1]); w.y = cvt_pk_bf16(a[2], a[3]); w.z = cvt_pk_bf16(b[0], b[1]); w.w = cvt_pk_bf16(b[2], b[3]); return w; }
__device__ __forceinline__ void unpack8(const u32x4 w, f32x4& a, f32x4& b) { a = (f32x4){bf_lo(w.x), bf_hi(w.x), bf_lo(w.y), bf_hi(w.y)}; b = (f32x4){bf_lo(w.z), bf_hi(w.z), bf_lo(w.w), bf_hi(w.w)}; }
__device__ __forceinline__ float row_rstd(const float* rp, int row) {
    const f32x4* q = (const f32x4*)(rp + (size_t)row * 32); f32x4 s = q[0];
#pragma unroll
    for (int i = 1; i < 8; ++i) s += q[i];
    return __builtin_amdgcn_rsqf(((s[0] + s[1]) + (s[2] + s[3])) * (1.0f / DM) + NORM_EPS);
}
constexpr int RSTD_OFF = RING_BYTES;
template <class Sched> __device__ __forceinline__ void rstd_table(LAS unsigned char* lds, const float* rp, const Sched& S, int tid) {
    LAS float* tab = (LAS float*)(lds + RSTD_OFF); Unit u;
    for (int i = 0; i < 8 && S.next(i, u); ++i) if (tid < 256) tab[i * 256 + tid] = row_rstd(rp, u.pm * 256 + tid);
    __syncthreads();
}
__device__ __forceinline__ float rstd_lds(const LAS unsigned char* lds, int slot, int r) { return ((const LAS float*)(lds + RSTD_OFF))[slot * 256 + r]; }

struct EpiRet1 {
    bf16_t *qd, *kd, *v, *sg; const float* rope; const float* l2g;
    __device__ __forceinline__ void operator()(EPI_ARGS) const {
        const int pn = u.pn, row0 = u.pm * 256 + wr * 64 + fr, c0 = wc * 32 + 8 * fq;
        if (pn < 16) {
            const int head = pn & 7; const bool isk = pn >= 8;
            bf16_t* out = (isk ? kd : qd) + head * 256; const float lg = l2g[head];
#pragma unroll
            for (int ai = 0; ai < 2; ++ai)
#pragma unroll
                for (int m = 0; m < 4; ++m) { const int row = row0 + ai * 128 + m * 16, r = row & 255;
                    const float dec = isk ? __builtin_amdgcn_exp2f(lg * (float)(255 - r)) * 0.0625f : __builtin_amdgcn_exp2f(lg * (float)(r - 255));
#pragma unroll
                    for (int bj = 0; bj < 2; ++bj) { const int c = c0 + bj * 128;
                        const f32x4* rp = (const f32x4*)(rope + ((size_t)row * 128 + (c >> 1)) * 2); const f32x4 t0 = rp[0], t1 = rp[1];
                        const f32x4 x = acc[ai][bj][m][0], y = acc[ai][bj][m][1]; f32x4 o0, o1;
                        o0[0] = (x[0] * t0[0] - x[1] * t0[1]) * dec; o0[1] = (x[1] * t0[0] + x[0] * t0[1]) * dec;
                        o0[2] = (x[2] * t0[2] - x[3] * t0[3]) * dec; o0[3] = (x[3] * t0[2] + x[2] * t0[3]) * dec;
                        o1[0] = (y[0] * t1[0] - y[1] * t1[1]) * dec; o1[1] = (y[1] * t1[0] + y[0] * t1[1]) * dec;
                        o1[2] = (y[2] * t1[2] - y[3] * t1[3]) * dec; o1[3] = (y[3] * t1[2] + y[2] * t1[3]) * dec;
                        if (isk) *(u32x4*)(out + (size_t)row * DM + c) = pack8(o0, o1); else __builtin_nontemporal_store(pack8(o0, o1), (u32x4*)(out + (size_t)row * DM + c)); } }
        } else if (pn < 32) {
            bf16_t* out = v + (pn - 16) * 256 + c0;
#pragma unroll
            for (int ai = 0; ai < 2; ++ai)
#pragma unroll
                for (int m = 0; m < 4; ++m) { const int row = row0 + ai * 128 + m * 16;
#pragma unroll
                    for (int bj = 0; bj < 2; ++bj) *(u32x4*)(out + (size_t)row * PW + bj * 128) = pack8(acc[ai][bj][m][0], acc[ai][bj][m][1]); }
        } else {
            bf16_t* out = sg + (pn - 32) * 256 + c0;
#pragma unroll
            for (int ai = 0; ai < 2; ++ai)
#pragma unroll
                for (int m = 0; m < 4; ++m) { const int row = row0 + ai * 128 + m * 16;
#pragma unroll
                    for (int bj = 0; bj < 2; ++bj) { f32x4 a = acc[ai][bj][m][0], b = acc[ai][bj][m][1];
#pragma unroll
                        for (int e = 0; e < 4; ++e) { a[e] = fsilu(a[e]); b[e] = fsilu(b[e]); }
                        __builtin_nontemporal_store(pack8(a, b), (u32x4*)(out + (size_t)row * PW + bj * 128)); } }
        }
    }
};
struct EpiPlain {
    bf16_t* O; int ldc;
    __device__ __forceinline__ void operator()(EPI_ARGS) const {
        bf16_t* out = O + (size_t)(u.pm * 256 + wr * 64 + fr) * ldc + u.pn * 256 + wc * 32 + 8 * fq;
#pragma unroll
        for (int ai = 0; ai < 2; ++ai)
#pragma unroll
            for (int m = 0; m < 4; ++m)
#pragma unroll
                for (int bj = 0; bj < 2; ++bj) *(u32x4*)(out + (size_t)(ai * 128 + m * 16) * ldc + bj * 128) = pack8(acc[ai][bj][m][0], acc[ai][bj][m][1]);
    }
};
template <bool RESF> struct EpiRes {
    const float* resf; const bf16_t* resb; bf16_t* aout; float* rpo;
    __device__ __forceinline__ void operator()(EPI_ARGS) const {
        const int row0 = u.pm * 256 + wr * 64 + fr, col0 = u.pn * 256 + wc * 32 + 8 * fq;
#pragma unroll
        for (int ai = 0; ai < 2; ++ai) {
            f32x4 rv[4][2][2];
#pragma unroll
            for (int m = 0; m < 4; ++m)
#pragma unroll
                for (int bj = 0; bj < 2; ++bj) { const size_t o = (size_t)(row0 + ai * 128 + m * 16) * DM + col0 + bj * 128;
                    if (RESF) { rv[m][bj][0] = __builtin_nontemporal_load((const f32x4*)(resf + o)); rv[m][bj][1] = __builtin_nontemporal_load((const f32x4*)(resf + o + 4)); }
                    else unpack8(*(const u32x4*)(resb + o), rv[m][bj][0], rv[m][bj][1]); }
#pragma unroll
            for (int m = 0; m < 4; ++m) { const int row = row0 + ai * 128 + m * 16; const size_t off = (size_t)row * DM + col0; float ss = 0.f;
#pragma unroll
                for (int bj = 0; bj < 2; ++bj) { const size_t o = off + bj * 128;
                    const f32x4 h0 = rv[m][bj][0] + acc[ai][bj][m][0], h1 = rv[m][bj][1] + acc[ai][bj][m][1];
                    ss += (h0[0] * h0[0] + h0[1] * h0[1]) + (h0[2] * h0[2] + h0[3] * h0[3]) + (h1[0] * h1[0] + h1[1] * h1[1]) + (h1[2] * h1[2] + h1[3] * h1[3]);
                    *(u32x4*)(aout + o) = pack8(h0, h1); }
                ss += __shfl_xor(ss, 16); ss += __shfl_xor(ss, 32);
                if (fq == 0) rpo[(size_t)row * 32 + u.pn * 4 + wc] = ss; }
            asm volatile("" ::: "memory"); }
    }
};
struct EpiPle {
    const bf16_t* hin; const bf16_t* pe; const LAS unsigned char* lds; bf16_t* aout; float* rpo;
    __device__ __forceinline__ void operator()(EPI_ARGS) const {
        const int row0 = u.pm * 256 + wr * 64 + fr, col0 = u.pn * 256 + wc * 32 + 8 * fq;
#pragma unroll
        for (int ai = 0; ai < 2; ++ai) {
            u32x4 hv[4][2], pv[4][2];
#pragma unroll
            for (int m = 0; m < 4; ++m)
#pragma unroll
                for (int bj = 0; bj < 2; ++bj) { const size_t o = (size_t)(row0 + ai * 128 + m * 16) * DM + col0 + bj * 128; hv[m][bj] = *(const u32x4*)(hin + o); pv[m][bj] = *(const u32x4*)(pe + o); }
#pragma unroll
            for (int m = 0; m < 4; ++m) { const int row = row0 + ai * 128 + m * 16; const size_t off = (size_t)row * DM + col0; float ss = 0.f;
                const float rstd = rstd_lds(lds, u.slot, row & 255);
#pragma unroll
                for (int bj = 0; bj < 2; ++bj) { const size_t o = off + bj * 128;
                    f32x4 h0, h1, p0, p1; unpack8(hv[m][bj], h0, h1); unpack8(pv[m][bj], p0, p1);
                    const f32x4 a0 = acc[ai][bj][m][0], a1 = acc[ai][bj][m][1];
#pragma unroll
                    for (int e = 0; e < 4; ++e) { h0[e] += fsigmoid(a0[e] * rstd) * p0[e]; h1[e] += fsigmoid(a1[e] * rstd) * p1[e]; }
                    ss += (h0[0] * h0[0] + h0[1] * h0[1]) + (h0[2] * h0[2] + h0[3] * h0[3]) + (h1[0] * h1[0] + h1[1] * h1[1]) + (h1[2] * h1[2] + h1[3] * h1[3]);
                    *(u32x4*)(aout + o) = pack8(h0, h1); }
                ss += __shfl_xor(ss, 16); ss += __shfl_xor(ss, 32);
                if (fq == 0) rpo[(size_t)row * 32 + u.pn * 4 + wc] = ss; }
            asm volatile("" ::: "memory"); }
    }
};
constexpr int FN_P_OFF = RING_BYTES + 8192, FN_S_OFF = FN_P_OFF + 4096;
constexpr int CW_FN_CNT = 16384, CW_FN_X = 32768;
struct EpiPleFinal {
    const bf16_t* hin; const bf16_t* pe; LAS unsigned char* lds; float* out; const float* gain; unsigned* ctl;
    __device__ __forceinline__ void operator()(EPI_ARGS) const {
        const int row0 = u.pm * 256 + wr * 64 + fr, col0 = u.pn * 256 + wc * 32 + 8 * fq;
        const int wid = wr * 4 + wc, tid = wid * 64 + fq * 16 + fr;
        LAS float* P = (LAS float*)(lds + FN_P_OFF); LAS float* S = (LAS float*)(lds + FN_S_OFF);
#pragma unroll
        for (int ai = 0; ai < 2; ++ai)
#pragma unroll
            for (int mp = 0; mp < 2; ++mp) {
                u32x4 hv[2][2], pv[2][2];
#pragma unroll
                for (int mm = 0; mm < 2; ++mm)
#pragma unroll
                    for (int bj = 0; bj < 2; ++bj) { const size_t o = (size_t)(row0 + ai * 128 + (2 * mp + mm) * 16) * DM + col0 + bj * 128;
                        hv[mm][bj] = *(const u32x4*)(hin + o); pv[mm][bj] = *(const u32x4*)(pe + o); }
#pragma unroll
                for (int mm = 0; mm < 2; ++mm) { const int m = 2 * mp + mm, row = row0 + ai * 128 + m * 16; float ss = 0.f;
                    const float rstd = rstd_lds(lds, u.slot, row & 255);
#pragma unroll
                    for (int bj = 0; bj < 2; ++bj) {
                        f32x4 h0, h1, p0, p1; unpack8(hv[mm][bj], h0, h1); unpack8(pv[mm][bj], p0, p1);
                        const f32x4 a0 = acc[ai][bj][m][0], a1 = acc[ai][bj][m][1];
#pragma unroll
                        for (int e = 0; e < 4; ++e) { h0[e] += fsigmoid(a0[e] * rstd) * p0[e]; h1[e] += fsigmoid(a1[e] * rstd) * p1[e]; }
                        acc[ai][bj][m][0] = h0; acc[ai][bj][m][1] = h1;
                        ss += (h0[0] * h0[0] + h0[1] * h0[1]) + (h0[2] * h0[2] + h0[3] * h0[3]) + (h1[0] * h1[0] + h1[1] * h1[1]) + (h1[2] * h1[2] + h1[3] * h1[3]); }
                    ss += __shfl_xor(ss, 16); ss += __shfl_xor(ss, 32);
                    if (fq == 0) P[(row & 255) * 4 + wc] = ss; }
                asm volatile("" ::: "memory"); }
        asm volatile("s_waitcnt lgkmcnt(0)" ::: "memory"); __builtin_amdgcn_s_barrier(); asm volatile("" ::: "memory");
        float* X = (float*)(ctl + CW_FN_X); unsigned* cnt = ctl + CW_FN_CNT + 64 * u.pm;
        if (tid < 256) { const float t = (P[tid * 4 + 0] + P[tid * 4 + 1]) + (P[tid * 4 + 2] + P[tid * 4 + 3]);
            __hip_atomic_store(X + ((size_t)(u.pm * 256 + tid) * 8 + u.pn), t, __ATOMIC_RELAXED, __HIP_MEMORY_SCOPE_AGENT);
            asm volatile("s_waitcnt vmcnt(0)" ::: "memory");
            if ((tid & 63) == 0) __hip_atomic_fetch_add(cnt, 1u, __ATOMIC_RELAXED, __HIP_MEMORY_SCOPE_AGENT); }
        if (wid == 0) {
            unsigned spins = 0;
            while ((unsigned)__builtin_amdgcn_readfirstlane(__hip_atomic_load(cnt, __ATOMIC_RELAXED, __HIP_MEMORY_SCOPE_AGENT)) < 32u) { __builtin_amdgcn_s_sleep(2); if (++spins > (1u << 22)) break; }
            __builtin_amdgcn_fence(__ATOMIC_ACQUIRE, "agent");
            asm volatile("s_waitcnt vmcnt(0)" ::: "memory"); }
        asm volatile("s_waitcnt vmcnt(0) lgkmcnt(0)" ::: "memory"); __builtin_amdgcn_s_barrier(); asm volatile("" ::: "memory");
        if (tid < 256) { const float* xs = X + (size_t)(u.pm * 256 + tid) * 8; float s = 0.f;
#pragma unroll
            for (int t = 0; t < 8; ++t) s += __hip_atomic_load(xs + t, __ATOMIC_RELAXED, __HIP_MEMORY_SCOPE_AGENT);
            S[tid] = __builtin_amdgcn_rsqf(s * (1.0f / DM) + NORM_EPS); }
        asm volatile("s_waitcnt lgkmcnt(0)" ::: "memory"); __builtin_amdgcn_s_barrier(); asm volatile("" ::: "memory");
        f32x4 gv[2][2];
#pragma unroll
        for (int bj = 0; bj < 2; ++bj) { gv[bj][0] = *(const f32x4*)(gain + col0 + bj * 128); gv[bj][1] = *(const f32x4*)(gain + col0 + bj * 128 + 4); }
#pragma unroll
        for (int ai = 0; ai < 2; ++ai)
#pragma unroll
            for (int m = 0; m < 4; ++m) { const int row = row0 + ai * 128 + m * 16; const float rs = S[row & 255]; const size_t off = (size_t)row * DM + col0;
#pragma unroll
                for (int bj = 0; bj < 2; ++bj) { *(f32x4*)(out + off + bj * 128) = acc[ai][bj][m][0] * rs * gv[bj][0]; *(f32x4*)(out + off + bj * 128 + 4) = acc[ai][bj][m][1] * rs * gv[bj][1]; } }
    }
};
struct EpiPoolIn {
    const LAS unsigned char* lds; bf16_t* uo; bf16_t* sgo;
    __device__ __forceinline__ void operator()(EPI_ARGS) const {
        const int row0 = u.pm * 256 + wr * 64 + fr; const bool isg = u.pn >= 16;
        bf16_t* out = (isg ? sgo : uo) + (u.pn & 15) * 256 + wc * 32 + 8 * fq;
#pragma unroll
        for (int ai = 0; ai < 2; ++ai)
#pragma unroll
            for (int m = 0; m < 4; ++m) { const int row = row0 + ai * 128 + m * 16; const float rstd = rstd_lds(lds, u.slot, row & 255);
#pragma unroll
                for (int bj = 0; bj < 2; ++bj) { f32x4 a = acc[ai][bj][m][0] * rstd, b = acc[ai][bj][m][1] * rstd;
                    if (isg) {
#pragma unroll
                        for (int e = 0; e < 4; ++e) { a[e] = fsilu(a[e]); b[e] = fsilu(b[e]); } }
                    *(u32x4*)(out + (size_t)row * PW + bj * 128) = pack8(a, b); } }
    }
};
struct EpiComb {
    bf16_t* O; int ldc; const float* scale;
    __device__ __forceinline__ void operator()(EPI_ARGS) const {
        const int row0 = u.pm * 256 + wr * 64 + fr;
        bf16_t* out = O + (size_t)row0 * ldc + u.pn * 256 + wc * 32 + 8 * fq;
#pragma unroll
        for (int ai = 0; ai < 2; ++ai)
#pragma unroll
            for (int m = 0; m < 4; ++m) { const float sc = scale[row0 + ai * 128 + m * 16];
#pragma unroll
                for (int bj = 0; bj < 2; ++bj) *(u32x4*)(out + (size_t)(ai * 128 + m * 16) * ldc + bj * 128) = pack8(acc[ai][bj][m][0] * sc, acc[ai][bj][m][1] * sc); }
    }
};

typedef GAS unsigned gu32;
#define RLX_AGENT __ATOMIC_RELAXED, __HIP_MEMORY_SCOPE_AGENT
#define XB_TMO      128
#define XB_XCNT(j)  (256  + 64 * (j))
#define XB_XSUB(j)  (1280 + 64 * (j))
#define XB_XGEN(j)  (2304 + 64 * (j))
#define XB_TOP      3328
#define XB_TOPGEN   3392
#define XCD_BAR_WORDS 3456
#define XB_SPIN_CAP (1u << 20)
__device__ __forceinline__ unsigned xb_ld(unsigned* p)              { return __hip_atomic_load(p, __ATOMIC_RELAXED, __HIP_MEMORY_SCOPE_AGENT); }
__device__ __forceinline__ unsigned xb_add(unsigned* p, unsigned v) { return __hip_atomic_fetch_add(p, v, __ATOMIC_RELAXED, __HIP_MEMORY_SCOPE_AGENT); }
__device__ __forceinline__ unsigned xb_xcc_id() { return (unsigned)__builtin_amdgcn_s_getreg((3 << 11) | 20) & 0xFu; }
#define XB_SPIN(cond, bar) do { unsigned _sp = 0; while (cond) { __builtin_amdgcn_s_sleep(1); \
    if ((++_sp & 255u) == 0u) { if (xb_ld(&(bar)[XB_TMO])) break; if (_sp > XB_SPIN_CAP) { atomicAdd(&(bar)[XB_TMO], 1u); break; } } } } while (0)
struct XcdBarrier { unsigned* bar; unsigned x; volatile LAS unsigned* st; };
__device__ __forceinline__ XcdBarrier xcd_barrier_post(unsigned* bar, volatile LAS unsigned* st, const int wave) {
    XcdBarrier b; b.bar = bar; b.x = xb_xcc_id(); b.st = st;
    if (wave == 0 && lane_id() == 0) (void)xb_add(&bar[XB_XCNT(b.x)], 1u);
    return b;
}
__device__ __forceinline__ void xcd_barrier_complete(unsigned* bar, unsigned x, unsigned& nloc, unsigned& nx) {
    const unsigned G = gridDim.x * gridDim.y * gridDim.z;
    unsigned sum, cnt, mine, sp = 0u;
    for (;;) {
        sum = 0u; cnt = 0u; mine = 0u;
#pragma unroll
        for (unsigned j = 0; j < 16; ++j) { const unsigned c = xb_ld(&bar[XB_XCNT(j)]); sum += c; cnt += (c > 0u) ? 1u : 0u; mine = (j == x) ? c : mine; }
        if (sum == G) break;
        __builtin_amdgcn_s_sleep(1);
        if ((++sp & 255u) == 0u) { if (xb_ld(&bar[XB_TMO])) break; if (sp > XB_SPIN_CAP) { atomicAdd(&bar[XB_TMO], 1u); break; } }
    }
    nloc = mine > 0u ? mine : 1u; nx = cnt > 0u ? cnt : 1u;
}
__device__ __forceinline__ void xcd_barrier(const XcdBarrier& b, const int wave) {
    asm volatile("s_waitcnt vmcnt(0)" ::: "memory");
    __syncthreads();
    if (wave == 0 && lane_id() == 0) {
        unsigned* bar = b.bar;
        __builtin_amdgcn_s_waitcnt(0);
        unsigned nloc = b.st[0], nx = b.st[1];
        if (nloc == 0u) { xcd_barrier_complete(bar, b.x, nloc, nx); b.st[0] = nloc; b.st[1] = nx; }
        const unsigned old = xb_add(&bar[XB_XSUB(b.x)], 1u);
        const unsigned gen = old / nloc;
        if (old + 1u == (gen + 1u) * nloc) {
            __builtin_amdgcn_fence(__ATOMIC_RELEASE, "agent");
            asm volatile("s_waitcnt vmcnt(0)" ::: "memory");
            const unsigned og = xb_add(&bar[XB_TOP], 1u);
            const unsigned tg = og / nx;
            if (og + 1u == (tg + 1u) * nx) xb_add(&bar[XB_TOPGEN], 1u);
            else XB_SPIN(xb_ld(&bar[XB_TOPGEN]) == tg, bar);
            __builtin_amdgcn_fence(__ATOMIC_ACQUIRE, "agent");
            xb_add(&bar[XB_XGEN(b.x)], 1u);
            asm volatile("s_waitcnt vmcnt(0)" ::: "memory");
        } else {
            XB_SPIN(xb_ld(&bar[XB_XGEN(b.x)]) == gen, bar);
            __builtin_amdgcn_fence(__ATOMIC_ACQUIRE, "agent");
            asm volatile("s_waitcnt vmcnt(0)" ::: "memory");
        }
    }
    __syncthreads();
}

__device__ __forceinline__ void tr_item(const float* W, int N, bf16_t* WT, int Kt, LAS float* scr, int item, int lane) {
    const int nblk = N >> 6, kb = item / nblk, nb = item - kb * nblk, k0 = kb << 6, n0 = nb << 6;
    const int c = lane & 15, rr = lane >> 4;
    f32x4 v[16];
#pragma unroll
    for (int i = 0; i < 16; ++i) v[i] = __builtin_nontemporal_load((const f32x4*)(W + (size_t)(k0 + 4 * i + rr) * N + n0 + 4 * c));
#pragma unroll
    for (int i = 0; i < 16; ++i) { LAS float* s = scr + (4 * i + rr) * 65 + 4 * c; s[0] = v[i][0]; s[1] = v[i][1]; s[2] = v[i][2]; s[3] = v[i][3]; }
    LDS_WAIT();
    const int kc = lane & 7;
#pragma unroll
    for (int jj = 0; jj < 8; ++jj) { const int n = (lane >> 3) + 8 * jj; const LAS float* s = scr + (8 * kc) * 65 + n;
        u32x4 o; o.x = cvt_pk_bf16(s[0], s[65]); o.y = cvt_pk_bf16(s[130], s[195]); o.z = cvt_pk_bf16(s[260], s[325]); o.w = cvt_pk_bf16(s[390], s[455]);
        *(u32x4*)(WT + (size_t)(n0 + n) * Kt + k0 + 8 * kc) = o; }
    LDS_WAIT();
}
__device__ __forceinline__ double sin2pi(double r) {
    r -= rint(r);
    if (r > 0.25) r = 0.5 - r; else if (r < -0.25) r = -0.5 - r;
    const double x = r * 6.283185307179586476925, x2 = x * x;
    double p = -1.0 / 1307674368000.0;
    p = p * x2 + 1.0 / 6227020800.0; p = p * x2 - 1.0 / 39916800.0; p = p * x2 + 1.0 / 362880.0; p = p * x2 - 1.0 / 5040.0;
    p = p * x2 + 1.0 / 120.0; p = p * x2 - 1.0 / 6.0; p = p * x2 + 1.0;
    return x * p;
}

struct Args { const float* in[14]; float* out; unsigned char* ws; float freq[128]; float l2g[8]; float g256[8]; int ph_lo, ph_hi; };

__device__ __forceinline__ void p_prologue(const Args& a, LAS unsigned char* lds, const int wave) {
    const int lane = lane_id(), tid = wave * 64 + lane;
    unsigned char* ws = a.ws;
    LAS float* scr = (LAS float*)(lds + wave * 16640);
    const int gw = blockIdx.x * 8 + wave, NGW = gridDim.x * 8;
    constexpr int I_RI = (DM / 64) * (RPROJ / 64);
    for (int it = gw; it < I_RI; it += NGW) tr_item(a.in[3], RPROJ, (bf16_t*)(ws + WS_WT_RI), DM, scr, it, lane);
    const float* x = a.in[0]; const float* gain = a.in[2]; bf16_t* xn = (bf16_t*)(ws + WS_XN0);
    for (int m = gw; m < SEQ; m += NGW) {
        const f32x4* xr = (const f32x4*)(x + (size_t)m * DM) + 2 * lane; f32x4 v[8]; float s = 0.f;
#pragma unroll
        for (int j = 0; j < 8; ++j) { v[j] = __builtin_nontemporal_load(xr + 128 * (j >> 1) + (j & 1)); s += (v[j][0] * v[j][0] + v[j][1] * v[j][1]) + (v[j][2] * v[j][2] + v[j][3] * v[j][3]); }
        const float rstd = __builtin_amdgcn_rsqf(wave_sum(s) * (1.0f / DM) + NORM_EPS);
        u32x4* o = (u32x4*)(xn + (size_t)m * DM) + lane;
#pragma unroll
        for (int j = 0; j < 4; ++j) { const f32x4 g0 = *((const f32x4*)gain + 2 * lane + 128 * j), g1 = *((const f32x4*)gain + 2 * lane + 128 * j + 1); o[64 * j] = pack8(v[2 * j] * rstd * g0, v[2 * j + 1] * rstd * g1); }
    }
    const int gt = blockIdx.x * 512 + tid, NGT = gridDim.x * 512;
    { const float* p = a.in[1]; bf16_t* pb = (bf16_t*)(ws + WS_PBF);
      for (int i = gt; i < 2 * SEQ * PLE / 8; i += NGT) { const f32x4 a0 = __builtin_nontemporal_load((const f32x4*)(p + (size_t)i * 8)), a1 = __builtin_nontemporal_load((const f32x4*)(p + (size_t)i * 8 + 4)); *(u32x4*)(pb + (size_t)i * 8) = pack8(a0, a1); } }
    { f32x4* rope = (f32x4*)(ws + WS_ROPE);
      for (int i = gt; i < SEQ * 64; i += NGT) { const int pos = i >> 6, fi = (i & 63) * 2; const float a0 = (float)pos * a.freq[fi], a1 = (float)pos * a.freq[fi + 1];
          const double r0 = (double)a0 * 0.15915494309189533577, r1 = (double)a1 * 0.15915494309189533577;
          rope[i] = (f32x4){(float)sin2pi(r0 + 0.25), (float)sin2pi(r0), (float)sin2pi(r1 + 0.25), (float)sin2pi(r1)}; } }
}
struct CvDesc { const float* src; bf16_t* dst; const float* kg; int N, Kt, plain; };
constexpr int CV_RO = (PW / 64) * (DM / 32), CV_G = (DM / 64) * (DM / 32), CV_P = (PLE / 64) * (DM / 32), CV_PIG = (DM / 64) * (PW / 32), CV_GR = (1024 / 64) * (1024 / 32), CV_WU = DM * PW / 2048;
constexpr int CV_ITEMS = CV_RO + 2 * CV_G + 2 * CV_P + CV_PIG + 4 * CV_GR + CV_RO + CV_WU;
__device__ __forceinline__ CvDesc cv_tr(const float* W, int N, int ncols, bf16_t* WT, int Kt, int r, const float* kg = nullptr) {
    const int nblk = ncols >> 5, kb = r / nblk, nb = r - kb * nblk; CvDesc d; d.src = W + (size_t)(kb * 64) * N + nb * 32; d.dst = WT + (size_t)(nb * 32) * Kt + kb * 64; d.kg = kg ? kg + kb * 64 : nullptr; d.N = N; d.Kt = Kt; d.plain = 0; return d; }
__device__ __forceinline__ CvDesc cv_decode(const Args& a, int r) {
    unsigned char* ws = a.ws;
    if (r < CV_RO) return cv_tr(a.in[4], DM, DM, (bf16_t*)(ws + WS_WT_RO), PW, r); r -= CV_RO;
    if (r < CV_G) return cv_tr(a.in[11], DM, DM, (bf16_t*)(ws + WS_WT_G0), DM, r, a.in[10]); r -= CV_G;
    if (r < CV_G) return cv_tr(a.in[11] + (size_t)DM * DM, DM, DM, (bf16_t*)(ws + WS_WT_G1), DM, r, a.in[10] + DM); r -= CV_G;
    if (r < CV_P) return cv_tr(a.in[12], DM, DM, (bf16_t*)(ws + WS_WT_P0), PLE, r); r -= CV_P;
    if (r < CV_P) return cv_tr(a.in[12] + (size_t)PLE * DM, DM, DM, (bf16_t*)(ws + WS_WT_P1), PLE, r); r -= CV_P;
    if (r < CV_PIG) return cv_tr(a.in[6] + PW, 2 * PW, PW, (bf16_t*)(ws + WS_WT_PI) + (size_t)PW * DM, DM, r, a.in[5]); r -= CV_PIG;
    if (r < 4 * CV_GR) { const int g = r / CV_GR; return cv_tr(a.in[7] + (size_t)g * 1024 * 1024, 1024, 1024, (bf16_t*)(ws + WS_WT_GR) + (size_t)g * 1024 * 1024, 1024, r - g * CV_GR); } r -= 4 * CV_GR;
    if (r < CV_RO) return cv_tr(a.in[9], DM, DM, (bf16_t*)(ws + WS_WT_PO), PW, r); r -= CV_RO;
    CvDesc d; const int row = r >> 1, c0 = (r & 1) * 2048; d.src = a.in[6] + (size_t)row * (2 * PW) + c0; d.dst = (bf16_t*)(ws + WS_WU) + (size_t)row * PW + c0; d.kg = a.in[5] + row; d.N = 0; d.Kt = 0; d.plain = 1; return d;
}
__device__ __forceinline__ void cv_load(const CvDesc& d, f32x4 (&cv)[8], int lane) {
    if (d.plain) {
#pragma unroll
        for (int j = 0; j < 4; ++j) { cv[2 * j] = __builtin_nontemporal_load((const f32x4*)(d.src + lane * 8 + 512 * j)); cv[2 * j + 1] = __builtin_nontemporal_load((const f32x4*)(d.src + lane * 8 + 512 * j + 4)); }
    } else {
#pragma unroll
        for (int i = 0; i < 8; ++i) cv[i] = __builtin_nontemporal_load((const f32x4*)(d.src + (size_t)(8 * i + (lane >> 3)) * d.N + 4 * (lane & 7)));
    }
}
__device__ __forceinline__ void cv_store(const CvDesc& d, const f32x4 (&cv)[8], LAS float* scr, int lane) {
    if (d.plain) {
        const float kgv = d.kg[0];
#pragma unroll
        for (int j = 0; j < 4; ++j) *(u32x4*)(d.dst + lane * 8 + 512 * j) = pack8(cv[2 * j] * kgv, cv[2 * j + 1] * kgv);
    } else {
#pragma unroll
        for (int i = 0; i < 8; ++i) { const float kgv = d.kg ? d.kg[8 * i + (lane >> 3)] : 1.0f; LAS float* s = scr + (8 * i + (lane >> 3)) * 33 + 4 * (lane & 7); s[0] = cv[i][0] * kgv; s[1] = cv[i][1] * kgv; s[2] = cv[i][2] * kgv; s[3] = cv[i][3] * kgv; }
        LDS_WAIT();
        const int kc = lane & 7;
#pragma unroll
        for (int j = 0; j < 4; ++j) { const int n = (lane >> 3) + 8 * j; const LAS float* s = scr + (8 * kc) * 33 + n;
            u32x4 o; o.x = cvt_pk_bf16(s[0], s[33]); o.y = cvt_pk_bf16(s[66], s[99]); o.z = cvt_pk_bf16(s[132], s[165]); o.w = cvt_pk_bf16(s[198], s[231]);
            *(u32x4*)(d.dst + (size_t)n * d.Kt + 8 * kc) = o; }
        LDS_WAIT();
    }
}

__device__ __forceinline__ void tr_item_g(const float* W, int N, int ncols, bf16_t* WT, int Kt, LAS float* scr, int item, int lane, const float* kg) {
    const int nblk = ncols >> 6, kb = item / nblk, nb = item - kb * nblk, k0 = kb << 6, n0 = nb << 6;
    const int c = lane & 15, rr = lane >> 4;
    f32x4 v[16];
#pragma unroll
    for (int i = 0; i < 16; ++i) v[i] = __builtin_nontemporal_load((const f32x4*)(W + (size_t)(k0 + 4 * i + rr) * N + n0 + 4 * c));
#pragma unroll
    for (int i = 0; i < 16; ++i) { const float g = kg ? kg[k0 + 4 * i + rr] : 1.0f; LAS float* s = scr + (4 * i + rr) * 65 + 4 * c; s[0] = v[i][0] * g; s[1] = v[i][1] * g; s[2] = v[i][2] * g; s[3] = v[i][3] * g; }
    LDS_WAIT();
    const int kc = lane & 7;
#pragma unroll
    for (int jj = 0; jj < 8; ++jj) { const int n = (lane >> 3) + 8 * jj; const LAS float* s = scr + (8 * kc) * 65 + n;
        u32x4 o; o.x = cvt_pk_bf16(s[0], s[65]); o.y = cvt_pk_bf16(s[130], s[195]); o.z = cvt_pk_bf16(s[260], s[325]); o.w = cvt_pk_bf16(s[390], s[455]);
        *(u32x4*)(WT + (size_t)(n0 + n) * Kt + k0 + 8 * kc) = o; }
    LDS_WAIT();
}
__device__ __forceinline__ void p_weights_big(const Args& a, LAS unsigned char* lds, const int wave) {
    const int lane = lane_id();
    unsigned char* ws = a.ws;
    LAS float* scr = (LAS float*)(lds + wave * 16640);
    const int gw = (blockIdx.x - 128) * 8 + wave, NGW = (gridDim.x - 128) * 8;
    constexpr int I_RO = (PW / 64) * (DM / 64), I_G = (DM / 64) * (DM / 64), I_P = (PLE / 64) * (DM / 64), I_PIG = (DM / 64) * (PW / 64), I_GR = (1024 / 64) * (1024 / 64), I_WU = DM * PW / 2048;
    for (int it = gw; it < I_RO + 2 * I_G + 2 * I_P + I_PIG + 4 * I_GR + I_RO + I_WU; it += NGW) {
        int r = it;
        if (r < I_RO) { tr_item_g(a.in[4], DM, DM, (bf16_t*)(ws + WS_WT_RO), PW, scr, r, lane, nullptr); continue; } r -= I_RO;
        if (r < I_G) { tr_item_g(a.in[11], DM, DM, (bf16_t*)(ws + WS_WT_G0), DM, scr, r, lane, a.in[10]); continue; } r -= I_G;
        if (r < I_G) { tr_item_g(a.in[11] + (size_t)DM * DM, DM, DM, (bf16_t*)(ws + WS_WT_G1), DM, scr, r, lane, a.in[10] + DM); continue; } r -= I_G;
        if (r < I_P) { tr_item_g(a.in[12], DM, DM, (bf16_t*)(ws + WS_WT_P0), PLE, scr, r, lane, nullptr); continue; } r -= I_P;
        if (r < I_P) { tr_item_g(a.in[12] + (size_t)PLE * DM, DM, DM, (bf16_t*)(ws + WS_WT_P1), PLE, scr, r, lane, nullptr); continue; } r -= I_P;
        if (r < I_PIG) { tr_item_g(a.in[6] + PW, 2 * PW, PW, (bf16_t*)(ws + WS_WT_PI) + (size_t)PW * DM, DM, scr, r, lane, a.in[5]); continue; } r -= I_PIG;
        if (r < 4 * I_GR) { const int g = r / I_GR; tr_item_g(a.in[7] + (size_t)g * 1024 * 1024, 1024, 1024, (bf16_t*)(ws + WS_WT_GR) + (size_t)g * 1024 * 1024, 1024, scr, r - g * I_GR, lane, nullptr); continue; } r -= 4 * I_GR;
        if (r < I_RO) { tr_item_g(a.in[9], DM, DM, (bf16_t*)(ws + WS_WT_PO), PW, scr, r, lane, nullptr); continue; } r -= I_RO;
        { const int row = r >> 1, c0 = (r & 1) * 2048 + lane * 8; const float* srcp = a.in[6] + (size_t)row * (2 * PW) + c0; bf16_t* dstp = (bf16_t*)(ws + WS_WU) + (size_t)row * PW + c0; const float g = a.in[5][row];
#pragma unroll
            for (int j = 0; j < 4; ++j) { const f32x4 x0 = __builtin_nontemporal_load((const f32x4*)(srcp + 512 * j)), x1 = __builtin_nontemporal_load((const f32x4*)(srcp + 512 * j + 4)); *(u32x4*)(dstp + 512 * j) = pack8(x0 * g, x1 * g); } }
    }
}

__device__ __forceinline__ bf16x8 tr_frag(const LAS unsigned char* p, int pitch16) {
    const s16x4 lo = __builtin_amdgcn_ds_read_tr16_b64_v4i16((LAS s16x4*)p), hi = __builtin_amdgcn_ds_read_tr16_b64_v4i16((LAS s16x4*)(p + pitch16));
    return (bf16x8){lo[0], lo[1], lo[2], lo[3], hi[0], hi[1], hi[2], hi[3]};
}

__device__ __forceinline__ void p_scan(const Args& a, LAS unsigned char* lds, const int w) {
    const int lane = lane_id();
    const int tid = w * 64 + lane, b = blockIdx.x, h = b & 7, tt = b >> 3, dt = tt >> 2, vt = tt & 3;
    const int db = w >> 1, vbp = w & 1, g = lane >> 4, i16 = lane & 15, q4 = i16 >> 2, p4 = i16 & 3;
    const float g256 = a.g256[h];
    constexpr int PK = 160, PV = 288, TK = 128 * PK, TV = 128 * PV, BUF = TK + TV;
    const bf16_t* kbase = (const bf16_t*)(a.ws + WS_KD) + h * 256 + dt * 64;
    const bf16_t* vbase = (const bf16_t*)(a.ws + WS_V) + h * 512 + vt * 128;
    bf16_t* st = (bf16_t*)(a.ws + WS_ST);
    u32x4 rk0[2], rv0[4], rk1[2], rv1[4], rk2[2], rv2[4], rk3[2], rv3[4];
#define P2_LOAD(RK, RV, hs) do { const int _hs = (hs) < 62 ? (hs) : 61; \
        _Pragma("unroll") for (int _i = 0; _i < 2; ++_i) { const int _p = tid + 512 * _i; RK[_i] = *(const u32x4*)(kbase + (size_t)(_hs * 128 + (_p >> 3)) * DM + (_p & 7) * 8); } \
        _Pragma("unroll") for (int _i = 0; _i < 4; ++_i) { const int _p = tid + 512 * _i; RV[_i] = *(const u32x4*)(vbase + (size_t)(_hs * 128 + (_p >> 4)) * PW + (_p & 15) * 8); } } while (0)
#define P2_STORE(RK, RV, s) do { \
        _Pragma("unroll") for (int _i = 0; _i < 2; ++_i) { const int _p = tid + 512 * _i; *(LAS u32x4*)(lds + (s) * BUF + (_p >> 3) * PK + (_p & 7) * 16) = RK[_i]; } \
        _Pragma("unroll") for (int _i = 0; _i < 4; ++_i) { const int _p = tid + 512 * _i; *(LAS u32x4*)(lds + (s) * BUF + TK + (_p >> 4) * PV + (_p & 15) * 16) = RV[_i]; } } while (0)
    f32x4 acc[4];
#pragma unroll
    for (int j = 0; j < 4; ++j) acc[j] = (f32x4){0.f, 0.f, 0.f, 0.f};
    const int lk = (4 * g + q4) * PK + 8 * p4 + db * 32, lv = (4 * g + q4) * PV + 16 * p4 + vbp * 128;
#define P2_STEP(hs, RKN, RVN) do { const int _h = (hs); if (_h < 62) { \
        const LAS unsigned char* kt = lds + (_h & 1) * BUF + lk; const LAS unsigned char* vtp = lds + (_h & 1) * BUF + TK + lv; \
        _Pragma("unroll") for (int ks = 0; ks < 4; ++ks) { \
            const bf16x8 kf = tr_frag(kt + ks * 32 * PK, 16 * PK); \
            _Pragma("unroll") for (int j = 0; j < 4; ++j) { const bf16x8 vf = tr_frag(vtp + ks * 32 * PV + 64 * (j >> 1) + 8 * (j & 1), 16 * PV); acc[j] = __builtin_amdgcn_mfma_f32_16x16x32_bf16(vf, kf, acc[j], 0, 0, 0); } } \
        if (_h & 1) { const int n = _h >> 1; \
            bf16_t* o = st + ((size_t)(n * 8 + h) * 256 + dt * 64 + db * 16 + i16) * 512 + vt * 128 + vbp * 64 + 8 * g; \
            _Pragma("unroll") for (int j = 0; j < 4; ++j) acc[j] *= g256; \
            _Pragma("unroll") for (int k = 0; k < 2; ++k) *(u32x4*)(o + 32 * k) = pack8(acc[2 * k], acc[2 * k + 1]); } \
        if (_h + 1 < 62) { P2_STORE(RKN, RVN, (_h + 1) & 1); P2_LOAD(RKN, RVN, _h + 5); } \
        __syncthreads(); } } while (0)
    P2_LOAD(rk0, rv0, 0); P2_LOAD(rk1, rv1, 1); P2_LOAD(rk2, rv2, 2); P2_LOAD(rk3, rv3, 3);
    P2_STORE(rk0, rv0, 0); P2_LOAD(rk0, rv0, 4); __syncthreads();
    for (int hs = 0; hs < 62; hs += 4) {
        P2_STEP(hs, rk1, rv1); P2_STEP(hs + 1, rk2, rv2); P2_STEP(hs + 2, rk3, rv3); P2_STEP(hs + 3, rk0, rv0);
    }
#undef P2_STEP
#undef P2_LOAD
#undef P2_STORE
}

__device__ __forceinline__ void p_retention(const Args& a, LAS unsigned char* lds, const int w) {
    const int lane = lane_id();
    const int tid = w * 64 + lane, b = blockIdx.x;
    const int g = lane >> 4, i16 = lane & 15, q4 = i16 >> 2, p4 = i16 & 3;
    constexpr int PP = 528, RINGO = 128 * PP, RB = 33792, ST1 = RINGO + 2 * RB, ST2 = ST1 + 8192;
    const bf16_t* qd = (const bf16_t*)(a.ws + WS_QD); const bf16_t* kd = (const bf16_t*)(a.ws + WS_KD); const bf16_t* v = (const bf16_t*)(a.ws + WS_V);
    const bf16_t* sg = (const bf16_t*)(a.ws + WS_SG); const bf16_t* st = (const bf16_t*)(a.ws + WS_ST); bf16_t* z = (bf16_t*)(a.ws + WS_Z);
    const unsigned offk = (unsigned)(((tid >> 5) * DM + (tid & 31) * 8) * 2), offv = (unsigned)(((tid >> 6) * PW + (tid & 63) * 8) * 2), offt = (unsigned)(((tid >> 6) * 512 + (tid & 63) * 8) * 2);
    const int xs = b & 7, kq = b >> 3, pair = kq >> 1, member = kq & 1;
    for (int rnd = 0; rnd < 2; ++rnd) {
        const int nh = (pair * 2 + rnd) * 8 + xs, n = nh >> 3, h = nh & 7, hf = member ^ rnd;
        const int nsb = 2 * (hf + 1), nvb = 4 * (hf + 1), ntb = n > 0 ? 8 : 0, nblk = nsb + nvb + ntb;
        const int rowbase = 256 * n + 128 * hf;
        u32x4 ra[4], rb[4];
#define P3_LOAD(R, it) do { const int _it = (it) < nblk ? (it) : nblk - 1; \
        if (_it < ntb) { const char* _b = (const char*)(st + ((size_t)((n - 1) * 8 + h) * 256 + 32 * _it) * 512); unsigned _o = offt; asm volatile("" : "+v"(_o)); \
            _Pragma("unroll") for (int _i = 0; _i < 4; ++_i) R[_i] = *(const u32x4*)(_b + (size_t)_i * (8 * 512 * 2) + _o); } \
        else if (_it < ntb + nsb) { const char* _b = (const char*)(kd + (size_t)(256 * n + 64 * (_it - ntb)) * DM + h * 256); unsigned _o = offk; asm volatile("" : "+v"(_o)); \
            _Pragma("unroll") for (int _i = 0; _i < 4; ++_i) R[_i] = *(const u32x4*)(_b + (size_t)_i * (16 * DM * 2) + _o); } \
        else { const char* _b = (const char*)(v + (size_t)(256 * n + 32 * (_it - ntb - nsb)) * PW + h * 512); unsigned _o = offv; asm volatile("" : "+v"(_o)); \
            _Pragma("unroll") for (int _i = 0; _i < 4; ++_i) R[_i] = *(const u32x4*)(_b + (size_t)_i * (8 * PW * 2) + _o); } } while (0)
#define P3_STORE(R, it) do { const int _it = (it); if (_it < nblk) { LAS unsigned char* _d = lds + RINGO + (_it & 1) * RB; \
        if (_it >= ntb && _it < ntb + nsb) { _Pragma("unroll") for (int _i = 0; _i < 4; ++_i) { const int _p = tid + 512 * _i; *(LAS u32x4*)(_d + (_p >> 5) * 528 + (_p & 31) * 16) = R[_i]; } } \
        else { _Pragma("unroll") for (int _i = 0; _i < 4; ++_i) { const int _p = tid + 512 * _i; *(LAS u32x4*)(_d + (_p >> 6) * 1056 + (_p & 63) * 16) = R[_i]; } } } } while (0)
        P3_LOAD(ra, 0); P3_LOAD(rb, 1);
        if (ntb) {
#pragma unroll 2
            for (int i = 0; i < 8; ++i) { const int p = tid + 512 * i, row = p >> 5, c = p & 31, G = c >> 2, cc = c & 3;
                const u32x4 x = *(const u32x4*)(qd + (size_t)(rowbase + row) * DM + h * 256 + c * 8);
                const int s = cc >> 1, glo = (2 * cc) & 3, ghi = (2 * cc + 1) & 3;
                LAS unsigned char* d = lds + row * PP + 64 * G;
                *(LAS u32x2*)(d + 8 * (2 * glo + s)) = (u32x2){x.x, x.y}; *(LAS u32x2*)(d + 8 * (2 * ghi + s)) = (u32x2){x.z, x.w}; }
        }
        P3_STORE(ra, 0); P3_LOAD(ra, 2); __syncthreads();
        f32x4 acc[8][4];
#pragma unroll
        for (int rbk = 0; rbk < 8; ++rbk)
#pragma unroll
            for (int cb = 0; cb < 4; ++cb) acc[rbk][cb] = (f32x4){0.f, 0.f, 0.f, 0.f};
#define P3_YSTEP(it_, RN, ISV) do { const int it = (it_); \
            const LAS unsigned char* ring = lds + RINGO + (it & 1) * RB; \
            { const int kk = (ISV) ? it - ntb - nsb : it; \
                bf16x8 vf[4]; \
                _Pragma("unroll") for (int cb = 0; cb < 4; ++cb) vf[cb] = tr_frag(ring + (4 * g + q4) * 1056 + (64 * w + 32 * (cb >> 1) + 8 * p4 + 4 * (cb & 1)) * 2, 16 * 1056);   \
                _Pragma("unroll") for (int rbk = 0; rbk < 8; ++rbk) { \
                    if ((ISV) && 32 * kk > 128 * hf + 16 * rbk + 15) continue; \
                    const bf16x8 pf = *(const LAS bf16x8*)(lds + (16 * rbk + i16) * PP + (32 * kk + 8 * g) * 2); \
                    _Pragma("unroll") for (int cb = 0; cb < 4; ++cb) acc[rbk][cb] = __builtin_amdgcn_mfma_f32_16x16x32_bf16(vf[cb], pf, acc[rbk][cb], 0, 0, 0); \
                } } \
            P3_STORE(RN, it + 1); P3_LOAD(RN, it + 3); \
            __syncthreads(); } while (0)
        for (int it2 = 0; it2 < ntb; it2 += 2) { P3_YSTEP(it2, rb, false); P3_YSTEP(it2 + 1, ra, false); }
        {
            bf16x8 qf[8];
#pragma unroll
            for (int ds = 0; ds < 8; ++ds) qf[ds] = *(const bf16x8*)(qd + (size_t)(rowbase + 16 * w + i16) * DM + h * 256 + 32 * ds + 8 * g);
#define P3_SSTEP(it_, RN) do { const int it = (it_), sbk = it - ntb; \
                const LAS unsigned char* ring = lds + RINGO + (it & 1) * RB; \
                _Pragma("unroll") for (int sb = 0; sb < 4; ++sb) { \
                    const int j0 = 64 * sbk + 16 * sb, i0 = 128 * hf + 16 * w; \
                    LAS unsigned char* dst = lds + (16 * w + i16) * PP + (32 * (2 * sbk + (sb >> 1)) + 8 * g + 4 * (sb & 1)) * 2; \
                    if (j0 > i0) { *(LAS u32x2*)dst = (u32x2){0u, 0u}; } \
                    else { \
                        f32x4 s4 = {0.f, 0.f, 0.f, 0.f}; \
                        _Pragma("unroll") for (int ds = 0; ds < 8; ++ds) { const bf16x8 kf = *(const LAS bf16x8*)(ring + (16 * sb + i16) * 528 + (32 * ds + 8 * g) * 2); \
                            s4 = __builtin_amdgcn_mfma_f32_16x16x32_bf16(kf, qf[ds], s4, 0, 0, 0); } \
                        if (j0 == i0) { _Pragma("unroll") for (int r = 0; r < 4; ++r) if (4 * g + r > i16) s4[r] = 0.f; } \
                        u32x2 wv; wv.x = cvt_pk_bf16(s4[0], s4[1]); wv.y = cvt_pk_bf16(s4[2], s4[3]); *(LAS u32x2*)dst = wv; \
                    } \
                } \
                P3_STORE(RN, it + 1); P3_LOAD(RN, it + 3); \
                __syncthreads(); } while (0)
            for (int it2 = ntb; it2 < ntb + nsb; it2 += 2) { P3_SSTEP(it2, rb); P3_SSTEP(it2 + 1, ra); }
#undef P3_SSTEP
        }
        for (int it2 = ntb + nsb; it2 < nblk; it2 += 2) { P3_YSTEP(it2, rb, true); P3_YSTEP(it2 + 1, ra, true); }
#undef P3_YSTEP
#undef P3_LOAD
#undef P3_STORE
        LAS f32x2* S1 = (LAS f32x2*)(lds + ST1); LAS f32x2* S2 = (LAS f32x2*)(lds + ST2);
#pragma unroll
        for (int rbk = 0; rbk < 8; ++rbk) { float s1 = 0.f, s2 = 0.f;
#pragma unroll
            for (int cb = 0; cb < 4; ++cb) { const f32x4 y = acc[rbk][cb]; s1 += (y[0] + y[1]) + (y[2] + y[3]); s2 += (y[0] * y[0] + y[1] * y[1]) + (y[2] * y[2] + y[3] * y[3]); }
            s1 += __shfl_xor(s1, 16); s1 += __shfl_xor(s1, 32); s2 += __shfl_xor(s2, 16); s2 += __shfl_xor(s2, 32);
            if (g == 0) S1[(16 * rbk + i16) * 8 + w] = (f32x2){s1, s2}; }
        __syncthreads();
        if (tid < 128) { float s1 = 0.f, s2 = 0.f;
#pragma unroll
            for (int k = 0; k < 8; ++k) { const f32x2 t = S1[tid * 8 + k]; s1 += t.x; s2 += t.y; }
            const float mean = s1 * (1.0f / 512.0f), var = s2 * (1.0f / 512.0f) - mean * mean;
            S2[tid] = (f32x2){mean, __builtin_amdgcn_rsqf(fmaxf(var, 0.f) + GN_EPS)}; }
        __syncthreads();
#pragma unroll
        for (int rbk = 0; rbk < 8; ++rbk) { const f32x2 ms = S2[16 * rbk + i16];
            const size_t off = (size_t)(rowbase + 16 * rbk + i16) * PW + h * 512 + 64 * w + 8 * g;
#pragma unroll
            for (int k = 0; k < 2; ++k) { const u32x4 gw = *(const u32x4*)(sg + off + 32 * k); f32x4 g0, g1; unpack8(gw, g0, g1);
                const f32x4 y0 = (acc[rbk][2 * k] - ms.x) * ms.y * g0, y1 = (acc[rbk][2 * k + 1] - ms.x) * ms.y * g1;
                *(u32x4*)(z + off + 32 * k) = pack8(y0, y1); } }
        __syncthreads();
    }
}

template <int W> __device__ __forceinline__ void pool_run(const bf16_t* uc, const bf16_t* gc, bf16_t* dc, int t0) {
    u32x4 ring[W]; f32x4 s0 = {0.f, 0.f, 0.f, 0.f}, s1 = {0.f, 0.f, 0.f, 0.f};
#pragma unroll
    for (int k = 0; k < W; ++k) { const int t = t0 - W + k; ring[k] = t >= 0 ? *(const u32x4*)(uc + (size_t)t * PW) : (u32x4){0u, 0u, 0u, 0u}; f32x4 x0, x1; unpack8(ring[k], x0, x1); s0 += x0; s1 += x1; }
    for (int tb = t0; tb < t0 + 32; tb += W) {
        u32x4 xr[W], gr[W];
#pragma unroll
        for (int k = 0; k < W; ++k) { xr[k] = *(const u32x4*)(uc + (size_t)(tb + k) * PW); gr[k] = *(const u32x4*)(gc + (size_t)(tb + k) * PW); }
#pragma unroll
        for (int k = 0; k < W; ++k) { const int t = tb + k;
            f32x4 x0, x1, y0, y1, g0, g1; unpack8(xr[k], x0, x1); unpack8(ring[k], y0, y1); unpack8(gr[k], g0, g1);
            s0 += x0 - y0; s1 += x1 - y1; ring[k] = xr[k];
            const float inv = 1.0f / (float)(t + 1 < W ? t + 1 : W);
            *(u32x4*)(dc + (size_t)t * PW) = pack8((s0 * inv - x0) * g0, (s1 * inv - x1) * g1); }
    }
}
__device__ __forceinline__ void p_pool(const Args& a, const int wave) {
    const int tid = wave * 64 + lane_id();
    const bf16_t* u = (const bf16_t*)(a.ws + WS_U); const bf16_t* sg = (const bf16_t*)(a.ws + WS_SG1); bf16_t* d = (bf16_t*)(a.ws + WS_ZZ);
    for (int task = blockIdx.x * 512 + tid; task < 512 * 256; task += gridDim.x * 512) {
        const int chunk = task & 511, run = task >> 9, grp = chunk >> 7, t0 = run * 32;
        const bf16_t* uc = u + chunk * 8; const bf16_t* gc = sg + chunk * 8; bf16_t* dc = d + chunk * 8;
        if (grp == 0) pool_run<2>(uc, gc, dc, t0); else if (grp == 1) pool_run<4>(uc, gc, dc, t0); else if (grp == 2) pool_run<8>(uc, gc, dc, t0); else pool_run<16>(uc, gc, dc, t0);
    }
}
__device__ __forceinline__ void p_final(const Args& a, const int wave) {
    const int lane = lane_id();
    const float* rp = (const float*)(a.ws + WS_RP + 3 * MiB); const float* gain = a.in[13]; float* out = a.out;
    for (int m = blockIdx.x * 8 + wave; m < SEQ; m += gridDim.x * 8) {
        const float part = lane < 32 ? rp[(size_t)m * 32 + lane] : 0.f;
        const float rstd = __builtin_amdgcn_rsqf(wave_sum(part) * (1.0f / DM) + NORM_EPS);
        f32x4* o = (f32x4*)(out + (size_t)m * DM) + lane;
#pragma unroll
        for (int j = 0; j < 8; ++j) { const f32x4 g = *((const f32x4*)gain + lane + 64 * j); o[64 * j] = o[64 * j] * rstd * g; }
    }
}

__global__ void __launch_bounds__(512, 2) trunk_fwd(Args args) {
    extern __shared__ __attribute__((aligned(16))) unsigned char lds_raw[];
    LAS unsigned char* lds = (LAS unsigned char*)lds_raw;
    const int wave = __builtin_amdgcn_readfirstlane(threadIdx.x >> 6);
    unsigned char* ws = args.ws;
    volatile LAS unsigned* MISC = (volatile LAS unsigned*)(lds + MISC_OFF);
    if (threadIdx.x < 64) MISC[threadIdx.x] = 0u;
    __syncthreads();
    XcdBarrier bar; bar.bar = (unsigned*)(ws + WS_CTL) + 4096; bar.x = 0; bar.st = nullptr;
    const int lo = args.ph_lo, hi = args.ph_hi;
    if (hi - lo > 1) bar = xcd_barrier_post((unsigned*)(ws + WS_CTL) + 4096, MISC + 8, wave);
#ifndef PH_MASK
#define PH_MASK 0x3FF
#endif
#define IN(k) (((PH_MASK >> (k)) & 1) && lo <= (k) && (k) < hi)
#define SEAM(k) do { if (IN(k) && IN((k) + 1)) xcd_barrier(bar, wave); } while (0)
#ifndef DUP_MASK
#define DUP_MASK 0
#endif
#define NDUP(k) (((DUP_MASK >> (k)) & 1) ? 2 : 1)
    const int G = gridDim.x, c = blockIdx.x;
    float* rp0 = (float*)(ws + WS_RP); float* rp1 = rp0 + SEQ * 32; float* rp2 = rp1 + SEQ * 32; float* rp3 = rp2 + SEQ * 32;

    if (IN(0)) for (int rep_ = 0; rep_ < NDUP(0); ++rep_) { if (rep_) xcd_barrier(bar, wave); p_prologue(args, lds, wave); VM_WAIT(); __syncthreads(); }
    SEAM(0);
    if (IN(1)) for (int rep_ = 0; rep_ < NDUP(1); ++rep_) { if (rep_) xcd_barrier(bar, wave);
        pg8::Gemm g{(const bf16_t*)(ws + WS_XN0), (const bf16_t*)(ws + WS_WT_RI), SEQ, RPROJ, DM, DM, DM}; pg8::StaticOrder S; S.init(SEQ, RPROJ, G, c);
        EpiRet1 E{(bf16_t*)(ws + WS_QD), (bf16_t*)(ws + WS_KD), (bf16_t*)(ws + WS_V), (bf16_t*)(ws + WS_SG), (const float*)(ws + WS_ROPE), args.l2g};
        pg8::gemm_phase(lds, g, S, E, wave);
    }
    SEAM(1);
    if (IN(2)) for (int rep_ = 0; rep_ < NDUP(2); ++rep_) { if (rep_) xcd_barrier(bar, wave); if (c < 128) p_scan(args, lds, wave); else p_weights_big(args, lds, wave);
        VM_WAIT(); __syncthreads(); }
    SEAM(2);
    if (IN(3)) for (int rep_ = 0; rep_ < NDUP(3); ++rep_) { if (rep_) xcd_barrier(bar, wave); p_retention(args, lds, wave); }
    SEAM(3);
    if (IN(4)) for (int rep_ = 0; rep_ < NDUP(4); ++rep_) { if (rep_) xcd_barrier(bar, wave);
        { pg8::Gemm g{(const bf16_t*)(ws + WS_Z), (const bf16_t*)(ws + WS_WT_RO), SEQ, DM, PW, PW, PW}; pg8::StaticOrder S; S.init(SEQ, DM, G, c);
          EpiRes<true> E{args.in[0], nullptr, (bf16_t*)(ws + WS_A1), rp0};
          pg8::gemm_phase(lds, g, S, E, wave); }
        { pg8::Gemm g{(const bf16_t*)(ws + WS_PBF), (const bf16_t*)(ws + WS_WT_P0), SEQ, DM, PLE, PLE, PLE}; pg8::UpperHalfOrder S; S.init(SEQ, DM, G, c);
          EpiPlain E{(bf16_t*)(ws + WS_PE0), DM};
          pg8::gemm_phase(lds, g, S, E, wave); }
        { pg8::Gemm g{(const bf16_t*)(ws + WS_WT_GR), (const bf16_t*)(ws + WS_WU), PW, DM, 1024, 1024, PW}; pg8::CombOrder S; S.init(PW, DM, G, c);
          EpiComb E{(bf16_t*)(ws + WS_WT_PI), DM, args.in[8]};
          pg8::gemm_phase(lds, g, S, E, wave); }
    }
    SEAM(4);
    if (IN(5)) for (int rep_ = 0; rep_ < NDUP(5); ++rep_) { if (rep_) xcd_barrier(bar, wave);
        pg8::Gemm g{(const bf16_t*)(ws + WS_A1), (const bf16_t*)(ws + WS_WT_G0), SEQ, DM, DM, DM, DM}; pg8::StaticOrder S; S.init(SEQ, DM, G, c);
        rstd_table(lds, rp0, S, wave * 64 + lane_id());
        EpiPle E{(const bf16_t*)(ws + WS_A1), (const bf16_t*)(ws + WS_PE0), lds, (bf16_t*)(ws + WS_A2), rp1};
        pg8::gemm_phase(lds, g, S, E, wave);
    }
    SEAM(5);
    if (IN(6)) for (int rep_ = 0; rep_ < NDUP(6); ++rep_) { if (rep_) xcd_barrier(bar, wave);
        pg8::Gemm g{(const bf16_t*)(ws + WS_A2), (const bf16_t*)(ws + WS_WT_PI), SEQ, 2 * PW, DM, DM, DM}; pg8::StaticOrder S; S.init(SEQ, 2 * PW, G, c);
        rstd_table(lds, rp1, S, wave * 64 + lane_id());
        EpiPoolIn E{lds, (bf16_t*)(ws + WS_U), (bf16_t*)(ws + WS_SG1)};
        pg8::gemm_phase(lds, g, S, E, wave);
    }
    SEAM(6);
    if (IN(7)) for (int rep_ = 0; rep_ < NDUP(7); ++rep_) { if (rep_) xcd_barrier(bar, wave); p_pool(args, wave); }
    SEAM(7);
    if (IN(8)) for (int rep_ = 0; rep_ < NDUP(8); ++rep_) { if (rep_) xcd_barrier(bar, wave);
        { pg8::Gemm g{(const bf16_t*)(ws + WS_ZZ), (const bf16_t*)(ws + WS_WT_PO), SEQ, DM, PW, PW, PW}; pg8::StaticOrder S; S.init(SEQ, DM, G, c);
          EpiRes<false> E{nullptr, (const bf16_t*)(ws + WS_A2), (bf16_t*)(ws + WS_A3), rp2};
          pg8::gemm_phase(lds, g, S, E, wave); }
        { pg8::Gemm g{(const bf16_t*)(ws + WS_PBF) + (size_t)SEQ * PLE, (const bf16_t*)(ws + WS_WT_P1), SEQ, DM, PLE, PLE, PLE}; pg8::StaticOrder S; S.init(SEQ, DM, G, c);
          EpiPlain E{(bf16_t*)(ws + WS_PE1), DM};
          pg8::gemm_phase(lds, g, S, E, wave); }
    }
    SEAM(8);
    if (IN(9)) for (int rep_ = 0; rep_ < NDUP(9); ++rep_) { if (rep_) xcd_barrier(bar, wave);
        pg8::Gemm g{(const bf16_t*)(ws + WS_A3), (const bf16_t*)(ws + WS_WT_G1), SEQ, DM, DM, DM, DM}; pg8::StaticOrder S; S.init(SEQ, DM, G, c);
        rstd_table(lds, rp2, S, wave * 64 + lane_id());
        EpiPleFinal E{(const bf16_t*)(ws + WS_A3), (const bf16_t*)(ws + WS_PE1), lds, args.out, args.in[13], (unsigned*)(ws + WS_CTL)};
        pg8::gemm_phase(lds, g, S, E, wave);
    }
#undef IN
#undef SEAM
}

extern "C" void kernel_launch(void* const* d_in, const int* in_sizes, int n_in, void* d_out, int out_size, void* d_ws, size_t ws_size, hipStream_t stream) {
    static int grid = 0;
    if (grid == 0) {
        if (n_in != 14 || out_size != SEQ * DM || ws_size < WS_END) { fprintf(stderr, "kernel_launch: unexpected problem: n_in %d out %d ws %zu (need %zu)\n", n_in, out_size, ws_size, (size_t)WS_END); grid = -1; return; }
        int dev = 0, cus = 0, per_cu = 0;
        if (hipGetDevice(&dev) != hipSuccess || hipDeviceGetAttribute(&cus, hipDeviceAttributeMultiprocessorCount, dev) != hipSuccess) { grid = -1; return; }
        if (hipFuncSetAttribute((const void*)trunk_fwd, hipFuncAttributeMaxDynamicSharedMemorySize, LDS_BYTES) != hipSuccess) { fprintf(stderr, "kernel_launch: hipFuncSetAttribute failed\n"); grid = -1; return; }
        if (hipOccupancyMaxActiveBlocksPerMultiprocessor(&per_cu, (const void*)trunk_fwd, 512, LDS_BYTES) != hipSuccess || per_cu < 1) { fprintf(stderr, "kernel_launch: occupancy query says %d\n", per_cu); (void)hipGetLastError(); }
        grid = cus;
        if (grid != 256) fprintf(stderr, "kernel_launch: %d CUs (built for 256)\n", grid);
    }
    if (grid < 0) return;
    (void)hipMemsetAsync((char*)d_ws + WS_CTL, 0, CTL_ZERO_BYTES, stream);
    Args a{};
    for (int i = 0; i < 14; ++i) a.in[i] = (const float*)d_in[i];
    a.out = (float*)d_out; a.ws = (unsigned char*)d_ws;
    for (int i = 0; i < 128; ++i) { const float lin = (float)i * (1.0f / 127.0f); a.freq[i] = (float)pow(10000.0, -(double)lin); }
    for (int h = 0; h < 8; ++h) { const double lg = log2(1.0 - pow(2.0, -5.0 - (double)h)); a.l2g[h] = (float)lg; a.g256[h] = (float)exp2(256.0 * lg); }
    constexpr int NPH = 10;
    if (MK_N_LAUNCHES == 1) {
        a.ph_lo = 0; a.ph_hi = NPH;
        void* kargs[] = {&a};
        const hipError_t le = hipLaunchCooperativeKernel((const void*)trunk_fwd, dim3(grid), dim3(512), kargs, LDS_BYTES, stream);
        if (le != hipSuccess) fprintf(stderr, "kernel_launch: cooperative launch failed: %s (grid %d)\n", hipGetErrorString(le), grid);
    } else {
        for (int ph = 0; ph < NPH; ++ph) { a.ph_lo = ph; a.ph_hi = ph + 1; hipLaunchKernelGGL(trunk_fwd, dim3(grid), dim3(512), LDS_BYTES, stream, a); }
    }
}
```

```cpp
#include <hip/hip_runtime.h>
#include <cstdio>
#include <cstdint>
#include <cmath>

#ifndef MK_N_LAUNCHES
#define MK_N_LAUNCHES 1
#define CV_BIG 1
#endif

#define LAS __attribute__((address_space(3)))
#define GAS __attribute__((address_space(1)))
typedef unsigned short bf16_t;
typedef short bf16x8 __attribute__((ext_vector_type(8)));
typedef short s16x4 __attribute__((ext_vector_type(4)));
typedef float f32x4 __attribute__((ext_vector_type(4)));
typedef float f32x2 __attribute__((ext_vector_type(2)));
typedef unsigned u32x4 __attribute__((ext_vector_type(4)));
typedef unsigned u32x2 __attribute__((ext_vector_type(2)));

constexpr int SEQ = 8192, DM = 2048, RPROJ = 12288, NH = 8, DKH = 256, DVH = 512, PW = 4096, PLE = 256;
constexpr float NORM_EPS = 1e-6f, GN_EPS = 1e-5f;

constexpr size_t MiB = 1u << 20;
constexpr size_t WS_CTL = 0, CTL_ZERO_BYTES = 128 * 1024;
constexpr size_t WS_RP = 1 * MiB;
constexpr size_t WS_ROPE = 5 * MiB;
constexpr size_t WS_PBF = 13 * MiB;
constexpr size_t WS_WT_RO = 21 * MiB;
constexpr size_t WS_WT_G0 = 37 * MiB;
constexpr size_t WS_WT_P0 = 45 * MiB;
constexpr size_t WS_WT_RI = 46 * MiB;
constexpr size_t WS_XN0 = 94 * MiB;
constexpr size_t WS_QD = 126 * MiB, WS_KD = 158 * MiB, WS_V = 190 * MiB, WS_SG = 254 * MiB;
constexpr size_t WS_Z = WS_SG;
constexpr size_t WS_ST = 318 * MiB;
constexpr size_t WS_WU = 46 * MiB;
constexpr size_t WS_WT_PI = 62 * MiB;
constexpr size_t WS_WT_GR = 94 * MiB, WS_WT_PO = 102 * MiB, WS_WT_G1 = 118 * MiB, WS_WT_P1 = 382 * MiB;
constexpr size_t WS_H1 = 126 * MiB, WS_A1 = 190 * MiB, WS_PE0 = 222 * MiB;
constexpr size_t WS_H2 = 254 * MiB, WS_A2 = 318 * MiB;
constexpr size_t WS_U = 126 * MiB, WS_SG1 = 190 * MiB, WS_ZZ = 254 * MiB;
constexpr size_t WS_H3 = 126 * MiB, WS_A3 = 190 * MiB, WS_PE1 = 222 * MiB;
constexpr size_t WS_END = 383 * MiB;

constexpr int RING_BYTES = 131072;
constexpr int LDS_BYTES = 155648;
constexpr int MISC_OFF = LDS_BYTES - 256;

#define LDS_WAIT() asm volatile("s_waitcnt lgkmcnt(0)" ::: "memory")
#define VM_WAIT() asm volatile("s_waitcnt vmcnt(0)" ::: "memory")

__device__ __forceinline__ unsigned cvt_pk_bf16(float lo, float hi) { unsigned r; asm volatile("v_cvt_pk_bf16_f32 %0, %1, %2" : "=v"(r) : "v"(lo), "v"(hi)); return r; }
__device__ __forceinline__ float bf_lo(unsigned w) { return __uint_as_float(w << 16); }
__device__ __forceinline__ float bf_hi(unsigned w) { return __uint_as_float(w & 0xffff0000u); }
__device__ __forceinline__ float fsigmoid(float x) { return __builtin_amdgcn_rcpf(1.0f + __builtin_amdgcn_exp2f(-1.44269504089f * x)); }
__device__ __forceinline__ float fsilu(float x) { return x * fsigmoid(x); }
__device__ __forceinline__ int lane_id() { int l; asm volatile("v_mbcnt_lo_u32_b32 %0, -1, 0\n\tv_mbcnt_hi_u32_b32 %0, -1, %0" : "=v"(l)); return l; }
__device__ __forceinline__ float wave_sum(float v) {
#pragma unroll
    for (int o = 1; o < 64; o <<= 1) v += __shfl_xor(v, o);
    return v;
}

namespace pg8 {
constexpr int BM = 256, BK = 64, HALF = 128, HTB = HALF * BK * 2, STAGE_BYTES = 8 * HTB, NXCD = 8, WGM = 4;
__host__ __device__ __forceinline__ int lds_byte(int r, int c) { const int st = (r >> 4) * 2 + (c >> 5), rr = r & 15, cc = c & 31, ob = rr * 64 + cc * 2; return st * 1024 + (ob ^ (((ob >> 9) & 1) << 5)); }
__host__ __device__ __forceinline__ void stage_rc(int b, int& R, int& C) { const int st = b / 1024, sb = b % 1024, swz = sb ^ (((sb >> 9) & 1) << 5); R = (st >> 1) * 16 + swz / 64; C = (st & 1) * 32 + (swz % 64) / 2; }
__host__ __device__ __forceinline__ int perm32(int rho) { const int n = rho >> 4, i = rho & 15; return 8 * (i >> 2) + 4 * n + (i & 3); }

struct Unit { int pm, pn, slot; };
struct Gemm { const bf16_t* A; const bf16_t* Bt; int M, N, K, lda, ldb; };

struct StaticOrder {
    int nM, nN, nwg, G, c;
    __host__ __device__ void init(int M, int N, int G_, int c_) { nM = M / BM; nN = N / BM; nwg = nM * nN; G = G_; c = c_; }
    __host__ __device__ bool next(int i, Unit& u) const {
        const long L = (long)i * G + c; if (L >= nwg) return false;
        int wgid = (int)L; { const int q = nwg / NXCD, r = nwg % NXCD, xcd = wgid % NXCD, off = wgid / NXCD; wgid = (xcd < r ? xcd * (q + 1) : r * (q + 1) + (xcd - r) * q) + off; }
        const int nig = WGM * nN, gid = wgid / nig, fm = gid * WGM, gsz = (nM - fm) < WGM ? (nM - fm) : WGM;
        u.pm = fm + ((wgid % nig) % gsz); u.pn = (wgid % nig) / gsz; u.slot = i; return true;
    }
    __device__ __forceinline__ size_t a_off(const Unit&) const { return 0; }
    __device__ __forceinline__ size_t b_off(const Unit&) const { return 0; }
};
struct UpperHalfOrder : StaticOrder {
    __host__ __device__ bool next(int i, Unit& u) const { const int hw = G >> 1, per = nwg / hw; if (c < hw || i >= per) return false; const int L = (c - hw) * per + i; u.pm = L / nN; u.pn = L - u.pm * nN; u.slot = i; return true; }
};
struct CombOrder : StaticOrder {
    __device__ __forceinline__ size_t b_off(const Unit& u) const { return (size_t)(u.pm >> 2) * 2048; }
};

template <class Epi, class Sched, int EPI_REPS = 1>
__device__ __forceinline__ void gemm_phase(LAS unsigned char* lds, const Gemm g, const Sched& S, const Epi& E, const int wid) {
    int lane_ = lane_id(); asm volatile("" : "+v"(lane_));
    const int lane = lane_, tid = wid * 64 + lane, wr = wid >> 2, wc = wid & 3, fr = lane & 15, fq = lane >> 4;
    const int K = g.K, nt = K / BK;
    unsigned voffA[2], voffB[2];
#pragma unroll
    for (int i = 0; i < 2; ++i) { int R, C; stage_rc(tid * 16 + i * 8192, R, C); const int Rb = (R & ~31) + perm32(R & 31);
        voffA[i] = (unsigned)(R * g.lda + C) * 2u; voffB[i] = (unsigned)(Rb * g.ldb + C) * 2u; }
    const size_t kstep = (size_t)(BK * 2);
    const size_t hstepA = (size_t)HALF * g.lda * 2, hstepB = (size_t)HALF * g.ldb * 2;
    const size_t tstepA = 2 * hstepA, tstepB = 2 * hstepB;
    const unsigned ldsw = (unsigned)wid * 1024u;
    const int aoff = lds_byte(wr * 64 + fr, fq * 8), boff = lds_byte(wc * 32 + fr, fq * 8);
#define PG8_SA(b, h) (((b) * 2 + (h)) * HTB)
#define PG8_SB(b, h) ((4 + (b) * 2 + (h)) * HTB)
#define PG8_STAGE(bufoff, gbase, voff) do { _Pragma("unroll") for (int _i = 0; _i < 2; ++_i) \
        __builtin_amdgcn_global_load_lds((const unsigned*)((const char*)(gbase) + (voff)[_i]), (LAS unsigned*)(lds + (bufoff) + ldsw + _i * 8192), 16, 0, 0); } while (0)
#define PG8_LDA(dst, b, h) do { _Pragma("unroll") for (int m = 0; m < 4; ++m) _Pragma("unroll") for (int k = 0; k < 2; ++k) dst[m][k] = *(const LAS bf16x8*)(lds + PG8_SA(b, h) + aoff + m * 2048 + k * 1024); } while (0)
#define PG8_LDB(dst, b, h) do { _Pragma("unroll") for (int n = 0; n < 2; ++n) _Pragma("unroll") for (int k = 0; k < 2; ++k) dst[n][k] = *(const LAS bf16x8*)(lds + PG8_SB(b, h) + boff + n * 2048 + k * 1024); } while (0)
#define PG8_MMA(ai, bj, At, Bt) do { __builtin_amdgcn_s_setprio(1); _Pragma("unroll") for (int m = 0; m < 4; ++m) _Pragma("unroll") for (int n = 0; n < 2; ++n) _Pragma("unroll") for (int k = 0; k < 2; ++k) \
        acc[ai][bj][m][n] = __builtin_amdgcn_mfma_f32_16x16x32_bf16(Bt[n][k], At[m][k], acc[ai][bj][m][n], 0, 0, 0); __builtin_amdgcn_s_setprio(0); } while (0)
#define PG8_WAIT_V(n) asm volatile("s_waitcnt vmcnt(" #n ")" ::: "memory")
#define PG8_WAIT_L(n) asm volatile("s_waitcnt lgkmcnt(" #n ")" ::: "memory")
#define PG8_BAR __builtin_amdgcn_s_barrier()
#define PG8_SCHED __builtin_amdgcn_sched_barrier(0)
    Unit cur, nxt; int ui = 0;
    if (!S.next(0, cur)) return;
    f32x4 acc[2][2][4][2];
#pragma unroll
    for (int a = 0; a < 2; ++a)
#pragma unroll
        for (int b = 0; b < 2; ++b)
#pragma unroll
            for (int m = 0; m < 4; ++m)
#pragma unroll
                for (int n = 0; n < 2; ++n) acc[a][b][m][n] = (f32x4){0.f, 0.f, 0.f, 0.f};
    bf16x8 At[4][2], B0[2][2], B1[2][2];
    const char* cA = (const char*)g.A + (size_t)cur.pm * tstepA + S.a_off(cur); const char* cB = (const char*)g.Bt + (size_t)cur.pn * tstepB + S.b_off(cur);
    PG8_STAGE(PG8_SB(0, 0), cB, voffB); PG8_STAGE(PG8_SB(0, 1), cB + hstepB, voffB); PG8_STAGE(PG8_SA(0, 0), cA, voffA); PG8_STAGE(PG8_SA(0, 1), cA + hstepA, voffA);
    if (wr == 1) PG8_BAR;
    PG8_WAIT_V(2); PG8_BAR;
    PG8_STAGE(PG8_SB(1, 0), cB + kstep, voffB); PG8_STAGE(PG8_SA(1, 0), cA + kstep, voffA); PG8_STAGE(PG8_SB(1, 1), cB + hstepB + kstep, voffB);
    PG8_WAIT_V(6); PG8_BAR;
    for (;;) {
        const bool has_next = S.next(ui + 1, nxt);
        const char* nA = has_next ? (const char*)g.A + (size_t)nxt.pm * tstepA + S.a_off(nxt) : cA; const char* nB = has_next ? (const char*)g.Bt + (size_t)nxt.pn * tstepB + S.b_off(nxt) : cB;
        for (int t = 0; t < nt; t += 2) {
            const bool last = (t == nt - 2);
            const char* a1 = cA + (size_t)(t + 1) * kstep;
            const char* a2 = last ? nA : cA + (size_t)(t + 2) * kstep; const char* b2 = last ? nB : cB + (size_t)(t + 2) * kstep;
            const char* a3 = a2 + kstep; const char* b3 = b2 + kstep;
            PG8_LDB(B0, 0, 0); PG8_LDB(B1, 0, 1); PG8_SCHED; PG8_LDA(At, 0, 0); PG8_STAGE(PG8_SA(1, 1), a1 + hstepA, voffA);
            PG8_WAIT_V(8); PG8_WAIT_L(0); PG8_BAR; PG8_MMA(0, 0, At, B0); PG8_MMA(0, 1, At, B1); PG8_BAR; PG8_SCHED;
            PG8_LDA(At, 0, 1); PG8_STAGE(PG8_SB(0, 0), b2, voffB); PG8_STAGE(PG8_SB(0, 1), b2 + hstepB, voffB); PG8_STAGE(PG8_SA(0, 0), a2, voffA);
            PG8_WAIT_V(8); PG8_WAIT_L(0); PG8_BAR; PG8_MMA(1, 0, At, B0); PG8_MMA(1, 1, At, B1); PG8_BAR; PG8_SCHED;
            PG8_LDB(B0, 1, 0); PG8_LDB(B1, 1, 1); PG8_SCHED; PG8_LDA(At, 1, 0); PG8_STAGE(PG8_SA(0, 1), a2 + hstepA, voffA);
            PG8_WAIT_V(8); PG8_WAIT_L(0); PG8_BAR; PG8_MMA(0, 0, At, B0); PG8_MMA(0, 1, At, B1); PG8_BAR; PG8_SCHED;
            PG8_LDA(At, 1, 1); PG8_STAGE(PG8_SB(1, 0), b3, voffB); PG8_STAGE(PG8_SB(1, 1), b3 + hstepB, voffB); PG8_STAGE(PG8_SA(1, 0), a3, voffA);
            PG8_WAIT_V(8); PG8_WAIT_L(0); PG8_BAR; PG8_MMA(1, 0, At, B0); PG8_MMA(1, 1, At, B1); PG8_BAR; PG8_SCHED;
        }
        if (wr == 0) PG8_BAR;
        for (int er_ = 0; er_ < EPI_REPS; ++er_) { const int l2 = lane_id(); E(acc, cur, wr, wc, l2 & 15, l2 >> 4); }
        if (!has_next) break;
#pragma unroll
        for (int a = 0; a < 2; ++a)
#pragma unroll
            for (int b = 0; b < 2; ++b)
#pragma unroll
                for (int m = 0; m < 4; ++m)
#pragma unroll
                    for (int n = 0; n < 2; ++n) acc[a][b][m][n] = (f32x4){0.f, 0.f, 0.f, 0.f};
        cur = nxt; cA = nA; cB = nB; ++ui;
        if (wr == 1) PG8_BAR;
    }
    PG8_WAIT_V(0);
    PG8_BAR;
#undef PG8_SA
#undef PG8_SB
#undef PG8_STAGE
#undef PG8_LDA
#undef PG8_LDB
#undef PG8_MMA
#undef PG8_WAIT_V
#undef PG8_WAIT_L
#undef PG8_BAR
#undef PG8_SCHED
}
}
using pg8::Unit;

#define EPI_ARGS f32x4 (&acc)[2][2][4][2], const Unit& u, int wr, int wc, int fr, int fq
__device__ __forceinline__ u32x4 pack8(const f32x4 a, const f32x4 b) { u32x4 w; w.x = cvt_pk_bf16(a[0], a[1]); w.y = cvt_pk_bf16(a[2], a[3]); w.z = cvt_pk_bf16(b[0], b[1]); w.w = cvt_pk_bf16(b[2], b[3]); return w; }
__device__ __forceinline__ void unpack8(const u32x4 w, f32x4& a, f32x4& b) { a = (f32x4){bf_lo(w.x), bf_hi(w.x), bf_lo(w.y), bf_hi(w.y)}; b = (f32x4){bf_lo(w.z), bf_hi(w.z), bf_lo(w.w), bf_hi(w.w)}; }
__device__ __forceinline__ float row_rstd(const float* rp, int row) {
    const f32x4* q = (const f32x4*)(rp + (size_t)row * 32); f32x4 s = q[0];
#pragma unroll
    for (int i = 1; i < 8; ++i) s += q[i];
    return __builtin_amdgcn_rsqf(((s[0] + s[1]) + (s[2] + s[3])) * (1.0f / DM) + NORM_EPS);
}
constexpr int RSTD_OFF = RING_BYTES;
template <class Sched> __device__ __forceinline__ void rstd_table(LAS unsigned char* lds, const float* rp, const Sched& S, int tid) {
    LAS float* tab = (LAS float*)(lds + RSTD_OFF); Unit u;
    for (int i = 0; i < 8 && S.next(i, u); ++i) if (tid < 256) tab[i * 256 + tid] = row_rstd(rp, u.pm * 256 + tid);
    __syncthreads();
}
__device__ __forceinline__ float rstd_lds(const LAS unsigned char* lds, int slot, int r) { return ((const LAS float*)(lds + RSTD_OFF))[slot * 256 + r]; }

struct EpiRet1 {
    bf16_t *qd, *kd, *v, *sg; const float* rope; const float* l2g;
    __device__ __forceinline__ void operator()(EPI_ARGS) const {
        const int pn = u.pn, row0 = u.pm * 256 + wr * 64 + fr, c0 = wc * 32 + 8 * fq;
        if (pn < 16) {
            const int head = pn & 7; const bool isk = pn >= 8;
            bf16_t* out = (isk ? kd : qd) + head * 256; const float lg = l2g[head];
#pragma unroll
            for (int ai = 0; ai < 2; ++ai)
#pragma unroll
                for (int m = 0; m < 4; ++m) { const int row = row0 + ai * 128 + m * 16, r = row & 255;
                    const float dec = isk ? __builtin_amdgcn_exp2f(lg * (float)(255 - r)) * 0.0625f : __builtin_amdgcn_exp2f(lg * (float)(r - 255));
#pragma unroll
                    for (int bj = 0; bj < 2; ++bj) { const int c = c0 + bj * 128;
                        const f32x4* rp = (const f32x4*)(rope + ((size_t)row * 128 + (c >> 1)) * 2); const f32x4 t0 = rp[0], t1 = rp[1];
                        const f32x4 x = acc[ai][bj][m][0], y = acc[ai][bj][m][1]; f32x4 o0, o1;
                        o0[0] = (x[0] * t0[0] - x[1] * t0[1]) * dec; o0[1] = (x[1] * t0[0] + x[0] * t0[1]) * dec;
                        o0[2] = (x[2] * t0[2] - x[3] * t0[3]) * dec; o0[3] = (x[3] * t0[2] + x[2] * t0[3]) * dec;
                        o1[0] = (y[0] * t1[0] - y[1] * t1[1]) * dec; o1[1] = (y[1] * t1[0] + y[0] * t1[1]) * dec;
                        o1[2] = (y[2] * t1[2] - y[3] * t1[3]) * dec; o1[3] = (y[3] * t1[2] + y[2] * t1[3]) * dec;
                        if (isk) *(u32x4*)(out + (size_t)row * DM + c) = pack8(o0, o1); else __builtin_nontemporal_store(pack8(o0, o1), (u32x4*)(out + (size_t)row * DM + c)); } }
        } else if (pn < 32) {
            bf16_t* out = v + (pn - 16) * 256 + c0;
#pragma unroll
            for (int ai = 0; ai < 2; ++ai)
#pragma unroll
                for (int m = 0; m < 4; ++m) { const int row = row0 + ai * 128 + m * 16;
#pragma unroll
                    for (int bj = 0; bj < 2; ++bj) *(u32x4*)(out + (size_t)row * PW + bj * 128) = pack8(acc[ai][bj][m][0], acc[ai][bj][m][1]); }
        } else {
            bf16_t* out = sg + (pn - 32) * 256 + c0;
#pragma unroll
            for (int ai = 0; ai < 2; ++ai)
#pragma unroll
                for (int m = 0; m < 4; ++m) { const int row = row0 + ai * 128 + m * 16;
#pragma unroll
                    for (int bj = 0; bj < 2; ++bj) { f32x4 a = acc[ai][bj][m][0], b = acc[ai][bj][m][1];
#pragma unroll
                        for (int e = 0; e < 4; ++e) { a[e] = fsilu(a[e]); b[e] = fsilu(b[e]); }
                        __builtin_nontemporal_store(pack8(a, b), (u32x4*)(out + (size_t)row * PW + bj * 128)); } }
        }
    }
};
struct EpiPlain {
    bf16_t* O; int ldc;
    __device__ __forceinline__ void operator()(EPI_ARGS) const {
        bf16_t* out = O + (size_t)(u.pm * 256 + wr * 64 + fr) * ldc + u.pn * 256 + wc * 32 + 8 * fq;
#pragma unroll
        for (int ai = 0; ai < 2; ++ai)
#pragma unroll
            for (int m = 0; m < 4; ++m)
#pragma unroll
                for (int bj = 0; bj < 2; ++bj) *(u32x4*)(out + (size_t)(ai * 128 + m * 16) * ldc + bj * 128) = pack8(acc[ai][bj][m][0], acc[ai][bj][m][1]);
    }
};
template <bool RESF> struct EpiRes {
    const float* resf; const bf16_t* resb; bf16_t* aout; float* rpo;
    __device__ __forceinline__ void operator()(EPI_ARGS) const {
        const int row0 = u.pm * 256 + wr * 64 + fr, col0 = u.pn * 256 + wc * 32 + 8 * fq;
#pragma unroll
        for (int ai = 0; ai < 2; ++ai) {
            f32x4 rv[4][2][2];
#pragma unroll
            for (int m = 0; m < 4; ++m)
#pragma unroll
                for (int bj = 0; bj < 2; ++bj) { const size_t o = (size_t)(row0 + ai * 128 + m * 16) * DM + col0 + bj * 128;
                    if (RESF) { rv[m][bj][0] = __builtin_nontemporal_load((const f32x4*)(resf + o)); rv[m][bj][1] = __builtin_nontemporal_load((const f32x4*)(resf + o + 4)); }
                    else unpack8(*(const u32x4*)(resb + o), rv[m][bj][0], rv[m][bj][1]); }
#pragma unroll
            for (int m = 0; m < 4; ++m) { const int row = row0 + ai * 128 + m * 16; const size_t off = (size_t)row * DM + col0; float ss = 0.f;
#pragma unroll
                for (int bj = 0; bj < 2; ++bj) { const size_t o = off + bj * 128;
                    const f32x4 h0 = rv[m][bj][0] + acc[ai][bj][m][0], h1 = rv[m][bj][1] + acc[ai][bj][m][1];
                    ss += (h0[0] * h0[0] + h0[1] * h0[1]) + (h0[2] * h0[2] + h0[3] * h0[3]) + (h1[0] * h1[0] + h1[1] * h1[1]) + (h1[2] * h1[2] + h1[3] * h1[3]);
                    *(u32x4*)(aout + o) = pack8(h0, h1); }
                ss += __shfl_xor(ss, 16); ss += __shfl_xor(ss, 32);
                if (fq == 0) rpo[(size_t)row * 32 + u.pn * 4 + wc] = ss; }
            asm volatile("" ::: "memory"); }
    }
};
struct EpiPle {
    const bf16_t* hin; const bf16_t* pe; const LAS unsigned char* lds; bf16_t* aout; float* rpo;
    __device__ __forceinline__ void operator()(EPI_ARGS) const {
        const int row0 = u.pm * 256 + wr * 64 + fr, col0 = u.pn * 256 + wc * 32 + 8 * fq;
#pragma unroll
        for (int ai = 0; ai < 2; ++ai) {
            u32x4 hv[4][2], pv[4][2];
#pragma unroll
            for (int m = 0; m < 4; ++m)
#pragma unroll
                for (int bj = 0; bj < 2; ++bj) { const size_t o = (size_t)(row0 + ai * 128 + m * 16) * DM + col0 + bj * 128; hv[m][bj] = *(const u32x4*)(hin + o); pv[m][bj] = *(const u32x4*)(pe + o); }
#pragma unroll
            for (int m = 0; m < 4; ++m) { const int row = row0 + ai * 128 + m * 16; const size_t off = (size_t)row * DM + col0; float ss = 0.f;
                const float rstd = rstd_lds(lds, u.slot, row & 255);
#pragma unroll
                for (int bj = 0; bj < 2; ++bj) { const size_t o = off + bj * 128;
                    f32x4 h0, h1, p0, p1; unpack8(hv[m][bj], h0, h1); unpack8(pv[m][bj], p0, p1);
                    const f32x4 a0 = acc[ai][bj][m][0], a1 = acc[ai][bj][m][1];
#pragma unroll
                    for (int e = 0; e < 4; ++e) { h0[e] += fsigmoid(a0[e] * rstd) * p0[e]; h1[e] += fsigmoid(a1[e] * rstd) * p1[e]; }
                    ss += (h0[0] * h0[0] + h0[1] * h0[1]) + (h0[2] * h0[2] + h0[3] * h0[3]) + (h1[0] * h1[0] + h1[1] * h1[1]) + (h1[2] * h1[2] + h1[3] * h1[3]);
                    *(u32x4*)(aout + o) = pack8(h0, h1); }
                ss += __shfl_xor(ss, 16); ss += __shfl_xor(ss, 32);
                if (fq == 0) rpo[(size_t)row * 32 + u.pn * 4 + wc] = ss; }
            asm volatile("" ::: "memory"); }
    }
};
constexpr int FN_P_OFF = RING_BYTES + 8192, FN_S_OFF = FN_P_OFF + 4096;
constexpr int CW_FN_CNT = 16384, CW_FN_X = 32768;
struct EpiPleFinal {
    const bf16_t* hin; const bf16_t* pe; LAS unsigned char* lds; float* out; const float* gain; unsigned* ctl;
    __device__ __forceinline__ void operator()(EPI_ARGS) const {
        const int row0 = u.pm * 256 + wr * 64 + fr, col0 = u.pn * 256 + wc * 32 + 8 * fq;
        const int wid = wr * 4 + wc, tid = wid * 64 + fq * 16 + fr;
        LAS float* P = (LAS float*)(lds + FN_P_OFF); LAS float* S = (LAS float*)(lds + FN_S_OFF);
#pragma unroll
        for (int ai = 0; ai < 2; ++ai)
#pragma unroll
            for (int mp = 0; mp < 2; ++mp) {
                u32x4 hv[2][2], pv[2][2];
#pragma unroll
                for (int mm = 0; mm < 2; ++mm)
#pragma unroll
                    for (int bj = 0; bj < 2; ++bj) { const size_t o = (size_t)(row0 + ai * 128 + (2 * mp + mm) * 16) * DM + col0 + bj * 128;
                        hv[mm][bj] = *(const u32x4*)(hin + o); pv[mm][bj] = *(const u32x4*)(pe + o); }
#pragma unroll
                for (int mm = 0; mm < 2; ++mm) { const int m = 2 * mp + mm, row = row0 + ai * 128 + m * 16; float ss = 0.f;
                    const float rstd = rstd_lds(lds, u.slot, row & 255);
#pragma unroll
                    for (int bj = 0; bj < 2; ++bj) {
                        f32x4 h0, h1, p0, p1; unpack8(hv[mm][bj], h0, h1); unpack8(pv[mm][bj], p0, p1);
                        const f32x4 a0 = acc[ai][bj][m][0], a1 = acc[ai][bj][m][1];
#pragma unroll
                        for (int e = 0; e < 4; ++e) { h0[e] += fsigmoid(a0[e] * rstd) * p0[e]; h1[e] += fsigmoid(a1[e] * rstd) * p1[e]; }
                        acc[ai][bj][m][0] = h0; acc[ai][bj][m][1] = h1;
                        ss += (h0[0] * h0[0] + h0[1] * h0[1]) + (h0[2] * h0[2] + h0[3] * h0[3]) + (h1[0] * h1[0] + h1[1] * h1[1]) + (h1[2] * h1[2] + h1[3] * h1[3]); }
                    ss += __shfl_xor(ss, 16); ss += __shfl_xor(ss, 32);
                    if (fq == 0) P[(row & 255) * 4 + wc] = ss; }
                asm volatile("" ::: "memory"); }
        asm volatile("s_waitcnt lgkmcnt(0)" ::: "memory"); __builtin_amdgcn_s_barrier(); asm volatile("" ::: "memory");
        float* X = (float*)(ctl + CW_FN_X); unsigned* cnt = ctl + CW_FN_CNT + 64 * u.pm;
        if (tid < 256) { const float t = (P[tid * 4 + 0] + P[tid * 4 + 1]) + (P[tid * 4 + 2] + P[tid * 4 + 3]);
            __hip_atomic_store(X + ((size_t)(u.pm * 256 + tid) * 8 + u.pn), t, __ATOMIC_RELAXED, __HIP_MEMORY_SCOPE_AGENT);
            asm volatile("s_waitcnt vmcnt(0)" ::: "memory");
            if ((tid & 63) == 0) __hip_atomic_fetch_add(cnt, 1u, __ATOMIC_RELAXED, __HIP_MEMORY_SCOPE_AGENT); }
        if (wid == 0) {
            unsigned spins = 0;
            while ((unsigned)__builtin_amdgcn_readfirstlane(__hip_atomic_load(cnt, __ATOMIC_RELAXED, __HIP_MEMORY_SCOPE_AGENT)) < 32u) { __builtin_amdgcn_s_sleep(2); if (++spins > (1u << 22)) break; }
            __builtin_amdgcn_fence(__ATOMIC_ACQUIRE, "agent");
            asm volatile("s_waitcnt vmcnt(0)" ::: "memory"); }
        asm volatile("s_waitcnt vmcnt(0) lgkmcnt(0)" ::: "memory"); __builtin_amdgcn_s_barrier(); asm volatile("" ::: "memory");
        if (tid < 256) { const float* xs = X + (size_t)(u.pm * 256 + tid) * 8; float s = 0.f;
#pragma unroll
            for (int t = 0; t < 8; ++t) s += __hip_atomic_load(xs + t, __ATOMIC_RELAXED, __HIP_MEMORY_SCOPE_AGENT);
            S[tid] = __builtin_amdgcn_rsqf(s * (1.0f / DM) + NORM_EPS); }
        asm volatile("s_waitcnt lgkmcnt(0)" ::: "memory"); __builtin_amdgcn_s_barrier(); asm volatile("" ::: "memory");
        f32x4 gv[2][2];
#pragma unroll
        for (int bj = 0; bj < 2; ++bj) { gv[bj][0] = *(const f32x4*)(gain + col0 + bj * 128); gv[bj][1] = *(const f32x4*)(gain + col0 + bj * 128 + 4); }
#pragma unroll
        for (int ai = 0; ai < 2; ++ai)
#pragma unroll
            for (int m = 0; m < 4; ++m) { const int row = row0 + ai * 128 + m * 16; const float rs = S[row & 255]; const size_t off = (size_t)row * DM + col0;
#pragma unroll
                for (int bj = 0; bj < 2; ++bj) { *(f32x4*)(out + off + bj * 128) = acc[ai][bj][m][0] * rs * gv[bj][0]; *(f32x4*)(out + off + bj * 128 + 4) = acc[ai][bj][m][1] * rs * gv[bj][1]; } }
    }
};
struct EpiPoolIn {
    const LAS unsigned char* lds; bf16_t* uo; bf16_t* sgo;
    __device__ __forceinline__ void operator()(EPI_ARGS) const {
        const int row0 = u.pm * 256 + wr * 64 + fr; const bool isg = u.pn >= 16;
        bf16_t* out = (isg ? sgo : uo) + (u.pn & 15) * 256 + wc * 32 + 8 * fq;
#pragma unroll
        for (int ai = 0; ai < 2; ++ai)
#pragma unroll
            for (int m = 0; m < 4; ++m) { const int row = row0 + ai * 128 + m * 16; const float rstd = rstd_lds(lds, u.slot, row & 255);
#pragma unroll
                for (int bj = 0; bj < 2; ++bj) { f32x4 a = acc[ai][bj][m][0] * rstd, b = acc[ai][bj][m][1] * rstd;
                    if (isg) {
#pragma unroll
                        for (int e = 0; e < 4; ++e) { a[e] = fsilu(a[e]); b[e] = fsilu(b[e]); } }
                    *(u32x4*)(out + (size_t)row * PW + bj * 128) = pack8(a, b); } }
    }
};
struct EpiComb {
    bf16_t* O; int ldc; const float* scale;
    __device__ __forceinline__ void operator()(EPI_ARGS) const {
        const int row0 = u.pm * 256 + wr * 64 + fr;
        bf16_t* out = O + (size_t)row0 * ldc + u.pn * 256 + wc * 32 + 8 * fq;
#pragma unroll
        for (int ai = 0; ai < 2; ++ai)
#pragma unroll
            for (int m = 0; m < 4; ++m) { const float sc = scale[row0 + ai * 128 + m * 16];
#pragma unroll
                for (int bj = 0; bj < 2; ++bj) *(u32x4*)(out + (size_t)(ai * 128 + m * 16) * ldc + bj * 128) = pack8(acc[ai][bj][m][0] * sc, acc[ai][bj][m][1] * sc); }
    }
};

typedef GAS unsigned gu32;
#define RLX_AGENT __ATOMIC_RELAXED, __HIP_MEMORY_SCOPE_AGENT
#define XB_TMO      128
#define XB_XCNT(j)  (256  + 64 * (j))
#define XB_XSUB(j)  (1280 + 64 * (j))
#define XB_XGEN(j)  (2304 + 64 * (j))
#define XB_TOP      3328
#define XB_TOPGEN   3392
#define XCD_BAR_WORDS 3456
#define XB_SPIN_CAP (1u << 20)
__device__ __forceinline__ unsigned xb_ld(unsigned* p)              { return __hip_atomic_load(p, __ATOMIC_RELAXED, __HIP_MEMORY_SCOPE_AGENT); }
__device__ __forceinline__ unsigned xb_add(unsigned* p, unsigned v) { return __hip_atomic_fetch_add(p, v, __ATOMIC_RELAXED, __HIP_MEMORY_SCOPE_AGENT); }
__device__ __forceinline__ unsigned xb_xcc_id() { return (unsigned)__builtin_amdgcn_s_getreg((3 << 11) | 20) & 0xFu; }
#define XB_SPIN(cond, bar) do { unsigned _sp = 0; while (cond) { __builtin_amdgcn_s_sleep(1); \
    if ((++_sp & 255u) == 0u) { if (xb_ld(&(bar)[XB_TMO])) break; if (_sp > XB_SPIN_CAP) { atomicAdd(&(bar)[XB_TMO], 1u); break; } } } } while (0)
struct XcdBarrier { unsigned* bar; unsigned x; volatile LAS unsigned* st; };
__device__ __forceinline__ XcdBarrier xcd_barrier_post(unsigned* bar, volatile LAS unsigned* st, const int wave) {
    XcdBarrier b; b.bar = bar; b.x = xb_xcc_id(); b.st = st;
    if (wave == 0 && lane_id() == 0) (void)xb_add(&bar[XB_XCNT(b.x)], 1u);
    return b;
}
__device__ __forceinline__ void xcd_barrier_complete(unsigned* bar, unsigned x, unsigned& nloc, unsigned& nx) {
    const unsigned G = gridDim.x * gridDim.y * gridDim.z;
    unsigned sum, cnt, mine, sp = 0u;
    for (;;) {
        sum = 0u; cnt = 0u; mine = 0u;
#pragma unroll
        for (unsigned j = 0; j < 16; ++j) { const unsigned c = xb_ld(&bar[XB_XCNT(j)]); sum += c; cnt += (c > 0u) ? 1u : 0u; mine = (j == x) ? c : mine; }
        if (sum == G) break;
        __builtin_amdgcn_s_sleep(1);
        if ((++sp & 255u) == 0u) { if (xb_ld(&bar[XB_TMO])) break; if (sp > XB_SPIN_CAP) { atomicAdd(&bar[XB_TMO], 1u); break; } }
    }
    nloc = mine > 0u ? mine : 1u; nx = cnt > 0u ? cnt : 1u;
}
__device__ __forceinline__ void xcd_barrier(const XcdBarrier& b, const int wave) {
    asm volatile("s_waitcnt vmcnt(0)" ::: "memory");
    __syncthreads();
    if (wave == 0 && lane_id() == 0) {
        unsigned* bar = b.bar;
        __builtin_amdgcn_s_waitcnt(0);
        unsigned nloc = b.st[0], nx = b.st[1];
        if (nloc == 0u) { xcd_barrier_complete(bar, b.x, nloc, nx); b.st[0] = nloc; b.st[1] = nx; }
        const unsigned old = xb_add(&bar[XB_XSUB(b.x)], 1u);
        const unsigned gen = old / nloc;
        if (old + 1u == (gen + 1u) * nloc) {
            __builtin_amdgcn_fence(__ATOMIC_RELEASE, "agent");
            asm volatile("s_waitcnt vmcnt(0)" ::: "memory");
            const unsigned og = xb_add(&bar[XB_TOP], 1u);
            const unsigned tg = og / nx;
            if (og + 1u == (tg + 1u) * nx) xb_add(&bar[XB_TOPGEN], 1u);
            else XB_SPIN(xb_ld(&bar[XB_TOPGEN]) == tg, bar);
            __builtin_amdgcn_fence(__ATOMIC_ACQUIRE, "agent");
            xb_add(&bar[XB_XGEN(b.x)], 1u);
            asm volatile("s_waitcnt vmcnt(0)" ::: "memory");
        } else {
            XB_SPIN(xb_ld(&bar[XB_XGEN(b.x)]) == gen, bar);
            __builtin_amdgcn_fence(__ATOMIC_ACQUIRE, "agent");
            asm volatile("s_waitcnt vmcnt(0)" ::: "memory");
        }
    }
    __syncthreads();
}

__device__ __forceinline__ void tr_item(const float* W, int N, bf16_t* WT, int Kt, LAS float* scr, int item, int lane) {
    const int nblk = N >> 6, kb = item / nblk, nb = item - kb * nblk, k0 = kb << 6, n0 = nb << 6;
    const int c = lane & 15, rr = lane >> 4;
    f32x4 v[16];
#pragma unroll
    for (int i = 0; i < 16; ++i) v[i] = __builtin_nontemporal_load((const f32x4*)(W + (size_t)(k0 + 4 * i + rr) * N + n0 + 4 * c));
#pragma unroll
    for (int i = 0; i < 16; ++i) { LAS float* s = scr + (4 * i + rr) * 65 + 4 * c; s[0] = v[i][0]; s[1] = v[i][1]; s[2] = v[i][2]; s[3] = v[i][3]; }
    LDS_WAIT();
    const int kc = lane & 7;
#pragma unroll
    for (int jj = 0; jj < 8; ++jj) { const int n = (lane >> 3) + 8 * jj; const LAS float* s = scr + (8 * kc) * 65 + n;
        u32x4 o; o.x = cvt_pk_bf16(s[0], s[65]); o.y = cvt_pk_bf16(s[130], s[195]); o.z = cvt_pk_bf16(s[260], s[325]); o.w = cvt_pk_bf16(s[390], s[455]);
        *(u32x4*)(WT + (size_t)(n0 + n) * Kt + k0 + 8 * kc) = o; }
    LDS_WAIT();
}
__device__ __forceinline__ double sin2pi(double r) {
    r -= rint(r);
    if (r > 0.25) r = 0.5 - r; else if (r < -0.25) r = -0.5 - r;
    const double x = r * 6.283185307179586476925, x2 = x * x;
    double p = -1.0 / 1307674368000.0;
    p = p * x2 + 1.0 / 6227020800.0; p = p * x2 - 1.0 / 39916800.0; p = p * x2 + 1.0 / 362880.0; p = p * x2 - 1.0 / 5040.0;
    p = p * x2 + 1.0 / 120.0; p = p * x2 - 1.0 / 6.0; p = p * x2 + 1.0;
    return x * p;
}

struct Args { const float* in[14]; float* out; unsigned char* ws; float freq[128]; float l2g[8]; float g256[8]; int ph_lo, ph_hi; };

__device__ __forceinline__ void p_prologue(const Args& a, LAS unsigned char* lds, const int wave) {
    const int lane = lane_id(), tid = wave * 64 + lane;
    unsigned char* ws = a.ws;
    LAS float* scr = (LAS float*)(lds + wave * 16640);
    const int gw = blockIdx.x * 8 + wave, NGW = gridDim.x * 8;
    constexpr int I_RI = (DM / 64) * (RPROJ / 64);
    for (int it = gw; it < I_RI; it += NGW) tr_item(a.in[3], RPROJ, (bf16_t*)(ws + WS_WT_RI), DM, scr, it, lane);
    const float* x = a.in[0]; const float* gain = a.in[2]; bf16_t* xn = (bf16_t*)(ws + WS_XN0);
    for (int m = gw; m < SEQ; m += NGW) {
        const f32x4* xr = (const f32x4*)(x + (size_t)m * DM) + 2 * lane; f32x4 v[8]; float s = 0.f;
#pragma unroll
        for (int j = 0; j < 8; ++j) { v[j] = __builtin_nontemporal_load(xr + 128 * (j >> 1) + (j & 1)); s += (v[j][0] * v[j][0] + v[j][1] * v[j][1]) + (v[j][2] * v[j][2] + v[j][3] * v[j][3]); }
        const float rstd = __builtin_amdgcn_rsqf(wave_sum(s) * (1.0f / DM) + NORM_EPS);
        u32x4* o = (u32x4*)(xn + (size_t)m * DM) + lane;
#pragma unroll
        for (int j = 0; j < 4; ++j) { const f32x4 g0 = *((const f32x4*)gain + 2 * lane + 128 * j), g1 = *((const f32x4*)gain + 2 * lane + 128 * j + 1); o[64 * j] = pack8(v[2 * j] * rstd * g0, v[2 * j + 1] * rstd * g1); }
    }
    const int gt = blockIdx.x * 512 + tid, NGT = gridDim.x * 512;
    { const float* p = a.in[1]; bf16_t* pb = (bf16_t*)(ws + WS_PBF);
      for (int i = gt; i < 2 * SEQ * PLE / 8; i += NGT) { const f32x4 a0 = __builtin_nontemporal_load((const f32x4*)(p + (size_t)i * 8)), a1 = __builtin_nontemporal_load((const f32x4*)(p + (size_t)i * 8 + 4)); *(u32x4*)(pb + (size_t)i * 8) = pack8(a0, a1); } }
    { f32x4* rope = (f32x4*)(ws + WS_ROPE);
      for (int i = gt; i < SEQ * 64; i += NGT) { const int pos = i >> 6, fi = (i & 63) * 2; const float a0 = (float)pos * a.freq[fi], a1 = (float)pos * a.freq[fi + 1];
          const double r0 = (double)a0 * 0.15915494309189533577, r1 = (double)a1 * 0.15915494309189533577;
          rope[i] = (f32x4){(float)sin2pi(r0 + 0.25), (float)sin2pi(r0), (float)sin2pi(r1 + 0.25), (float)sin2pi(r1)}; } }
}
struct CvDesc { const float* src; bf16_t* dst; const float* kg; int N, Kt, plain; };
constexpr int CV_RO = (PW / 64) * (DM / 32), CV_G = (DM / 64) * (DM / 32), CV_P = (PLE / 64) * (DM / 32), CV_PIG = (DM / 64) * (PW / 32), CV_GR = (1024 / 64) * (1024 / 32), CV_WU = DM * PW / 2048;
constexpr int CV_ITEMS = CV_RO + 2 * CV_G + 2 * CV_P + CV_PIG + 4 * CV_GR + CV_RO + CV_WU;
__device__ __forceinline__ CvDesc cv_tr(const float* W, int N, int ncols, bf16_t* WT, int Kt, int r, const float* kg = nullptr) {
    const int nblk = ncols >> 5, kb = r / nblk, nb = r - kb * nblk; CvDesc d; d.src = W + (size_t)(kb * 64) * N + nb * 32; d.dst = WT + (size_t)(nb * 32) * Kt + kb * 64; d.kg = kg ? kg + kb * 64 : nullptr; d.N = N; d.Kt = Kt; d.plain = 0; return d; }
__device__ __forceinline__ CvDesc cv_decode(const Args& a, int r) {
    unsigned char* ws = a.ws;
    if (r < CV_RO) return cv_tr(a.in[4], DM, DM, (bf16_t*)(ws + WS_WT_RO), PW, r); r -= CV_RO;
    if (r < CV_G) return cv_tr(a.in[11], DM, DM, (bf16_t*)(ws + WS_WT_G0), DM, r, a.in[10]); r -= CV_G;
    if (r < CV_G) return cv_tr(a.in[11] + (size_t)DM * DM, DM, DM, (bf16_t*)(ws + WS_WT_G1), DM, r, a.in[10] + DM); r -= CV_G;
    if (r < CV_P) return cv_tr(a.in[12], DM, DM, (bf16_t*)(ws + WS_WT_P0), PLE, r); r -= CV_P;
    if (r < CV_P) return cv_tr(a.in[12] + (size_t)PLE * DM, DM, DM, (bf16_t*)(ws + WS_WT_P1), PLE, r); r -= CV_P;
    if (r < CV_PIG) return cv_tr(a.in[6] + PW, 2 * PW, PW, (bf16_t*)(ws + WS_WT_PI) + (size_t)PW * DM, DM, r, a.in[5]); r -= CV_PIG;
    if (r < 4 * CV_GR) { const int g = r / CV_GR; return cv_tr(a.in[7] + (size_t)g * 1024 * 1024, 1024, 1024, (bf16_t*)(ws + WS_WT_GR) + (size_t)g * 1024 * 1024, 1024, r - g * CV_GR); } r -= 4 * CV_GR;
    if (r < CV_RO) return cv_tr(a.in[9], DM, DM, (bf16_t*)(ws + WS_WT_PO), PW, r); r -= CV_RO;
    CvDesc d; const int row = r >> 1, c0 = (r & 1) * 2048; d.src = a.in[6] + (size_t)row * (2 * PW) + c0; d.dst = (bf16_t*)(ws + WS_WU) + (size_t)row * PW + c0; d.kg = a.in[5] + row; d.N = 0; d.Kt = 0; d.plain = 1; return d;
}
__device__ __forceinline__ void cv_load(const CvDesc& d, f32x4 (&cv)[8], int lane) {
    if (d.plain) {
#pragma unroll
        for (int j = 0; j < 4; ++j) { cv[2 * j] = __builtin_nontemporal_load((const f32x4*)(d.src + lane * 8 + 512 * j)); cv[2 * j + 1] = __builtin_nontemporal_load((const f32x4*)(d.src + lane * 8 + 512 * j + 4)); }
    } else {
#pragma unroll
        for (int i = 0; i < 8; ++i) cv[i] = __builtin_nontemporal_load((const f32x4*)(d.src + (size_t)(8 * i + (lane >> 3)) * d.N + 4 * (lane & 7)));
    }
}
__device__ __forceinline__ void cv_store(const CvDesc& d, const f32x4 (&cv)[8], LAS float* scr, int lane) {
    if (d.plain) {
        const float kgv = d.kg[0];
#pragma unroll
        for (int j = 0; j < 4; ++j) *(u32x4*)(d.dst + lane * 8 + 512 * j) = pack8(cv[2 * j] * kgv, cv[2 * j + 1] * kgv);
    } else {
#pragma unroll
        for (int i = 0; i < 8; ++i) { const float kgv = d.kg ? d.kg[8 * i + (lane >> 3)] : 1.0f; LAS float* s = scr + (8 * i + (lane >> 3)) * 33 + 4 * (lane & 7); s[0] = cv[i][0] * kgv; s[1] = cv[i][1] * kgv; s[2] = cv[i][2] * kgv; s[3] = cv[i][3] * kgv; }
        LDS_WAIT();
        const int kc = lane & 7;
#pragma unroll
        for (int j = 0; j < 4; ++j) { const int n = (lane >> 3) + 8 * j; const LAS float* s = scr + (8 * kc) * 33 + n;
            u32x4 o; o.x = cvt_pk_bf16(s[0], s[33]); o.y = cvt_pk_bf16(s[66], s[99]); o.z = cvt_pk_bf16(s[132], s[165]); o.w = cvt_pk_bf16(s[198], s[231]);
            *(u32x4*)(d.dst + (size_t)n * d.Kt + 8 * kc) = o; }
        LDS_WAIT();
    }
}

__device__ __forceinline__ void tr_item_g(const float* W, int N, int ncols, bf16_t* WT, int Kt, LAS float* scr, int item, int lane, const float* kg) {
    const int nblk = ncols >> 6, kb = item / nblk, nb = item - kb * nblk, k0 = kb << 6, n0 = nb << 6;
    const int c = lane & 15, rr = lane >> 4;
    f32x4 v[16];
#pragma unroll
    for (int i = 0; i < 16; ++i) v[i] = __builtin_nontemporal_load((const f32x4*)(W + (size_t)(k0 + 4 * i + rr) * N + n0 + 4 * c));
#pragma unroll
    for (int i = 0; i < 16; ++i) { const float g = kg ? kg[k0 + 4 * i + rr] : 1.0f; LAS float* s = scr + (4 * i + rr) * 65 + 4 * c; s[0] = v[i][0] * g; s[1] = v[i][1] * g; s[2] = v[i][2] * g; s[3] = v[i][3] * g; }
    LDS_WAIT();
    const int kc = lane & 7;
#pragma unroll
    for (int jj = 0; jj < 8; ++jj) { const int n = (lane >> 3) + 8 * jj; const LAS float* s = scr + (8 * kc) * 65 + n;
        u32x4 o; o.x = cvt_pk_bf16(s[0], s[65]); o.y = cvt_pk_bf16(s[130], s[195]); o.z = cvt_pk_bf16(s[260], s[325]); o.w = cvt_pk_bf16(s[390], s[455]);
        __builtin_nontemporal_store(o, (u32x4*)(WT + (size_t)(n0 + n) * Kt + k0 + 8 * kc)); }
    LDS_WAIT();
}
__device__ __forceinline__ void p_weights_big(const Args& a, LAS unsigned char* lds, const int wave) {
    const int lane = lane_id();
    unsigned char* ws = a.ws;
    LAS float* scr = (LAS float*)(lds + wave * 16640);
    const int gw = (blockIdx.x - 128) * 8 + wave, NGW = (gridDim.x - 128) * 8;
    constexpr int I_RO = (PW / 64) * (DM / 64), I_G = (DM / 64) * (DM / 64), I_P = (PLE / 64) * (DM / 64), I_PIG = (DM / 64) * (PW / 64), I_GR = (1024 / 64) * (1024 / 64), I_WU = DM * PW / 2048;
    for (int it = gw; it < I_RO + 2 * I_G + 2 * I_P + I_PIG + 4 * I_GR + I_RO + I_WU; it += NGW) {
        int r = it;
        if (r < I_RO) { tr_item_g(a.in[4], DM, DM, (bf16_t*)(ws + WS_WT_RO), PW, scr, r, lane, nullptr); continue; } r -= I_RO;
        if (r < I_G) { tr_item_g(a.in[11], DM, DM, (bf16_t*)(ws + WS_WT_G0), DM, scr, r, lane, a.in[10]); continue; } r -= I_G;
        if (r < I_G) { tr_item_g(a.in[11] + (size_t)DM * DM, DM, DM, (bf16_t*)(ws + WS_WT_G1), DM, scr, r, lane, a.in[10] + DM); continue; } r -= I_G;
        if (r < I_P) { tr_item_g(a.in[12], DM, DM, (bf16_t*)(ws + WS_WT_P0), PLE, scr, r, lane, nullptr); continue; } r -= I_P;
        if (r < I_P) { tr_item_g(a.in[12] + (size_t)PLE * DM, DM, DM, (bf16_t*)(ws + WS_WT_P1), PLE, scr, r, lane, nullptr); continue; } r -= I_P;
        if (r < I_PIG) { tr_item_g(a.in[6] + PW, 2 * PW, PW, (bf16_t*)(ws + WS_WT_PI) + (size_t)PW * DM, DM, scr, r, lane, a.in[5]); continue; } r -= I_PIG;
        if (r < 4 * I_GR) { const int g = r / I_GR; tr_item_g(a.in[7] + (size_t)g * 1024 * 1024, 1024, 1024, (bf16_t*)(ws + WS_WT_GR) + (size_t)g * 1024 * 1024, 1024, scr, r - g * I_GR, lane, nullptr); continue; } r -= 4 * I_GR;
        if (r < I_RO) { tr_item_g(a.in[9], DM, DM, (bf16_t*)(ws + WS_WT_PO), PW, scr, r, lane, nullptr); continue; } r -= I_RO;
        { const int row = r >> 1, c0 = (r & 1) * 2048 + lane * 8; const float* srcp = a.in[6] + (size_t)row * (2 * PW) + c0; bf16_t* dstp = (bf16_t*)(ws + WS_WU) + (size_t)row * PW + c0; const float g = a.in[5][row];
#pragma unroll
            for (int j = 0; j < 4; ++j) { const f32x4 x0 = __builtin_nontemporal_load((const f32x4*)(srcp + 512 * j)), x1 = __builtin_nontemporal_load((const f32x4*)(srcp + 512 * j + 4)); __builtin_nontemporal_store(pack8(x0 * g, x1 * g), (u32x4*)(dstp + 512 * j)); } }
    }
}

__device__ __forceinline__ bf16x8 tr_frag(const LAS unsigned char* p, int pitch16) {
    const s16x4 lo = __builtin_amdgcn_ds_read_tr16_b64_v4i16((LAS s16x4*)p), hi = __builtin_amdgcn_ds_read_tr16_b64_v4i16((LAS s16x4*)(p + pitch16));
    return (bf16x8){lo[0], lo[1], lo[2], lo[3], hi[0], hi[1], hi[2], hi[3]};
}

__device__ __forceinline__ void p_scan(const Args& a, LAS unsigned char* lds, const int w) {
    const int lane = lane_id();
    const int tid = w * 64 + lane, b = blockIdx.x, h = b & 7, tt = b >> 3, dt = tt >> 2, vt = tt & 3;
    const int db = w >> 1, vbp = w & 1, g = lane >> 4, i16 = lane & 15, q4 = i16 >> 2, p4 = i16 & 3;
    const float g256 = a.g256[h];
    constexpr int PK = 160, PV = 288, TK = 128 * PK, TV = 128 * PV, BUF = TK + TV;
    const bf16_t* kbase = (const bf16_t*)(a.ws + WS_KD) + h * 256 + dt * 64;
    const bf16_t* vbase = (const bf16_t*)(a.ws + WS_V) + h * 512 + vt * 128;
    bf16_t* st = (bf16_t*)(a.ws + WS_ST);
    u32x4 rk0[2], rv0[4], rk1[2], rv1[4], rk2[2], rv2[4], rk3[2], rv3[4];
#define P2_LOAD(RK, RV, hs) do { const int _hs = (hs) < 62 ? (hs) : 61; \
        _Pragma("unroll") for (int _i = 0; _i < 2; ++_i) { const int _p = tid + 512 * _i; RK[_i] = *(const u32x4*)(kbase + (size_t)(_hs * 128 + (_p >> 3)) * DM + (_p & 7) * 8); } \
        _Pragma("unroll") for (int _i = 0; _i < 4; ++_i) { const int _p = tid + 512 * _i; RV[_i] = *(const u32x4*)(vbase + (size_t)(_hs * 128 + (_p >> 4)) * PW + (_p & 15) * 8); } } while (0)
#define P2_STORE(RK, RV, s) do { \
        _Pragma("unroll") for (int _i = 0; _i < 2; ++_i) { const int _p = tid + 512 * _i; *(LAS u32x4*)(lds + (s) * BUF + (_p >> 3) * PK + (_p & 7) * 16) = RK[_i]; } \
        _Pragma("unroll") for (int _i = 0; _i < 4; ++_i) { const int _p = tid + 512 * _i; *(LAS u32x4*)(lds + (s) * BUF + TK + (_p >> 4) * PV + (_p & 15) * 16) = RV[_i]; } } while (0)
    f32x4 acc[4];
#pragma unroll
    for (int j = 0; j < 4; ++j) acc[j] = (f32x4){0.f, 0.f, 0.f, 0.f};
    const int lk = (4 * g + q4) * PK + 8 * p4 + db * 32, lv = (4 * g + q4) * PV + 16 * p4 + vbp * 128;
#define P2_STEP(hs, RKN, RVN) do { const int _h = (hs); if (_h < 62) { \
        const LAS unsigned char* kt = lds + (_h & 1) * BUF + lk; const LAS unsigned char* vtp = lds + (_h & 1) * BUF + TK + lv; \
        _Pragma("unroll") for (int ks = 0; ks < 4; ++ks) { \
            const bf16x8 kf = tr_frag(kt + ks * 32 * PK, 16 * PK); \
            _Pragma("unroll") for (int j = 0; j < 4; ++j) { const bf16x8 vf = tr_frag(vtp + ks * 32 * PV + 64 * (j >> 1) + 8 * (j & 1), 16 * PV); acc[j] = __builtin_amdgcn_mfma_f32_16x16x32_bf16(vf, kf, acc[j], 0, 0, 0); } } \
        if (_h & 1) { const int n = _h >> 1; \
            bf16_t* o = st + ((size_t)(n * 8 + h) * 256 + dt * 64 + db * 16 + i16) * 512 + vt * 128 + vbp * 64 + 8 * g; \
            _Pragma("unroll") for (int j = 0; j < 4; ++j) acc[j] *= g256; \
            _Pragma("unroll") for (int k = 0; k < 2; ++k) *(u32x4*)(o + 32 * k) = pack8(acc[2 * k], acc[2 * k + 1]); } \
        if (_h + 1 < 62) { P2_STORE(RKN, RVN, (_h + 1) & 1); P2_LOAD(RKN, RVN, _h + 5); } \
        __syncthreads(); } } while (0)
    P2_LOAD(rk0, rv0, 0); P2_LOAD(rk1, rv1, 1); P2_LOAD(rk2, rv2, 2); P2_LOAD(rk3, rv3, 3);
    P2_STORE(rk0, rv0, 0); P2_LOAD(rk0, rv0, 4); __syncthreads();
    for (int hs = 0; hs < 62; hs += 4) {
        P2_STEP(hs, rk1, rv1); P2_STEP(hs + 1, rk2, rv2); P2_STEP(hs + 2, rk3, rv3); P2_STEP(hs + 3, rk0, rv0);
    }
#undef P2_STEP
#undef P2_LOAD
#undef P2_STORE
}

__device__ __forceinline__ void p_retention(const Args& a, LAS unsigned char* lds, const int w) {
    const int lane = lane_id();
    const int tid = w * 64 + lane, b = blockIdx.x;
    const int g = lane >> 4, i16 = lane & 15, q4 = i16 >> 2, p4 = i16 & 3;
    constexpr int PP = 528, RINGO = 128 * PP, RB = 33792, ST1 = RINGO + 2 * RB, ST2 = ST1 + 8192;
    const bf16_t* qd = (const bf16_t*)(a.ws + WS_QD); const bf16_t* kd = (const bf16_t*)(a.ws + WS_KD); const bf16_t* v = (const bf16_t*)(a.ws + WS_V);
    const bf16_t* sg = (const bf16_t*)(a.ws + WS_SG); const bf16_t* st = (const bf16_t*)(a.ws + WS_ST); bf16_t* z = (bf16_t*)(a.ws + WS_Z);
    const unsigned offk = (unsigned)(((tid >> 5) * DM + (tid & 31) * 8) * 2), offv = (unsigned)(((tid >> 6) * PW + (tid & 63) * 8) * 2), offt = (unsigned)(((tid >> 6) * 512 + (tid & 63) * 8) * 2);
    const int xs = b & 7, kq = b >> 3, pair = kq >> 1, member = kq & 1;
    for (int rnd = 0; rnd < 2; ++rnd) {
        const int nh = (pair * 2 + rnd) * 8 + xs, n = nh >> 3, h = nh & 7, hf = member ^ rnd;
        const int nsb = 2 * (hf + 1), nvb = 4 * (hf + 1), ntb = n > 0 ? 8 : 0, nblk = nsb + nvb + ntb;
        const int rowbase = 256 * n + 128 * hf;
        u32x4 ra[4], rb[4];
#define P3_LOAD(R, it) do { const int _it = (it) < nblk ? (it) : nblk - 1; \
        if (_it < ntb) { const char* _b = (const char*)(st + ((size_t)((n - 1) * 8 + h) * 256 + 32 * _it) * 512); unsigned _o = offt; asm volatile("" : "+v"(_o)); \
            _Pragma("unroll") for (int _i = 0; _i < 4; ++_i) R[_i] = *(const u32x4*)(_b + (size_t)_i * (8 * 512 * 2) + _o); } \
        else if (_it < ntb + nsb) { const char* _b = (const char*)(kd + (size_t)(256 * n + 64 * (_it - ntb)) * DM + h * 256); unsigned _o = offk; asm volatile("" : "+v"(_o)); \
            _Pragma("unroll") for (int _i = 0; _i < 4; ++_i) R[_i] = *(const u32x4*)(_b + (size_t)_i * (16 * DM * 2) + _o); } \
        else { const char* _b = (const char*)(v + (size_t)(256 * n + 32 * (_it - ntb - nsb)) * PW + h * 512); unsigned _o = offv; asm volatile("" : "+v"(_o)); \
            _Pragma("unroll") for (int _i = 0; _i < 4; ++_i) R[_i] = *(const u32x4*)(_b + (size_t)_i * (8 * PW * 2) + _o); } } while (0)
#define P3_STORE(R, it) do { const int _it = (it); if (_it < nblk) { LAS unsigned char* _d = lds + RINGO + (_it & 1) * RB; \
        if (_it >= ntb && _it < ntb + nsb) { _Pragma("unroll") for (int _i = 0; _i < 4; ++_i) { const int _p = tid + 512 * _i; *(LAS u32x4*)(_d + (_p >> 5) * 528 + (_p & 31) * 16) = R[_i]; } } \
        else { _Pragma("unroll") for (int _i = 0; _i < 4; ++_i) { const int _p = tid + 512 * _i; *(LAS u32x4*)(_d + (_p >> 6) * 1056 + (_p & 63) * 16) = R[_i]; } } } } while (0)
        P3_LOAD(ra, 0); P3_LOAD(rb, 1);
        if (ntb) {
#pragma unroll 2
            for (int i = 0; i < 8; ++i) { const int p = tid + 512 * i, row = p >> 5, c = p & 31, G = c >> 2, cc = c & 3;
                const u32x4 x = __builtin_nontemporal_load((const u32x4*)(qd + (size_t)(rowbase + row) * DM + h * 256 + c * 8));
                const int s = cc >> 1, glo = (2 * cc) & 3, ghi = (2 * cc + 1) & 3;
                LAS unsigned char* d = lds + row * PP + 64 * G;
                *(LAS u32x2*)(d + 8 * (2 * glo + s)) = (u32x2){x.x, x.y}; *(LAS u32x2*)(d + 8 * (2 * ghi + s)) = (u32x2){x.z, x.w}; }
        }
        P3_STORE(ra, 0); P3_LOAD(ra, 2); __syncthreads();
        f32x4 acc[8][4];
#pragma unroll
        for (int rbk = 0; rbk < 8; ++rbk)
#pragma unroll
            for (int cb = 0; cb < 4; ++cb) acc[rbk][cb] = (f32x4){0.f, 0.f, 0.f, 0.f};
#define P3_YSTEP(it_, RN, ISV) do { const int it = (it_); \
            const LAS unsigned char* ring = lds + RINGO + (it & 1) * RB; \
            { const int kk = (ISV) ? it - ntb - nsb : it; \
                bf16x8 vf[4]; \
                _Pragma("unroll") for (int cb = 0; cb < 4; ++cb) vf[cb] = tr_frag(ring + (4 * g + q4) * 1056 + (64 * w + 32 * (cb >> 1) + 8 * p4 + 4 * (cb & 1)) * 2, 16 * 1056);   \
                _Pragma("unroll") for (int rbk = 0; rbk < 8; ++rbk) { \
                    if ((ISV) && 32 * kk > 128 * hf + 16 * rbk + 15) continue; \
                    const bf16x8 pf = *(const LAS bf16x8*)(lds + (16 * rbk + i16) * PP + (32 * kk + 8 * g) * 2); \
                    _Pragma("unroll") for (int cb = 0; cb < 4; ++cb) acc[rbk][cb] = __builtin_amdgcn_mfma_f32_16x16x32_bf16(vf[cb], pf, acc[rbk][cb], 0, 0, 0); \
                } } \
            P3_STORE(RN, it + 1); P3_LOAD(RN, it + 3); \
            __syncthreads(); } while (0)
        for (int it2 = 0; it2 < ntb; it2 += 2) { P3_YSTEP(it2, rb, false); P3_YSTEP(it2 + 1, ra, false); }
        {
            bf16x8 qf[8];
#pragma unroll
            for (int ds = 0; ds < 8; ++ds) qf[ds] = *(const bf16x8*)(qd + (size_t)(rowbase + 16 * w + i16) * DM + h * 256 + 32 * ds + 8 * g);
#define P3_SSTEP(it_, RN) do { const int it = (it_), sbk = it - ntb; \
                const LAS unsigned char* ring = lds + RINGO + (it & 1) * RB; \
                _Pragma("unroll") for (int sb = 0; sb < 4; ++sb) { \
                    const int j0 = 64 * sbk + 16 * sb, i0 = 128 * hf + 16 * w; \
                    LAS unsigned char* dst = lds + (16 * w + i16) * PP + (32 * (2 * sbk + (sb >> 1)) + 8 * g + 4 * (sb & 1)) * 2; \
                    if (j0 > i0) { *(LAS u32x2*)dst = (u32x2){0u, 0u}; } \
                    else { \
                        f32x4 s4 = {0.f, 0.f, 0.f, 0.f}; \
                        _Pragma("unroll") for (int ds = 0; ds < 8; ++ds) { const bf16x8 kf = *(const LAS bf16x8*)(ring + (16 * sb + i16) * 528 + (32 * ds + 8 * g) * 2); \
                            s4 = __builtin_amdgcn_mfma_f32_16x16x32_bf16(kf, qf[ds], s4, 0, 0, 0); } \
                        if (j0 == i0) { _Pragma("unroll") for (int r = 0; r < 4; ++r) if (4 * g + r > i16) s4[r] = 0.f; } \
                        u32x2 wv; wv.x = cvt_pk_bf16(s4[0], s4[1]); wv.y = cvt_pk_bf16(s4[2], s4[3]); *(LAS u32x2*)dst = wv; \
                    } \
                } \
                P3_STORE(RN, it + 1); P3_LOAD(RN, it + 3); \
                __syncthreads(); } while (0)
            for (int it2 = ntb; it2 < ntb + nsb; it2 += 2) { P3_SSTEP(it2, rb); P3_SSTEP(it2 + 1, ra); }
#undef P3_SSTEP
        }
        for (int it2 = ntb + nsb; it2 < nblk; it2 += 2) { P3_YSTEP(it2, rb, true); P3_YSTEP(it2 + 1, ra, true); }
#undef P3_YSTEP
#undef P3_LOAD
#undef P3_STORE
        LAS f32x2* S1 = (LAS f32x2*)(lds + ST1); LAS f32x2* S2 = (LAS f32x2*)(lds + ST2);
#pragma unroll
        for (int rbk = 0; rbk < 8; ++rbk) { float s1 = 0.f, s2 = 0.f;
#pragma unroll
            for (int cb = 0; cb < 4; ++cb) { const f32x4 y = acc[rbk][cb]; s1 += (y[0] + y[1]) + (y[2] + y[3]); s2 += (y[0] * y[0] + y[1] * y[1]) + (y[2] * y[2] + y[3] * y[3]); }
            s1 += __shfl_xor(s1, 16); s1 += __shfl_xor(s1, 32); s2 += __shfl_xor(s2, 16); s2 += __shfl_xor(s2, 32);
            if (g == 0) S1[(16 * rbk + i16) * 8 + w] = (f32x2){s1, s2}; }
        __syncthreads();
        if (tid < 128) { float s1 = 0.f, s2 = 0.f;
#pragma unroll
            for (int k = 0; k < 8; ++k) { const f32x2 t = S1[tid * 8 + k]; s1 += t.x; s2 += t.y; }
            const float mean = s1 * (1.0f / 512.0f), var = s2 * (1.0f / 512.0f) - mean * mean;
            S2[tid] = (f32x2){mean, __builtin_amdgcn_rsqf(fmaxf(var, 0.f) + GN_EPS)}; }
        __syncthreads();
#pragma unroll
        for (int rbk = 0; rbk < 8; ++rbk) { const f32x2 ms = S2[16 * rbk + i16];
            const size_t off = (size_t)(rowbase + 16 * rbk + i16) * PW + h * 512 + 64 * w + 8 * g;
#pragma unroll
            for (int k = 0; k < 2; ++k) { const u32x4 gw = __builtin_nontemporal_load((const u32x4*)(sg + off + 32 * k)); f32x4 g0, g1; unpack8(gw, g0, g1);
                const f32x4 y0 = (acc[rbk][2 * k] - ms.x) * ms.y * g0, y1 = (acc[rbk][2 * k + 1] - ms.x) * ms.y * g1;
                *(u32x4*)(z + off + 32 * k) = pack8(y0, y1); } }
        __syncthreads();
    }
}

template <int W> __device__ __forceinline__ void pool_run(const bf16_t* uc, const bf16_t* gc, bf16_t* dc, int t0) {
    u32x4 ring[W]; f32x4 s0 = {0.f, 0.f, 0.f, 0.f}, s1 = {0.f, 0.f, 0.f, 0.f};
#pragma unroll
    for (int k = 0; k < W; ++k) { const int t = t0 - W + k; ring[k] = t >= 0 ? *(const u32x4*)(uc + (size_t)t * PW) : (u32x4){0u, 0u, 0u, 0u}; f32x4 x0, x1; unpack8(ring[k], x0, x1); s0 += x0; s1 += x1; }
    for (int tb = t0; tb < t0 + 32; tb += W) {
        u32x4 xr[W], gr[W];
#pragma unroll
        for (int k = 0; k < W; ++k) { xr[k] = *(const u32x4*)(uc + (size_t)(tb + k) * PW); gr[k] = *(const u32x4*)(gc + (size_t)(tb + k) * PW); }
#pragma unroll
        for (int k = 0; k < W; ++k) { const int t = tb + k;
            f32x4 x0, x1, y0, y1, g0, g1; unpack8(xr[k], x0, x1); unpack8(ring[k], y0, y1); unpack8(gr[k], g0, g1);
            s0 += x0 - y0; s1 += x1 - y1; ring[k] = xr[k];
            const float inv = 1.0f / (float)(t + 1 < W ? t + 1 : W);
            *(u32x4*)(dc + (size_t)t * PW) = pack8((s0 * inv - x0) * g0, (s1 * inv - x1) * g1); }
    }
}
__device__ __forceinline__ void p_pool(const Args& a, const int wave) {
    const int tid = wave * 64 + lane_id();
    const bf16_t* u = (const bf16_t*)(a.ws + WS_U); const bf16_t* sg = (const bf16_t*)(a.ws + WS_SG1); bf16_t* d = (bf16_t*)(a.ws + WS_ZZ);
    for (int task = blockIdx.x * 512 + tid; task < 512 * 256; task += gridDim.x * 512) {
        const int chunk = task & 511, run = task >> 9, grp = chunk >> 7, t0 = run * 32;
        const bf16_t* uc = u + chunk * 8; const bf16_t* gc = sg + chunk * 8; bf16_t* dc = d + chunk * 8;
        if (grp == 0) pool_run<2>(uc, gc, dc, t0); else if (grp == 1) pool_run<4>(uc, gc, dc, t0); else if (grp == 2) pool_run<8>(uc, gc, dc, t0); else pool_run<16>(uc, gc, dc, t0);
    }
}
__device__ __forceinline__ void p_final(const Args& a, const int wave) {
    const int lane = lane_id();
    const float* rp = (const float*)(a.ws + WS_RP + 3 * MiB); const float* gain = a.in[13]; float* out = a.out;
    for (int m = blockIdx.x * 8 + wave; m < SEQ; m += gridDim.x * 8) {
        const float part = lane < 32 ? rp[(size_t)m * 32 + lane] : 0.f;
        const float rstd = __builtin_amdgcn_rsqf(wave_sum(part) * (1.0f / DM) + NORM_EPS);
        f32x4* o = (f32x4*)(out + (size_t)m * DM) + lane;
#pragma unroll
        for (int j = 0; j < 8; ++j) { const f32x4 g = *((const f32x4*)gain + lane + 64 * j); o[64 * j] = o[64 * j] * rstd * g; }
    }
}

__global__ void __launch_bounds__(512, 2) trunk_fwd(Args args) {
    extern __shared__ __attribute__((aligned(16))) unsigned char lds_raw[];
    LAS unsigned char* lds = (LAS unsigned char*)lds_raw;
    const int wave = __builtin_amdgcn_readfirstlane(threadIdx.x >> 6);
    unsigned char* ws = args.ws;
    volatile LAS unsigned* MISC = (volatile LAS unsigned*)(lds + MISC_OFF);
    if (threadIdx.x < 64) MISC[threadIdx.x] = 0u;
    __syncthreads();
    XcdBarrier bar; bar.bar = (unsigned*)(ws + WS_CTL) + 4096; bar.x = 0; bar.st = nullptr;
    const int lo = args.ph_lo, hi = args.ph_hi;
    if (hi - lo > 1) bar = xcd_barrier_post((unsigned*)(ws + WS_CTL) + 4096, MISC + 8, wave);
#ifndef PH_MASK
#define PH_MASK 0x3FF
#endif
#define IN(k) (((PH_MASK >> (k)) & 1) && lo <= (k) && (k) < hi)
#define SEAM(k) do { if (IN(k) && IN((k) + 1)) xcd_barrier(bar, wave); } while (0)
#ifndef DUP_MASK
#define DUP_MASK 0
#endif
#define NDUP(k) (((DUP_MASK >> (k)) & 1) ? 2 : 1)
    const int G = gridDim.x, c = blockIdx.x;
    float* rp0 = (float*)(ws + WS_RP); float* rp1 = rp0 + SEQ * 32; float* rp2 = rp1 + SEQ * 32; float* rp3 = rp2 + SEQ * 32;

    if (IN(0)) for (int rep_ = 0; rep_ < NDUP(0); ++rep_) { if (rep_) xcd_barrier(bar, wave); p_prologue(args, lds, wave); VM_WAIT(); __syncthreads(); }
    SEAM(0);
    if (IN(1)) for (int rep_ = 0; rep_ < NDUP(1); ++rep_) { if (rep_) xcd_barrier(bar, wave);
        pg8::Gemm g{(const bf16_t*)(ws + WS_XN0), (const bf16_t*)(ws + WS_WT_RI), SEQ, RPROJ, DM, DM, DM}; pg8::StaticOrder S; S.init(SEQ, RPROJ, G, c);
        EpiRet1 E{(bf16_t*)(ws + WS_QD), (bf16_t*)(ws + WS_KD), (bf16_t*)(ws + WS_V), (bf16_t*)(ws + WS_SG), (const float*)(ws + WS_ROPE), args.l2g};
        pg8::gemm_phase(lds, g, S, E, wave);
    }
    SEAM(1);
    if (IN(2)) for (int rep_ = 0; rep_ < NDUP(2); ++rep_) { if (rep_) xcd_barrier(bar, wave); if (c < 128) p_scan(args, lds, wave); else p_weights_big(args, lds, wave);
        VM_WAIT(); __syncthreads(); }
    SEAM(2);
    if (IN(3)) for (int rep_ = 0; rep_ < NDUP(3); ++rep_) { if (rep_) xcd_barrier(bar, wave); p_retention(args, lds, wave); }
    SEAM(3);
    if (IN(4)) for (int rep_ = 0; rep_ < NDUP(4); ++rep_) { if (rep_) xcd_barrier(bar, wave);
        { pg8::Gemm g{(const bf16_t*)(ws + WS_Z), (const bf16_t*)(ws + WS_WT_RO), SEQ, DM, PW, PW, PW}; pg8::StaticOrder S; S.init(SEQ, DM, G, c);
          EpiRes<true> E{args.in[0], nullptr, (bf16_t*)(ws + WS_A1), rp0};
          pg8::gemm_phase(lds, g, S, E, wave); }
        { pg8::Gemm g{(const bf16_t*)(ws + WS_PBF), (const bf16_t*)(ws + WS_WT_P0), SEQ, DM, PLE, PLE, PLE}; pg8::UpperHalfOrder S; S.init(SEQ, DM, G, c);
          EpiPlain E{(bf16_t*)(ws + WS_PE0), DM};
          pg8::gemm_phase(lds, g, S, E, wave); }
        { pg8::Gemm g{(const bf16_t*)(ws + WS_WT_GR), (const bf16_t*)(ws + WS_WU), PW, DM, 1024, 1024, PW}; pg8::CombOrder S; S.init(PW, DM, G, c);
          EpiComb E{(bf16_t*)(ws + WS_WT_PI), DM, args.in[8]};
          pg8::gemm_phase(lds, g, S, E, wave); }
    }
    SEAM(4);
    if (IN(5)) for (int rep_ = 0; rep_ < NDUP(5); ++rep_) { if (rep_) xcd_barrier(bar, wave);
        pg8::Gemm g{(const bf16_t*)(ws + WS_A1), (const bf16_t*)(ws + WS_WT_G0), SEQ, DM, DM, DM, DM}; pg8::StaticOrder S; S.init(SEQ, DM, G, c);
        rstd_table(lds, rp0, S, wave * 64 + lane_id());
        EpiPle E{(const bf16_t*)(ws + WS_A1), (const bf16_t*)(ws + WS_PE0), lds, (bf16_t*)(ws + WS_A2), rp1};
        pg8::gemm_phase(lds, g, S, E, wave);
    }
    SEAM(5);
    if (IN(6)) for (int rep_ = 0; rep_ < NDUP(6); ++rep_) { if (rep_) xcd_barrier(bar, wave);
        pg8::Gemm g{(const bf16_t*)(ws + WS_A2), (const bf16_t*)(ws + WS_WT_PI), SEQ, 2 * PW, DM, DM, DM}; pg8::StaticOrder S; S.init(SEQ, 2 * PW, G, c);
        rstd_table(lds, rp1, S, wave * 64 + lane_id());
        EpiPoolIn E{lds, (bf16_t*)(ws + WS_U), (bf16_t*)(ws + WS_SG1)};
        pg8::gemm_phase(lds, g, S, E, wave);
    }
    SEAM(6);
    if (IN(7)) for (int rep_ = 0; rep_ < NDUP(7); ++rep_) { if (rep_) xcd_barrier(bar, wave); p_pool(args, wave); }
    SEAM(7);
    if (IN(8)) for (int rep_ = 0; rep_ < NDUP(8); ++rep_) { if (rep_) xcd_barrier(bar, wave);
        { pg8::Gemm g{(const bf16_t*)(ws + WS_ZZ), (const bf16_t*)(ws + WS_WT_PO), SEQ, DM, PW, PW, PW}; pg8::StaticOrder S; S.init(SEQ, DM, G, c);
          EpiRes<false> E{nullptr, (const bf16_t*)(ws + WS_A2), (bf16_t*)(ws + WS_A3), rp2};
          pg8::gemm_phase(lds, g, S, E, wave); }
        { pg8::Gemm g{(const bf16_t*)(ws + WS_PBF) + (size_t)SEQ * PLE, (const bf16_t*)(ws + WS_WT_P1), SEQ, DM, PLE, PLE, PLE}; pg8::StaticOrder S; S.init(SEQ, DM, G, c);
          EpiPlain E{(bf16_t*)(ws + WS_PE1), DM};
          pg8::gemm_phase(lds, g, S, E, wave); }
    }
    SEAM(8);
    if (IN(9)) for (int rep_ = 0; rep_ < NDUP(9); ++rep_) { if (rep_) xcd_barrier(bar, wave);
        pg8::Gemm g{(const bf16_t*)(ws + WS_A3), (const bf16_t*)(ws + WS_WT_G1), SEQ, DM, DM, DM, DM}; pg8::StaticOrder S; S.init(SEQ, DM, G, c);
        rstd_table(lds, rp2, S, wave * 64 + lane_id());
        EpiPleFinal E{(const bf16_t*)(ws + WS_A3), (const bf16_t*)(ws + WS_PE1), lds, args.out, args.in[13], (unsigned*)(ws + WS_CTL)};
        pg8::gemm_phase(lds, g, S, E, wave);
    }
#undef IN
#undef SEAM
}

extern "C" void kernel_launch(void* const* d_in, const int* in_sizes, int n_in, void* d_out, int out_size, void* d_ws, size_t ws_size, hipStream_t stream) {
    static int grid = 0;
    if (grid == 0) {
        if (n_in != 14 || out_size != SEQ * DM || ws_size < WS_END) { fprintf(stderr, "kernel_launch: unexpected problem: n_in %d out %d ws %zu (need %zu)\n", n_in, out_size, ws_size, (size_t)WS_END); grid = -1; return; }
        int dev = 0, cus = 0, per_cu = 0;
        if (hipGetDevice(&dev) != hipSuccess || hipDeviceGetAttribute(&cus, hipDeviceAttributeMultiprocessorCount, dev) != hipSuccess) { grid = -1; return; }
        if (hipFuncSetAttribute((const void*)trunk_fwd, hipFuncAttributeMaxDynamicSharedMemorySize, LDS_BYTES) != hipSuccess) { fprintf(stderr, "kernel_launch: hipFuncSetAttribute failed\n"); grid = -1; return; }
        if (hipOccupancyMaxActiveBlocksPerMultiprocessor(&per_cu, (const void*)trunk_fwd, 512, LDS_BYTES) != hipSuccess || per_cu < 1) { fprintf(stderr, "kernel_launch: occupancy query says %d\n", per_cu); (void)hipGetLastError(); }
        grid = cus;
        if (grid != 256) fprintf(stderr, "kernel_launch: %d CUs (built for 256)\n", grid);
    }
    if (grid < 0) return;
    (void)hipMemsetAsync((char*)d_ws + WS_CTL, 0, CTL_ZERO_BYTES, stream);
    Args a{};
    for (int i = 0; i < 14; ++i) a.in[i] = (const float*)d_in[i];
    a.out = (float*)d_out; a.ws = (unsigned char*)d_ws;
    for (int i = 0; i < 128; ++i) { const float lin = (float)i * (1.0f / 127.0f); a.freq[i] = (float)pow(10000.0, -(double)lin); }
    for (int h = 0; h < 8; ++h) { const double lg = log2(1.0 - pow(2.0, -5.0 - (double)h)); a.l2g[h] = (float)lg; a.g256[h] = (float)exp2(256.0 * lg); }
    constexpr int NPH = 10;
    if (MK_N_LAUNCHES == 1) {
        a.ph_lo = 0; a.ph_hi = NPH;
        void* kargs[] = {&a};
        const hipError_t le = hipLaunchCooperativeKernel((const void*)trunk_fwd, dim3(grid), dim3(512), kargs, LDS_BYTES, stream);
        if (le != hipSuccess) fprintf(stderr, "kernel_launch: cooperative launch failed: %s (grid %d)\n", hipGetErrorString(le), grid);
    } else {
        for (int ph = 0; ph < NPH; ++ph) { a.ph_lo = ph; a.ph_hi = ph + 1; hipLaunchKernelGGL(trunk_fwd, dim3(grid), dim3(512), LDS_BYTES, stream, a); }
    }
}
```

```cpp
#include <hip/hip_runtime.h>
#include <cstdio>
#include <cstdint>
#include <cmath>

#ifndef MK_N_LAUNCHES
#define MK_N_LAUNCHES 1
#define CV_BIG 1
#endif

#define LAS __attribute__((address_space(3)))
#define GAS __attribute__((address_space(1)))
typedef unsigned short bf16_t;
typedef short bf16x8 __attribute__((ext_vector_type(8)));
typedef short s16x4 __attribute__((ext_vector_type(4)));
typedef float f32x4 __attribute__((ext_vector_type(4)));
typedef float f32x2 __attribute__((ext_vector_type(2)));
typedef unsigned u32x4 __attribute__((ext_vector_type(4)));
typedef unsigned u32x2 __attribute__((ext_vector_type(2)));

constexpr int SEQ = 8192, DM = 2048, RPROJ = 12288, NH = 8, DKH = 256, DVH = 512, PW = 4096, PLE = 256;
constexpr float NORM_EPS = 1e-6f, GN_EPS = 1e-5f;

constexpr size_t MiB = 1u << 20;
constexpr size_t WS_CTL = 0, CTL_ZERO_BYTES = 128 * 1024;
constexpr size_t WS_RP = 1 * MiB;
constexpr size_t WS_ROPE = 5 * MiB;
constexpr size_t WS_PBF = 13 * MiB;
constexpr size_t WS_WT_RO = 21 * MiB;
constexpr size_t WS_WT_G0 = 37 * MiB;
constexpr size_t WS_WT_P0 = 45 * MiB;
constexpr size_t WS_WT_RI = 46 * MiB;
constexpr size_t WS_XN0 = 94 * MiB;
constexpr size_t WS_QD = 126 * MiB, WS_KD = 158 * MiB, WS_V = 190 * MiB, WS_SG = 254 * MiB;
constexpr size_t WS_Z = WS_SG;
constexpr size_t WS_ST = 318 * MiB;
constexpr size_t WS_WU = 46 * MiB;
constexpr size_t WS_WT_PI = 62 * MiB;
constexpr size_t WS_WT_GR = 94 * MiB, WS_WT_PO = 102 * MiB, WS_WT_G1 = 118 * MiB, WS_WT_P1 = 382 * MiB;
constexpr size_t WS_H1 = 126 * MiB, WS_A1 = 190 * MiB, WS_PE0 = 222 * MiB;
constexpr size_t WS_H2 = 254 * MiB, WS_A2 = 318 * MiB;
constexpr size_t WS_U = 126 * MiB, WS_SG1 = 190 * MiB, WS_ZZ = 254 * MiB;
constexpr size_t WS_H3 = 126 * MiB, WS_A3 = 190 * MiB, WS_PE1 = 222 * MiB;
constexpr size_t WS_END = 383 * MiB;

constexpr int RING_BYTES = 131072;
constexpr int LDS_BYTES = 155648;
constexpr int MISC_OFF = LDS_BYTES - 256;

#define LDS_WAIT() asm volatile("s_waitcnt lgkmcnt(0)" ::: "memory")
#define VM_WAIT() asm volatile("s_waitcnt vmcnt(0)" ::: "memory")

__device__ __forceinline__ unsigned cvt_pk_bf16(float lo, float hi) { unsigned r; asm volatile("v_cvt_pk_bf16_f32 %0, %1, %2" : "=v"(r) : "v"(lo), "v"(hi)); return r; }
__device__ __forceinline__ float bf_lo(unsigned w) { return __uint_as_float(w << 16); }
__device__ __forceinline__ float bf_hi(unsigned w) { return __uint_as_float(w & 0xffff0000u); }
__device__ __forceinline__ float fsigmoid(float x) { return __builtin_amdgcn_rcpf(1.0f + __builtin_amdgcn_exp2f(-1.44269504089f * x)); }
__device__ __forceinline__ float fsilu(float x) { return x * fsigmoid(x); }
__device__ __forceinline__ int lane_id() { int l; asm volatile("v_mbcnt_lo_u32_b32 %0, -1, 0\n\tv_mbcnt_hi_u32_b32 %0, -1, %0" : "=v"(l)); return l; }
__device__ __forceinline__ float wave_sum(float v) {
#pragma unroll
    for (int o = 1; o < 64; o <<= 1) v += __shfl_xor(v, o);
    return v;
}

namespace pg8 {
constexpr int BM = 256, BK = 64, HALF = 128, HTB = HALF * BK * 2, STAGE_BYTES = 8 * HTB, NXCD = 8, WGM = 4;
__host__ __device__ __forceinline__ int lds_byte(int r, int c) { const int st = (r >> 4) * 2 + (c >> 5), rr = r & 15, cc = c & 31, ob = rr * 64 + cc * 2; return st * 1024 + (ob ^ (((ob >> 9) & 1) << 5)); }
__host__ __device__ __forceinline__ void stage_rc(int b, int& R, int& C) { const int st = b / 1024, sb = b % 1024, swz = sb ^ (((sb >> 9) & 1) << 5); R = (st >> 1) * 16 + swz / 64; C = (st & 1) * 32 + (swz % 64) / 2; }
__host__ __device__ __forceinline__ int perm32(int rho) { const int n = rho >> 4, i = rho & 15; return 8 * (i >> 2) + 4 * n + (i & 3); }

struct Unit { int pm, pn, slot; };
struct Gemm { const bf16_t* A; const bf16_t* Bt; int M, N, K, lda, ldb; };

struct StaticOrder {
    int nM, nN, nwg, G, c;
    __host__ __device__ void init(int M, int N, int G_, int c_) { nM = M / BM; nN = N / BM; nwg = nM * nN; G = G_; c = c_; }
    __host__ __device__ bool next(int i, Unit& u) const {
        const long L = (long)i * G + c; if (L >= nwg) return false;
        int wgid = (int)L; { const int q = nwg / NXCD, r = nwg % NXCD, xcd = wgid % NXCD, off = wgid / NXCD; wgid = (xcd < r ? xcd * (q + 1) : r * (q + 1) + (xcd - r) * q) + off; }
        const int nig = WGM * nN, gid = wgid / nig, fm = gid * WGM, gsz = (nM - fm) < WGM ? (nM - fm) : WGM;
        u.pm = fm + ((wgid % nig) % gsz); u.pn = (wgid % nig) / gsz; u.slot = i; return true;
    }
    __device__ __forceinline__ size_t a_off(const Unit&) const { return 0; }
    __device__ __forceinline__ size_t b_off(const Unit&) const { return 0; }
};
struct UpperHalfOrder : StaticOrder {
    __host__ __device__ bool next(int i, Unit& u) const { const int hw = G >> 1, per = nwg / hw; if (c < hw || i >= per) return false; const int L = (c - hw) * per + i; u.pm = L / nN; u.pn = L - u.pm * nN; u.slot = i; return true; }
};
struct CombOrder : StaticOrder {
    __device__ __forceinline__ size_t b_off(const Unit& u) const { return (size_t)(u.pm >> 2) * 2048; }
};

template <class Epi, class Sched, int EPI_REPS = 1>
__device__ __forceinline__ void gemm_phase(LAS unsigned char* lds, const Gemm g, const Sched& S, const Epi& E, const int wid) {
    int lane_ = lane_id(); asm volatile("" : "+v"(lane_));
    const int lane = lane_, tid = wid * 64 + lane, wr = wid >> 2, wc = wid & 3, fr = lane & 15, fq = lane >> 4;
    const int K = g.K, nt = K / BK;
    unsigned voffA[2], voffB[2];
#pragma unroll
    for (int i = 0; i < 2; ++i) { int R, C; stage_rc(tid * 16 + i * 8192, R, C); const int Rb = (R & ~31) + perm32(R & 31);
        voffA[i] = (unsigned)(R * g.lda + C) * 2u; voffB[i] = (unsigned)(Rb * g.ldb + C) * 2u; }
    const size_t kstep = (size_t)(BK * 2);
    const size_t hstepA = (size_t)HALF * g.lda * 2, hstepB = (size_t)HALF * g.ldb * 2;
    const size_t tstepA = 2 * hstepA, tstepB = 2 * hstepB;
    const unsigned ldsw = (unsigned)wid * 1024u;
    const int aoff = lds_byte(wr * 64 + fr, fq * 8), boff = lds_byte(wc * 32 + fr, fq * 8);
#define PG8_SA(b, h) (((b) * 2 + (h)) * HTB)
#define PG8_SB(b, h) ((4 + (b) * 2 + (h)) * HTB)
#define PG8_STAGE(bufoff, gbase, voff) do { _Pragma("unroll") for (int _i = 0; _i < 2; ++_i) \
        __builtin_amdgcn_global_load_lds((const unsigned*)((const char*)(gbase) + (voff)[_i]), (LAS unsigned*)(lds + (bufoff) + ldsw + _i * 8192), 16, 0, 0); } while (0)
#define PG8_LDA(dst, b, h) do { _Pragma("unroll") for (int m = 0; m < 4; ++m) _Pragma("unroll") for (int k = 0; k < 2; ++k) dst[m][k] = *(const LAS bf16x8*)(lds + PG8_SA(b, h) + aoff + m * 2048 + k * 1024); } while (0)
#define PG8_LDB(dst, b, h) do { _Pragma("unroll") for (int n = 0; n < 2; ++n) _Pragma("unroll") for (int k = 0; k < 2; ++k) dst[n][k] = *(const LAS bf16x8*)(lds + PG8_SB(b, h) + boff + n * 2048 + k * 1024); } while (0)
#define PG8_MMA(ai, bj, At, Bt) do { __builtin_amdgcn_s_setprio(1); _Pragma("unroll") for (int m = 0; m < 4; ++m) _Pragma("unroll") for (int n = 0; n < 2; ++n) _Pragma("unroll") for (int k = 0; k < 2; ++k) \
        acc[ai][bj][m][n] = __builtin_amdgcn_mfma_f32_16x16x32_bf16(Bt[n][k], At[m][k], acc[ai][bj][m][n], 0, 0, 0); __builtin_amdgcn_s_setprio(0); } while (0)
#define PG8_WAIT_V(n) asm volatile("s_waitcnt vmcnt(" #n ")" ::: "memory")
#define PG8_WAIT_L(n) asm volatile("s_waitcnt lgkmcnt(" #n ")" ::: "memory")
#define PG8_BAR __builtin_amdgcn_s_barrier()
#define PG8_SCHED __builtin_amdgcn_sched_barrier(0)
    Unit cur, nxt; int ui = 0;
    if (!S.next(0, cur)) return;
    f32x4 acc[2][2][4][2];
#pragma unroll
    for (int a = 0; a < 2; ++a)
#pragma unroll
        for (int b = 0; b < 2; ++b)
#pragma unroll
            for (int m = 0; m < 4; ++m)
#pragma unroll
                for (int n = 0; n < 2; ++n) acc[a][b][m][n] = (f32x4){0.f, 0.f, 0.f, 0.f};
    bf16x8 At[4][2], B0[2][2], B1[2][2];
    const char* cA = (const char*)g.A + (size_t)cur.pm * tstepA + S.a_off(cur); const char* cB = (const char*)g.Bt + (size_t)cur.pn * tstepB + S.b_off(cur);
    PG8_STAGE(PG8_SB(0, 0), cB, voffB); PG8_STAGE(PG8_SB(0, 1), cB + hstepB, voffB); PG8_STAGE(PG8_SA(0, 0), cA, voffA); PG8_STAGE(PG8_SA(0, 1), cA + hstepA, voffA);
    if (wr == 1) PG8_BAR;
    PG8_WAIT_V(2); PG8_BAR;
    PG8_STAGE(PG8_SB(1, 0), cB + kstep, voffB); PG8_STAGE(PG8_SA(1, 0), cA + kstep, voffA); PG8_STAGE(PG8_SB(1, 1), cB + hstepB + kstep, voffB);
    PG8_WAIT_V(6); PG8_BAR;
    for (;;) {
        const bool has_next = S.next(ui + 1, nxt);
        const char* nA = has_next ? (const char*)g.A + (size_t)nxt.pm * tstepA + S.a_off(nxt) : cA; const char* nB = has_next ? (const char*)g.Bt + (size_t)nxt.pn * tstepB + S.b_off(nxt) : cB;
        for (int t = 0; t < nt; t += 2) {
            const bool last = (t == nt - 2);
            const char* a1 = cA + (size_t)(t + 1) * kstep;
            const char* a2 = last ? nA : cA + (size_t)(t + 2) * kstep; const char* b2 = last ? nB : cB + (size_t)(t + 2) * kstep;
            const char* a3 = a2 + kstep; const char* b3 = b2 + kstep;
            PG8_LDB(B0, 0, 0); PG8_LDB(B1, 0, 1); PG8_SCHED; PG8_LDA(At, 0, 0); PG8_STAGE(PG8_SA(1, 1), a1 + hstepA, voffA);
            PG8_WAIT_V(8); PG8_WAIT_L(0); PG8_BAR; PG8_MMA(0, 0, At, B0); PG8_MMA(0, 1, At, B1); PG8_BAR; PG8_SCHED;
            PG8_LDA(At, 0, 1); PG8_STAGE(PG8_SB(0, 0), b2, voffB); PG8_STAGE(PG8_SB(0, 1), b2 + hstepB, voffB); PG8_STAGE(PG8_SA(0, 0), a2, voffA);
            PG8_WAIT_V(8); PG8_WAIT_L(0); PG8_BAR; PG8_MMA(1, 0, At, B0); PG8_MMA(1, 1, At, B1); PG8_BAR; PG8_SCHED;
            PG8_LDB(B0, 1, 0); PG8_LDB(B1, 1, 1); PG8_SCHED; PG8_LDA(At, 1, 0); PG8_STAGE(PG8_SA(0, 1), a2 + hstepA, voffA);
            PG8_WAIT_V(8); PG8_WAIT_L(0); PG8_BAR; PG8_MMA(0, 0, At, B0); PG8_MMA(0, 1, At, B1); PG8_BAR; PG8_SCHED;
            PG8_LDA(At, 1, 1); PG8_STAGE(PG8_SB(1, 0), b3, voffB); PG8_STAGE(PG8_SB(1, 1), b3 + hstepB, voffB); PG8_STAGE(PG8_SA(1, 0), a3, voffA);
            PG8_WAIT_V(8); PG8_WAIT_L(0); PG8_BAR; PG8_MMA(1, 0, At, B0); PG8_MMA(1, 1, At, B1); PG8_BAR; PG8_SCHED;
        }
        if (wr == 0) PG8_BAR;
        for (int er_ = 0; er_ < EPI_REPS; ++er_) { const int l2 = lane_id(); E(acc, cur, wr, wc, l2 & 15, l2 >> 4); }
        if (!has_next) break;
#pragma unroll
        for (int a = 0; a < 2; ++a)
#pragma unroll
            for (int b = 0; b < 2; ++b)
#pragma unroll
                for (int m = 0; m < 4; ++m)
#pragma unroll
                    for (int n = 0; n < 2; ++n) acc[a][b][m][n] = (f32x4){0.f, 0.f, 0.f, 0.f};
        cur = nxt; cA = nA; cB = nB; ++ui;
        if (wr == 1) PG8_BAR;
    }
    PG8_WAIT_V(0);
    PG8_BAR;
#undef PG8_SA
#undef PG8_SB
#undef PG8_STAGE
#undef PG8_LDA
#undef PG8_LDB
#undef PG8_MMA
#undef PG8_WAIT_V
#undef PG8_WAIT_L
#undef PG8_BAR
#undef PG8_SCHED
}
}
using pg8::Unit;

#define EPI_ARGS f32x4 (&acc)[2][2][4][2], const Unit& u, int wr, int wc, int fr, int fq
__device__ __forceinline__ u32x4 pack8(const f32x4 a, const f32x4 b) { u32x4 w; w.x = cvt_pk_bf16(a[0], a[1]); w.y = cvt_pk_bf16(a[2], a[3]); w.z = cvt_pk_bf16(b[0], b[1]); w.w = cvt_pk_bf16(b[2], b[3]); return w; }
__device__ __forceinline__ void unpack8(const u32x4 w, f32x4& a, f32x4& b) { a = (f32x4){bf_lo(w.x), bf_hi(w.x), bf_lo(w.y), bf_hi(w.y)}; b = (f32x4){bf_lo(w.z), bf_hi(w.z), bf_lo(w.w), bf_hi(w.w)}; }
__device__ __forceinline__ float row_rstd(const float* rp, int row) {
    const f32x4* q = (const f32x4*)(rp + (size_t)row * 32); f32x4 s = q[0];
#pragma unroll
    for (int i = 1; i < 8; ++i) s += q[i];
    return __builtin_amdgcn_rsqf(((s[0] + s[1]) + (s[2] + s[3])) * (1.0f / DM) + NORM_EPS);
}
constexpr int RSTD_OFF = RING_BYTES;
template <class Sched> __device__ __forceinline__ void rstd_table(LAS unsigned char* lds, const float* rp, const Sched& S, int tid) {
    LAS float* tab = (LAS float*)(lds + RSTD_OFF); Unit u;
    for (int i = 0; i < 8 && S.next(i, u); ++i) if (tid < 256) tab[i * 256 + tid] = row_rstd(rp, u.pm * 256 + tid);
    __syncthreads();
}
__device__ __forceinline__ float rstd_lds(const LAS unsigned char* lds, int slot, int r) { return ((const LAS float*)(lds + RSTD_OFF))[slot * 256 + r]; }

struct EpiRet1 {
    bf16_t *qd, *kd, *v, *sg; const float* rope; const float* l2g;
    __device__ __forceinline__ void operator()(EPI_ARGS) const {
        const int pn = u.pn, row0 = u.pm * 256 + wr * 64 + fr, c0 = wc * 32 + 8 * fq;
        if (pn < 16) {
            const int head = pn & 7; const bool isk = pn >= 8;
            bf16_t* out = (isk ? kd : qd) + head * 256; const float lg = l2g[head];
#pragma unroll
            for (int ai = 0; ai < 2; ++ai)
#pragma unroll
                for (int m = 0; m < 4; ++m) { const int row = row0 + ai * 128 + m * 16, r = row & 255;
                    const float dec = isk ? __builtin_amdgcn_exp2f(lg * (float)(255 - r)) * 0.0625f : __builtin_amdgcn_exp2f(lg * (float)(r - 255));
#pragma unroll
                    for (int bj = 0; bj < 2; ++bj) { const int c = c0 + bj * 128;
                        const f32x4* rp = (const f32x4*)(rope + ((size_t)row * 128 + (c >> 1)) * 2); const f32x4 t0 = rp[0], t1 = rp[1];
                        const f32x4 x = acc[ai][bj][m][0], y = acc[ai][bj][m][1]; f32x4 o0, o1;
                        o0[0] = (x[0] * t0[0] - x[1] * t0[1]) * dec; o0[1] = (x[1] * t0[0] + x[0] * t0[1]) * dec;
                        o0[2] = (x[2] * t0[2] - x[3] * t0[3]) * dec; o0[3] = (x[3] * t0[2] + x[2] * t0[3]) * dec;
                        o1[0] = (y[0] * t1[0] - y[1] * t1[1]) * dec; o1[1] = (y[1] * t1[0] + y[0] * t1[1]) * dec;
                        o1[2] = (y[2] * t1[2] - y[3] * t1[3]) * dec; o1[3] = (y[3] * t1[2] + y[2] * t1[3]) * dec;
                        if (isk) *(u32x4*)(out + (size_t)row * DM + c) = pack8(o0, o1); else __builtin_nontemporal_store(pack8(o0, o1), (u32x4*)(out + (size_t)row * DM + c)); } }
        } else if (pn < 32) {
            bf16_t* out = v + (pn - 16) * 256 + c0;
#pragma unroll
            for (int ai = 0; ai < 2; ++ai)
#pragma unroll
                for (int m = 0; m < 4; ++m) { const int row = row0 + ai * 128 + m * 16;
#pragma unroll
                    for (int bj = 0; bj < 2; ++bj) *(u32x4*)(out + (size_t)row * PW + bj * 128) = pack8(acc[ai][bj][m][0], acc[ai][bj][m][1]); }
        } else {
            bf16_t* out = sg + (pn - 32) * 256 + c0;
#pragma unroll
            for (int ai = 0; ai < 2; ++ai)
#pragma unroll
                for (int m = 0; m < 4; ++m) { const int row = row0 + ai * 128 + m * 16;
#pragma unroll
                    for (int bj = 0; bj < 2; ++bj) { f32x4 a = acc[ai][bj][m][0], b = acc[ai][bj][m][1];
#pragma unroll
                        for (int e = 0; e < 4; ++e) { a[e] = fsilu(a[e]); b[e] = fsilu(b[e]); }
                        __builtin_nontemporal_store(pack8(a, b), (u32x4*)(out + (size_t)row * PW + bj * 128)); } }
        }
    }
};
struct EpiPlain {
    bf16_t* O; int ldc;
    __device__ __forceinline__ void operator()(EPI_ARGS) const {
        bf16_t* out = O + (size_t)(u.pm * 256 + wr * 64 + fr) * ldc + u.pn * 256 + wc * 32 + 8 * fq;
#pragma unroll
        for (int ai = 0; ai < 2; ++ai)
#pragma unroll
            for (int m = 0; m < 4; ++m)
#pragma unroll
                for (int bj = 0; bj < 2; ++bj) *(u32x4*)(out + (size_t)(ai * 128 + m * 16) * ldc + bj * 128) = pack8(acc[ai][bj][m][0], acc[ai][bj][m][1]);
    }
};
template <bool RESF> struct EpiRes {
    const float* resf; const bf16_t* resb; bf16_t* aout; float* rpo;
    __device__ __forceinline__ void operator()(EPI_ARGS) const {
        const int row0 = u.pm * 256 + wr * 64 + fr, col0 = u.pn * 256 + wc * 32 + 8 * fq;
#pragma unroll
        for (int ai = 0; ai < 2; ++ai) {
            f32x4 rv[4][2][2];
#pragma unroll
            for (int m = 0; m < 4; ++m)
#pragma unroll
                for (int bj = 0; bj < 2; ++bj) { const size_t o = (size_t)(row0 + ai * 128 + m * 16) * DM + col0 + bj * 128;
                    if (RESF) { rv[m][bj][0] = *(const f32x4*)(resf + o); rv[m][bj][1] = *(const f32x4*)(resf + o + 4); }
                    else unpack8(*(const u32x4*)(resb + o), rv[m][bj][0], rv[m][bj][1]); }
#pragma unroll
            for (int m = 0; m < 4; ++m) { const int row = row0 + ai * 128 + m * 16; const size_t off = (size_t)row * DM + col0; float ss = 0.f;
#pragma unroll
                for (int bj = 0; bj < 2; ++bj) { const size_t o = off + bj * 128;
                    const f32x4 h0 = rv[m][bj][0] + acc[ai][bj][m][0], h1 = rv[m][bj][1] + acc[ai][bj][m][1];
                    ss += (h0[0] * h0[0] + h0[1] * h0[1]) + (h0[2] * h0[2] + h0[3] * h0[3]) + (h1[0] * h1[0] + h1[1] * h1[1]) + (h1[2] * h1[2] + h1[3] * h1[3]);
                    *(u32x4*)(aout + o) = pack8(h0, h1); }
                ss += __shfl_xor(ss, 16); ss += __shfl_xor(ss, 32);
                if (fq == 0) rpo[(size_t)row * 32 + u.pn * 4 + wc] = ss; }
            asm volatile("" ::: "memory"); }
    }
};
struct EpiPle {
    const bf16_t* hin; const bf16_t* pe; const LAS unsigned char* lds; bf16_t* aout; float* rpo;
    __device__ __forceinline__ void operator()(EPI_ARGS) const {
        const int row0 = u.pm * 256 + wr * 64 + fr, col0 = u.pn * 256 + wc * 32 + 8 * fq;
#pragma unroll
        for (int ai = 0; ai < 2; ++ai) {
            u32x4 hv[4][2], pv[4][2];
#pragma unroll
            for (int m = 0; m < 4; ++m)
#pragma unroll
                for (int bj = 0; bj < 2; ++bj) { const size_t o = (size_t)(row0 + ai * 128 + m * 16) * DM + col0 + bj * 128; hv[m][bj] = *(const u32x4*)(hin + o); pv[m][bj] = *(const u32x4*)(pe + o); }
#pragma unroll
            for (int m = 0; m < 4; ++m) { const int row = row0 + ai * 128 + m * 16; const size_t off = (size_t)row * DM + col0; float ss = 0.f;
                const float rstd = rstd_lds(lds, u.slot, row & 255);
#pragma unroll
                for (int bj = 0; bj < 2; ++bj) { const size_t o = off + bj * 128;
                    f32x4 h0, h1, p0, p1; unpack8(hv[m][bj], h0, h1); unpack8(pv[m][bj], p0, p1);
                    const f32x4 a0 = acc[ai][bj][m][0], a1 = acc[ai][bj][m][1];
#pragma unroll
                    for (int e = 0; e < 4; ++e) { h0[e] += fsigmoid(a0[e] * rstd) * p0[e]; h1[e] += fsigmoid(a1[e] * rstd) * p1[e]; }
                    ss += (h0[0] * h0[0] + h0[1] * h0[1]) + (h0[2] * h0[2] + h0[3] * h0[3]) + (h1[0] * h1[0] + h1[1] * h1[1]) + (h1[2] * h1[2] + h1[3] * h1[3]);
                    *(u32x4*)(aout + o) = pack8(h0, h1); }
                ss += __shfl_xor(ss, 16); ss += __shfl_xor(ss, 32);
                if (fq == 0) rpo[(size_t)row * 32 + u.pn * 4 + wc] = ss; }
            asm volatile("" ::: "memory"); }
    }
};
constexpr int FN_P_OFF = RING_BYTES + 8192, FN_S_OFF = FN_P_OFF + 4096;
constexpr int CW_FN_CNT = 16384, CW_FN_X = 32768;
struct EpiPleFinal {
    const bf16_t* hin; const bf16_t* pe; LAS unsigned char* lds; float* out; const float* gain; unsigned* ctl;
    __device__ __forceinline__ void operator()(EPI_ARGS) const {
        const int row0 = u.pm * 256 + wr * 64 + fr, col0 = u.pn * 256 + wc * 32 + 8 * fq;
        const int wid = wr * 4 + wc, tid = wid * 64 + fq * 16 + fr;
        LAS float* P = (LAS float*)(lds + FN_P_OFF); LAS float* S = (LAS float*)(lds + FN_S_OFF);
#pragma unroll
        for (int ai = 0; ai < 2; ++ai)
#pragma unroll
            for (int mp = 0; mp < 2; ++mp) {
                u32x4 hv[2][2], pv[2][2];
#pragma unroll
                for (int mm = 0; mm < 2; ++mm)
#pragma unroll
                    for (int bj = 0; bj < 2; ++bj) { const size_t o = (size_t)(row0 + ai * 128 + (2 * mp + mm) * 16) * DM + col0 + bj * 128;
                        hv[mm][bj] = *(const u32x4*)(hin + o); pv[mm][bj] = *(const u32x4*)(pe + o); }
#pragma unroll
                for (int mm = 0; mm < 2; ++mm) { const int m = 2 * mp + mm, row = row0 + ai * 128 + m * 16; float ss = 0.f;
                    const float rstd = rstd_lds(lds, u.slot, row & 255);
#pragma unroll
                    for (int bj = 0; bj < 2; ++bj) {
                        f32x4 h0, h1, p0, p1; unpack8(hv[mm][bj], h0, h1); unpack8(pv[mm][bj], p0, p1);
                        const f32x4 a0 = acc[ai][bj][m][0], a1 = acc[ai][bj][m][1];
#pragma unroll
                        for (int e = 0; e < 4; ++e) { h0[e] += fsigmoid(a0[e] * rstd) * p0[e]; h1[e] += fsigmoid(a1[e] * rstd) * p1[e]; }
                        acc[ai][bj][m][0] = h0; acc[ai][bj][m][1] = h1;
                        ss += (h0[0] * h0[0] + h0[1] * h0[1]) + (h0[2] * h0[2] + h0[3] * h0[3]) + (h1[0] * h1[0] + h1[1] * h1[1]) + (h1[2] * h1[2] + h1[3] * h1[3]); }
                    ss += __shfl_xor(ss, 16); ss += __shfl_xor(ss, 32);
                    if (fq == 0) P[(row & 255) * 4 + wc] = ss; }
                asm volatile("" ::: "memory"); }
        asm volatile("s_waitcnt lgkmcnt(0)" ::: "memory"); __builtin_amdgcn_s_barrier(); asm volatile("" ::: "memory");
        float* X = (float*)(ctl + CW_FN_X); unsigned* cnt = ctl + CW_FN_CNT + 64 * u.pm;
        if (tid < 256) { const float t = (P[tid * 4 + 0] + P[tid * 4 + 1]) + (P[tid * 4 + 2] + P[tid * 4 + 3]);
            __hip_atomic_store(X + ((size_t)(u.pm * 256 + tid) * 8 + u.pn), t, __ATOMIC_RELAXED, __HIP_MEMORY_SCOPE_AGENT);
            asm volatile("s_waitcnt vmcnt(0)" ::: "memory");
            if ((tid & 63) == 0) __hip_atomic_fetch_add(cnt, 1u, __ATOMIC_RELAXED, __HIP_MEMORY_SCOPE_AGENT); }
        if (wid == 0) {
            unsigned spins = 0;
            while ((unsigned)__builtin_amdgcn_readfirstlane(__hip_atomic_load(cnt, __ATOMIC_RELAXED, __HIP_MEMORY_SCOPE_AGENT)) < 32u) { __builtin_amdgcn_s_sleep(2); if (++spins > (1u << 22)) break; }
            __builtin_amdgcn_fence(__ATOMIC_ACQUIRE, "agent");
            asm volatile("s_waitcnt vmcnt(0)" ::: "memory"); }
        asm volatile("s_waitcnt vmcnt(0) lgkmcnt(0)" ::: "memory"); __builtin_amdgcn_s_barrier(); asm volatile("" ::: "memory");
        if (tid < 256) { const float* xs = X + (size_t)(u.pm * 256 + tid) * 8; float s = 0.f;
#pragma unroll
            for (int t = 0; t < 8; ++t) s += __hip_atomic_load(xs + t, __ATOMIC_RELAXED, __HIP_MEMORY_SCOPE_AGENT);
            S[tid] = __builtin_amdgcn_rsqf(s * (1.0f / DM) + NORM_EPS); }
        asm volatile("s_waitcnt lgkmcnt(0)" ::: "memory"); __builtin_amdgcn_s_barrier(); asm volatile("" ::: "memory");
        f32x4 gv[2][2];
#pragma unroll
        for (int bj = 0; bj < 2; ++bj) { gv[bj][0] = *(const f32x4*)(gain + col0 + bj * 128); gv[bj][1] = *(const f32x4*)(gain + col0 + bj * 128 + 4); }
#pragma unroll
        for (int ai = 0; ai < 2; ++ai)
#pragma unroll
            for (int m = 0; m < 4; ++m) { const int row = row0 + ai * 128 + m * 16; const float rs = S[row & 255]; const size_t off = (size_t)row * DM + col0;
#pragma unroll
                for (int bj = 0; bj < 2; ++bj) { *(f32x4*)(out + off + bj * 128) = acc[ai][bj][m][0] * rs * gv[bj][0]; *(f32x4*)(out + off + bj * 128 + 4) = acc[ai][bj][m][1] * rs * gv[bj][1]; } }
    }
};
struct EpiPoolIn {
    const LAS unsigned char* lds; bf16_t* uo; bf16_t* sgo;
    __device__ __forceinline__ void operator()(EPI_ARGS) const {
        const int row0 = u.pm * 256 + wr * 64 + fr; const bool isg = u.pn >= 16;
        bf16_t* out = (isg ? sgo : uo) + (u.pn & 15) * 256 + wc * 32 + 8 * fq;
#pragma unroll
        for (int ai = 0; ai < 2; ++ai)
#pragma unroll
            for (int m = 0; m < 4; ++m) { const int row = row0 + ai * 128 + m * 16; const float rstd = rstd_lds(lds, u.slot, row & 255);
#pragma unroll
                for (int bj = 0; bj < 2; ++bj) { f32x4 a = acc[ai][bj][m][0] * rstd, b = acc[ai][bj][m][1] * rstd;
                    if (isg) {
#pragma unroll
                        for (int e = 0; e < 4; ++e) { a[e] = fsilu(a[e]); b[e] = fsilu(b[e]); } }
                    *(u32x4*)(out + (size_t)row * PW + bj * 128) = pack8(a, b); } }
    }
};
struct EpiComb {
    bf16_t* O; int ldc; const float* scale;
    __device__ __forceinline__ void operator()(EPI_ARGS) const {
        const int row0 = u.pm * 256 + wr * 64 + fr;
        bf16_t* out = O + (size_t)row0 * ldc + u.pn * 256 + wc * 32 + 8 * fq;
#pragma unroll
        for (int ai = 0; ai < 2; ++ai)
#pragma unroll
            for (int m = 0; m < 4; ++m) { const float sc = scale[row0 + ai * 128 + m * 16];
#pragma unroll
                for (int bj = 0; bj < 2; ++bj) *(u32x4*)(out + (size_t)(ai * 128 + m * 16) * ldc + bj * 128) = pack8(acc[ai][bj][m][0] * sc, acc[ai][bj][m][1] * sc); }
    }
};

typedef GAS unsigned gu32;
#define RLX_AGENT __ATOMIC_RELAXED, __HIP_MEMORY_SCOPE_AGENT
#define XB_TMO      128
#define XB_XCNT(j)  (256  + 64 * (j))
#define XB_XSUB(j)  (1280 + 64 * (j))
#define XB_XGEN(j)  (2304 + 64 * (j))
#define XB_TOP      3328
#define XB_TOPGEN   3392
#define XCD_BAR_WORDS 3456
#define XB_SPIN_CAP (1u << 20)
__device__ __forceinline__ unsigned xb_ld(unsigned* p)              { return __hip_atomic_load(p, __ATOMIC_RELAXED, __HIP_MEMORY_SCOPE_AGENT); }
__device__ __forceinline__ unsigned xb_add(unsigned* p, unsigned v) { return __hip_atomic_fetch_add(p, v, __ATOMIC_RELAXED, __HIP_MEMORY_SCOPE_AGENT); }
__device__ __forceinline__ unsigned xb_xcc_id() { return (unsigned)__builtin_amdgcn_s_getreg((3 << 11) | 20) & 0xFu; }
#define XB_SPIN(cond, bar) do { unsigned _sp = 0; while (cond) { __builtin_amdgcn_s_sleep(1); \
    if ((++_sp & 255u) == 0u) { if (xb_ld(&(bar)[XB_TMO])) break; if (_sp > XB_SPIN_CAP) { atomicAdd(&(bar)[XB_TMO], 1u); break; } } } } while (0)
struct XcdBarrier { unsigned* bar; unsigned x; volatile LAS unsigned* st; };
__device__ __forceinline__ XcdBarrier xcd_barrier_post(unsigned* bar, volatile LAS unsigned* st, const int wave) {
    XcdBarrier b; b.bar = bar; b.x = xb_xcc_id(); b.st = st;
    if (wave == 0 && lane_id() == 0) (void)xb_add(&bar[XB_XCNT(b.x)], 1u);
    return b;
}
__device__ __forceinline__ void xcd_barrier_complete(unsigned* bar, unsigned x, unsigned& nloc, unsigned& nx) {
    const unsigned G = gridDim.x * gridDim.y * gridDim.z;
    unsigned sum, cnt, mine, sp = 0u;
    for (;;) {
        sum = 0u; cnt = 0u; mine = 0u;
#pragma unroll
        for (unsigned j = 0; j < 16; ++j) { const unsigned c = xb_ld(&bar[XB_XCNT(j)]); sum += c; cnt += (c > 0u) ? 1u : 0u; mine = (j == x) ? c : mine; }
        if (sum == G) break;
        __builtin_amdgcn_s_sleep(1);
        if ((++sp & 255u) == 0u) { if (xb_ld(&bar[XB_TMO])) break; if (sp > XB_SPIN_CAP) { atomicAdd(&bar[XB_TMO], 1u); break; } }
    }
    nloc = mine > 0u ? mine : 1u; nx = cnt > 0u ? cnt : 1u;
}
__device__ __forceinline__ void xcd_barrier(const XcdBarrier& b, const int wave) {
    asm volatile("s_waitcnt vmcnt(0)" ::: "memory");
    __syncthreads();
    if (wave == 0 && lane_id() == 0) {
        unsigned* bar = b.bar;
        __builtin_amdgcn_s_waitcnt(0);
        unsigned nloc = b.st[0], nx = b.st[1];
        if (nloc == 0u) { xcd_barrier_complete(bar, b.x, nloc, nx); b.st[0] = nloc; b.st[1] = nx; }
        const unsigned old = xb_add(&bar[XB_XSUB(b.x)], 1u);
        const unsigned gen = old / nloc;
        if (old + 1u == (gen + 1u) * nloc) {
            __builtin_amdgcn_fence(__ATOMIC_RELEASE, "agent");
            asm volatile("s_waitcnt vmcnt(0)" ::: "memory");
            const unsigned og = xb_add(&bar[XB_TOP], 1u);
            const unsigned tg = og / nx;
            if (og + 1u == (tg + 1u) * nx) xb_add(&bar[XB_TOPGEN], 1u);
            else XB_SPIN(xb_ld(&bar[XB_TOPGEN]) == tg, bar);
            __builtin_amdgcn_fence(__ATOMIC_ACQUIRE, "agent");
            xb_add(&bar[XB_XGEN(b.x)], 1u);
            asm volatile("s_waitcnt vmcnt(0)" ::: "memory");
        } else {
            XB_SPIN(xb_ld(&bar[XB_XGEN(b.x)]) == gen, bar);
            __builtin_amdgcn_fence(__ATOMIC_ACQUIRE, "agent");
            asm volatile("s_waitcnt vmcnt(0)" ::: "memory");
        }
    }
    __syncthreads();
}

__device__ __forceinline__ void tr_item(const float* W, int N, bf16_t* WT, int Kt, LAS float* scr, int item, int lane) {
    const int nblk = N >> 6, kb = item / nblk, nb = item - kb * nblk, k0 = kb << 6, n0 = nb << 6;
    const int c = lane & 15, rr = lane >> 4;
    f32x4 v[16];
#pragma unroll
    for (int i = 0; i < 16; ++i) v[i] = __builtin_nontemporal_load((const f32x4*)(W + (size_t)(k0 + 4 * i + rr) * N + n0 + 4 * c));
#pragma unroll
    for (int i = 0; i < 16; ++i) { LAS float* s = scr + (4 * i + rr) * 65 + 4 * c; s[0] = v[i][0]; s[1] = v[i][1]; s[2] = v[i][2]; s[3] = v[i][3]; }
    LDS_WAIT();
    const int kc = lane & 7;
#pragma unroll
    for (int jj = 0; jj < 8; ++jj) { const int n = (lane >> 3) + 8 * jj; const LAS float* s = scr + (8 * kc) * 65 + n;
        u32x4 o; o.x = cvt_pk_bf16(s[0], s[65]); o.y = cvt_pk_bf16(s[130], s[195]); o.z = cvt_pk_bf16(s[260], s[325]); o.w = cvt_pk_bf16(s[390], s[455]);
        *(u32x4*)(WT + (size_t)(n0 + n) * Kt + k0 + 8 * kc) = o; }
    LDS_WAIT();
}
__device__ __forceinline__ double sin2pi(double r) {
    r -= rint(r);
    if (r > 0.25) r = 0.5 - r; else if (r < -0.25) r = -0.5 - r;
    const double x = r * 6.283185307179586476925, x2 = x * x;
    double p = -1.0 / 1307674368000.0;
    p = p * x2 + 1.0 / 6227020800.0; p = p * x2 - 1.0 / 39916800.0; p = p * x2 + 1.0 / 362880.0; p = p * x2 - 1.0 / 5040.0;
    p = p * x2 + 1.0 / 120.0; p = p * x2 - 1.0 / 6.0; p = p * x2 + 1.0;
    return x * p;
}

struct Args { const float* in[14]; float* out; unsigned char* ws; float freq[128]; float l2g[8]; float g256[8]; int ph_lo, ph_hi; };

__device__ __forceinline__ void p_prologue(const Args& a, LAS unsigned char* lds, const int wave) {
    const int lane = lane_id(), tid = wave * 64 + lane;
    unsigned char* ws = a.ws;
    LAS float* scr = (LAS float*)(lds + wave * 16640);
    const int gw = blockIdx.x * 8 + wave, NGW = gridDim.x * 8;
    constexpr int I_RI = (DM / 64) * (RPROJ / 64);
    for (int it = gw; it < I_RI; it += NGW) tr_item(a.in[3], RPROJ, (bf16_t*)(ws + WS_WT_RI), DM, scr, it, lane);
    const float* x = a.in[0]; const float* gain = a.in[2]; bf16_t* xn = (bf16_t*)(ws + WS_XN0);
    for (int m = gw; m < SEQ; m += NGW) {
        const f32x4* xr = (const f32x4*)(x + (size_t)m * DM) + 2 * lane; f32x4 v[8]; float s = 0.f;
#pragma unroll
        for (int j = 0; j < 8; ++j) { v[j] = __builtin_nontemporal_load(xr + 128 * (j >> 1) + (j & 1)); s += (v[j][0] * v[j][0] + v[j][1] * v[j][1]) + (v[j][2] * v[j][2] + v[j][3] * v[j][3]); }
        const float rstd = __builtin_amdgcn_rsqf(wave_sum(s) * (1.0f / DM) + NORM_EPS);
        u32x4* o = (u32x4*)(xn + (size_t)m * DM) + lane;
#pragma unroll
        for (int j = 0; j < 4; ++j) { const f32x4 g0 = *((const f32x4*)gain + 2 * lane + 128 * j), g1 = *((const f32x4*)gain + 2 * lane + 128 * j + 1); o[64 * j] = pack8(v[2 * j] * rstd * g0, v[2 * j + 1] * rstd * g1); }
    }
    const int gt = blockIdx.x * 512 + tid, NGT = gridDim.x * 512;
    { const float* p = a.in[1]; bf16_t* pb = (bf16_t*)(ws + WS_PBF);
      for (int i = gt; i < 2 * SEQ * PLE / 8; i += NGT) { const f32x4 a0 = __builtin_nontemporal_load((const f32x4*)(p + (size_t)i * 8)), a1 = __builtin_nontemporal_load((const f32x4*)(p + (size_t)i * 8 + 4)); *(u32x4*)(pb + (size_t)i * 8) = pack8(a0, a1); } }
    { f32x4* rope = (f32x4*)(ws + WS_ROPE);
      for (int i = gt; i < SEQ * 64; i += NGT) { const int pos = i >> 6, fi = (i & 63) * 2; const float a0 = (float)pos * a.freq[fi], a1 = (float)pos * a.freq[fi + 1];
          const double r0 = (double)a0 * 0.15915494309189533577, r1 = (double)a1 * 0.15915494309189533577;
          rope[i] = (f32x4){(float)sin2pi(r0 + 0.25), (float)sin2pi(r0), (float)sin2pi(r1 + 0.25), (float)sin2pi(r1)}; } }
}
struct CvDesc { const float* src; bf16_t* dst; const float* kg; int N, Kt, plain; };
constexpr int CV_RO = (PW / 64) * (DM / 32), CV_G = (DM / 64) * (DM / 32), CV_P = (PLE / 64) * (DM / 32), CV_PIG = (DM / 64) * (PW / 32), CV_GR = (1024 / 64) * (1024 / 32), CV_WU = DM * PW / 2048;
constexpr int CV_ITEMS = CV_RO + 2 * CV_G + 2 * CV_P + CV_PIG + 4 * CV_GR + CV_RO + CV_WU;
__device__ __forceinline__ CvDesc cv_tr(const float* W, int N, int ncols, bf16_t* WT, int Kt, int r, const float* kg = nullptr) {
    const int nblk = ncols >> 5, kb = r / nblk, nb = r - kb * nblk; CvDesc d; d.src = W + (size_t)(kb * 64) * N + nb * 32; d.dst = WT + (size_t)(nb * 32) * Kt + kb * 64; d.kg = kg ? kg + kb * 64 : nullptr; d.N = N; d.Kt = Kt; d.plain = 0; return d; }
__device__ __forceinline__ CvDesc cv_decode(const Args& a, int r) {
    unsigned char* ws = a.ws;
    if (r < CV_RO) return cv_tr(a.in[4], DM, DM, (bf16_t*)(ws + WS_WT_RO), PW, r); r -= CV_RO;
    if (r < CV_G) return cv_tr(a.in[11], DM, DM, (bf16_t*)(ws + WS_WT_G0), DM, r, a.in[10]); r -= CV_G;
    if (r < CV_G) return cv_tr(a.in[11] + (size_t)DM * DM, DM, DM, (bf16_t*)(ws + WS_WT_G1), DM, r, a.in[10] + DM); r -= CV_G;
    if (r < CV_P) return cv_tr(a.in[12], DM, DM, (bf16_t*)(ws + WS_WT_P0), PLE, r); r -= CV_P;
    if (r < CV_P) return cv_tr(a.in[12] + (size_t)PLE * DM, DM, DM, (bf16_t*)(ws + WS_WT_P1), PLE, r); r -= CV_P;
    if (r < CV_PIG) return cv_tr(a.in[6] + PW, 2 * PW, PW, (bf16_t*)(ws + WS_WT_PI) + (size_t)PW * DM, DM, r, a.in[5]); r -= CV_PIG;
    if (r < 4 * CV_GR) { const int g = r / CV_GR; return cv_tr(a.in[7] + (size_t)g * 1024 * 1024, 1024, 1024, (bf16_t*)(ws + WS_WT_GR) + (size_t)g * 1024 * 1024, 1024, r - g * CV_GR); } r -= 4 * CV_GR;
    if (r < CV_RO) return cv_tr(a.in[9], DM, DM, (bf16_t*)(ws + WS_WT_PO), PW, r); r -= CV_RO;
    CvDesc d; const int row = r >> 1, c0 = (r & 1) * 2048; d.src = a.in[6] + (size_t)row * (2 * PW) + c0; d.dst = (bf16_t*)(ws + WS_WU) + (size_t)row * PW + c0; d.kg = a.in[5] + row; d.N = 0; d.Kt = 0; d.plain = 1; return d;
}
__device__ __forceinline__ void cv_load(const CvDesc& d, f32x4 (&cv)[8], int lane) {
    if (d.plain) {
#pragma unroll
        for (int j = 0; j < 4; ++j) { cv[2 * j] = __builtin_nontemporal_load((const f32x4*)(d.src + lane * 8 + 512 * j)); cv[2 * j + 1] = __builtin_nontemporal_load((const f32x4*)(d.src + lane * 8 + 512 * j + 4)); }
    } else {
#pragma unroll
        for (int i = 0; i < 8; ++i) cv[i] = __builtin_nontemporal_load((const f32x4*)(d.src + (size_t)(8 * i + (lane >> 3)) * d.N + 4 * (lane & 7)));
    }
}
__device__ __forceinline__ void cv_store(const CvDesc& d, const f32x4 (&cv)[8], LAS float* scr, int lane) {
    if (d.plain) {
        const float kgv = d.kg[0];
#pragma unroll
        for (int j = 0; j < 4; ++j) *(u32x4*)(d.dst + lane * 8 + 512 * j) = pack8(cv[2 * j] * kgv, cv[2 * j + 1] * kgv);
    } else {
#pragma unroll
        for (int i = 0; i < 8; ++i) { const float kgv = d.kg ? d.kg[8 * i + (lane >> 3)] : 1.0f; LAS float* s = scr + (8 * i + (lane >> 3)) * 33 + 4 * (lane & 7); s[0] = cv[i][0] * kgv; s[1] = cv[i][1] * kgv; s[2] = cv[i][2] * kgv; s[3] = cv[i][3] * kgv; }
        LDS_WAIT();
        const int kc = lane & 7;
#pragma unroll
        for (int j = 0; j < 4; ++j) { const int n = (lane >> 3) + 8 * j; const LAS float* s = scr + (8 * kc) * 33 + n;
            u32x4 o; o.x = cvt_pk_bf16(s[0], s[33]); o.y = cvt_pk_bf16(s[66], s[99]); o.z = cvt_pk_bf16(s[132], s[165]); o.w = cvt_pk_bf16(s[198], s[231]);
            *(u32x4*)(d.dst + (size_t)n * d.Kt + 8 * kc) = o; }
        LDS_WAIT();
    }
}

__device__ __forceinline__ void tr_item_g(const float* W, int N, int ncols, bf16_t* WT, int Kt, LAS float* scr, int item, int lane, const float* kg) {
    const int nblk = ncols >> 6, kb = item / nblk, nb = item - kb * nblk, k0 = kb << 6, n0 = nb << 6;
    const int c = lane & 15, rr = lane >> 4;
    f32x4 v[16];
#pragma unroll
    for (int i = 0; i < 16; ++i) v[i] = __builtin_nontemporal_load((const f32x4*)(W + (size_t)(k0 + 4 * i + rr) * N + n0 + 4 * c));
#pragma unroll
    for (int i = 0; i < 16; ++i) { const float g = kg ? kg[k0 + 4 * i + rr] : 1.0f; LAS float* s = scr + (4 * i + rr) * 65 + 4 * c; s[0] = v[i][0] * g; s[1] = v[i][1] * g; s[2] = v[i][2] * g; s[3] = v[i][3] * g; }
    LDS_WAIT();
    const int kc = lane & 7;
#pragma unroll
    for (int jj = 0; jj < 8; ++jj) { const int n = (lane >> 3) + 8 * jj; const LAS float* s = scr + (8 * kc) * 65 + n;
        u32x4 o; o.x = cvt_pk_bf16(s[0], s[65]); o.y = cvt_pk_bf16(s[130], s[195]); o.z = cvt_pk_bf16(s[260], s[325]); o.w = cvt_pk_bf16(s[390], s[455]);
        __builtin_nontemporal_store(o, (u32x4*)(WT + (size_t)(n0 + n) * Kt + k0 + 8 * kc)); }
    LDS_WAIT();
}
__device__ __forceinline__ void p_weights_big(const Args& a, LAS unsigned char* lds, const int wave) {
    const int lane = lane_id();
    unsigned char* ws = a.ws;
    LAS float* scr = (LAS float*)(lds + wave * 16640);
    const int gw = (blockIdx.x - 128) * 8 + wave, NGW = (gridDim.x - 128) * 8;
    constexpr int I_RO = (PW / 64) * (DM / 64), I_G = (DM / 64) * (DM / 64), I_P = (PLE / 64) * (DM / 64), I_PIG = (DM / 64) * (PW / 64), I_GR = (1024 / 64) * (1024 / 64), I_WU = DM * PW / 2048;
    for (int it = gw; it < I_RO + 2 * I_G + 2 * I_P + I_PIG + 4 * I_GR + I_RO + I_WU; it += NGW) {
        int r = it;
        if (r < I_RO) { tr_item_g(a.in[4], DM, DM, (bf16_t*)(ws + WS_WT_RO), PW, scr, r, lane, nullptr); continue; } r -= I_RO;
        if (r < I_G) { tr_item_g(a.in[11], DM, DM, (bf16_t*)(ws + WS_WT_G0), DM, scr, r, lane, a.in[10]); continue; } r -= I_G;
        if (r < I_G) { tr_item_g(a.in[11] + (size_t)DM * DM, DM, DM, (bf16_t*)(ws + WS_WT_G1), DM, scr, r, lane, a.in[10] + DM); continue; } r -= I_G;
        if (r < I_P) { tr_item_g(a.in[12], DM, DM, (bf16_t*)(ws + WS_WT_P0), PLE, scr, r, lane, nullptr); continue; } r -= I_P;
        if (r < I_P) { tr_item_g(a.in[12] + (size_t)PLE * DM, DM, DM, (bf16_t*)(ws + WS_WT_P1), PLE, scr, r, lane, nullptr); continue; } r -= I_P;
        if (r < I_PIG) { tr_item_g(a.in[6] + PW, 2 * PW, PW, (bf16_t*)(ws + WS_WT_PI) + (size_t)PW * DM, DM, scr, r, lane, a.in[5]); continue; } r -= I_PIG;
        if (r < 4 * I_GR) { const int g = r / I_GR; tr_item_g(a.in[7] + (size_t)g * 1024 * 1024, 1024, 1024, (bf16_t*)(ws + WS_WT_GR) + (size_t)g * 1024 * 1024, 1024, scr, r - g * I_GR, lane, nullptr); continue; } r -= 4 * I_GR;
        if (r < I_RO) { tr_item_g(a.in[9], DM, DM, (bf16_t*)(ws + WS_WT_PO), PW, scr, r, lane, nullptr); continue; } r -= I_RO;
        { const int row = r >> 1, c0 = (r & 1) * 2048 + lane * 8; const float* srcp = a.in[6] + (size_t)row * (2 * PW) + c0; bf16_t* dstp = (bf16_t*)(ws + WS_WU) + (size_t)row * PW + c0; const float g = a.in[5][row];
#pragma unroll
            for (int j = 0; j < 4; ++j) { const f32x4 x0 = __builtin_nontemporal_load((const f32x4*)(srcp + 512 * j)), x1 = __builtin_nontemporal_load((const f32x4*)(srcp + 512 * j + 4)); __builtin_nontemporal_store(pack8(x0 * g, x1 * g), (u32x4*)(dstp + 512 * j)); } }
    }
}

__device__ __forceinline__ bf16x8 tr_frag(const LAS unsigned char* p, int pitch16) {
    const s16x4 lo = __builtin_amdgcn_ds_read_tr16_b64_v4i16((LAS s16x4*)p), hi = __builtin_amdgcn_ds_read_tr16_b64_v4i16((LAS s16x4*)(p + pitch16));
    return (bf16x8){lo[0], lo[1], lo[2], lo[3], hi[0], hi[1], hi[2], hi[3]};
}

__device__ __forceinline__ void p_scan(const Args& a, LAS unsigned char* lds, const int w) {
    const int lane = lane_id();
    const int tid = w * 64 + lane, b = blockIdx.x, h = b & 7, tt = b >> 3, dt = tt >> 2, vt = tt & 3;
    const int db = w >> 1, vbp = w & 1, g = lane >> 4, i16 = lane & 15, q4 = i16 >> 2, p4 = i16 & 3;
    const float g256 = a.g256[h];
    constexpr int PK = 160, PV = 288, TK = 128 * PK, TV = 128 * PV, BUF = TK + TV;
    const bf16_t* kbase = (const bf16_t*)(a.ws + WS_KD) + h * 256 + dt * 64;
    const bf16_t* vbase = (const bf16_t*)(a.ws + WS_V) + h * 512 + vt * 128;
    bf16_t* st = (bf16_t*)(a.ws + WS_ST);
    u32x4 rk0[2], rv0[4], rk1[2], rv1[4], rk2[2], rv2[4], rk3[2], rv3[4];
#define P2_LOAD(RK, RV, hs) do { const int _hs = (hs) < 62 ? (hs) : 61; \
        _Pragma("unroll") for (int _i = 0; _i < 2; ++_i) { const int _p = tid + 512 * _i; RK[_i] = *(const u32x4*)(kbase + (size_t)(_hs * 128 + (_p >> 3)) * DM + (_p & 7) * 8); } \
        _Pragma("unroll") for (int _i = 0; _i < 4; ++_i) { const int _p = tid + 512 * _i; RV[_i] = *(const u32x4*)(vbase + (size_t)(_hs * 128 + (_p >> 4)) * PW + (_p & 15) * 8); } } while (0)
#define P2_STORE(RK, RV, s) do { \
        _Pragma("unroll") for (int _i = 0; _i < 2; ++_i) { const int _p = tid + 512 * _i; *(LAS u32x4*)(lds + (s) * BUF + (_p >> 3) * PK + (_p & 7) * 16) = RK[_i]; } \
        _Pragma("unroll") for (int _i = 0; _i < 4; ++_i) { const int _p = tid + 512 * _i; *(LAS u32x4*)(lds + (s) * BUF + TK + (_p >> 4) * PV + (_p & 15) * 16) = RV[_i]; } } while (0)
    f32x4 acc[4];
#pragma unroll
    for (int j = 0; j < 4; ++j) acc[j] = (f32x4){0.f, 0.f, 0.f, 0.f};
    const int lk = (4 * g + q4) * PK + 8 * p4 + db * 32, lv = (4 * g + q4) * PV + 16 * p4 + vbp * 128;
#define P2_STEP(hs, RKN, RVN) do { const int _h = (hs); if (_h < 62) { \
        const LAS unsigned char* kt = lds + (_h & 1) * BUF + lk; const LAS unsigned char* vtp = lds + (_h & 1) * BUF + TK + lv; \
        _Pragma("unroll") for (int ks = 0; ks < 4; ++ks) { \
            const bf16x8 kf = tr_frag(kt + ks * 32 * PK, 16 * PK); \
            _Pragma("unroll") for (int j = 0; j < 4; ++j) { const bf16x8 vf = tr_frag(vtp + ks * 32 * PV + 64 * (j >> 1) + 8 * (j & 1), 16 * PV); acc[j] = __builtin_amdgcn_mfma_f32_16x16x32_bf16(vf, kf, acc[j], 0, 0, 0); } } \
        if (_h & 1) { const int n = _h >> 1; \
            bf16_t* o = st + ((size_t)(n * 8 + h) * 256 + dt * 64 + db * 16 + i16) * 512 + vt * 128 + vbp * 64 + 8 * g; \
            _Pragma("unroll") for (int j = 0; j < 4; ++j) acc[j] *= g256; \
            _Pragma("unroll") for (int k = 0; k < 2; ++k) *(u32x4*)(o + 32 * k) = pack8(acc[2 * k], acc[2 * k + 1]); } \
        if (_h + 1 < 62) { P2_STORE(RKN, RVN, (_h + 1) & 1); P2_LOAD(RKN, RVN, _h + 5); } \
        __syncthreads(); } } while (0)
    P2_LOAD(rk0, rv0, 0); P2_LOAD(rk1, rv1, 1); P2_LOAD(rk2, rv2, 2); P2_LOAD(rk3, rv3, 3);
    P2_STORE(rk0, rv0, 0); P2_LOAD(rk0, rv0, 4); __syncthreads();
    for (int hs = 0; hs < 62; hs += 4) {
        P2_STEP(hs, rk1, rv1); P2_STEP(hs + 1, rk2, rv2); P2_STEP(hs + 2, rk3, rv3); P2_STEP(hs + 3, rk0, rv0);
    }
#undef P2_STEP
#undef P2_LOAD
#undef P2_STORE
}

__device__ __forceinline__ void p_retention(const Args& a, LAS unsigned char* lds, const int w) {
    const int lane = lane_id();
    const int tid = w * 64 + lane, b = blockIdx.x;
    const int g = lane >> 4, i16 = lane & 15, q4 = i16 >> 2, p4 = i16 & 3;
    constexpr int PP = 528, RINGO = 128 * PP, RB = 33792, ST1 = RINGO + 2 * RB, ST2 = ST1 + 8192;
    const bf16_t* qd = (const bf16_t*)(a.ws + WS_QD); const bf16_t* kd = (const bf16_t*)(a.ws + WS_KD); const bf16_t* v = (const bf16_t*)(a.ws + WS_V);
    const bf16_t* sg = (const bf16_t*)(a.ws + WS_SG); const bf16_t* st = (const bf16_t*)(a.ws + WS_ST); bf16_t* z = (bf16_t*)(a.ws + WS_Z);
    const unsigned offk = (unsigned)(((tid >> 5) * DM + (tid & 31) * 8) * 2), offv = (unsigned)(((tid >> 6) * PW + (tid & 63) * 8) * 2), offt = (unsigned)(((tid >> 6) * 512 + (tid & 63) * 8) * 2);
    const int xs = b & 7, kq = b >> 3, pair = kq >> 1, member = kq & 1;
    for (int rnd = 0; rnd < 2; ++rnd) {
        const int nh = (pair * 2 + rnd) * 8 + xs, n = nh >> 3, h = nh & 7, hf = member ^ rnd;
        const int nsb = 2 * (hf + 1), nvb = 4 * (hf + 1), ntb = n > 0 ? 8 : 0, nblk = nsb + nvb + ntb;
        const int rowbase = 256 * n + 128 * hf;
        u32x4 ra[4], rb[4];
#define P3_LOAD(R, it) do { const int _it = (it) < nblk ? (it) : nblk - 1; \
        if (_it < ntb) { const char* _b = (const char*)(st + ((size_t)((n - 1) * 8 + h) * 256 + 32 * _it) * 512); unsigned _o = offt; asm volatile("" : "+v"(_o)); \
            _Pragma("unroll") for (int _i = 0; _i < 4; ++_i) R[_i] = *(const u32x4*)(_b + (size_t)_i * (8 * 512 * 2) + _o); } \
        else if (_it < ntb + nsb) { const char* _b = (const char*)(kd + (size_t)(256 * n + 64 * (_it - ntb)) * DM + h * 256); unsigned _o = offk; asm volatile("" : "+v"(_o)); \
            _Pragma("unroll") for (int _i = 0; _i < 4; ++_i) R[_i] = *(const u32x4*)(_b + (size_t)_i * (16 * DM * 2) + _o); } \
        else { const char* _b = (const char*)(v + (size_t)(256 * n + 32 * (_it - ntb - nsb)) * PW + h * 512); unsigned _o = offv; asm volatile("" : "+v"(_o)); \
            _Pragma("unroll") for (int _i = 0; _i < 4; ++_i) R[_i] = *(const u32x4*)(_b + (size_t)_i * (8 * PW * 2) + _o); } } while (0)
#define P3_STORE(R, it) do { const int _it = (it); if (_it < nblk) { LAS unsigned char* _d = lds + RINGO + (_it & 1) * RB; \
        if (_it >= ntb && _it < ntb + nsb) { _Pragma("unroll") for (int _i = 0; _i < 4; ++_i) { const int _p = tid + 512 * _i; *(LAS u32x4*)(_d + (_p >> 5) * 528 + (_p & 31) * 16) = R[_i]; } } \
        else { _Pragma("unroll") for (int _i = 0; _i < 4; ++_i) { const int _p = tid + 512 * _i; *(LAS u32x4*)(_d + (_p >> 6) * 1056 + (_p & 63) * 16) = R[_i]; } } } } while (0)
        P3_LOAD(ra, 0); P3_LOAD(rb, 1);
        if (ntb) {
#pragma unroll 2
            for (int i = 0; i < 8; ++i) { const int p = tid + 512 * i, row = p >> 5, c = p & 31, G = c >> 2, cc = c & 3;
                const u32x4 x = __builtin_nontemporal_load((const u32x4*)(qd + (size_t)(rowbase + row) * DM + h * 256 + c * 8));
                const int s = cc >> 1, glo = (2 * cc) & 3, ghi = (2 * cc + 1) & 3;
                LAS unsigned char* d = lds + row * PP + 64 * G;
                *(LAS u32x2*)(d + 8 * (2 * glo + s)) = (u32x2){x.x, x.y}; *(LAS u32x2*)(d + 8 * (2 * ghi + s)) = (u32x2){x.z, x.w}; }
        }
        P3_STORE(ra, 0); P3_LOAD(ra, 2); __syncthreads();
        f32x4 acc[8][4];
#pragma unroll
        for (int rbk = 0; rbk < 8; ++rbk)
#pragma unroll
            for (int cb = 0; cb < 4; ++cb) acc[rbk][cb] = (f32x4){0.f, 0.f, 0.f, 0.f};
#define P3_YSTEP(it_, RN, ISV) do { const int it = (it_); \
            const LAS unsigned char* ring = lds + RINGO + (it & 1) * RB; \
            { const int kk = (ISV) ? it - ntb - nsb : it; \
                bf16x8 vf[4]; \
                _Pragma("unroll") for (int cb = 0; cb < 4; ++cb) vf[cb] = tr_frag(ring + (4 * g + q4) * 1056 + (64 * w + 32 * (cb >> 1) + 8 * p4 + 4 * (cb & 1)) * 2, 16 * 1056);   \
                _Pragma("unroll") for (int rbk = 0; rbk < 8; ++rbk) { \
                    if ((ISV) && 32 * kk > 128 * hf + 16 * rbk + 15) continue; \
                    const bf16x8 pf = *(const LAS bf16x8*)(lds + (16 * rbk + i16) * PP + (32 * kk + 8 * g) * 2); \
                    _Pragma("unroll") for (int cb = 0; cb < 4; ++cb) acc[rbk][cb] = __builtin_amdgcn_mfma_f32_16x16x32_bf16(vf[cb], pf, acc[rbk][cb], 0, 0, 0); \
                } } \
            P3_STORE(RN, it + 1); P3_LOAD(RN, it + 3); \
            __syncthreads(); } while (0)
        for (int it2 = 0; it2 < ntb; it2 += 2) { P3_YSTEP(it2, rb, false); P3_YSTEP(it2 + 1, ra, false); }
        {
            bf16x8 qf[8];
#pragma unroll
            for (int ds = 0; ds < 8; ++ds) qf[ds] = *(const bf16x8*)(qd + (size_t)(rowbase + 16 * w + i16) * DM + h * 256 + 32 * ds + 8 * g);
#define P3_SSTEP(it_, RN) do { const int it = (it_), sbk = it - ntb; \
                const LAS unsigned char* ring = lds + RINGO + (it & 1) * RB; \
                _Pragma("unroll") for (int sb = 0; sb < 4; ++sb) { \
                    const int j0 = 64 * sbk + 16 * sb, i0 = 128 * hf + 16 * w; \
                    LAS unsigned char* dst = lds + (16 * w + i16) * PP + (32 * (2 * sbk + (sb >> 1)) + 8 * g + 4 * (sb & 1)) * 2; \
                    if (j0 > i0) { *(LAS u32x2*)dst = (u32x2){0u, 0u}; } \
                    else { \
                        f32x4 s4 = {0.f, 0.f, 0.f, 0.f}; \
                        _Pragma("unroll") for (int ds = 0; ds < 8; ++ds) { const bf16x8 kf = *(const LAS bf16x8*)(ring + (16 * sb + i16) * 528 + (32 * ds + 8 * g) * 2); \
                            s4 = __builtin_amdgcn_mfma_f32_16x16x32_bf16(kf, qf[ds], s4, 0, 0, 0); } \
                        if (j0 == i0) { _Pragma("unroll") for (int r = 0; r < 4; ++r) if (4 * g + r > i16) s4[r] = 0.f; } \
                        u32x2 wv; wv.x = cvt_pk_bf16(s4[0], s4[1]); wv.y = cvt_pk_bf16(s4[2], s4[3]); *(LAS u32x2*)dst = wv; \
                    } \
                } \
                P3_STORE(RN, it + 1); P3_LOAD(RN, it + 3); \
                __syncthreads(); } while (0)
            for (int it2 = ntb; it2 < ntb + nsb; it2 += 2) { P3_SSTEP(it2, rb); P3_SSTEP(it2 + 1, ra); }
#undef P3_SSTEP
        }
        for (int it2 = ntb + nsb; it2 < nblk; it2 += 2) { P3_YSTEP(it2, rb, true); P3_YSTEP(it2 + 1, ra, true); }
#undef P3_YSTEP
#undef P3_LOAD
#undef P3_STORE
        LAS f32x2* S1 = (LAS f32x2*)(lds + ST1); LAS f32x2* S2 = (LAS f32x2*)(lds + ST2);
#pragma unroll
        for (int rbk = 0; rbk < 8; ++rbk) { float s1 = 0.f, s2 = 0.f;
#pragma unroll
            for (int cb = 0; cb < 4; ++cb) { const f32x4 y = acc[rbk][cb]; s1 += (y[0] + y[1]) + (y[2] + y[3]); s2 += (y[0] * y[0] + y[1] * y[1]) + (y[2] * y[2] + y[3] * y[3]); }
            s1 += __shfl_xor(s1, 16); s1 += __shfl_xor(s1, 32); s2 += __shfl_xor(s2, 16); s2 += __shfl_xor(s2, 32);
            if (g == 0) S1[(16 * rbk + i16) * 8 + w] = (f32x2){s1, s2}; }
        __syncthreads();
        if (tid < 128) { float s1 = 0.f, s2 = 0.f;
#pragma unroll
            for (int k = 0; k < 8; ++k) { const f32x2 t = S1[tid * 8 + k]; s1 += t.x; s2 += t.y; }
            const float mean = s1 * (1.0f / 512.0f), var = s2 * (1.0f / 512.0f) - mean * mean;
            S2[tid] = (f32x2){mean, __builtin_amdgcn_rsqf(fmaxf(var, 0.f) + GN_EPS)}; }
        __syncthreads();
#pragma unroll
        for (int rbk = 0; rbk < 8; ++rbk) { const f32x2 ms = S2[16 * rbk + i16];
            const size_t off = (size_t)(rowbase + 16 * rbk + i16) * PW + h * 512 + 64 * w + 8 * g;
#pragma unroll
            for (int k = 0; k < 2; ++k) { const u32x4 gw = __builtin_nontemporal_load((const u32x4*)(sg + off + 32 * k)); f32x4 g0, g1; unpack8(gw, g0, g1);
                const f32x4 y0 = (acc[rbk][2 * k] - ms.x) * ms.y * g0, y1 = (acc[rbk][2 * k + 1] - ms.x) * ms.y * g1;
                *(u32x4*)(z + off + 32 * k) = pack8(y0, y1); } }
        __syncthreads();
    }
}

template <int W> __device__ __forceinline__ void pool_run(const bf16_t* uc, const bf16_t* gc, bf16_t* dc, int t0) {
    u32x4 ring[W]; f32x4 s0 = {0.f, 0.f, 0.f, 0.f}, s1 = {0.f, 0.f, 0.f, 0.f};
#pragma unroll
    for (int k = 0; k < W; ++k) { const int t = t0 - W + k; ring[k] = t >= 0 ? *(const u32x4*)(uc + (size_t)t * PW) : (u32x4){0u, 0u, 0u, 0u}; f32x4 x0, x1; unpack8(ring[k], x0, x1); s0 += x0; s1 += x1; }
    for (int tb = t0; tb < t0 + 32; tb += W) {
        u32x4 xr[W], gr[W];
#pragma unroll
        for (int k = 0; k < W; ++k) { xr[k] = __builtin_nontemporal_load((const u32x4*)(uc + (size_t)(tb + k) * PW)); gr[k] = __builtin_nontemporal_load((const u32x4*)(gc + (size_t)(tb + k) * PW)); }
#pragma unroll
        for (int k = 0; k < W; ++k) { const int t = tb + k;
            f32x4 x0, x1, y0, y1, g0, g1; unpack8(xr[k], x0, x1); unpack8(ring[k], y0, y1); unpack8(gr[k], g0, g1);
            s0 += x0 - y0; s1 += x1 - y1; ring[k] = xr[k];
            const float inv = 1.0f / (float)(t + 1 < W ? t + 1 : W);
            *(u32x4*)(dc + (size_t)t * PW) = pack8((s0 * inv - x0) * g0, (s1 * inv - x1) * g1); }
    }
}
__device__ __forceinline__ void p_pool(const Args& a, const int wave) {
    const int tid = wave * 64 + lane_id();
    const bf16_t* u = (const bf16_t*)(a.ws + WS_U); const bf16_t* sg = (const bf16_t*)(a.ws + WS_SG1); bf16_t* d = (bf16_t*)(a.ws + WS_ZZ);
    for (int task = blockIdx.x * 512 + tid; task < 512 * 256; task += gridDim.x * 512) {
        const int chunk = task & 511, run = task >> 9, grp = chunk >> 7, t0 = run * 32;
        const bf16_t* uc = u + chunk * 8; const bf16_t* gc = sg + chunk * 8; bf16_t* dc = d + chunk * 8;
        if (grp == 0) pool_run<2>(uc, gc, dc, t0); else if (grp == 1) pool_run<4>(uc, gc, dc, t0); else if (grp == 2) pool_run<8>(uc, gc, dc, t0); else pool_run<16>(uc, gc, dc, t0);
    }
}
__device__ __forceinline__ void p_final(const Args& a, const int wave) {
    const int lane = lane_id();
    const float* rp = (const float*)(a.ws + WS_RP + 3 * MiB); const float* gain = a.in[13]; float* out = a.out;
    for (int m = blockIdx.x * 8 + wave; m < SEQ; m += gridDim.x * 8) {
        const float part = lane < 32 ? rp[(size_t)m * 32 + lane] : 0.f;
        const float rstd = __builtin_amdgcn_rsqf(wave_sum(part) * (1.0f / DM) + NORM_EPS);
        f32x4* o = (f32x4*)(out + (size_t)m * DM) + lane;
#pragma unroll
        for (int j = 0; j < 8; ++j) { const f32x4 g = *((const f32x4*)gain + lane + 64 * j); o[64 * j] = o[64 * j] * rstd * g; }
    }
}

__global__ void __launch_bounds__(512, 2) trunk_fwd(Args args) {
    extern __shared__ __attribute__((aligned(16))) unsigned char lds_raw[];
    LAS unsigned char* lds = (LAS unsigned char*)lds_raw;
    const int wave = __builtin_amdgcn_readfirstlane(threadIdx.x >> 6);
    unsigned char* ws = args.ws;
    volatile LAS unsigned* MISC = (volatile LAS unsigned*)(lds + MISC_OFF);
    if (threadIdx.x < 64) MISC[threadIdx.x] = 0u;
    __syncthreads();
    XcdBarrier bar; bar.bar = (unsigned*)(ws + WS_CTL) + 4096; bar.x = 0; bar.st = nullptr;
    const int lo = args.ph_lo, hi = args.ph_hi;
    if (hi - lo > 1) bar = xcd_barrier_post((unsigned*)(ws + WS_CTL) + 4096, MISC + 8, wave);
#ifndef PH_MASK
#define PH_MASK 0x3FF
#endif
#define IN(k) (((PH_MASK >> (k)) & 1) && lo <= (k) && (k) < hi)
#define SEAM(k) do { if (IN(k) && IN((k) + 1)) xcd_barrier(bar, wave); } while (0)
#ifndef DUP_MASK
#define DUP_MASK 0
#endif
#define NDUP(k) (((DUP_MASK >> (k)) & 1) ? 2 : 1)
    const int G = gridDim.x, c = blockIdx.x;
    float* rp0 = (float*)(ws + WS_RP); float* rp1 = rp0 + SEQ * 32; float* rp2 = rp1 + SEQ * 32; float* rp3 = rp2 + SEQ * 32;

    if (IN(0)) for (int rep_ = 0; rep_ < NDUP(0); ++rep_) { if (rep_) xcd_barrier(bar, wave); p_prologue(args, lds, wave); VM_WAIT(); __syncthreads(); }
    SEAM(0);
    if (IN(1)) for (int rep_ = 0; rep_ < NDUP(1); ++rep_) { if (rep_) xcd_barrier(bar, wave);
        pg8::Gemm g{(const bf16_t*)(ws + WS_XN0), (const bf16_t*)(ws + WS_WT_RI), SEQ, RPROJ, DM, DM, DM}; pg8::StaticOrder S; S.init(SEQ, RPROJ, G, c);
        EpiRet1 E{(bf16_t*)(ws + WS_QD), (bf16_t*)(ws + WS_KD), (bf16_t*)(ws + WS_V), (bf16_t*)(ws + WS_SG), (const float*)(ws + WS_ROPE), args.l2g};
        pg8::gemm_phase(lds, g, S, E, wave);
    }
    SEAM(1);
    if (IN(2)) for (int rep_ = 0; rep_ < NDUP(2); ++rep_) { if (rep_) xcd_barrier(bar, wave); if (c < 128) p_scan(args, lds, wave); else p_weights_big(args, lds, wave);
        VM_WAIT(); __syncthreads(); }
    SEAM(2);
    if (IN(3)) for (int rep_ = 0; rep_ < NDUP(3); ++rep_) { if (rep_) xcd_barrier(bar, wave); p_retention(args, lds, wave); }
    SEAM(3);
    if (IN(4)) for (int rep_ = 0; rep_ < NDUP(4); ++rep_) { if (rep_) xcd_barrier(bar, wave);
        { pg8::Gemm g{(const bf16_t*)(ws + WS_Z), (const bf16_t*)(ws + WS_WT_RO), SEQ, DM, PW, PW, PW}; pg8::StaticOrder S; S.init(SEQ, DM, G, c);
          EpiRes<true> E{args.in[0], nullptr, (bf16_t*)(ws + WS_A1), rp0};
          pg8::gemm_phase(lds, g, S, E, wave); }
        { pg8::Gemm g{(const bf16_t*)(ws + WS_PBF), (const bf16_t*)(ws + WS_WT_P0), SEQ, DM, PLE, PLE, PLE}; pg8::UpperHalfOrder S; S.init(SEQ, DM, G, c);
          EpiPlain E{(bf16_t*)(ws + WS_PE0), DM};
          pg8::gemm_phase(lds, g, S, E, wave); }
        { pg8::Gemm g{(const bf16_t*)(ws + WS_WT_GR), (const bf16_t*)(ws + WS_WU), PW, DM, 1024, 1024, PW}; pg8::CombOrder S; S.init(PW, DM, G, c);
          EpiComb E{(bf16_t*)(ws + WS_WT_PI), DM, args.in[8]};
          pg8::gemm_phase(lds, g, S, E, wave); }
    }
    SEAM(4);
    if (IN(5)) for (int rep_ = 0; rep_ < NDUP(5); ++rep_) { if (rep_) xcd_barrier(bar, wave);
        pg8::Gemm g{(const bf16_t*)(ws + WS_A1), (const bf16_t*)(ws + WS_WT_G0), SEQ, DM, DM, DM, DM}; pg8::StaticOrder S; S.init(SEQ, DM, G, c);
        rstd_table(lds, rp0, S, wave * 64 + lane_id());
        EpiPle E{(const bf16_t*)(ws + WS_A1), (const bf16_t*)(ws + WS_PE0), lds, (bf16_t*)(ws + WS_A2), rp1};
        pg8::gemm_phase(lds, g, S, E, wave);
    }
    SEAM(5);
    if (IN(6)) for (int rep_ = 0; rep_ < NDUP(6); ++rep_) { if (rep_) xcd_barrier(bar, wave);
        pg8::Gemm g{(const bf16_t*)(ws + WS_A2), (const bf16_t*)(ws + WS_WT_PI), SEQ, 2 * PW, DM, DM, DM}; pg8::StaticOrder S; S.init(SEQ, 2 * PW, G, c);
        rstd_table(lds, rp1, S, wave * 64 + lane_id());
        EpiPoolIn E{lds, (bf16_t*)(ws + WS_U), (bf16_t*)(ws + WS_SG1)};
        pg8::gemm_phase(lds, g, S, E, wave);
    }
    SEAM(6);
    if (IN(7)) for (int rep_ = 0; rep_ < NDUP(7); ++rep_) { if (rep_) xcd_barrier(bar, wave); p_pool(args, wave); }
    SEAM(7);
    if (IN(8)) for (int rep_ = 0; rep_ < NDUP(8); ++rep_) { if (rep_) xcd_barrier(bar, wave);
        { pg8::Gemm g{(const bf16_t*)(ws + WS_ZZ), (const bf16_t*)(ws + WS_WT_PO), SEQ, DM, PW, PW, PW}; pg8::StaticOrder S; S.init(SEQ, DM, G, c);
          EpiRes<false> E{nullptr, (const bf16_t*)(ws + WS_A2), (bf16_t*)(ws + WS_A3), rp2};
          pg8::gemm_phase(lds, g, S, E, wave); }
        { pg8::Gemm g{(const bf16_t*)(ws + WS_PBF) + (size_t)SEQ * PLE, (const bf16_t*)(ws + WS_WT_P1), SEQ, DM, PLE, PLE, PLE}; pg8::StaticOrder S; S.init(SEQ, DM, G, c);
          EpiPlain E{(bf16_t*)(ws + WS_PE1), DM};
          pg8::gemm_phase(lds, g, S, E, wave); }
    }
    SEAM(8);
    if (IN(9)) for (int rep_ = 0; rep_ < NDUP(9); ++rep_) { if (rep_) xcd_barrier(bar, wave);
        pg8::Gemm g{(const bf16_t*)(ws + WS_A3), (const bf16_t*)(ws + WS_WT_G1), SEQ, DM, DM, DM, DM}; pg8::StaticOrder S; S.init(SEQ, DM, G, c);
        rstd_table(lds, rp2, S, wave * 64 + lane_id());
        EpiPleFinal E{(const bf16_t*)(ws + WS_A3), (const bf16_t*)(ws + WS_PE1), lds, args.out, args.in[13], (unsigned*)(ws + WS_CTL)};
        pg8::gemm_phase(lds, g, S, E, wave);
    }
#undef IN
#undef SEAM
}

extern "C" void kernel_launch(void* const* d_in, const int* in_sizes, int n_in, void* d_out, int out_size, void* d_ws, size_t ws_size, hipStream_t stream) {
    static int grid = 0;
    if (grid == 0) {
        if (n_in != 14 || out_size != SEQ * DM || ws_size < WS_END) { fprintf(stderr, "kernel_launch: unexpected problem: n_in %d out %d ws %zu (need %zu)\n", n_in, out_size, ws_size, (size_t)WS_END); grid = -1; return; }
        int dev = 0, cus = 0, per_cu = 0;
        if (hipGetDevice(&dev) != hipSuccess || hipDeviceGetAttribute(&cus, hipDeviceAttributeMultiprocessorCount, dev) != hipSuccess) { grid = -1; return; }
        if (hipFuncSetAttribute((const void*)trunk_fwd, hipFuncAttributeMaxDynamicSharedMemorySize, LDS_BYTES) != hipSuccess) { fprintf(stderr, "kernel_launch: hipFuncSetAttribute failed\n"); grid = -1; return; }
        if (hipOccupancyMaxActiveBlocksPerMultiprocessor(&per_cu, (const void*)trunk_fwd, 512, LDS_BYTES) != hipSuccess || per_cu < 1) { fprintf(stderr, "kernel_launch: occupancy query says %d\n", per_cu); (void)hipGetLastError(); }
        grid = cus;
        if (grid != 256) fprintf(stderr, "kernel_launch: %d CUs (built for 256)\n", grid);
    }
    if (grid < 0) return;
    (void)hipMemsetAsync((char*)d_ws + WS_CTL, 0, CTL_ZERO_BYTES, stream);
    Args a{};
    for (int i = 0; i < 14; ++i) a.in[i] = (const float*)d_in[i];
    a.out = (float*)d_out; a.ws = (unsigned char*)d_ws;
    for (int i = 0; i < 128; ++i) { const float lin = (float)i * (1.0f / 127.0f); a.freq[i] = (float)pow(10000.0, -(double)lin); }
    for (int h = 0; h < 8; ++h) { const double lg = log2(1.0 - pow(2.0, -5.0 - (double)h)); a.l2g[h] = (float)lg; a.g256[h] = (float)exp2(256.0 * lg); }
    constexpr int NPH = 10;
    if (MK_N_LAUNCHES == 1) {
        a.ph_lo = 0; a.ph_hi = NPH;
        void* kargs[] = {&a};
        const hipError_t le = hipLaunchCooperativeKernel((const void*)trunk_fwd, dim3(grid), dim3(512), kargs, LDS_BYTES, stream);
        if (le != hipSuccess) fprintf(stderr, "kernel_launch: cooperative launch failed: %s (grid %d)\n", hipGetErrorString(le), grid);
    } else {
        for (int ph = 0; ph < NPH; ++ph) { a.ph_lo = ph; a.ph_hi = ph + 1; hipLaunchKernelGGL(trunk_fwd, dim3(grid), dim3(512), LDS_BYTES, stream, a); }
    }
}
```
